# Optimizing an MI355X kernel written in HIP

```python
import math
import jax
import jax.numpy as jnp
from jax import lax
import numpy as np

D_MODEL = 2048
BATCH = 2
SEQ = 4096
DEPTH = 4
DEC_BATCH = 8
DEC_SEQ = 4096
PAST_LEN = 128

N_MIXERS = 4
GRID_W = 64
PLE_DIM = 256
EPS = 1e-6
NEG_INF = -1e30

D_FF = 5632
FFN_CONV = 3

NA_HEADS = 16
NA_HEAD_DIM = D_MODEL // NA_HEADS
NA_WIN_R = 8
NA_WIN_C = 16

SG_CHUNK = 128
SG_WIDTH = D_MODEL
SG_GROUPS = 16
SG_GROUP_DIM = SG_WIDTH // SG_GROUPS

GDN_QK_HEADS = 16
GDN_V_HEADS = 32
GDN_DK = 128
GDN_DV = 128
GDN_CONV = 3
GDN_CHUNK = 64
GDN_QK_WIDTH = GDN_QK_HEADS * GDN_DK
GDN_V_WIDTH = GDN_V_HEADS * GDN_DV
GDN_CONV_WIDTH = 2 * GDN_QK_WIDTH + GDN_V_WIDTH
GDN_IN_WIDTH = GDN_CONV_WIDTH + GDN_V_WIDTH + 4 * GDN_V_HEADS

S5_GROUP_DIM = 16
S5_GROUPS = D_MODEL // S5_GROUP_DIM
S5_STATE = 64
S5_CHUNK = 128

N_NA = len(range(0, DEPTH, N_MIXERS))
N_SG = len(range(1, DEPTH, N_MIXERS))
N_GDN = len(range(2, DEPTH, N_MIXERS))
N_S5 = len(range(3, DEPTH, N_MIXERS))

kernel_name = 'hybrid_bidir_encoder_na_sgu_gdn_s5'


def rmsnorm(x, g):
    xf = x.astype(jnp.float32)
    y = xf * lax.rsqrt(jnp.mean(xf * xf, axis=-1, keepdims=True) + EPS)
    return (y * g.astype(jnp.float32)).astype(x.dtype)


def l2norm(t):
    return t * lax.rsqrt(jnp.sum(t * t, axis=-1, keepdims=True) + EPS)


def dwconv_centred(x, w):
    width = w.shape[0]
    half = width // 2
    seq = x.shape[1]
    xp = jnp.pad(x, ((0, 0), (half, half), (0, 0)))
    return sum(xp[:, k:k + seq] * w[k] for k in range(width))


def neighbourhood_attention(h, w_qkv, w_o, rpb):
    bsz, seq, _ = h.shape
    rows = seq // GRID_W
    win_r = min(NA_WIN_R, rows)
    q, k, v = jnp.split(h @ w_qkv, 3, axis=-1)
    grid = lambda t: t.reshape(bsz, rows, GRID_W, NA_HEADS, NA_HEAD_DIM)
    q, k, v = grid(q) * NA_HEAD_DIM ** -0.5, grid(k), grid(v)
    row_start = np.clip(np.arange(rows) - win_r // 2, 0, rows - win_r)
    cols = np.arange(GRID_W)
    col_start = np.clip(cols - NA_WIN_C // 2, 0, GRID_W - NA_WIN_C)
    col_valid = (cols[None, :] >= col_start[:, None]) & (cols[None, :] < col_start[:, None] + NA_WIN_C)
    dc_idx = np.clip(cols[None, :] - cols[:, None] + NA_WIN_C - 1, 0, 2 * NA_WIN_C - 2)
    bias_c = jnp.where(col_valid, rpb[:, :, dc_idx].astype(jnp.float32), NEG_INF)
    bias_c = jnp.transpose(bias_c, (0, 2, 1, 3))
    dr_idx = row_start[:, None] + np.arange(win_r)[None, :] - np.arange(rows)[:, None] + NA_WIN_R - 1

    def one_row(args):
        q_r, r0, dri = args
        k_w = lax.dynamic_slice_in_dim(k, r0, win_r, axis=1)
        v_w = lax.dynamic_slice_in_dim(v, r0, win_r, axis=1)
        s = jnp.einsum('bqhd,bajhd->bhqaj', q_r, k_w, preferred_element_type=jnp.float32)
        s = s + jnp.take(bias_c, dri, axis=2)
        pr = jax.nn.softmax(s.reshape(bsz, NA_HEADS, GRID_W, win_r * GRID_W), axis=-1).reshape(s.shape)
        return jnp.einsum('bhqaj,bajhd->bqhd', pr.astype(v.dtype), v_w)

    out = lax.map(one_row, (jnp.moveaxis(q, 1, 0), jnp.asarray(row_start, jnp.int32), jnp.asarray(dr_idx, jnp.int32)))
    out = jnp.moveaxis(out, 0, 1).reshape(bsz, seq, D_MODEL)
    return out @ w_o


def spatial_gating(h, w_in, sg_norm, w_s, b_s, w_o):
    bsz, seq, _ = h.shape
    n = seq // SG_CHUNK
    u, v = jnp.split(jax.nn.gelu(h @ w_in), 2, axis=-1)
    v = rmsnorm(v, sg_norm).reshape(bsz, n, SG_CHUNK, SG_GROUPS, SG_GROUP_DIM)
    mixed = jnp.einsum('gts,bnsgc->bntgc', w_s, v) + b_s.T[:, :, None]
    return (u * mixed.reshape(bsz, seq, SG_WIDTH)) @ w_o


def gated_delta_scan(q, k, v, g, beta):
    bsz, seq = q.shape[:2]
    n = seq // GDN_CHUNK
    rep = GDN_V_HEADS // GDN_QK_HEADS
    tri_incl = np.tril(np.ones((GDN_CHUNK, GDN_CHUNK), bool))
    tri_strict = np.tril(np.ones((GDN_CHUNK, GDN_CHUNK), bool), -1)
    eye = jnp.eye(GDN_CHUNK, dtype=jnp.float32)

    def chunks(t):
        return jnp.moveaxis(t.reshape(bsz, n, GDN_CHUNK, *t.shape[2:]), 1, 0)

    def tr(t):
        return jnp.swapaxes(t, -1, -2)

    def step(state, inp):
        qc, kc, vc, gc, bc = inp
        qh = jnp.swapaxes(jnp.repeat(qc, rep, axis=2), 1, 2)
        kh = jnp.swapaxes(jnp.repeat(kc, rep, axis=2), 1, 2)
        vh = jnp.swapaxes(vc, 1, 2)
        gam = jnp.cumsum(jnp.swapaxes(gc, 1, 2), axis=-1)
        bet = jnp.swapaxes(bc, 1, 2)
        decay = jnp.exp(jnp.where(tri_incl, gam[..., :, None] - gam[..., None, :], -jnp.inf))
        m = jnp.where(tri_strict, (kh @ tr(kh)) * decay, 0.0) * bet[..., :, None]
        e_gam = jnp.exp(gam)
        rhs = jnp.concatenate([kh * (bet * e_gam)[..., None], vh * bet[..., None]], axis=-1)
        sol = lax.linalg.triangular_solve(eye + m, rhs, left_side=True, lower=True, unit_diagonal=True)
        w_mat, u_val = sol[..., :GDN_DK], sol[..., GDN_DK:]
        u = u_val - w_mat @ state
        o = (qh * e_gam[..., None]) @ state + ((qh @ tr(kh)) * decay) @ u
        k_dec = kh * jnp.exp(gam[..., -1:] - gam)[..., None]
        new_state = e_gam[..., -1][..., None, None] * state + tr(k_dec) @ u
        return new_state, o

    state0 = jnp.zeros((bsz, GDN_V_HEADS, GDN_DK, GDN_DV), jnp.float32)
    _, o = lax.scan(step, state0, (chunks(q), chunks(k), chunks(v), chunks(g), chunks(beta)))
    return jnp.transpose(o, (1, 0, 3, 2, 4)).reshape(bsz, seq, GDN_V_HEADS, GDN_DV)


def gated_deltanet(h, w_in, conv_w, a_log, dt_bias, out_norm, w_o):
    bsz, seq, _ = h.shape
    proj = h @ w_in
    qkv = jax.nn.silu(dwconv_centred(proj[..., :GDN_CONV_WIDTH], conv_w)).astype(jnp.float32)
    z = proj[..., GDN_CONV_WIDTH:GDN_CONV_WIDTH + GDN_V_WIDTH]
    ab = proj[..., GDN_CONV_WIDTH + GDN_V_WIDTH:].astype(jnp.float32).reshape(bsz, seq, 2, 2, GDN_V_HEADS)
    q = l2norm(qkv[..., :GDN_QK_WIDTH].reshape(bsz, seq, GDN_QK_HEADS, GDN_DK)) * GDN_DK ** -0.5
    k = l2norm(qkv[..., GDN_QK_WIDTH:2 * GDN_QK_WIDTH].reshape(bsz, seq, GDN_QK_HEADS, GDN_DK))
    v = qkv[..., 2 * GDN_QK_WIDTH:].reshape(bsz, seq, GDN_V_HEADS, GDN_DV)
    decay_rate = jnp.exp(a_log.astype(jnp.float32))
    g = -decay_rate * jax.nn.softplus(ab[:, :, :, 0] + dt_bias.astype(jnp.float32))
    beta = jax.nn.sigmoid(ab[:, :, :, 1])
    o_fwd = gated_delta_scan(q, k, v, g[:, :, 0], beta[:, :, 0])
    o_bwd = jnp.flip(gated_delta_scan(jnp.flip(q, 1), jnp.flip(k, 1), jnp.flip(v, 1),
                                      jnp.flip(g[:, :, 1], 1), jnp.flip(beta[:, :, 1], 1)), 1)
    zg = jax.nn.silu(z.astype(jnp.float32).reshape(bsz, seq, GDN_V_HEADS, GDN_DV))
    o = rmsnorm(o_fwd + o_bwd, out_norm) * zg
    return o.reshape(bsz, seq, GDN_V_WIDTH).astype(h.dtype) @ w_o


def s5_direction(u, a_re, a_im, log_dt, b_re, b_im, c_re, c_im):
    bsz, seq = u.shape[:2]
    n = seq // S5_CHUNK
    f32 = jnp.float32
    lam = lax.complex(a_re.astype(f32), a_im.astype(f32))
    dt = jnp.exp(log_dt.astype(f32))[:, None]
    a_bar = jnp.exp(lam * dt)
    b_bar = ((a_bar - 1.0) / lam)[..., None] * lax.complex(b_re.astype(f32), b_im.astype(f32))
    c = lax.complex(c_re.astype(f32), c_im.astype(f32))
    bu = jnp.einsum('gpc,bsgc->bsgp', b_bar, u.astype(jnp.complex64))
    bu = jnp.moveaxis(bu.reshape(bsz, n, S5_CHUNK, S5_GROUPS, S5_STATE), 1, 0)
    a_elems = jnp.broadcast_to(a_bar, (bsz, S5_CHUNK, S5_GROUPS, S5_STATE))
    powers = jnp.exp(lam[None] * dt[None] * jnp.arange(1, S5_CHUNK + 1, dtype=f32)[:, None, None])

    def binop(e1, e2):
        return (e2[0] * e1[0], e2[0] * e1[1] + e2[1])

    def step(x_prev, bu_c):
        _, xs = lax.associative_scan(binop, (a_elems, bu_c), axis=1)
        xs = xs + powers[None] * x_prev[:, None]
        y = jnp.einsum('gcp,blgp->blgc', c, xs).real
        return xs[:, -1], y

    x0 = jnp.zeros((bsz, S5_GROUPS, S5_STATE), jnp.complex64)
    _, ys = lax.scan(step, x0, bu)
    return jnp.moveaxis(ys, 0, 1).reshape(bsz, seq, S5_GROUPS, S5_GROUP_DIM)


def s5_mixer(h, a_re, a_im, log_dt, b_re, b_im, c_re, c_im, d_skip, w_glu):
    bsz, seq, _ = h.shape
    hf = h.astype(jnp.float32)
    u = hf.reshape(bsz, seq, S5_GROUPS, S5_GROUP_DIM)
    y_f = s5_direction(u, a_re[0], a_im[0], log_dt[0], b_re[0], b_im[0], c_re[0], c_im[0])
    y_b = jnp.flip(s5_direction(jnp.flip(u, 1), a_re[1], a_im[1], log_dt[1], b_re[1], b_im[1], c_re[1], c_im[1]), 1)
    y = (y_f + y_b).reshape(bsz, seq, D_MODEL) + d_skip * hf
    y = jax.nn.gelu(y).astype(h.dtype)
    a, b = jnp.split(y @ w_glu, 2, axis=-1)
    return a * jax.nn.sigmoid(b)


def conv_glu_ffn(h, w_gu, conv_w, conv_b, w_down):
    gate, up = jnp.split(h @ w_gu, 2, axis=-1)
    gate = dwconv_centred(gate, conv_w) + conv_b
    return (jax.nn.silu(gate) * up) @ w_down


def trunk(x, p, w):
    for i in range(DEPTH):
        kind, j = i % N_MIXERS, i // N_MIXERS
        h = rmsnorm(x, w['norm_mix'][i])
        if kind == 0:
            mix = neighbourhood_attention(h, w['na_w_qkv'][j], w['na_w_o'][j], w['na_rpb'][j])
        elif kind == 1:
            mix = spatial_gating(h, w['sg_w_in'][j], w['sg_norm'][j], w['sg_w_s'][j], w['sg_b_s'][j], w['sg_w_o'][j])
        elif kind == 2:
            mix = gated_deltanet(h, w['gdn_w_in'][j], w['gdn_conv_w'][j], w['gdn_a_log'][j], w['gdn_dt_bias'][j],
                                 w['gdn_out_norm'][j], w['gdn_w_o'][j])
        else:
            mix = s5_mixer(h, w['s5_a_re'][j], w['s5_a_im'][j], w['s5_log_dt'][j], w['s5_b_re'][j], w['s5_b_im'][j],
                           w['s5_c_re'][j], w['s5_c_im'][j], w['s5_d'][j], w['s5_w_glu'][j])
        x = x + mix
        x = x + conv_glu_ffn(rmsnorm(x, w['norm_ffn'][i]), w['ffn_w_gu'][i], w['ffn_conv_w'][i],
                             w['ffn_conv_b'][i], w['ffn_w_down'][i])
        gate = jax.nn.sigmoid(rmsnorm(x, w['norm_ple'][i]) @ w['ple_w_gate'][i])
        x = x + gate * (p[i] @ w['ple_w_proj'][i])
    return rmsnorm(x, w['final_norm'])


def setup_inputs(seed: int = 0) -> dict:
    key = jax.random.key(seed)
    keys = iter(list(jax.random.split(key, 64)))
    f32 = jnp.float32

    def normal(shape, scale):
        return jax.random.normal(next(keys), shape, f32) * scale

    def uniform(shape, lo, hi):
        return jax.random.uniform(next(keys), shape, f32, lo, hi)

    def gain(shape):
        return 1.0 + normal(shape, 0.02)

    d = D_MODEL
    inp = {}
    inp['x_prompt'] = normal((BATCH, SEQ, d), 1.0)
    inp['x_sample'] = normal((DEC_BATCH, DEC_SEQ, d), 1.0)
    inp['p_prompt'] = normal((DEPTH, BATCH, SEQ, PLE_DIM), 1.0)
    inp['p_sample'] = normal((DEPTH, DEC_BATCH, DEC_SEQ, PLE_DIM), 1.0)
    inp['norm_mix'] = gain((DEPTH, d))
    inp['norm_ffn'] = gain((DEPTH, d))
    inp['norm_ple'] = gain((DEPTH, d))
    inp['final_norm'] = gain((d,))
    inp['na_w_qkv'] = normal((N_NA, d, 3 * d), d ** -0.5)
    inp['na_w_o'] = normal((N_NA, d, d), d ** -0.5)
    inp['na_rpb'] = normal((N_NA, NA_HEADS, 2 * NA_WIN_R - 1, 2 * NA_WIN_C - 1), 0.1)
    inp['sg_w_in'] = normal((N_SG, d, 2 * SG_WIDTH), d ** -0.5)
    inp['sg_norm'] = gain((N_SG, SG_WIDTH))
    inp['sg_w_s'] = normal((N_SG, SG_GROUPS, SG_CHUNK, SG_CHUNK), SG_CHUNK ** -0.5)
    inp['sg_b_s'] = gain((N_SG, SG_GROUPS, SG_CHUNK))
    inp['sg_w_o'] = normal((N_SG, SG_WIDTH, d), SG_WIDTH ** -0.5)
    inp['gdn_w_in'] = normal((N_GDN, d, GDN_IN_WIDTH), d ** -0.5)
    inp['gdn_conv_w'] = normal((N_GDN, GDN_CONV, GDN_CONV_WIDTH), GDN_CONV ** -0.5)
    inp['gdn_a_log'] = jnp.log(uniform((N_GDN, 2, GDN_V_HEADS), 1.0, 16.0))
    dt = jnp.exp(uniform((N_GDN, 2, GDN_V_HEADS), math.log(1e-3), math.log(1e-1)))
    inp['gdn_dt_bias'] = dt + jnp.log(-jnp.expm1(-dt))
    inp['gdn_out_norm'] = gain((N_GDN, GDN_DV))
    inp['gdn_w_o'] = normal((N_GDN, GDN_V_WIDTH, d), GDN_V_WIDTH ** -0.5)
    a_shape = (N_S5, 2, S5_GROUPS, S5_STATE)
    inp['s5_a_re'] = -0.5 + normal(a_shape, 0.01)
    inp['s5_a_im'] = jnp.broadcast_to(math.pi * jnp.arange(S5_STATE, dtype=f32), a_shape) + normal(a_shape, 0.01)
    inp['s5_log_dt'] = uniform((N_S5, 2, S5_GROUPS), math.log(1e-3), math.log(1e-1))
    inp['s5_b_re'] = normal((N_S5, 2, S5_GROUPS, S5_STATE, S5_GROUP_DIM), (2 * S5_GROUP_DIM) ** -0.5)
    inp['s5_b_im'] = normal((N_S5, 2, S5_GROUPS, S5_STATE, S5_GROUP_DIM), (2 * S5_GROUP_DIM) ** -0.5)
    inp['s5_c_re'] = normal((N_S5, 2, S5_GROUPS, S5_GROUP_DIM, S5_STATE), (2 * S5_STATE) ** -0.5)
    inp['s5_c_im'] = normal((N_S5, 2, S5_GROUPS, S5_GROUP_DIM, S5_STATE), (2 * S5_STATE) ** -0.5)
    inp['s5_d'] = normal((N_S5, d), 1.0)
    inp['s5_w_glu'] = normal((N_S5, d, 2 * d), d ** -0.5)
    inp['ffn_w_gu'] = normal((DEPTH, d, 2 * D_FF), d ** -0.5)
    inp['ffn_conv_w'] = normal((DEPTH, FFN_CONV, D_FF), FFN_CONV ** -0.5)
    inp['ffn_conv_b'] = normal((DEPTH, D_FF), 0.02)
    inp['ffn_w_down'] = normal((DEPTH, D_FF, d), D_FF ** -0.5)
    inp['ple_w_proj'] = normal((DEPTH, PLE_DIM, d), PLE_DIM ** -0.5)
    inp['ple_w_gate'] = normal((DEPTH, d, d), d ** -0.5)
    return inp


def reference(x_prompt, x_sample, p_prompt, p_sample,
              norm_mix, norm_ffn, norm_ple, final_norm,
              na_w_qkv, na_w_o, na_rpb,
              sg_w_in, sg_norm, sg_w_s, sg_b_s, sg_w_o,
              gdn_w_in, gdn_conv_w, gdn_a_log, gdn_dt_bias, gdn_out_norm, gdn_w_o,
              s5_a_re, s5_a_im, s5_log_dt, s5_b_re, s5_b_im, s5_c_re, s5_c_im, s5_d, s5_w_glu,
              ffn_w_gu, ffn_conv_w, ffn_conv_b, ffn_w_down,
              ple_w_proj, ple_w_gate):
    w = dict(norm_mix=norm_mix, norm_ffn=norm_ffn, norm_ple=norm_ple, final_norm=final_norm,
             na_w_qkv=na_w_qkv, na_w_o=na_w_o, na_rpb=na_rpb,
             sg_w_in=sg_w_in, sg_norm=sg_norm, sg_w_s=sg_w_s, sg_b_s=sg_b_s, sg_w_o=sg_w_o,
             gdn_w_in=gdn_w_in, gdn_conv_w=gdn_conv_w, gdn_a_log=gdn_a_log, gdn_dt_bias=gdn_dt_bias,
             gdn_out_norm=gdn_out_norm, gdn_w_o=gdn_w_o,
             s5_a_re=s5_a_re, s5_a_im=s5_a_im, s5_log_dt=s5_log_dt, s5_b_re=s5_b_re, s5_b_im=s5_b_im,
             s5_c_re=s5_c_re, s5_c_im=s5_c_im, s5_d=s5_d, s5_w_glu=s5_w_glu,
             ffn_w_gu=ffn_w_gu, ffn_conv_w=ffn_conv_w, ffn_conv_b=ffn_conv_b, ffn_w_down=ffn_w_down,
             ple_w_proj=ple_w_proj, ple_w_gate=ple_w_gate)
    y_prompt = trunk(x_prompt, p_prompt, w)
    y_sample = trunk(x_sample, p_sample, w)
    return (y_prompt, y_sample)
```

```cpp
#include <hip/hip_runtime.h>
#include <cstdio>
#include <cstdint>
#define XB_TMO      128
#define XB_XCNT(j)  (256  + 64 * (j))
#define XB_XSUB(j)  (1280 + 64 * (j))
#define XB_XGEN(j)  (2304 + 64 * (j))
#define XB_TOP      3328
#define XB_TOPGEN   3392
#define XCD_BAR_WORDS 3456
#define XB_SPIN_CAP (1u << 18)
#define LAS __attribute__((address_space(3)))

__device__ __forceinline__ unsigned xb_ld(unsigned* p)              { return __hip_atomic_load(p, __ATOMIC_RELAXED, __HIP_MEMORY_SCOPE_AGENT); }
__device__ __forceinline__ unsigned xb_add(unsigned* p, unsigned v) { return __hip_atomic_fetch_add(p, v, __ATOMIC_RELAXED, __HIP_MEMORY_SCOPE_AGENT); }
__device__ __forceinline__ unsigned xb_xcc_id() { return (unsigned)__builtin_amdgcn_s_getreg((3 << 11) | 20) & 0xFu; }
#define XB_SPIN(cond, bar) do { unsigned _sp = 0; while (cond) { __builtin_amdgcn_s_sleep(1); \
    if ((++_sp & 255u) == 0u) { if (xb_ld(&(bar)[XB_TMO])) break; if (_sp > XB_SPIN_CAP) { atomicAdd(&(bar)[XB_TMO], 1u); break; } } } } while (0)

struct XcdBarrier {
    unsigned* bar; unsigned x;
    volatile LAS unsigned* st;
};

__device__ __forceinline__ XcdBarrier xcd_barrier_post(unsigned* bar, volatile LAS unsigned* st) {
    XcdBarrier b; b.bar = bar; b.x = xb_xcc_id(); b.st = st;
    if (threadIdx.x == 0) (void)xb_add(&bar[XB_XCNT(b.x)], 1u);
    return b;
}
__device__ __forceinline__ void xcd_barrier_complete(unsigned* bar, unsigned x, unsigned& nloc, unsigned& nx) {
    const unsigned G = gridDim.x * gridDim.y * gridDim.z;
    unsigned sum, cnt, mine, sp = 0u;
    for (;;) {
        sum = 0u; cnt = 0u; mine = 0u;
#pragma unroll
        for (unsigned j = 0; j < 16; ++j) { const unsigned c = xb_ld(&bar[XB_XCNT(j)]); sum += c; cnt += (c > 0u) ? 1u : 0u; mine = (j == x) ? c : mine; }
        if (sum == G) break;
        __builtin_amdgcn_s_sleep(1);
        if ((++sp & 255u) == 0u) { if (xb_ld(&bar[XB_TMO])) break; if (sp > XB_SPIN_CAP) { atomicAdd(&bar[XB_TMO], 1u); break; } }
    }
    nloc = mine > 0u ? mine : 1u; nx = cnt > 0u ? cnt : 1u;
}

__device__ __forceinline__ void xcd_barrier(const XcdBarrier& b) {
    asm volatile("s_waitcnt vmcnt(0)" ::: "memory");
    __syncthreads();
    if (threadIdx.x == 0) {
        unsigned* bar = b.bar;
        __builtin_amdgcn_s_waitcnt(0);
        unsigned nloc = b.st[0], nx = b.st[1];
        if (nloc == 0u) { xcd_barrier_complete(bar, b.x, nloc, nx); b.st[0] = nloc; b.st[1] = nx; }
        const unsigned old = xb_add(&bar[XB_XSUB(b.x)], 1u);
        const unsigned gen = old / nloc;
        if (old + 1u == (gen + 1u) * nloc) {
            __builtin_amdgcn_fence(__ATOMIC_RELEASE, "agent");
            asm volatile("s_waitcnt vmcnt(0)" ::: "memory");
            const unsigned og = xb_add(&bar[XB_TOP], 1u);
            const unsigned tg = og / nx;
            if (og + 1u == (tg + 1u) * nx) xb_add(&bar[XB_TOPGEN], 1u);
            else XB_SPIN(xb_ld(&bar[XB_TOPGEN]) == tg, bar);
            __builtin_amdgcn_fence(__ATOMIC_ACQUIRE, "agent");
            xb_add(&bar[XB_XGEN(b.x)], 1u);
            asm volatile("s_waitcnt vmcnt(0)" ::: "memory");
        } else {
            XB_SPIN(xb_ld(&bar[XB_XGEN(b.x)]) == gen, bar);
            __builtin_amdgcn_fence(__ATOMIC_ACQUIRE, "agent");
            asm volatile("s_waitcnt vmcnt(0)" ::: "memory");
        }
    }
    __syncthreads();
}
namespace pg8 {
#define PG8_LAS __attribute__((address_space(3)))
typedef unsigned short bf16_t;
typedef short bf16x8 __attribute__((ext_vector_type(8)));
typedef float f32x4 __attribute__((ext_vector_type(4)));
typedef unsigned u32x4 __attribute__((ext_vector_type(4)));
constexpr int BM = 256, BK = 64, HALF = 128, HTB = HALF * BK * 2  , STAGE_BYTES = 8 * HTB, NXCD = 8, WGM = 8;

__host__ __device__ __forceinline__ int lds_byte(int r, int c) { const int st = (r >> 4) * 2 + (c >> 5), rr = r & 15, cc = c & 31, ob = rr * 64 + cc * 2; return st * 1024 + (ob ^ (((ob >> 9) & 1) << 5)); }
__host__ __device__ __forceinline__ void stage_rc(int b, int& R, int& C) { const int st = b / 1024, sb = b % 1024, swz = sb ^ (((sb >> 9) & 1) << 5); R = (st >> 1) * 16 + swz / 64; C = (st & 1) * 32 + (swz % 64) / 2; }
__host__ __device__ __forceinline__ int perm32(int rho) { const int n = rho >> 4, i = rho & 15; return 8 * (i >> 2) + 4 * n + (i & 3); }

struct Unit { int pm, pn; };
struct Gemm { const bf16_t* A; const bf16_t* Bt; int M, N, K; };

struct StaticOrder {
    int nM, nN, nwg, G, c;
    __host__ __device__ void init(int M, int N, int G_, int c_) { nM = M / BM; nN = N / BM; nwg = nM * nN; G = G_; c = c_; }
    __host__ __device__ bool next(int i, Unit& u) const {
        const long L = (long)i * G + c; if (L >= nwg) return false;
        int wgid = (int)L; { const int q = nwg / NXCD, r = nwg % NXCD, xcd = wgid % NXCD, off = wgid / NXCD; wgid = (xcd < r ? xcd * (q + 1) : r * (q + 1) + (xcd - r) * q) + off; }
        const int nig = WGM * nN, gid = wgid / nig, fm = gid * WGM, gsz = (nM - fm) < WGM ? (nM - fm) : WGM;
        u.pm = fm + ((wgid % nig) % gsz); u.pn = (wgid % nig) / gsz; return true;
    }
    __device__ __forceinline__ void a_ready(const Unit&) const {}
    __device__ __forceinline__ void done(const Unit&) const {}
};


__device__ __forceinline__ unsigned cvt_pk_bf16(float lo, float hi) { unsigned r; asm volatile("v_cvt_pk_bf16_f32 %0, %1, %2" : "=v"(r) : "v"(lo), "v"(hi)); return r; }

template <class Epi, class Sched, bool ALIGN_EPI = false, bool SP2 = false>
__device__ __forceinline__ void gemm_phase(PG8_LAS unsigned char* lds, const Gemm g, const Sched& S, const Epi& E) {
    int tid_ = threadIdx.x; asm volatile("" : "+v"(tid_)); const int tid = tid_, wid = __builtin_amdgcn_readfirstlane(tid >> 6), lane = tid & 63, wr = wid >> 2, wc = wid & 3, fr = lane & 15, fq = lane >> 4;
    const int K = g.K, nt = K / BK;
    unsigned voffA[2], voffB[2];
#pragma unroll
    for (int i = 0; i < 2; ++i) { int R, C; stage_rc(tid * 16 + i * 8192, R, C); const int Rb = Epi::PERM ? ((R & ~31) + perm32(R & 31)) : R;
        voffA[i] = (unsigned)(R * K + C) * 2u; voffB[i] = (unsigned)(Rb * K + C) * 2u; }
    const size_t kstep = (size_t)(BK * 2);
    const size_t hstep = (size_t)HALF * K * 2;
    const size_t tstep = 2 * hstep;
    const unsigned ldsw = (unsigned)wid * 1024u;
    const int aoff = lds_byte(wr * 64 + fr, fq * 8), boff = lds_byte(wc * 32 + fr, fq * 8);
#define PG8_SA(b, h) (((b) * 2 + (h)) * HTB)
#define PG8_SB(b, h) ((4 + (b) * 2 + (h)) * HTB)
#define PG8_STAGE(bufoff, gbase, voff) do { _Pragma("unroll") for (int _i = 0; _i < 2; ++_i) \
        __builtin_amdgcn_global_load_lds((const unsigned*)((const char*)(gbase) + (voff)[_i]), (PG8_LAS unsigned*)(lds + (bufoff) + ldsw + _i * 8192), 16, 0, 0); } while (0)
#define PG8_LDA(dst, b, h) do { _Pragma("unroll") for (int m = 0; m < 4; ++m) _Pragma("unroll") for (int k = 0; k < 2; ++k) dst[m][k] = *(const PG8_LAS bf16x8*)(lds + PG8_SA(b, h) + aoff + m * 2048 + k * 1024); } while (0)
#define PG8_LDB(dst, b, h) do { _Pragma("unroll") for (int n = 0; n < 2; ++n) _Pragma("unroll") for (int k = 0; k < 2; ++k) dst[n][k] = *(const PG8_LAS bf16x8*)(lds + PG8_SB(b, h) + boff + n * 2048 + k * 1024); } while (0)
#define PG8_MMA(ai, bj, At, Bt) do { __builtin_amdgcn_s_setprio(1); _Pragma("unroll") for (int m = 0; m < 4; ++m) _Pragma("unroll") for (int n = 0; n < 2; ++n) _Pragma("unroll") for (int k = 0; k < 2; ++k) \
        acc[ai][bj][m][n] = __builtin_amdgcn_mfma_f32_16x16x32_bf16(Bt[n][k], At[m][k], acc[ai][bj][m][n], 0, 0, 0); __builtin_amdgcn_s_setprio(0); } while (0)
#define PG8_WAIT_V(n) asm volatile("s_waitcnt vmcnt(" #n ")" ::: "memory")
#define PG8_WAIT_L(n) asm volatile("s_waitcnt lgkmcnt(" #n ")" ::: "memory")
#define PG8_BAR __builtin_amdgcn_s_barrier()
#define PG8_SCHED __builtin_amdgcn_sched_barrier(0)
    Unit cur, nxt; int ui = 0;
    if (!S.next(0, cur)) return;
    f32x4 acc[2][2][4][2];
#pragma unroll
    for (int a = 0; a < 2; ++a)
#pragma unroll
        for (int b = 0; b < 2; ++b)
#pragma unroll
            for (int m = 0; m < 4; ++m)
#pragma unroll
                for (int n = 0; n < 2; ++n) acc[a][b][m][n] = (f32x4){0.f, 0.f, 0.f, 0.f};
    bf16x8 At[4][2], B0[2][2], B1[2][2];
    const char* cA = (const char*)g.A + (size_t)cur.pm * tstep; const char* cB = (const char*)g.Bt + (size_t)cur.pn * tstep;
    S.a_ready(cur);
    if constexpr (SP2) {
        PG8_STAGE(PG8_SB(0, 0), cB, voffB); PG8_STAGE(PG8_SB(0, 1), cB + hstep, voffB); PG8_STAGE(PG8_SA(0, 0), cA, voffA); PG8_STAGE(PG8_SA(0, 1), cA + hstep, voffA);
        if (wr == 1) PG8_BAR;
        PG8_WAIT_V(2); PG8_BAR;
        PG8_STAGE(PG8_SB(1, 0), cB + kstep, voffB); PG8_STAGE(PG8_SA(1, 0), cA + kstep, voffA); PG8_STAGE(PG8_SB(1, 1), cB + hstep + kstep, voffB);
        PG8_WAIT_V(6); PG8_BAR;
    } else {
        PG8_STAGE(PG8_SB(0, 0), cB, voffB); PG8_STAGE(PG8_SA(0, 0), cA, voffA); PG8_STAGE(PG8_SB(0, 1), cB + hstep, voffB); PG8_STAGE(PG8_SA(0, 1), cA + hstep, voffA);
        if (wr == 1) PG8_BAR;
        PG8_WAIT_V(4); PG8_BAR;
        PG8_STAGE(PG8_SB(1, 0), cB + kstep, voffB); PG8_STAGE(PG8_SA(1, 0), cA + kstep, voffA); PG8_STAGE(PG8_SB(1, 1), cB + hstep + kstep, voffB);
        PG8_WAIT_V(6); PG8_BAR;
    }
    for (;;) {
        const bool has_next = S.next(ui + 1, nxt);
        const char* nA = has_next ? (const char*)g.A + (size_t)nxt.pm * tstep : cA; const char* nB = has_next ? (const char*)g.Bt + (size_t)nxt.pn * tstep : cB;
        for (int t = 0; t < nt; t += 2) {
            const bool last = (t == nt - 2);
            const char* a1 = cA + (size_t)(t + 1) * kstep;
            const char* a2 = last ? nA : cA + (size_t)(t + 2) * kstep; const char* b2 = last ? nB : cB + (size_t)(t + 2) * kstep;
            const char* a3 = a2 + kstep; const char* b3 = b2 + kstep;
            if (last && has_next) S.a_ready(nxt);
            if constexpr (SP2) {
            PG8_LDB(B0, 0, 0); PG8_LDB(B1, 0, 1); PG8_SCHED; PG8_LDA(At, 0, 0); PG8_STAGE(PG8_SA(1, 1), a1 + hstep, voffA);
            PG8_WAIT_V(8); PG8_WAIT_L(0); PG8_BAR; PG8_MMA(0, 0, At, B0); PG8_MMA(0, 1, At, B1); PG8_BAR; PG8_SCHED;
            PG8_LDA(At, 0, 1); PG8_STAGE(PG8_SB(0, 0), b2, voffB); PG8_STAGE(PG8_SB(0, 1), b2 + hstep, voffB); PG8_STAGE(PG8_SA(0, 0), a2, voffA);
            PG8_WAIT_V(8); PG8_WAIT_L(0); PG8_BAR; PG8_MMA(1, 0, At, B0); PG8_MMA(1, 1, At, B1); PG8_BAR; PG8_SCHED;
            PG8_LDB(B0, 1, 0); PG8_LDB(B1, 1, 1); PG8_SCHED; PG8_LDA(At, 1, 0); PG8_STAGE(PG8_SA(0, 1), a2 + hstep, voffA);
            PG8_WAIT_V(8); PG8_WAIT_L(0); PG8_BAR; PG8_MMA(0, 0, At, B0); PG8_MMA(0, 1, At, B1); PG8_BAR; PG8_SCHED;
            PG8_LDA(At, 1, 1); PG8_STAGE(PG8_SB(1, 0), b3, voffB); PG8_STAGE(PG8_SB(1, 1), b3 + hstep, voffB); PG8_STAGE(PG8_SA(1, 0), a3, voffA);
            PG8_WAIT_V(8); PG8_WAIT_L(0); PG8_BAR; PG8_MMA(1, 0, At, B0); PG8_MMA(1, 1, At, B1); PG8_BAR; PG8_SCHED;
            } else {
            PG8_LDB(B0, 0, 0); PG8_SCHED; PG8_LDA(At, 0, 0); PG8_STAGE(PG8_SA(1, 1), a1 + hstep, voffA);
            PG8_WAIT_L(8); PG8_BAR; PG8_WAIT_L(0); PG8_MMA(0, 0, At, B0); PG8_BAR; PG8_SCHED;
            PG8_LDB(B1, 0, 1); PG8_STAGE(PG8_SB(0, 0), b2, voffB);
            PG8_BAR; PG8_WAIT_L(0); PG8_MMA(0, 1, At, B1); PG8_BAR;
            PG8_LDA(At, 0, 1); PG8_STAGE(PG8_SA(0, 0), a2, voffA);
            PG8_BAR; PG8_WAIT_L(0); PG8_MMA(1, 0, At, B0); PG8_BAR; PG8_SCHED;
            PG8_STAGE(PG8_SB(0, 1), b2 + hstep, voffB);
            PG8_WAIT_V(6); PG8_BAR; PG8_MMA(1, 1, At, B1); PG8_BAR;
            PG8_LDB(B0, 1, 0); PG8_SCHED; PG8_LDA(At, 1, 0); PG8_STAGE(PG8_SA(0, 1), a2 + hstep, voffA);
            PG8_WAIT_L(8); PG8_BAR; PG8_WAIT_L(0); PG8_MMA(0, 0, At, B0); PG8_BAR; PG8_SCHED;
            PG8_LDB(B1, 1, 1); PG8_STAGE(PG8_SB(1, 0), b3, voffB);
            PG8_BAR; PG8_WAIT_L(0); PG8_MMA(0, 1, At, B1); PG8_BAR;
            PG8_LDA(At, 1, 1); PG8_STAGE(PG8_SA(1, 0), a3, voffA);
            PG8_BAR; PG8_WAIT_L(0); PG8_MMA(1, 0, At, B0); PG8_BAR; PG8_SCHED;
            PG8_STAGE(PG8_SB(1, 1), b3 + hstep, voffB);
            PG8_WAIT_V(6); PG8_BAR; PG8_MMA(1, 1, At, B1); PG8_BAR;
            }
        }
        if constexpr (ALIGN_EPI) { if (wr == 0) PG8_BAR; }
        if constexpr (!Epi::AFTER_DRAIN) { E(acc, cur, wr, wc, fr, fq); S.done(cur); }
        if (!has_next) break;
#pragma unroll
        for (int a = 0; a < 2; ++a)
#pragma unroll
            for (int b = 0; b < 2; ++b)
#pragma unroll
                for (int m = 0; m < 4; ++m)
#pragma unroll
                    for (int n = 0; n < 2; ++n) acc[a][b][m][n] = (f32x4){0.f, 0.f, 0.f, 0.f};
        cur = nxt; cA = nA; cB = nB; ++ui;
        if constexpr (ALIGN_EPI) { if (wr == 1) PG8_BAR; }
    }
    PG8_WAIT_V(0);
    if constexpr (!ALIGN_EPI) { if (wr == 0) PG8_BAR; }
    PG8_BAR;
    if constexpr (Epi::AFTER_DRAIN) { E.fused(acc, cur, wr, wc, fr, fq, lds, wid, lane); S.done(cur); }
#undef PG8_SA
#undef PG8_SB
#undef PG8_STAGE
#undef PG8_LDA
#undef PG8_LDB
#undef PG8_MMA
#undef PG8_WAIT_V
#undef PG8_WAIT_L
#undef PG8_BAR
#undef PG8_SCHED
}
}

namespace mk {
using pg8::bf16_t; using pg8::f32x4; using pg8::u32x4; using pg8::Unit;
typedef unsigned u32x2 __attribute__((ext_vector_type(2)));
constexpr int D = 2048, T = 40960, NSEQ = 10, SEQ = 4096, DFF = 5632, PLED = 256;
constexpr float EPS = 1e-6f;
constexpr int NTHR = 512;

constexpr size_t AL(size_t x) { return (x + 255) & ~size_t(255); }
constexpr size_t WS_CTL = 0, CTL_BYTES = 65536;
constexpr int NRS = 14;
constexpr size_t WS_RS = WS_CTL + CTL_BYTES, RS_BYTES = (size_t)NRS * T * 8;
constexpr size_t ZERO_BYTES = WS_RS + RS_BYTES;
constexpr size_t SZ_WGU = (size_t)2 * DFF * D * 2, SZ_WDN = (size_t)D * DFF * 2, SZ_WPG = (size_t)D * D * 2, SZ_WPP = (size_t)D * PLED * 2;
constexpr size_t WS_WGU = AL(ZERO_BYTES);
constexpr size_t WS_WDN = WS_WGU + 4 * SZ_WGU;
constexpr size_t WS_WPG = WS_WDN + 4 * SZ_WDN;
constexpr size_t WS_WPP = WS_WPG + 4 * SZ_WPG;
constexpr size_t WS_NAQ = WS_WPP + 4 * SZ_WPP;
constexpr size_t WS_NAO = WS_NAQ + (size_t)6144 * D * 2;
constexpr size_t WS_SGI = WS_NAO + (size_t)D * D * 2;
constexpr size_t WS_SGO = WS_SGI + (size_t)4096 * D * 2;
constexpr int    GDI_N = 12544, GDI_N1 = 8448;
constexpr size_t WS_GDI = WS_SGO + (size_t)D * D * 2;
constexpr size_t WS_GDO = WS_GDI + (size_t)GDI_N * D * 2;
constexpr size_t WS_S5G = WS_GDO + (size_t)D * 4096 * 2;
constexpr size_t WS_PB  = WS_S5G + (size_t)4096 * D * 2;
constexpr size_t WS_XB0 = WS_PB + (size_t)4 * T * PLED * 2;
constexpr size_t WS_XB1 = WS_XB0 + (size_t)T * D * 2;
constexpr size_t WS_BIG = WS_XB1 + (size_t)T * D * 2;
constexpr size_t BIG_BYTES = 524288000;
constexpr size_t WS_END = WS_BIG + BIG_BYTES;
constexpr int FG_ROWS = 8192, NFG = 5;
constexpr size_t BIG_GU = 0, BIG_HID = (size_t)FG_ROWS * 2 * DFF * 2;
constexpr int GG_ROWS = 20480, NGG = 2;
constexpr size_t BIG_PROJ = 0, BIG_OB = (size_t)GG_ROWS * 4096 * 2, BIG_VP = (size_t)GG_ROWS * 8192 * 2, BIG_AB = BIG_VP + (size_t)GG_ROWS * 4096 * 2, BIG_GB = BIG_AB + (size_t)GG_ROWS * 128 * 4;
static_assert(BIG_GB + (size_t)GG_ROWS * 128 * 4 <= BIG_BYTES, "BIG");
static_assert((size_t)T * 6144 * 2 <= BIG_BYTES, "BIG");

constexpr int LDS_STAGE = 131072, LDS_BYTES = LDS_STAGE + 1024;

struct Args { const float* in[37]; float* out; unsigned char* ws; int ph_lo, ph_hi; };
typedef const Args __attribute__((address_space(4)))* ArgsCP;
__device__ __forceinline__ ArgsCP argp() { ArgsCP p = (ArgsCP)__builtin_amdgcn_kernarg_segment_ptr(); asm volatile("" : "+s"(p)); return p; }
__device__ __forceinline__ int tidx() { int t = threadIdx.x; asm volatile("" : "+v"(t)); return t; }

__device__ __forceinline__ float bf2f(bf16_t b) { return __uint_as_float(((unsigned)b) << 16); }
__device__ __forceinline__ float blo(unsigned w) { return __uint_as_float(w << 16); }
__device__ __forceinline__ float bhi(unsigned w) { return __uint_as_float(w & 0xffff0000u); }
__device__ __forceinline__ unsigned pk2(float lo, float hi) { return pg8::cvt_pk_bf16(lo, hi); }
__device__ __forceinline__ bf16_t f2bf(float f) { return (bf16_t)(pk2(f, 0.f) & 0xffffu); }
typedef unsigned long long rs_t;
__device__ __forceinline__ float rs_val(rs_t v) { return (float)(unsigned)(v >> 24) + (float)(unsigned)(v & 0xffffffull) * (1.0f / 16777216.0f); }
__device__ __forceinline__ rs_t rs_fix(float ss) { return (rs_t)__float2ull_rn(ss * 16777216.0f); }
__device__ __forceinline__ void rs_add(rs_t* p, float ss) { atomicAdd(p, rs_fix(ss)); }
__device__ __forceinline__ float rstd_of(rs_t v) { return rsqrtf(rs_val(v) * (1.0f / (float)D) + EPS); }
__device__ __forceinline__ float sigmoidf_(float x) { return __builtin_amdgcn_rcpf(1.0f + __expf(-x)); }
__device__ __forceinline__ float siluf_(float x) { return x * sigmoidf_(x); }
__device__ __forceinline__ float geluf_(float x) { const float z = 1.5957691216f * (x + 0.044715f * x * x * x); return x * sigmoidf_(z); }
__device__ __forceinline__ void unpack8(const u32x4 w, float (&v)[8]) { v[0] = blo(w.x); v[1] = bhi(w.x); v[2] = blo(w.y); v[3] = bhi(w.y); v[4] = blo(w.z); v[5] = bhi(w.z); v[6] = blo(w.w); v[7] = bhi(w.w); }
__device__ __forceinline__ u32x4 pack8(const float (&v)[8]) { u32x4 w; w.x = pk2(v[0], v[1]); w.y = pk2(v[2], v[3]); w.z = pk2(v[4], v[5]); w.w = pk2(v[6], v[7]); return w; }
__device__ __forceinline__ float wave_sum(float v) {
#pragma unroll
    for (int o = 32; o > 0; o >>= 1) v += __shfl_xor(v, o);
    return v; }
__device__ __forceinline__ float wave_max(float v) {
#pragma unroll
    for (int o = 32; o > 0; o >>= 1) v = fmaxf(v, __shfl_xor(v, o));
    return v; }

typedef const f32x4 (&AccT)[2][2][4][2];

struct EpiScale {
    static constexpr bool PERM = true, AFTER_DRAIN = false;
    bf16_t* O; int ldc; const rs_t* rs; float* ab; int ab_pn;
    __device__ __forceinline__ void operator()(AccT acc, const Unit& u, int wr, int wc, int fr, int fq) const {
        const int row0 = u.pm * 256 + wr * 64 + fr, colw = wc * 32 + 8 * fq;
        const bool side = (ab != nullptr) && (u.pn == ab_pn);
#pragma unroll
        for (int ai = 0; ai < 2; ++ai)
#pragma unroll
            for (int m = 0; m < 4; ++m) {
                const int row = row0 + ai * 128 + m * 16;
                const float s = rs ? rstd_of(rs[row]) : 1.0f;
#pragma unroll
                for (int bj = 0; bj < 2; ++bj) {
                    const f32x4 v0 = acc[ai][bj][m][0] * s, v1 = acc[ai][bj][m][1] * s;
                    if (side) { if (bj == 0) { float* p = ab + (size_t)row * 128 + colw; *(f32x4*)p = v0; *(f32x4*)(p + 4) = v1; } }
                    else { u32x4 w; w.x = pk2(v0[0], v0[1]); w.y = pk2(v0[2], v0[3]); w.z = pk2(v1[0], v1[1]); w.w = pk2(v1[2], v1[3]);
                           *(u32x4*)(O + (size_t)row * ldc + u.pn * 256 + bj * 128 + colw) = w; }
                }
            }
    }
};
struct EpiGelu {
    static constexpr bool PERM = true, AFTER_DRAIN = false;
    bf16_t* O; int ldc; const rs_t* rs; rs_t* rsv; int vtile0;
    __device__ __forceinline__ void operator()(AccT acc, const Unit& u, int wr, int wc, int fr, int fq) const {
        const int row0 = u.pm * 256 + wr * 64 + fr, colw = wc * 32 + 8 * fq;
        const bool isv = u.pn >= vtile0;
#pragma unroll
        for (int ai = 0; ai < 2; ++ai)
#pragma unroll
            for (int m = 0; m < 4; ++m) {
                const int row = row0 + ai * 128 + m * 16;
                const float s = rstd_of(rs[row]); float ss = 0.f;
#pragma unroll
                for (int bj = 0; bj < 2; ++bj) {
                    float v[8];
#pragma unroll
                    for (int j = 0; j < 4; ++j) { v[j] = geluf_(acc[ai][bj][m][0][j] * s); v[4 + j] = geluf_(acc[ai][bj][m][1][j] * s); }
#pragma unroll
                    for (int j = 0; j < 8; ++j) ss += v[j] * v[j];
                    *(u32x4*)(O + (size_t)row * ldc + u.pn * 256 + bj * 128 + colw) = pack8(v);
                }
                if (isv) { ss += __shfl_xor(ss, 16); ss += __shfl_xor(ss, 32); if (fq == 0) rs_add(rsv + row, ss); }
            }
    }
};
__device__ __forceinline__ float put_x(float* X, bf16_t* XB, size_t off, const float (&xn)[8]) {
    *(f32x4*)(X + off) = (f32x4){xn[0], xn[1], xn[2], xn[3]}; *(f32x4*)(X + off + 4) = (f32x4){xn[4], xn[5], xn[6], xn[7]};
    *(u32x4*)(XB + off) = pack8(xn);
    float ss = 0.f;
#pragma unroll
    for (int j = 0; j < 8; ++j) ss += xn[j] * xn[j];
    return ss;
}
struct EpiResid {
    static constexpr bool PERM = true, AFTER_DRAIN = false;
    float* X; bf16_t* XB; rs_t* rsq;
    __device__ __forceinline__ void operator()(AccT acc, const Unit& u, int wr, int wc, int fr, int fq) const {
        const int row0 = u.pm * 256 + wr * 64 + fr, colw = wc * 32 + 8 * fq;
#pragma unroll
        for (int ai = 0; ai < 2; ++ai)
#pragma unroll
            for (int m = 0; m < 4; ++m) {
                const int row = row0 + ai * 128 + m * 16; float ss = 0.f;
#pragma unroll
                for (int bj = 0; bj < 2; ++bj) {
                    const size_t off = (size_t)row * D + u.pn * 256 + bj * 128 + colw;
                    const f32x4 x0 = *(const f32x4*)(X + off), x1 = *(const f32x4*)(X + off + 4);
                    float xn[8];
#pragma unroll
                    for (int j = 0; j < 4; ++j) { xn[j] = x0[j] + acc[ai][bj][m][0][j]; xn[4 + j] = x1[j] + acc[ai][bj][m][1][j]; }
                    ss += put_x(X, XB, off, xn);
                }
                ss += __shfl_xor(ss, 16); ss += __shfl_xor(ss, 32); if (fq == 0) rs_add(rsq + row, ss);
            }
    }
};
struct EpiPle {
    static constexpr bool PERM = true, AFTER_DRAIN = false;
    float* X; bf16_t* XB; rs_t* rsq; const rs_t* rs_in; const bf16_t* PP;
    __device__ __forceinline__ void operator()(AccT acc, const Unit& u, int wr, int wc, int fr, int fq) const {
        const int row0 = u.pm * 256 + wr * 64 + fr, colw = wc * 32 + 8 * fq;
#pragma unroll
        for (int ai = 0; ai < 2; ++ai)
#pragma unroll
            for (int m = 0; m < 4; ++m) {
                const int row = row0 + ai * 128 + m * 16; float ss = 0.f; const float s = rstd_of(rs_in[row]);
#pragma unroll
                for (int bj = 0; bj < 2; ++bj) {
                    const size_t off = (size_t)row * D + u.pn * 256 + bj * 128 + colw;
                    const f32x4 x0 = *(const f32x4*)(X + off), x1 = *(const f32x4*)(X + off + 4);
                    float pv[8]; unpack8(*(const u32x4*)(PP + off), pv);
                    float xn[8];
#pragma unroll
                    for (int j = 0; j < 4; ++j) { xn[j] = x0[j] + sigmoidf_(acc[ai][bj][m][0][j] * s) * pv[j]; xn[4 + j] = x1[j] + sigmoidf_(acc[ai][bj][m][1][j] * s) * pv[4 + j]; }
                    ss += put_x(X, XB, off, xn);
                }
                ss += __shfl_xor(ss, 16); ss += __shfl_xor(ss, 32); if (fq == 0) rs_add(rsq + row, ss);
            }
    }
};
struct EpiGlu {
    static constexpr bool PERM = true, AFTER_DRAIN = false;
    float* X; bf16_t* XB; rs_t* rsq;
    __device__ __forceinline__ void operator()(AccT acc, const Unit& u, int wr, int wc, int fr, int fq) const {
        const int row0 = u.pm * 256 + wr * 64 + fr, colw = wc * 32 + 8 * fq;
#pragma unroll
        for (int ai = 0; ai < 2; ++ai)
#pragma unroll
            for (int m = 0; m < 4; ++m) {
                const int row = row0 + ai * 128 + m * 16;
                const size_t off = (size_t)row * D + u.pn * 128 + colw;
                const f32x4 x0 = *(const f32x4*)(X + off), x1 = *(const f32x4*)(X + off + 4);
                float xn[8];
#pragma unroll
                for (int j = 0; j < 4; ++j) { xn[j] = x0[j] + acc[ai][0][m][0][j] * sigmoidf_(acc[ai][1][m][0][j]); xn[4 + j] = x1[j] + acc[ai][0][m][1][j] * sigmoidf_(acc[ai][1][m][1][j]); }
                float ss = put_x(X, XB, off, xn);
                ss += __shfl_xor(ss, 16); ss += __shfl_xor(ss, 32); if (fq == 0) rs_add(rsq + row, ss);
            }
    }
};
struct EpiGdnZ {
    static constexpr bool PERM = true, AFTER_DRAIN = false;
    bf16_t* O; int ldc; const rs_t* rs;
    __device__ __forceinline__ void operator()(AccT acc, const Unit& u, int wr, int wc, int fr, int fq) const {
        const int row0 = u.pm * 256 + wr * 64 + fr, colw = wc * 32 + 8 * fq;
#pragma unroll
        for (int ai = 0; ai < 2; ++ai)
#pragma unroll
            for (int m = 0; m < 4; ++m) {
                const int row = row0 + ai * 128 + m * 16; const float s = rstd_of(rs[row]);
#pragma unroll
                for (int bj = 0; bj < 2; ++bj) {
                    bf16_t* p = O + (size_t)row * ldc + u.pn * 256 + bj * 128 + colw;
                    float ov[8]; unpack8(*(const u32x4*)p, ov);
#pragma unroll
                    for (int j = 0; j < 4; ++j) { ov[j] *= siluf_(acc[ai][bj][m][0][j] * s); ov[4 + j] *= siluf_(acc[ai][bj][m][1][j] * s); }
                    *(u32x4*)p = pack8(ov);
                }
            }
    }
};

template <class Epi>
__device__ __forceinline__ void run_gemm(LAS unsigned char* lds, const bf16_t* A, const bf16_t* Bt, int M, int N, int K, const Epi& E) {
    pg8::Gemm g{A, Bt, M, N, K}; pg8::StaticOrder S; S.init(M, N, (int)gridDim.x, (int)blockIdx.x);
    pg8::gemm_phase<Epi, pg8::StaticOrder, true, true>(lds, g, S, E);
}

struct Job { const float* src; bf16_t* dst; const float* gain; int K, Nsrc, Ndst, map, qcols; };
__device__ __forceinline__ void get_job(ArgsCP a, int j, Job& J) {
    unsigned char* ws = a->ws; J.gain = nullptr; J.map = 0; J.qcols = 0;
    if (j < 16) { const int L = j >> 2, k = j & 3;
        if (k == 0)      { J.src = a->in[31] + (size_t)L * D * 2 * DFF; J.dst = (bf16_t*)(ws + WS_WGU + L * SZ_WGU); J.gain = a->in[5] + L * D; J.K = D; J.Nsrc = 2 * DFF; J.Ndst = 2 * DFF; J.map = 1; }
        else if (k == 1) { J.src = a->in[34] + (size_t)L * DFF * D;     J.dst = (bf16_t*)(ws + WS_WDN + L * SZ_WDN); J.K = DFF; J.Nsrc = D; J.Ndst = D; }
        else if (k == 2) { J.src = a->in[36] + (size_t)L * D * D;       J.dst = (bf16_t*)(ws + WS_WPG + L * SZ_WPG); J.gain = a->in[6] + L * D; J.K = D; J.Nsrc = D; J.Ndst = D; }
        else             { J.src = a->in[35] + (size_t)L * PLED * D;    J.dst = (bf16_t*)(ws + WS_WPP + L * SZ_WPP); J.K = PLED; J.Nsrc = D; J.Ndst = D; }
    } else switch (j) {
        case 16: J.src = a->in[8];  J.dst = (bf16_t*)(ws + WS_NAQ); J.gain = a->in[4] + 0 * D; J.K = D; J.Nsrc = 6144; J.Ndst = 6144; J.qcols = 2048; break;
        case 17: J.src = a->in[9];  J.dst = (bf16_t*)(ws + WS_NAO); J.K = D; J.Nsrc = D; J.Ndst = D; break;
        case 18: J.src = a->in[11]; J.dst = (bf16_t*)(ws + WS_SGI); J.gain = a->in[4] + 1 * D; J.K = D; J.Nsrc = 4096; J.Ndst = 4096; break;
        case 19: J.src = a->in[15]; J.dst = (bf16_t*)(ws + WS_SGO); J.K = D; J.Nsrc = D; J.Ndst = D; break;
        case 20: J.src = a->in[16]; J.dst = (bf16_t*)(ws + WS_GDI); J.gain = a->in[4] + 2 * D; J.K = D; J.Nsrc = 12416; J.Ndst = GDI_N; J.map = 2; break;
        case 21: J.src = a->in[21]; J.dst = (bf16_t*)(ws + WS_GDO); J.K = 4096; J.Nsrc = D; J.Ndst = D; break;
        default: J.src = a->in[30]; J.dst = (bf16_t*)(ws + WS_S5G); J.K = D; J.Nsrc = 4096; J.Ndst = 4096; J.map = 1; break;
    }
}
__device__ __forceinline__ int map_col(const Job& J, int n0) {
    if (J.map == 0) return n0;
    if (J.map == 1) { const int tile = n0 >> 8, w = n0 & 255, H = J.Nsrc >> 1; return w < 128 ? tile * 128 + w : H + tile * 128 + (w - 128); }
    if (n0 < 8192) return n0;
    if (n0 < 8320) return 12288 + (n0 - 8192);
    if (n0 < GDI_N1) return -1;
    return 8192 + (n0 - GDI_N1);
}
__device__ __forceinline__ void prologue(ArgsCP a, LAS unsigned char* lds) {
    const int tid = tidx(), G = gridDim.x, bid = blockIdx.x;
    LAS float* tile = (LAS float*)lds;
    int base = 0;
    for (int j = 0; j < 23; ++j) {
        Job J; get_job(a, j, J);
        const int kt = J.K >> 6, ntl = J.Ndst >> 6, nt = kt * ntl;
        int first = (bid - (base % G) + G) % G;
        for (int i = first; i < nt; i += G) {
            const int nb = i / kt, kb = i - nb * kt, n0 = nb * 64, k0 = kb * 64, s0 = map_col(J, n0);
            const float cs = (n0 < J.qcols) ? 0.08838834764831845f : 1.0f;
            const int kk = tid >> 4, nn4 = (tid & 15) * 4;
#pragma unroll
            for (int p = 0; p < 2; ++p) {
                const int k = k0 + kk + 32 * p;
                f32x4 v = (f32x4){0.f, 0.f, 0.f, 0.f};
                if (s0 >= 0) v = *(const f32x4*)(J.src + (size_t)k * J.Nsrc + s0 + nn4);
                const float sc = (J.gain ? J.gain[k] : 1.0f) * cs;
#pragma unroll
                for (int q = 0; q < 4; ++q) tile[(nn4 + q) * 65 + kk + 32 * p] = v[q] * sc;
            }
            __syncthreads();
            { const int nn = tid >> 3, kk8 = (tid & 7) * 8; float v[8];
#pragma unroll
              for (int q = 0; q < 8; ++q) v[q] = tile[nn * 65 + kk8 + q];
              *(u32x4*)(J.dst + (size_t)(n0 + nn) * J.K + k0 + kk8) = pack8(v); }
            __syncthreads();
        }
        base += nt;
    }
    { bf16_t* PB = (bf16_t*)(a->ws + WS_PB);
      const long total = (long)4 * T * 64;
      for (long i = (long)bid * NTHR + tid; i < total; i += (long)G * NTHR) {
          const int L = (int)(i / ((long)T * 64)); const int rem = (int)(i - (long)L * T * 64); const int row = rem >> 6, c4 = (rem & 63) * 4;
          const float* src = row < 8192 ? a->in[2] + ((size_t)L * 8192 + row) * PLED + c4 : a->in[3] + ((size_t)L * 32768 + (row - 8192)) * PLED + c4;
          const f32x4 v = *(const f32x4*)src; u32x2 w; w.x = pk2(v[0], v[1]); w.y = pk2(v[2], v[3]);
          *(u32x2*)(PB + ((size_t)L * T + row) * PLED + c4) = w; } }
    { bf16_t* XB = (bf16_t*)(a->ws + WS_XB0); rs_t* rs = (rs_t*)(a->ws + WS_RS);
      const int w = tid >> 6, lane = tid & 63;
      for (int row = bid * 8 + w; row < T; row += G * 8) {
          const float* src = row < 8192 ? a->in[0] + (size_t)row * D : a->in[1] + (size_t)(row - 8192) * D;
          float ss = 0.f;
#pragma unroll
          for (int q = 0; q < 8; ++q) { const int c = (q * 64 + lane) * 4; const f32x4 v = *(const f32x4*)(src + c);
              *(f32x4*)(a->out + (size_t)row * D + c) = v; u32x2 wv; wv.x = pk2(v[0], v[1]); wv.y = pk2(v[2], v[3]); *(u32x2*)(XB + (size_t)row * D + c) = wv;
              ss += v[0] * v[0] + v[1] * v[1] + v[2] * v[2] + v[3] * v[3]; }
          ss = wave_sum(ss); if (lane == 0) rs[row] = rs_fix(ss); } }
}

__device__ __forceinline__ void na_attention(ArgsCP a, LAS unsigned char* lds, const bf16_t* QKV, bf16_t* AO) {
    const int tid = tidx(), w = tid >> 6, lane = tid & 63;
    LAS float* qs = (LAS float*)(lds + w * 1024); LAS float* ps = qs + 128;
    const float* rpb = a->in[10];
    for (long task = (long)blockIdx.x * 8 + w; task < (long)T * 16; task += (long)gridDim.x * 8) {
        const int seq = (int)(task >> 16), rem = (int)(task & 65535), h = rem >> 12, pos = rem & 4095, r = pos >> 6, c = pos & 63;
        const int r0 = min(max(r - 4, 0), 56), c0 = min(max(c - 8, 0), 48);
        const size_t trow = (size_t)seq * SEQ + pos;
        { const unsigned qq = *(const unsigned*)(QKV + trow * 6144 + h * 128 + 2 * lane); qs[2 * lane] = blo(qq); qs[2 * lane + 1] = bhi(qq); }
        __builtin_amdgcn_wave_barrier();
        float s[2];
#pragma unroll
        for (int kk = 0; kk < 2; ++kk) {
            const int j = lane + 64 * kk, kr = r0 + (j >> 4), kc = c0 + (j & 15);
            const u32x4* kp = (const u32x4*)(QKV + ((size_t)seq * SEQ + kr * 64 + kc) * 6144 + 2048 + h * 128);
            float acc = 0.f;
#pragma unroll 4
            for (int d8 = 0; d8 < 16; ++d8) { const u32x4 kv = kp[d8]; const f32x4 q0 = *(const LAS f32x4*)(qs + d8 * 8), q1 = *(const LAS f32x4*)(qs + d8 * 8 + 4);
                acc += q0[0] * blo(kv.x) + q0[1] * bhi(kv.x) + q0[2] * blo(kv.y) + q0[3] * bhi(kv.y) + q1[0] * blo(kv.z) + q1[1] * bhi(kv.z) + q1[2] * blo(kv.w) + q1[3] * bhi(kv.w); }
            s[kk] = acc + rpb[(h * 15 + (kr - r + 7)) * 31 + (kc - c + 15)];
        }
        const float mx = wave_max(fmaxf(s[0], s[1]));
        const float e0 = __expf(s[0] - mx), e1 = __expf(s[1] - mx);
        const float inv = 1.0f / wave_sum(e0 + e1);
        ps[lane] = e0 * inv; ps[lane + 64] = e1 * inv;
        __builtin_amdgcn_wave_barrier();
        float o0 = 0.f, o1 = 0.f;
        const bf16_t* vb = QKV + ((size_t)seq * SEQ) * 6144 + 4096 + h * 128 + 2 * lane;
#pragma unroll 4
        for (int j = 0; j < 128; ++j) { const int kr = r0 + (j >> 4), kc = c0 + (j & 15);
            const unsigned vv = *(const unsigned*)(vb + (size_t)(kr * 64 + kc) * 6144); const float p = ps[j]; o0 += p * blo(vv); o1 += p * bhi(vv); }
        *(unsigned*)(AO + trow * D + h * 128 + 2 * lane) = pk2(o0, o1);
        __builtin_amdgcn_wave_barrier();
    }
}

__device__ __forceinline__ void sgu_mix(ArgsCP a, LAS unsigned char* lds, const bf16_t* UV, const rs_t* rsv, bf16_t* MX) {
    const int tid = tidx(), G = gridDim.x;
    LAS float* WT = (LAS float*)lds;
    LAS float* VS = (LAS float*)(lds + 65536);
    const float* w_s = a->in[13]; const float* b_s = a->in[14]; const float* sgn = a->in[12];
    const int per = (5120 + G - 1) / G, u0 = blockIdx.x * per, u1 = min(5120, u0 + per);
    int gcur = -1;
    for (int u = u0; u < u1; ++u) {
        const int g = u / 320, sc = u - g * 320, seq = sc >> 5, n = sc & 31; const size_t row0 = (size_t)seq * SEQ + n * 128;
        __syncthreads();
        if (g != gcur) { gcur = g;
            for (int idx = tid; idx < 16384; idx += NTHR) { const int t = idx >> 7, s = idx & 127; WT[s * 128 + t] = w_s[(size_t)g * 16384 + idx]; } }
        { const int s = tid >> 2, c32 = (tid & 3) * 32; const float rsd = rstd_of(rsv[row0 + s]);
#pragma unroll
          for (int q = 0; q < 4; ++q) { float v[8]; unpack8(*(const u32x4*)(UV + (row0 + s) * 4096 + 2048 + g * 128 + c32 + q * 8), v);
#pragma unroll
              for (int j = 0; j < 8; ++j) VS[s * 128 + c32 + q * 8 + j] = v[j] * rsd * sgn[g * 128 + c32 + q * 8 + j]; } }
        __syncthreads();
        const int t0 = (tid >> 4) * 4, c0 = (tid & 15) * 8;
        float acc[4][8];
#pragma unroll
        for (int i = 0; i < 4; ++i)
#pragma unroll
            for (int j = 0; j < 8; ++j) acc[i][j] = 0.f;
#pragma unroll 4
        for (int s = 0; s < 128; ++s) {
            const f32x4 av = *(const LAS f32x4*)(WT + s * 128 + t0), v0 = *(const LAS f32x4*)(VS + s * 128 + c0), v1 = *(const LAS f32x4*)(VS + s * 128 + c0 + 4);
#pragma unroll
            for (int i = 0; i < 4; ++i) {
#pragma unroll
                for (int j = 0; j < 4; ++j) { acc[i][j] += av[i] * v0[j]; acc[i][4 + j] += av[i] * v1[j]; } }
        }
#pragma unroll
        for (int i = 0; i < 4; ++i) { const int t = t0 + i; const float bias = b_s[g * 128 + t]; const size_t row = row0 + t;
            float uv[8]; unpack8(*(const u32x4*)(UV + row * 4096 + g * 128 + c0), uv);
#pragma unroll
            for (int j = 0; j < 8; ++j) uv[j] *= (acc[i][j] + bias);
            *(u32x4*)(MX + row * D + g * 128 + c0) = pack8(uv); }
    }
}

__device__ __forceinline__ void ffn_convglu(ArgsCP a, int layer, const bf16_t* GU, bf16_t* HID, int rows) {
    const float* cw = a->in[32] + (size_t)layer * 3 * DFF; const float* cb = a->in[33] + (size_t)layer * DFF;
    const long total = (long)rows * 704;
    for (long i = (long)blockIdx.x * NTHR + tidx(); i < total; i += (long)gridDim.x * NTHR) {
        const int r = (int)(i / 704), cbk = (int)(i - (long)r * 704), ch = cbk * 8, pos = r & (SEQ - 1);
        const bf16_t* gp = GU + (size_t)r * (2 * DFF) + (cbk >> 4) * 256 + (cbk & 15) * 8;
        float g0[8], gm[8], gn[8], up[8];
        unpack8(*(const u32x4*)gp, g0); unpack8(*(const u32x4*)(gp + 128), up);
        if (pos > 0) unpack8(*(const u32x4*)(gp - 2 * DFF), gm); else {
#pragma unroll
            for (int j = 0; j < 8; ++j) gm[j] = 0.f; }
        if (pos < SEQ - 1) unpack8(*(const u32x4*)(gp + 2 * DFF), gn); else {
#pragma unroll
            for (int j = 0; j < 8; ++j) gn[j] = 0.f; }
        float o[8];
#pragma unroll
        for (int j = 0; j < 8; ++j) { const float gv = cw[ch + j] * gm[j] + cw[DFF + ch + j] * g0[j] + cw[2 * DFF + ch + j] * gn[j] + cb[ch + j]; o[j] = siluf_(gv) * up[j]; }
        *(u32x4*)(HID + (size_t)r * DFF + ch) = pack8(o);
    }
}

__device__ __forceinline__ void gdn_conv(ArgsCP a, const bf16_t* PROJ, const float* AB, bf16_t* QK, bf16_t* VP, float* GB, int rows) {
    const int tid = tidx(), ch0 = tid * 16;
    const float* cw = a->in[17];
    float w0[16], w1[16], w2[16];
#pragma unroll
    for (int j = 0; j < 16; ++j) { w0[j] = cw[ch0 + j]; w1[j] = cw[8192 + ch0 + j]; w2[j] = cw[16384 + ch0 + j]; }
    for (int r = blockIdx.x; r < rows; r += gridDim.x) {
        const int pos = r & (SEQ - 1);
        const bf16_t* p = PROJ + (size_t)r * 8192 + ch0;
        float x0[16], xm[16], xn[16];
        { float t[8]; unpack8(*(const u32x4*)p, t);
#pragma unroll
          for (int j = 0; j < 8; ++j) x0[j] = t[j];
          unpack8(*(const u32x4*)(p + 8), t);
#pragma unroll
          for (int j = 0; j < 8; ++j) x0[8 + j] = t[j]; }
        if (pos > 0) { float t[8]; unpack8(*(const u32x4*)(p - 8192), t);
#pragma unroll
          for (int j = 0; j < 8; ++j) xm[j] = t[j];
          unpack8(*(const u32x4*)(p - 8192 + 8), t);
#pragma unroll
          for (int j = 0; j < 8; ++j) xm[8 + j] = t[j]; } else {
#pragma unroll
          for (int j = 0; j < 16; ++j) xm[j] = 0.f; }
        if (pos < SEQ - 1) { float t[8]; unpack8(*(const u32x4*)(p + 8192), t);
#pragma unroll
          for (int j = 0; j < 8; ++j) xn[j] = t[j];
          unpack8(*(const u32x4*)(p + 8192 + 8), t);
#pragma unroll
          for (int j = 0; j < 8; ++j) xn[8 + j] = t[j]; } else {
#pragma unroll
          for (int j = 0; j < 16; ++j) xn[j] = 0.f; }
        float y[16], ss = 0.f;
#pragma unroll
        for (int j = 0; j < 16; ++j) { y[j] = siluf_(w0[j] * xm[j] + w1[j] * x0[j] + w2[j] * xn[j]); ss += y[j] * y[j]; }
        ss += __shfl_xor(ss, 1); ss += __shfl_xor(ss, 2); ss += __shfl_xor(ss, 4);
        float sc = 1.0f;
        if (ch0 < 4096) { sc = rsqrtf(ss + EPS); if (ch0 < 2048) sc *= 0.08838834764831845f; }
        float o0[8], o1[8];
#pragma unroll
        for (int j = 0; j < 8; ++j) { o0[j] = y[j] * sc; o1[j] = y[8 + j] * sc; }
        bf16_t* dst = ch0 < 4096 ? QK + (size_t)r * 4096 + ch0 : VP + (size_t)r * 4096 + (ch0 - 4096);
        *(u32x4*)dst = pack8(o0); *(u32x4*)(dst + 8) = pack8(o1);
        if (tid < 64) { const int dir = tid >> 5, head = tid & 31;
            const float av = AB[(size_t)r * 128 + dir * 64 + head], bv = AB[(size_t)r * 128 + dir * 64 + 32 + head];
            const float xx = av + a->in[19][dir * 32 + head];
            const float sp = xx > 20.f ? xx : log1pf(expf(xx));
            GB[(size_t)r * 128 + dir * 64 + head] = -expf(a->in[18][dir * 32 + head]) * sp;
            GB[(size_t)r * 128 + dir * 64 + 32 + head] = 1.0f / (1.0f + expf(-bv)); }
    }
}
__device__ __forceinline__ void gdn_scan_naive(LAS unsigned char* lds, const bf16_t* QK, const bf16_t* VP, const float* GB, bf16_t* OF, bf16_t* OB, int nseq) {
    const int tid = tidx(), vh = tid >> 8, j = (tid & 255) >> 1, half = tid & 1;
    LAS float* KQ = (LAS float*)lds;
    LAS float* VS = (LAS float*)(lds + 16384);
    LAS float* GS = (LAS float*)(lds + 32768);
    const int nunits = nseq * 32;
    for (int unit = blockIdx.x; unit < nunits; unit += gridDim.x) {
        const int seq = unit >> 5, hq = (unit >> 1) & 15, dir = unit & 1, head = 2 * hq + vh;
        bf16_t* OD = dir ? OB : OF;
        float S[64];
#pragma unroll
        for (int i = 0; i < 64; ++i) S[i] = 0.f;
        for (int blk = 0; blk < SEQ / 16; ++blk) {
            __syncthreads();
            { const int tok = tid >> 5, part = tid & 31, step = blk * 16 + tok, pos = dir ? SEQ - 1 - step : step; const size_t row = (size_t)seq * SEQ + pos;
              const bf16_t* src = part < 16 ? QK + row * 4096 + hq * 128 + part * 8 : QK + row * 4096 + 2048 + hq * 128 + (part - 16) * 8;
              float v[8]; unpack8(*(const u32x4*)src, v);
              *(LAS f32x4*)(KQ + tok * 256 + part * 8) = (f32x4){v[0], v[1], v[2], v[3]}; *(LAS f32x4*)(KQ + tok * 256 + part * 8 + 4) = (f32x4){v[4], v[5], v[6], v[7]};
              unpack8(*(const u32x4*)(VP + row * 4096 + hq * 256 + part * 8), v);
              *(LAS f32x4*)(VS + tok * 256 + part * 8) = (f32x4){v[0], v[1], v[2], v[3]}; *(LAS f32x4*)(VS + tok * 256 + part * 8 + 4) = (f32x4){v[4], v[5], v[6], v[7]};
              if (tid < 64) { const int tk = tid >> 2, which = tid & 3, hh = 2 * hq + (which & 1), isb = which >> 1, st = blk * 16 + tk, ps = dir ? SEQ - 1 - st : st;
                  const float gv = GB[((size_t)seq * SEQ + ps) * 128 + dir * 64 + isb * 32 + hh]; GS[tk * 4 + which] = isb ? gv : expf(gv); } }
            __syncthreads();
            for (int s = 0; s < 16; ++s) {
                const float av = GS[s * 4 + vh], bv = GS[s * 4 + 2 + vh], vt = VS[s * 256 + vh * 128 + j];
                const LAS float* kp = KQ + s * 256 + 128 + half * 64; const LAS float* qp = KQ + s * 256 + half * 64;
                float ks = 0.f;
#pragma unroll
                for (int i = 0; i < 64; i += 4) { const f32x4 k4 = *(const LAS f32x4*)(kp + i); ks += k4[0] * S[i] + k4[1] * S[i + 1] + k4[2] * S[i + 2] + k4[3] * S[i + 3]; }
                ks += __shfl_xor(ks, 1);
                const float uu = bv * (vt - av * ks);
                float os = 0.f;
#pragma unroll
                for (int i = 0; i < 64; i += 4) { const f32x4 k4 = *(const LAS f32x4*)(kp + i), q4 = *(const LAS f32x4*)(qp + i);
#pragma unroll
                    for (int e = 0; e < 4; ++e) { S[i + e] = av * S[i + e] + k4[e] * uu; os += q4[e] * S[i + e]; } }
                os += __shfl_xor(os, 1);
                if (half == 0) { const int step = blk * 16 + s, pos = dir ? SEQ - 1 - step : step; OD[((size_t)seq * SEQ + pos) * 4096 + head * 128 + j] = f2bf(os); }
            }
        }
    }
}
__device__ __forceinline__ void gdn_sumnorm(ArgsCP a, bf16_t* OF, const bf16_t* OB, int rows) {
    const int tid = tidx(), rsub = tid >> 8, c0 = (tid & 255) * 16;
    const float* on = a->in[20];
    for (int r = blockIdx.x * 2 + rsub; r < rows; r += gridDim.x * 2) {
        float x[16], t[8];
        unpack8(*(const u32x4*)(OF + (size_t)r * 4096 + c0), t);
#pragma unroll
        for (int q = 0; q < 8; ++q) x[q] = t[q];
        unpack8(*(const u32x4*)(OF + (size_t)r * 4096 + c0 + 8), t);
#pragma unroll
        for (int q = 0; q < 8; ++q) x[8 + q] = t[q];
        unpack8(*(const u32x4*)(OB + (size_t)r * 4096 + c0), t);
#pragma unroll
        for (int q = 0; q < 8; ++q) x[q] += t[q];
        unpack8(*(const u32x4*)(OB + (size_t)r * 4096 + c0 + 8), t);
#pragma unroll
        for (int q = 0; q < 8; ++q) x[8 + q] += t[q];
        float ss = 0.f;
#pragma unroll
        for (int q = 0; q < 16; ++q) ss += x[q] * x[q];
        ss += __shfl_xor(ss, 1); ss += __shfl_xor(ss, 2); ss += __shfl_xor(ss, 4);
        const float sc = rsqrtf(ss * (1.0f / 128.0f) + EPS);
        float o0[8], o1[8];
#pragma unroll
        for (int q = 0; q < 8; ++q) { o0[q] = x[q] * sc * on[(c0 & 127) + q]; o1[q] = x[8 + q] * sc * on[(c0 & 127) + 8 + q]; }
        *(u32x4*)(OF + (size_t)r * 4096 + c0) = pack8(o0); *(u32x4*)(OF + (size_t)r * 4096 + c0 + 8) = pack8(o1);
    }
}

__device__ __forceinline__ void s5_scan(ArgsCP a, LAS unsigned char* lds, const float* X, const rs_t* rs, float* YF, bf16_t* Y) {
    const int tid = tidx(), w = tid >> 6, lane = tid & 63;
    LAS float* U = (LAS float*)(lds + w * 9216);
    LAS float* XS = U + 256;
    const float* gmix = a->in[4] + 3 * D;
    for (int task = blockIdx.x * 8 + w; task < NSEQ * 128; task += gridDim.x * 8) {
        const int seq = task >> 7, gr = task & 127;
        for (int dir = 0; dir < 2; ++dir) {
            const int dg = dir * 128 + gr;
            const float are = a->in[22][dg * 64 + lane], aim = a->in[23][dg * 64 + lane], dt = expf(a->in[24][dg]);
            const float er = expf(are * dt); float sn, cs; sincosf(aim * dt, &sn, &cs);
            const float abr = er * cs, abi = er * sn;
            const float den = 1.0f / (are * are + aim * aim);
            const float cr = ((abr - 1.0f) * are + abi * aim) * den, ci = (abi * are - (abr - 1.0f) * aim) * den;
            float Br[16], Bi[16];
#pragma unroll
            for (int c = 0; c < 16; ++c) { const float bre = a->in[25][((size_t)dg * 64 + lane) * 16 + c], bim = a->in[26][((size_t)dg * 64 + lane) * 16 + c]; Br[c] = cr * bre - ci * bim; Bi[c] = cr * bim + ci * bre; }
            const int oc = lane & 15, tb = lane >> 4;
            float Cr[64], Ci[64];
#pragma unroll
            for (int p = 0; p < 64; ++p) { Cr[p] = a->in[27][((size_t)dg * 16 + oc) * 64 + p]; Ci[p] = a->in[28][((size_t)dg * 16 + oc) * 64 + p]; }
            const float dsk = a->in[29][gr * 16 + oc];
            float xr = 0.f, xi = 0.f;
            for (int blk = 0; blk < SEQ / 16; ++blk) {
                { const int tt = lane >> 2, c4 = (lane & 3) * 4, step = blk * 16 + tt, pos = dir ? SEQ - 1 - step : step; const size_t row = (size_t)seq * SEQ + pos;
                  const f32x4 xv = *(const f32x4*)(X + row * D + gr * 16 + c4); const f32x4 gm = *(const f32x4*)(gmix + gr * 16 + c4); const float rsd = rstd_of(rs[row]);
                  *(LAS f32x4*)(U + tt * 16 + c4) = xv * gm * rsd; }
                __builtin_amdgcn_wave_barrier();
                for (int tt = 0; tt < 16; ++tt) {
                    float bur = 0.f, bui = 0.f;
#pragma unroll
                    for (int c = 0; c < 16; c += 4) { const f32x4 u4 = *(const LAS f32x4*)(U + tt * 16 + c);
#pragma unroll
                        for (int e = 0; e < 4; ++e) { bur += Br[c + e] * u4[e]; bui += Bi[c + e] * u4[e]; } }
                    const float nr = abr * xr - abi * xi + bur, ni = abr * xi + abi * xr + bui; xr = nr; xi = ni;
                    XS[(tt * 64 + lane) * 2] = xr; XS[(tt * 64 + lane) * 2 + 1] = xi;
                }
                __builtin_amdgcn_wave_barrier();
                for (int i = 0; i < 4; ++i) {
                    const int t = tb * 4 + i; float y = 0.f;
#pragma unroll
                    for (int p = 0; p < 64; p += 2) { const f32x4 x2 = *(const LAS f32x4*)(XS + (t * 64 + p) * 2); y += Cr[p] * x2[0] - Ci[p] * x2[1] + Cr[p + 1] * x2[2] - Ci[p + 1] * x2[3]; }
                    const int step = blk * 16 + t, pos = dir ? SEQ - 1 - step : step; const size_t row = (size_t)seq * SEQ + pos;
                    if (dir == 0) YF[row * D + gr * 16 + oc] = y;
                    else { const float yt = y + YF[row * D + gr * 16 + oc] + dsk * U[t * 16 + oc]; Y[row * D + gr * 16 + oc] = f2bf(geluf_(yt)); }
                }
                __builtin_amdgcn_wave_barrier();
            }
        }
    }
}

__device__ __forceinline__ void final_norm(ArgsCP a, const rs_t* rs) {
    const int tid = tidx(), w = tid >> 6, lane = tid & 63; const float* g = a->in[7];
    for (int row = blockIdx.x * 8 + w; row < T; row += gridDim.x * 8) {
        const float s = rstd_of(rs[row]);
#pragma unroll
        for (int q = 0; q < 8; ++q) { const int c = (q * 64 + lane) * 4; f32x4 v = *(const f32x4*)(a->out + (size_t)row * D + c); const f32x4 gv = *(const f32x4*)(g + c); v = v * gv * s; *(f32x4*)(a->out + (size_t)row * D + c) = v; }
    }
}

#ifndef MK_SINGLE
#define MK_SINGLE 0
#endif
constexpr int NPH = 90;

__global__ void __launch_bounds__(NTHR, 2) mk_fwd(Args a_unused) {
    extern __shared__ __attribute__((aligned(16))) unsigned char lds_raw[];
    LAS unsigned char* lds = (LAS unsigned char*)lds_raw;
    int ph_lo, ph_hi;
    XcdBarrier bar;
    { ArgsCP a0 = argp(); ph_lo = a0->ph_lo; ph_hi = a0->ph_hi;
      bar.bar = (unsigned*)(a0->ws + WS_CTL); bar.x = 0; bar.st = (volatile LAS unsigned*)(lds + LDS_STAGE);
      if (ph_hi - ph_lo > 1) {
          if (threadIdx.x < 4) ((LAS unsigned*)(lds + LDS_STAGE))[threadIdx.x] = 0u;
          __syncthreads();
          bar = xcd_barrier_post((unsigned*)(a0->ws + WS_CTL), (volatile LAS unsigned*)(lds + LDS_STAGE));
      } }
    int ph = 0;
#define PH_BEGIN if (ph >= ph_lo && ph < ph_hi) { ArgsCP a = argp(); unsigned char* ws = a->ws; float* X = a->out; rs_t* RS = (rs_t*)(ws + WS_RS); \
        bf16_t* XB0 = (bf16_t*)(ws + WS_XB0); bf16_t* XB1 = (bf16_t*)(ws + WS_XB1); unsigned char* BIG = ws + WS_BIG; (void)X; (void)RS; (void)XB0; (void)XB1; (void)BIG;
#define PH_END   } if (ph >= ph_lo && ph + 1 < ph_hi) xcd_barrier(bar); ++ph;
#define RSB(k) (RS + (size_t)(k) * T)

    PH_BEGIN prologue(a, lds); PH_END

#define FFN_PLE(L, XBc, XBo) \
    _Pragma("unroll 1") for (int fg = 0; fg < NFG; ++fg) { \
        const size_t r0 = (size_t)fg * FG_ROWS; \
        PH_BEGIN { EpiScale E{(bf16_t*)(BIG + BIG_GU), 2 * DFF, RSB(3 * (L) + 1) + r0, nullptr, -1}; \
                   run_gemm(lds, XBc + r0 * D, (const bf16_t*)(ws + WS_WGU + (L) * SZ_WGU), FG_ROWS, 2 * DFF, D, E); } PH_END \
        PH_BEGIN ffn_convglu(a, (L), (const bf16_t*)(BIG + BIG_GU), (bf16_t*)(BIG + BIG_HID), FG_ROWS); PH_END \
        PH_BEGIN { EpiResid E{X + r0 * D, XBc + r0 * D, RSB(3 * (L) + 2) + r0}; \
                   run_gemm(lds, (const bf16_t*)(BIG + BIG_HID), (const bf16_t*)(ws + WS_WDN + (L) * SZ_WDN), FG_ROWS, D, DFF, E); } PH_END \
    } \
    PH_BEGIN { EpiScale E{(bf16_t*)BIG, D, nullptr, nullptr, -1}; \
               run_gemm(lds, (const bf16_t*)(ws + WS_PB) + (size_t)(L) * T * PLED, (const bf16_t*)(ws + WS_WPP + (L) * SZ_WPP), T, D, PLED, E); } PH_END \
    PH_BEGIN { EpiPle E{X, XBo, RSB(3 * (L) + 3), RSB(3 * (L) + 2), (const bf16_t*)BIG}; \
               run_gemm(lds, XBc, (const bf16_t*)(ws + WS_WPG + (L) * SZ_WPG), T, D, D, E); } PH_END

    PH_BEGIN { EpiScale E{(bf16_t*)BIG, 6144, RSB(0), nullptr, -1}; run_gemm(lds, XB0, (const bf16_t*)(ws + WS_NAQ), T, 6144, D, E); } PH_END
    PH_BEGIN na_attention(a, lds, (const bf16_t*)BIG, XB1); PH_END
    PH_BEGIN { EpiResid E{X, XB0, RSB(1)}; run_gemm(lds, XB1, (const bf16_t*)(ws + WS_NAO), T, D, D, E); } PH_END
    FFN_PLE(0, XB0, XB1)
    PH_BEGIN { EpiGelu E{(bf16_t*)BIG, 4096, RSB(3), RSB(13), 8}; run_gemm(lds, XB1, (const bf16_t*)(ws + WS_SGI), T, 4096, D, E); } PH_END
    PH_BEGIN sgu_mix(a, lds, (const bf16_t*)BIG, RSB(13), XB0); PH_END
    PH_BEGIN { EpiResid E{X, XB1, RSB(4)}; run_gemm(lds, XB0, (const bf16_t*)(ws + WS_SGO), T, D, D, E); } PH_END
    FFN_PLE(1, XB1, XB0)
#pragma unroll 1
    for (int gg = 0; gg < NGG; ++gg) {
        const size_t r0 = (size_t)gg * GG_ROWS;
#define GDN_PTRS bf16_t* PROJ = (bf16_t*)(BIG + BIG_PROJ); bf16_t* OF = PROJ; bf16_t* OB = (bf16_t*)(BIG + BIG_OB); bf16_t* VP = (bf16_t*)(BIG + BIG_VP); \
        float* AB = (float*)(BIG + BIG_AB); float* GB = (float*)(BIG + BIG_GB); bf16_t* QK = XB1; (void)PROJ; (void)OF; (void)OB; (void)VP; (void)AB; (void)GB; (void)QK;
        PH_BEGIN { GDN_PTRS EpiScale E{PROJ, 8192, RSB(6) + r0, AB, 32}; run_gemm(lds, XB0 + r0 * D, (const bf16_t*)(ws + WS_GDI), GG_ROWS, GDI_N1, D, E); } PH_END
        PH_BEGIN { GDN_PTRS gdn_conv(a, PROJ, AB, QK, VP, GB, GG_ROWS); } PH_END
        PH_BEGIN { GDN_PTRS gdn_scan_naive(lds, QK, VP, GB, OF, OB, GG_ROWS / SEQ); } PH_END
        PH_BEGIN { GDN_PTRS gdn_sumnorm(a, OF, OB, GG_ROWS); } PH_END
        PH_BEGIN { GDN_PTRS EpiGdnZ E{OF, 4096, RSB(6) + r0}; run_gemm(lds, XB0 + r0 * D, (const bf16_t*)(ws + WS_GDI) + (size_t)GDI_N1 * D, GG_ROWS, 4096, D, E); } PH_END
        PH_BEGIN { GDN_PTRS EpiResid E{X + r0 * D, XB0 + r0 * D, RSB(7) + r0}; run_gemm(lds, OF, (const bf16_t*)(ws + WS_GDO), GG_ROWS, D, 4096, E); } PH_END
    }
    FFN_PLE(2, XB0, XB1)
    PH_BEGIN s5_scan(a, lds, X, RSB(9), (float*)BIG, XB0); PH_END
    PH_BEGIN { EpiGlu E{X, XB1, RSB(10)}; run_gemm(lds, XB0, (const bf16_t*)(ws + WS_S5G), T, 4096, D, E); } PH_END
    FFN_PLE(3, XB1, XB0)
    PH_BEGIN final_norm(a, RSB(12)); PH_END
}
}

extern "C" void kernel_launch(void* const* d_in, const int* in_sizes, int n_in, void* d_out, int out_size, void* d_ws, size_t ws_size, hipStream_t stream) {
    using namespace mk;
    static int grid = 0;
    if (grid == 0) {
        if (n_in != 37 || out_size != T * D || ws_size < WS_END) { fprintf(stderr, "kernel_launch: unexpected problem (n_in %d, out %d, ws %zu < %zu)\n", n_in, out_size, ws_size, (size_t)WS_END); grid = -1; return; }
        int dev = 0, cus = 0;
        if (hipGetDevice(&dev) != hipSuccess || hipDeviceGetAttribute(&cus, hipDeviceAttributeMultiprocessorCount, dev) != hipSuccess) { grid = -1; return; }
        if (hipFuncSetAttribute((const void*)mk_fwd, hipFuncAttributeMaxDynamicSharedMemorySize, LDS_BYTES) != hipSuccess) { fprintf(stderr, "kernel_launch: hipFuncSetAttribute failed\n"); grid = -1; return; }
        int per_cu = 0;
        if (hipOccupancyMaxActiveBlocksPerMultiprocessor(&per_cu, (const void*)mk_fwd, NTHR, LDS_BYTES) != hipSuccess || per_cu < 1) fprintf(stderr, "kernel_launch: occupancy query says %d\n", per_cu);
        (void)hipGetLastError();
        grid = cus > 0 ? cus : 256;
    }
    if (grid < 0) return;
    (void)hipMemsetAsync(d_ws, 0, ZERO_BYTES, stream);
    Args a{};
    for (int i = 0; i < 37; ++i) a.in[i] = (const float*)d_in[i];
    a.out = (float*)d_out; a.ws = (unsigned char*)d_ws;
#if MK_SINGLE
    a.ph_lo = 0; a.ph_hi = NPH;
    hipLaunchKernelGGL(mk_fwd, dim3(grid), dim3(NTHR), LDS_BYTES, stream, a);
#else
    for (int p = 0; p < NPH; ++p) { a.ph_lo = p; a.ph_hi = p + 1; hipLaunchKernelGGL(mk_fwd, dim3(grid), dim3(NTHR), LDS_BYTES, stream, a); }
#endif
}
```

```cpp
#include <hip/hip_runtime.h>
#include <cstdio>
#include <cstdint>
#define XB_TMO      128
#define XB_XCNT(j)  (256  + 64 * (j))
#define XB_XSUB(j)  (1280 + 64 * (j))
#define XB_XGEN(j)  (2304 + 64 * (j))
#define XB_TOP      3328
#define XB_TOPGEN   3392
#define XCD_BAR_WORDS 3456
#define XB_SPIN_CAP (1u << 18)
#define LAS __attribute__((address_space(3)))

__device__ __forceinline__ unsigned xb_ld(unsigned* p)              { return __hip_atomic_load(p, __ATOMIC_RELAXED, __HIP_MEMORY_SCOPE_AGENT); }
__device__ __forceinline__ unsigned xb_add(unsigned* p, unsigned v) { return __hip_atomic_fetch_add(p, v, __ATOMIC_RELAXED, __HIP_MEMORY_SCOPE_AGENT); }
__device__ __forceinline__ unsigned xb_xcc_id() { return (unsigned)__builtin_amdgcn_s_getreg((3 << 11) | 20) & 0xFu; }
#define XB_SPIN(cond, bar) do { unsigned _sp = 0; while (cond) { __builtin_amdgcn_s_sleep(1); \
    if ((++_sp & 255u) == 0u) { if (xb_ld(&(bar)[XB_TMO])) break; if (_sp > XB_SPIN_CAP) { atomicAdd(&(bar)[XB_TMO], 1u); break; } } } } while (0)

struct XcdBarrier {
    unsigned* bar; unsigned x;
    volatile LAS unsigned* st;
};

__device__ __forceinline__ XcdBarrier xcd_barrier_post(unsigned* bar, volatile LAS unsigned* st) {
    XcdBarrier b; b.bar = bar; b.x = xb_xcc_id(); b.st = st;
    if (threadIdx.x == 0) (void)xb_add(&bar[XB_XCNT(b.x)], 1u);
    return b;
}
__device__ __forceinline__ void xcd_barrier_complete(unsigned* bar, unsigned x, unsigned& nloc, unsigned& nx) {
    const unsigned G = gridDim.x * gridDim.y * gridDim.z;
    unsigned sum, cnt, mine, sp = 0u;
    for (;;) {
        sum = 0u; cnt = 0u; mine = 0u;
#pragma unroll
        for (unsigned j = 0; j < 16; ++j) { const unsigned c = xb_ld(&bar[XB_XCNT(j)]); sum += c; cnt += (c > 0u) ? 1u : 0u; mine = (j == x) ? c : mine; }
        if (sum == G) break;
        __builtin_amdgcn_s_sleep(1);
        if ((++sp & 255u) == 0u) { if (xb_ld(&bar[XB_TMO])) break; if (sp > XB_SPIN_CAP) { atomicAdd(&bar[XB_TMO], 1u); break; } }
    }
    nloc = mine > 0u ? mine : 1u; nx = cnt > 0u ? cnt : 1u;
}

__device__ __forceinline__ void xcd_barrier(const XcdBarrier& b) {
    asm volatile("s_waitcnt vmcnt(0)" ::: "memory");
    __syncthreads();
    if (threadIdx.x == 0) {
        unsigned* bar = b.bar;
        __builtin_amdgcn_s_waitcnt(0);
        unsigned nloc = b.st[0], nx = b.st[1];
        if (nloc == 0u) { xcd_barrier_complete(bar, b.x, nloc, nx); b.st[0] = nloc; b.st[1] = nx; }
        const unsigned old = xb_add(&bar[XB_XSUB(b.x)], 1u);
        const unsigned gen = old / nloc;
        if (old + 1u == (gen + 1u) * nloc) {
            __builtin_amdgcn_fence(__ATOMIC_RELEASE, "agent");
            asm volatile("s_waitcnt vmcnt(0)" ::: "memory");
            const unsigned og = xb_add(&bar[XB_TOP], 1u);
            const unsigned tg = og / nx;
            if (og + 1u == (tg + 1u) * nx) xb_add(&bar[XB_TOPGEN], 1u);
            else XB_SPIN(xb_ld(&bar[XB_TOPGEN]) == tg, bar);
            __builtin_amdgcn_fence(__ATOMIC_ACQUIRE, "agent");
            xb_add(&bar[XB_XGEN(b.x)], 1u);
            asm volatile("s_waitcnt vmcnt(0)" ::: "memory");
        } else {
            XB_SPIN(xb_ld(&bar[XB_XGEN(b.x)]) == gen, bar);
            __builtin_amdgcn_fence(__ATOMIC_ACQUIRE, "agent");
            asm volatile("s_waitcnt vmcnt(0)" ::: "memory");
        }
    }
    __syncthreads();
}
namespace pg8 {
#define PG8_LAS __attribute__((address_space(3)))
typedef unsigned short bf16_t;
typedef short bf16x8 __attribute__((ext_vector_type(8)));
typedef float f32x4 __attribute__((ext_vector_type(4)));
typedef unsigned u32x4 __attribute__((ext_vector_type(4)));
constexpr int BM = 256, BK = 64, HALF = 128, HTB = HALF * BK * 2  , STAGE_BYTES = 8 * HTB, NXCD = 8, WGM = 8;

__host__ __device__ __forceinline__ int lds_byte(int r, int c) { const int st = (r >> 4) * 2 + (c >> 5), rr = r & 15, cc = c & 31, ob = rr * 64 + cc * 2; return st * 1024 + (ob ^ (((ob >> 9) & 1) << 5)); }
__host__ __device__ __forceinline__ void stage_rc(int b, int& R, int& C) { const int st = b / 1024, sb = b % 1024, swz = sb ^ (((sb >> 9) & 1) << 5); R = (st >> 1) * 16 + swz / 64; C = (st & 1) * 32 + (swz % 64) / 2; }
__host__ __device__ __forceinline__ int perm32(int rho) { const int n = rho >> 4, i = rho & 15; return 8 * (i >> 2) + 4 * n + (i & 3); }

struct Unit { int pm, pn; };
struct Gemm { const bf16_t* A; const bf16_t* Bt; int M, N, K; };

struct StaticOrder {
    int nM, nN, nwg, G, c;
    __host__ __device__ void init(int M, int N, int G_, int c_) { nM = M / BM; nN = N / BM; nwg = nM * nN; G = G_; c = c_; }
    __host__ __device__ bool next(int i, Unit& u) const {
        const long L = (long)i * G + c; if (L >= nwg) return false;
        int wgid = (int)L; { const int q = nwg / NXCD, r = nwg % NXCD, xcd = wgid % NXCD, off = wgid / NXCD; wgid = (xcd < r ? xcd * (q + 1) : r * (q + 1) + (xcd - r) * q) + off; }
        const int nig = WGM * nN, gid = wgid / nig, fm = gid * WGM, gsz = (nM - fm) < WGM ? (nM - fm) : WGM;
        u.pm = fm + ((wgid % nig) % gsz); u.pn = (wgid % nig) / gsz; return true;
    }
    __device__ __forceinline__ void a_ready(const Unit&) const {}
    __device__ __forceinline__ void done(const Unit&) const {}
};


__device__ __forceinline__ unsigned cvt_pk_bf16(float lo, float hi) { unsigned r; asm volatile("v_cvt_pk_bf16_f32 %0, %1, %2" : "=v"(r) : "v"(lo), "v"(hi)); return r; }

template <class Epi, class Sched, bool ALIGN_EPI = false, bool SP2 = false>
__device__ __forceinline__ void gemm_phase(PG8_LAS unsigned char* lds, const Gemm g, const Sched& S, const Epi& E) {
    int tid_ = threadIdx.x; asm volatile("" : "+v"(tid_)); const int tid = tid_, wid = __builtin_amdgcn_readfirstlane(tid >> 6), lane = tid & 63, wr = wid >> 2, wc = wid & 3, fr = lane & 15, fq = lane >> 4;
    const int K = g.K, nt = K / BK;
    unsigned voffA[2], voffB[2];
#pragma unroll
    for (int i = 0; i < 2; ++i) { int R, C; stage_rc(tid * 16 + i * 8192, R, C); const int Rb = Epi::PERM ? ((R & ~31) + perm32(R & 31)) : R;
        voffA[i] = (unsigned)(R * K + C) * 2u; voffB[i] = (unsigned)(Rb * K + C) * 2u; }
    const size_t kstep = (size_t)(BK * 2);
    const size_t hstep = (size_t)HALF * K * 2;
    const size_t tstep = 2 * hstep;
    const unsigned ldsw = (unsigned)wid * 1024u;
    const int aoff = lds_byte(wr * 64 + fr, fq * 8), boff = lds_byte(wc * 32 + fr, fq * 8);
#define PG8_SA(b, h) (((b) * 2 + (h)) * HTB)
#define PG8_SB(b, h) ((4 + (b) * 2 + (h)) * HTB)
#define PG8_STAGE(bufoff, gbase, voff) do { _Pragma("unroll") for (int _i = 0; _i < 2; ++_i) \
        __builtin_amdgcn_global_load_lds((const unsigned*)((const char*)(gbase) + (voff)[_i]), (PG8_LAS unsigned*)(lds + (bufoff) + ldsw + _i * 8192), 16, 0, 0); } while (0)
#define PG8_LDA(dst, b, h) do { _Pragma("unroll") for (int m = 0; m < 4; ++m) _Pragma("unroll") for (int k = 0; k < 2; ++k) dst[m][k] = *(const PG8_LAS bf16x8*)(lds + PG8_SA(b, h) + aoff + m * 2048 + k * 1024); } while (0)
#define PG8_LDB(dst, b, h) do { _Pragma("unroll") for (int n = 0; n < 2; ++n) _Pragma("unroll") for (int k = 0; k < 2; ++k) dst[n][k] = *(const PG8_LAS bf16x8*)(lds + PG8_SB(b, h) + boff + n * 2048 + k * 1024); } while (0)
#define PG8_MMA(ai, bj, At, Bt) do { __builtin_amdgcn_s_setprio(1); _Pragma("unroll") for (int m = 0; m < 4; ++m) _Pragma("unroll") for (int n = 0; n < 2; ++n) _Pragma("unroll") for (int k = 0; k < 2; ++k) \
        acc[ai][bj][m][n] = __builtin_amdgcn_mfma_f32_16x16x32_bf16(Bt[n][k], At[m][k], acc[ai][bj][m][n], 0, 0, 0); __builtin_amdgcn_s_setprio(0); } while (0)
#define PG8_WAIT_V(n) asm volatile("s_waitcnt vmcnt(" #n ")" ::: "memory")
#define PG8_WAIT_L(n) asm volatile("s_waitcnt lgkmcnt(" #n ")" ::: "memory")
#define PG8_BAR __builtin_amdgcn_s_barrier()
#define PG8_SCHED __builtin_amdgcn_sched_barrier(0)
    Unit cur, nxt; int ui = 0;
    if (!S.next(0, cur)) return;
    f32x4 acc[2][2][4][2];
#pragma unroll
    for (int a = 0; a < 2; ++a)
#pragma unroll
        for (int b = 0; b < 2; ++b)
#pragma unroll
            for (int m = 0; m < 4; ++m)
#pragma unroll
                for (int n = 0; n < 2; ++n) acc[a][b][m][n] = (f32x4){0.f, 0.f, 0.f, 0.f};
    bf16x8 At[4][2], B0[2][2], B1[2][2];
    const char* cA = (const char*)g.A + (size_t)cur.pm * tstep; const char* cB = (const char*)g.Bt + (size_t)cur.pn * tstep;
    S.a_ready(cur);
    if constexpr (SP2) {
        PG8_STAGE(PG8_SB(0, 0), cB, voffB); PG8_STAGE(PG8_SB(0, 1), cB + hstep, voffB); PG8_STAGE(PG8_SA(0, 0), cA, voffA); PG8_STAGE(PG8_SA(0, 1), cA + hstep, voffA);
        if (wr == 1) PG8_BAR;
        PG8_WAIT_V(2); PG8_BAR;
        PG8_STAGE(PG8_SB(1, 0), cB + kstep, voffB); PG8_STAGE(PG8_SA(1, 0), cA + kstep, voffA); PG8_STAGE(PG8_SB(1, 1), cB + hstep + kstep, voffB);
        PG8_WAIT_V(6); PG8_BAR;
    } else {
        PG8_STAGE(PG8_SB(0, 0), cB, voffB); PG8_STAGE(PG8_SA(0, 0), cA, voffA); PG8_STAGE(PG8_SB(0, 1), cB + hstep, voffB); PG8_STAGE(PG8_SA(0, 1), cA + hstep, voffA);
        if (wr == 1) PG8_BAR;
        PG8_WAIT_V(4); PG8_BAR;
        PG8_STAGE(PG8_SB(1, 0), cB + kstep, voffB); PG8_STAGE(PG8_SA(1, 0), cA + kstep, voffA); PG8_STAGE(PG8_SB(1, 1), cB + hstep + kstep, voffB);
        PG8_WAIT_V(6); PG8_BAR;
    }
    for (;;) {
        const bool has_next = S.next(ui + 1, nxt);
        const char* nA = has_next ? (const char*)g.A + (size_t)nxt.pm * tstep : cA; const char* nB = has_next ? (const char*)g.Bt + (size_t)nxt.pn * tstep : cB;
        for (int t = 0; t < nt; t += 2) {
            const bool last = (t == nt - 2);
            const char* a1 = cA + (size_t)(t + 1) * kstep;
            const char* a2 = last ? nA : cA + (size_t)(t + 2) * kstep; const char* b2 = last ? nB : cB + (size_t)(t + 2) * kstep;
            const char* a3 = a2 + kstep; const char* b3 = b2 + kstep;
            if (last && has_next) S.a_ready(nxt);
            if constexpr (SP2) {
            PG8_LDB(B0, 0, 0); PG8_LDB(B1, 0, 1); PG8_SCHED; PG8_LDA(At, 0, 0); PG8_STAGE(PG8_SA(1, 1), a1 + hstep, voffA);
            PG8_WAIT_V(8); PG8_WAIT_L(0); PG8_BAR; PG8_MMA(0, 0, At, B0); PG8_MMA(0, 1, At, B1); PG8_BAR; PG8_SCHED;
            PG8_LDA(At, 0, 1); PG8_STAGE(PG8_SB(0, 0), b2, voffB); PG8_STAGE(PG8_SB(0, 1), b2 + hstep, voffB); PG8_STAGE(PG8_SA(0, 0), a2, voffA);
            PG8_WAIT_V(8); PG8_WAIT_L(0); PG8_BAR; PG8_MMA(1, 0, At, B0); PG8_MMA(1, 1, At, B1); PG8_BAR; PG8_SCHED;
            PG8_LDB(B0, 1, 0); PG8_LDB(B1, 1, 1); PG8_SCHED; PG8_LDA(At, 1, 0); PG8_STAGE(PG8_SA(0, 1), a2 + hstep, voffA);
            PG8_WAIT_V(8); PG8_WAIT_L(0); PG8_BAR; PG8_MMA(0, 0, At, B0); PG8_MMA(0, 1, At, B1); PG8_BAR; PG8_SCHED;
            PG8_LDA(At, 1, 1); PG8_STAGE(PG8_SB(1, 0), b3, voffB); PG8_STAGE(PG8_SB(1, 1), b3 + hstep, voffB); PG8_STAGE(PG8_SA(1, 0), a3, voffA);
            PG8_WAIT_V(8); PG8_WAIT_L(0); PG8_BAR; PG8_MMA(1, 0, At, B0); PG8_MMA(1, 1, At, B1); PG8_BAR; PG8_SCHED;
            } else {
            PG8_LDB(B0, 0, 0); PG8_SCHED; PG8_LDA(At, 0, 0); PG8_STAGE(PG8_SA(1, 1), a1 + hstep, voffA);
            PG8_WAIT_L(8); PG8_BAR; PG8_WAIT_L(0); PG8_MMA(0, 0, At, B0); PG8_BAR; PG8_SCHED;
            PG8_LDB(B1, 0, 1); PG8_STAGE(PG8_SB(0, 0), b2, voffB);
            PG8_BAR; PG8_WAIT_L(0); PG8_MMA(0, 1, At, B1); PG8_BAR;
            PG8_LDA(At, 0, 1); PG8_STAGE(PG8_SA(0, 0), a2, voffA);
            PG8_BAR; PG8_WAIT_L(0); PG8_MMA(1, 0, At, B0); PG8_BAR; PG8_SCHED;
            PG8_STAGE(PG8_SB(0, 1), b2 + hstep, voffB);
            PG8_WAIT_V(6); PG8_BAR; PG8_MMA(1, 1, At, B1); PG8_BAR;
            PG8_LDB(B0, 1, 0); PG8_SCHED; PG8_LDA(At, 1, 0); PG8_STAGE(PG8_SA(0, 1), a2 + hstep, voffA);
            PG8_WAIT_L(8); PG8_BAR; PG8_WAIT_L(0); PG8_MMA(0, 0, At, B0); PG8_BAR; PG8_SCHED;
            PG8_LDB(B1, 1, 1); PG8_STAGE(PG8_SB(1, 0), b3, voffB);
            PG8_BAR; PG8_WAIT_L(0); PG8_MMA(0, 1, At, B1); PG8_BAR;
            PG8_LDA(At, 1, 1); PG8_STAGE(PG8_SA(1, 0), a3, voffA);
            PG8_BAR; PG8_WAIT_L(0); PG8_MMA(1, 0, At, B0); PG8_BAR; PG8_SCHED;
            PG8_STAGE(PG8_SB(1, 1), b3 + hstep, voffB);
            PG8_WAIT_V(6); PG8_BAR; PG8_MMA(1, 1, At, B1); PG8_BAR;
            }
        }
        if constexpr (ALIGN_EPI) { if (wr == 0) PG8_BAR; }
        if constexpr (!Epi::AFTER_DRAIN) { E(acc, cur, wr, wc, fr, fq); S.done(cur); }
        if (!has_next) break;
#pragma unroll
        for (int a = 0; a < 2; ++a)
#pragma unroll
            for (int b = 0; b < 2; ++b)
#pragma unroll
                for (int m = 0; m < 4; ++m)
#pragma unroll
                    for (int n = 0; n < 2; ++n) acc[a][b][m][n] = (f32x4){0.f, 0.f, 0.f, 0.f};
        cur = nxt; cA = nA; cB = nB; ++ui;
        if constexpr (ALIGN_EPI) { if (wr == 1) PG8_BAR; }
    }
    PG8_WAIT_V(0);
    if constexpr (!ALIGN_EPI) { if (wr == 0) PG8_BAR; }
    PG8_BAR;
    if constexpr (Epi::AFTER_DRAIN) { E.fused(acc, cur, wr, wc, fr, fq, lds, wid, lane); S.done(cur); }
#undef PG8_SA
#undef PG8_SB
#undef PG8_STAGE
#undef PG8_LDA
#undef PG8_LDB
#undef PG8_MMA
#undef PG8_WAIT_V
#undef PG8_WAIT_L
#undef PG8_BAR
#undef PG8_SCHED
}
}

namespace mk {
using pg8::bf16_t; using pg8::f32x4; using pg8::u32x4; using pg8::Unit;
typedef unsigned u32x2 __attribute__((ext_vector_type(2)));
constexpr int D = 2048, T = 40960, NSEQ = 10, SEQ = 4096, DFF = 5632, PLED = 256;
constexpr float EPS = 1e-6f;
constexpr int NTHR = 512;

constexpr size_t AL(size_t x) { return (x + 255) & ~size_t(255); }
constexpr size_t WS_CTL = 0, CTL_BYTES = 65536;
constexpr int NRS = 14;
constexpr size_t WS_RS = WS_CTL + CTL_BYTES, RS_BYTES = (size_t)NRS * T * 8;
constexpr size_t ZERO_BYTES = WS_RS + RS_BYTES;
constexpr size_t SZ_WGU = (size_t)2 * DFF * D * 2, SZ_WDN = (size_t)D * DFF * 2, SZ_WPG = (size_t)D * D * 2, SZ_WPP = (size_t)D * PLED * 2;
constexpr size_t WS_WGU = AL(ZERO_BYTES);
constexpr size_t WS_WDN = WS_WGU + 4 * SZ_WGU;
constexpr size_t WS_WPG = WS_WDN + 4 * SZ_WDN;
constexpr size_t WS_WPP = WS_WPG + 4 * SZ_WPG;
constexpr size_t WS_NAQ = WS_WPP + 4 * SZ_WPP;
constexpr size_t WS_NAO = WS_NAQ + (size_t)6144 * D * 2;
constexpr size_t WS_SGI = WS_NAO + (size_t)D * D * 2;
constexpr size_t WS_SGO = WS_SGI + (size_t)4096 * D * 2;
constexpr int    GDI_N = 12544, GDI_N1 = 8448;
constexpr size_t WS_GDI = WS_SGO + (size_t)D * D * 2;
constexpr size_t WS_GDO = WS_GDI + (size_t)GDI_N * D * 2;
constexpr size_t WS_S5G = WS_GDO + (size_t)D * 4096 * 2;
constexpr size_t WS_PB  = WS_S5G + (size_t)4096 * D * 2;
constexpr size_t WS_XB0 = WS_PB + (size_t)4 * T * PLED * 2;
constexpr size_t WS_XB1 = WS_XB0 + (size_t)T * D * 2;
constexpr size_t WS_BIG = WS_XB1 + (size_t)T * D * 2;
constexpr size_t BIG_BYTES = 524288000;
constexpr size_t WS_END = WS_BIG + BIG_BYTES;
constexpr int FG_ROWS = 8192, NFG = 5;
constexpr size_t BIG_GU = 0, BIG_HID = (size_t)FG_ROWS * 2 * DFF * 2;
constexpr int GG_ROWS = 20480, NGG = 2;
constexpr size_t BIG_PROJ = 0, BIG_OB = (size_t)GG_ROWS * 4096 * 2, BIG_VP = (size_t)GG_ROWS * 8192 * 2, BIG_AB = BIG_VP + (size_t)GG_ROWS * 4096 * 2, BIG_GB = BIG_AB + (size_t)GG_ROWS * 128 * 4;
static_assert(BIG_GB + (size_t)GG_ROWS * 128 * 4 <= BIG_BYTES, "BIG");
static_assert((size_t)T * 6144 * 2 <= BIG_BYTES, "BIG");

constexpr int LDS_STAGE = 131072, LDS_BYTES = LDS_STAGE + 1024;

struct Args { const float* in[37]; float* out; unsigned char* ws; int ph_lo, ph_hi; };
typedef const Args __attribute__((address_space(4)))* ArgsCP;
__device__ __forceinline__ ArgsCP argp() { ArgsCP p = (ArgsCP)__builtin_amdgcn_kernarg_segment_ptr(); asm volatile("" : "+s"(p)); return p; }
__device__ __forceinline__ int tidx() { int t = threadIdx.x; asm volatile("" : "+v"(t)); return t; }

__device__ __forceinline__ float bf2f(bf16_t b) { return __uint_as_float(((unsigned)b) << 16); }
__device__ __forceinline__ float blo(unsigned w) { return __uint_as_float(w << 16); }
__device__ __forceinline__ float bhi(unsigned w) { return __uint_as_float(w & 0xffff0000u); }
__device__ __forceinline__ unsigned pk2(float lo, float hi) { return pg8::cvt_pk_bf16(lo, hi); }
__device__ __forceinline__ bf16_t f2bf(float f) { return (bf16_t)(pk2(f, 0.f) & 0xffffu); }
typedef unsigned long long rs_t;
__device__ __forceinline__ float rs_val(rs_t v) { return (float)(unsigned)(v >> 24) + (float)(unsigned)(v & 0xffffffull) * (1.0f / 16777216.0f); }
__device__ __forceinline__ rs_t rs_fix(float ss) { return (rs_t)__float2ull_rn(ss * 16777216.0f); }
__device__ __forceinline__ void rs_add(rs_t* p, float ss) { atomicAdd(p, rs_fix(ss)); }
__device__ __forceinline__ float rstd_of(rs_t v) { return rsqrtf(rs_val(v) * (1.0f / (float)D) + EPS); }
__device__ __forceinline__ float sigmoidf_(float x) { return __builtin_amdgcn_rcpf(1.0f + __expf(-x)); }
__device__ __forceinline__ float siluf_(float x) { return x * sigmoidf_(x); }
__device__ __forceinline__ float geluf_(float x) { const float z = 1.5957691216f * (x + 0.044715f * x * x * x); return x * sigmoidf_(z); }
__device__ __forceinline__ void unpack8(const u32x4 w, float (&v)[8]) { v[0] = blo(w.x); v[1] = bhi(w.x); v[2] = blo(w.y); v[3] = bhi(w.y); v[4] = blo(w.z); v[5] = bhi(w.z); v[6] = blo(w.w); v[7] = bhi(w.w); }
__device__ __forceinline__ u32x4 pack8(const float (&v)[8]) { u32x4 w; w.x = pk2(v[0], v[1]); w.y = pk2(v[2], v[3]); w.z = pk2(v[4], v[5]); w.w = pk2(v[6], v[7]); return w; }
__device__ __forceinline__ float wave_sum(float v) {
#pragma unroll
    for (int o = 32; o > 0; o >>= 1) v += __shfl_xor(v, o);
    return v; }
__device__ __forceinline__ float wave_max(float v) {
#pragma unroll
    for (int o = 32; o > 0; o >>= 1) v = fmaxf(v, __shfl_xor(v, o));
    return v; }

typedef const f32x4 (&AccT)[2][2][4][2];

struct EpiScale {
    static constexpr bool PERM = true, AFTER_DRAIN = false;
    bf16_t* O; int ldc; const rs_t* rs; float* ab; int ab_pn;
    __device__ __forceinline__ void operator()(AccT acc, const Unit& u, int wr, int wc, int fr, int fq) const {
        const int row0 = u.pm * 256 + wr * 64 + fr, colw = wc * 32 + 8 * fq;
        const bool side = (ab != nullptr) && (u.pn == ab_pn);
#pragma unroll
        for (int ai = 0; ai < 2; ++ai)
#pragma unroll
            for (int m = 0; m < 4; ++m) {
                const int row = row0 + ai * 128 + m * 16;
                const float s = rs ? rstd_of(rs[row]) : 1.0f;
#pragma unroll
                for (int bj = 0; bj < 2; ++bj) {
                    const f32x4 v0 = acc[ai][bj][m][0] * s, v1 = acc[ai][bj][m][1] * s;
                    if (side) { if (bj == 0) { float* p = ab + (size_t)row * 128 + colw; *(f32x4*)p = v0; *(f32x4*)(p + 4) = v1; } }
                    else { u32x4 w; w.x = pk2(v0[0], v0[1]); w.y = pk2(v0[2], v0[3]); w.z = pk2(v1[0], v1[1]); w.w = pk2(v1[2], v1[3]);
                           *(u32x4*)(O + (size_t)row * ldc + u.pn * 256 + bj * 128 + colw) = w; }
                }
            }
    }
};
struct EpiGelu {
    static constexpr bool PERM = true, AFTER_DRAIN = false;
    bf16_t* O; int ldc; const rs_t* rs; rs_t* rsv; int vtile0;
    __device__ __forceinline__ void operator()(AccT acc, const Unit& u, int wr, int wc, int fr, int fq) const {
        const int row0 = u.pm * 256 + wr * 64 + fr, colw = wc * 32 + 8 * fq;
        const bool isv = u.pn >= vtile0;
#pragma unroll
        for (int ai = 0; ai < 2; ++ai)
#pragma unroll
            for (int m = 0; m < 4; ++m) {
                const int row = row0 + ai * 128 + m * 16;
                const float s = rstd_of(rs[row]); float ss = 0.f;
#pragma unroll
                for (int bj = 0; bj < 2; ++bj) {
                    float v[8];
#pragma unroll
                    for (int j = 0; j < 4; ++j) { v[j] = geluf_(acc[ai][bj][m][0][j] * s); v[4 + j] = geluf_(acc[ai][bj][m][1][j] * s); }
#pragma unroll
                    for (int j = 0; j < 8; ++j) ss += v[j] * v[j];
                    *(u32x4*)(O + (size_t)row * ldc + u.pn * 256 + bj * 128 + colw) = pack8(v);
                }
                if (isv) { ss += __shfl_xor(ss, 16); ss += __shfl_xor(ss, 32); if (fq == 0) rs_add(rsv + row, ss); }
            }
    }
};
__device__ __forceinline__ float put_x(float* X, bf16_t* XB, size_t off, const float (&xn)[8]) {
    *(f32x4*)(X + off) = (f32x4){xn[0], xn[1], xn[2], xn[3]}; *(f32x4*)(X + off + 4) = (f32x4){xn[4], xn[5], xn[6], xn[7]};
    *(u32x4*)(XB + off) = pack8(xn);
    float ss = 0.f;
#pragma unroll
    for (int j = 0; j < 8; ++j) ss += xn[j] * xn[j];
    return ss;
}
struct EpiResid {
    static constexpr bool PERM = true, AFTER_DRAIN = false;
    float* X; bf16_t* XB; rs_t* rsq;
    __device__ __forceinline__ void operator()(AccT acc, const Unit& u, int wr, int wc, int fr, int fq) const {
        const int row0 = u.pm * 256 + wr * 64 + fr, colw = wc * 32 + 8 * fq;
#pragma unroll
        for (int ai = 0; ai < 2; ++ai)
#pragma unroll
            for (int m = 0; m < 4; ++m) {
                const int row = row0 + ai * 128 + m * 16; float ss = 0.f;
#pragma unroll
                for (int bj = 0; bj < 2; ++bj) {
                    const size_t off = (size_t)row * D + u.pn * 256 + bj * 128 + colw;
                    const f32x4 x0 = *(const f32x4*)(X + off), x1 = *(const f32x4*)(X + off + 4);
                    float xn[8];
#pragma unroll
                    for (int j = 0; j < 4; ++j) { xn[j] = x0[j] + acc[ai][bj][m][0][j]; xn[4 + j] = x1[j] + acc[ai][bj][m][1][j]; }
                    ss += put_x(X, XB, off, xn);
                }
                ss += __shfl_xor(ss, 16); ss += __shfl_xor(ss, 32); if (fq == 0) rs_add(rsq + row, ss);
            }
    }
};
struct EpiPle {
    static constexpr bool PERM = true, AFTER_DRAIN = false;
    float* X; bf16_t* XB; rs_t* rsq; const rs_t* rs_in; const bf16_t* PP;
    __device__ __forceinline__ void operator()(AccT acc, const Unit& u, int wr, int wc, int fr, int fq) const {
        const int row0 = u.pm * 256 + wr * 64 + fr, colw = wc * 32 + 8 * fq;
#pragma unroll
        for (int ai = 0; ai < 2; ++ai)
#pragma unroll
            for (int m = 0; m < 4; ++m) {
                const int row = row0 + ai * 128 + m * 16; float ss = 0.f; const float s = rstd_of(rs_in[row]);
#pragma unroll
                for (int bj = 0; bj < 2; ++bj) {
                    const size_t off = (size_t)row * D + u.pn * 256 + bj * 128 + colw;
                    const f32x4 x0 = *(const f32x4*)(X + off), x1 = *(const f32x4*)(X + off + 4);
                    float pv[8]; unpack8(*(const u32x4*)(PP + off), pv);
                    float xn[8];
#pragma unroll
                    for (int j = 0; j < 4; ++j) { xn[j] = x0[j] + sigmoidf_(acc[ai][bj][m][0][j] * s) * pv[j]; xn[4 + j] = x1[j] + sigmoidf_(acc[ai][bj][m][1][j] * s) * pv[4 + j]; }
                    ss += put_x(X, XB, off, xn);
                }
                ss += __shfl_xor(ss, 16); ss += __shfl_xor(ss, 32); if (fq == 0) rs_add(rsq + row, ss);
            }
    }
};
struct EpiGlu {
    static constexpr bool PERM = true, AFTER_DRAIN = false;
    float* X; bf16_t* XB; rs_t* rsq;
    __device__ __forceinline__ void operator()(AccT acc, const Unit& u, int wr, int wc, int fr, int fq) const {
        const int row0 = u.pm * 256 + wr * 64 + fr, colw = wc * 32 + 8 * fq;
#pragma unroll
        for (int ai = 0; ai < 2; ++ai)
#pragma unroll
            for (int m = 0; m < 4; ++m) {
                const int row = row0 + ai * 128 + m * 16;
                const size_t off = (size_t)row * D + u.pn * 128 + colw;
                const f32x4 x0 = *(const f32x4*)(X + off), x1 = *(const f32x4*)(X + off + 4);
                float xn[8];
#pragma unroll
                for (int j = 0; j < 4; ++j) { xn[j] = x0[j] + acc[ai][0][m][0][j] * sigmoidf_(acc[ai][1][m][0][j]); xn[4 + j] = x1[j] + acc[ai][0][m][1][j] * sigmoidf_(acc[ai][1][m][1][j]); }
                float ss = put_x(X, XB, off, xn);
                ss += __shfl_xor(ss, 16); ss += __shfl_xor(ss, 32); if (fq == 0) rs_add(rsq + row, ss);
            }
    }
};
struct EpiGdnZ {
    static constexpr bool PERM = true, AFTER_DRAIN = false;
    bf16_t* O; int ldc; const rs_t* rs;
    __device__ __forceinline__ void operator()(AccT acc, const Unit& u, int wr, int wc, int fr, int fq) const {
        const int row0 = u.pm * 256 + wr * 64 + fr, colw = wc * 32 + 8 * fq;
#pragma unroll
        for (int ai = 0; ai < 2; ++ai)
#pragma unroll
            for (int m = 0; m < 4; ++m) {
                const int row = row0 + ai * 128 + m * 16; const float s = rstd_of(rs[row]);
#pragma unroll
                for (int bj = 0; bj < 2; ++bj) {
                    bf16_t* p = O + (size_t)row * ldc + u.pn * 256 + bj * 128 + colw;
                    float ov[8]; unpack8(*(const u32x4*)p, ov);
#pragma unroll
                    for (int j = 0; j < 4; ++j) { ov[j] *= siluf_(acc[ai][bj][m][0][j] * s); ov[4 + j] *= siluf_(acc[ai][bj][m][1][j] * s); }
                    *(u32x4*)p = pack8(ov);
                }
            }
    }
};

template <class Epi>
__device__ __forceinline__ void run_gemm(LAS unsigned char* lds, const bf16_t* A, const bf16_t* Bt, int M, int N, int K, const Epi& E) {
    pg8::Gemm g{A, Bt, M, N, K}; pg8::StaticOrder S; S.init(M, N, (int)gridDim.x, (int)blockIdx.x);
    pg8::gemm_phase<Epi, pg8::StaticOrder, true, true>(lds, g, S, E);
}

struct Job { const float* src; bf16_t* dst; const float* gain; int K, Nsrc, Ndst, map, qcols; };
__device__ __forceinline__ void get_job(ArgsCP a, int j, Job& J) {
    unsigned char* ws = a->ws; J.gain = nullptr; J.map = 0; J.qcols = 0;
    if (j < 16) { const int L = j >> 2, k = j & 3;
        if (k == 0)      { J.src = a->in[31] + (size_t)L * D * 2 * DFF; J.dst = (bf16_t*)(ws + WS_WGU + L * SZ_WGU); J.gain = a->in[5] + L * D; J.K = D; J.Nsrc = 2 * DFF; J.Ndst = 2 * DFF; J.map = 1; }
        else if (k == 1) { J.src = a->in[34] + (size_t)L * DFF * D;     J.dst = (bf16_t*)(ws + WS_WDN + L * SZ_WDN); J.K = DFF; J.Nsrc = D; J.Ndst = D; }
        else if (k == 2) { J.src = a->in[36] + (size_t)L * D * D;       J.dst = (bf16_t*)(ws + WS_WPG + L * SZ_WPG); J.gain = a->in[6] + L * D; J.K = D; J.Nsrc = D; J.Ndst = D; }
        else             { J.src = a->in[35] + (size_t)L * PLED * D;    J.dst = (bf16_t*)(ws + WS_WPP + L * SZ_WPP); J.K = PLED; J.Nsrc = D; J.Ndst = D; }
    } else switch (j) {
        case 16: J.src = a->in[8];  J.dst = (bf16_t*)(ws + WS_NAQ); J.gain = a->in[4] + 0 * D; J.K = D; J.Nsrc = 6144; J.Ndst = 6144; J.qcols = 2048; break;
        case 17: J.src = a->in[9];  J.dst = (bf16_t*)(ws + WS_NAO); J.K = D; J.Nsrc = D; J.Ndst = D; break;
        case 18: J.src = a->in[11]; J.dst = (bf16_t*)(ws + WS_SGI); J.gain = a->in[4] + 1 * D; J.K = D; J.Nsrc = 4096; J.Ndst = 4096; break;
        case 19: J.src = a->in[15]; J.dst = (bf16_t*)(ws + WS_SGO); J.K = D; J.Nsrc = D; J.Ndst = D; break;
        case 20: J.src = a->in[16]; J.dst = (bf16_t*)(ws + WS_GDI); J.gain = a->in[4] + 2 * D; J.K = D; J.Nsrc = 12416; J.Ndst = GDI_N; J.map = 2; break;
        case 21: J.src = a->in[21]; J.dst = (bf16_t*)(ws + WS_GDO); J.K = 4096; J.Nsrc = D; J.Ndst = D; break;
        default: J.src = a->in[30]; J.dst = (bf16_t*)(ws + WS_S5G); J.K = D; J.Nsrc = 4096; J.Ndst = 4096; J.map = 1; break;
    }
}
__device__ __forceinline__ int map_col(const Job& J, int n0) {
    if (J.map == 0) return n0;
    if (J.map == 1) { const int tile = n0 >> 8, w = n0 & 255, H = J.Nsrc >> 1; return w < 128 ? tile * 128 + w : H + tile * 128 + (w - 128); }
    if (n0 < 8192) return n0;
    if (n0 < 8320) return 12288 + (n0 - 8192);
    if (n0 < GDI_N1) return -1;
    return 8192 + (n0 - GDI_N1);
}
__device__ __forceinline__ void prologue(ArgsCP a, LAS unsigned char* lds) {
    const int tid = tidx(), G = gridDim.x, bid = blockIdx.x;
    LAS float* tile = (LAS float*)lds;
    int base = 0;
    for (int j = 0; j < 23; ++j) {
        Job J; get_job(a, j, J);
        const int kt = J.K >> 6, ntl = J.Ndst >> 6, nt = kt * ntl;
        int first = (bid - (base % G) + G) % G;
        for (int i = first; i < nt; i += G) {
            const int nb = i / kt, kb = i - nb * kt, n0 = nb * 64, k0 = kb * 64, s0 = map_col(J, n0);
            const float cs = (n0 < J.qcols) ? 0.08838834764831845f : 1.0f;
            const int kk = tid >> 4, nn4 = (tid & 15) * 4;
#pragma unroll
            for (int p = 0; p < 2; ++p) {
                const int k = k0 + kk + 32 * p;
                f32x4 v = (f32x4){0.f, 0.f, 0.f, 0.f};
                if (s0 >= 0) v = *(const f32x4*)(J.src + (size_t)k * J.Nsrc + s0 + nn4);
                const float sc = (J.gain ? J.gain[k] : 1.0f) * cs;
#pragma unroll
                for (int q = 0; q < 4; ++q) tile[(nn4 + q) * 65 + kk + 32 * p] = v[q] * sc;
            }
            __syncthreads();
            { const int nn = tid >> 3, kk8 = (tid & 7) * 8; float v[8];
#pragma unroll
              for (int q = 0; q < 8; ++q) v[q] = tile[nn * 65 + kk8 + q];
              *(u32x4*)(J.dst + (size_t)(n0 + nn) * J.K + k0 + kk8) = pack8(v); }
            __syncthreads();
        }
        base += nt;
    }
    { bf16_t* PB = (bf16_t*)(a->ws + WS_PB);
      const long total = (long)4 * T * 64;
      for (long i = (long)bid * NTHR + tid; i < total; i += (long)G * NTHR) {
          const int L = (int)(i / ((long)T * 64)); const int rem = (int)(i - (long)L * T * 64); const int row = rem >> 6, c4 = (rem & 63) * 4;
          const float* src = row < 8192 ? a->in[2] + ((size_t)L * 8192 + row) * PLED + c4 : a->in[3] + ((size_t)L * 32768 + (row - 8192)) * PLED + c4;
          const f32x4 v = *(const f32x4*)src; u32x2 w; w.x = pk2(v[0], v[1]); w.y = pk2(v[2], v[3]);
          *(u32x2*)(PB + ((size_t)L * T + row) * PLED + c4) = w; } }
    { bf16_t* XB = (bf16_t*)(a->ws + WS_XB0); rs_t* rs = (rs_t*)(a->ws + WS_RS);
      const int w = tid >> 6, lane = tid & 63;
      for (int row = bid * 8 + w; row < T; row += G * 8) {
          const float* src = row < 8192 ? a->in[0] + (size_t)row * D : a->in[1] + (size_t)(row - 8192) * D;
          float ss = 0.f;
#pragma unroll
          for (int q = 0; q < 8; ++q) { const int c = (q * 64 + lane) * 4; const f32x4 v = *(const f32x4*)(src + c);
              *(f32x4*)(a->out + (size_t)row * D + c) = v; u32x2 wv; wv.x = pk2(v[0], v[1]); wv.y = pk2(v[2], v[3]); *(u32x2*)(XB + (size_t)row * D + c) = wv;
              ss += v[0] * v[0] + v[1] * v[1] + v[2] * v[2] + v[3] * v[3]; }
          ss = wave_sum(ss); if (lane == 0) rs[row] = rs_fix(ss); } }
}

__device__ __forceinline__ void na_attention(ArgsCP a, LAS unsigned char* lds, const bf16_t* QKV, bf16_t* AO) {
    const int tid = tidx(), w = tid >> 6, lane = tid & 63;
    LAS float* qs = (LAS float*)(lds + w * 1024); LAS float* ps = qs + 128;
    const float* rpb = a->in[10];
    for (long task = (long)blockIdx.x * 8 + w; task < (long)T * 16; task += (long)gridDim.x * 8) {
        const int seq = (int)(task >> 16), rem = (int)(task & 65535), h = rem >> 12, pos = rem & 4095, r = pos >> 6, c = pos & 63;
        const int r0 = min(max(r - 4, 0), 56), c0 = min(max(c - 8, 0), 48);
        const size_t trow = (size_t)seq * SEQ + pos;
        { const unsigned qq = *(const unsigned*)(QKV + trow * 6144 + h * 128 + 2 * lane); qs[2 * lane] = blo(qq); qs[2 * lane + 1] = bhi(qq); }
        __builtin_amdgcn_wave_barrier();
        float s[2];
#pragma unroll
        for (int kk = 0; kk < 2; ++kk) {
            const int j = lane + 64 * kk, kr = r0 + (j >> 4), kc = c0 + (j & 15);
            const u32x4* kp = (const u32x4*)(QKV + ((size_t)seq * SEQ + kr * 64 + kc) * 6144 + 2048 + h * 128);
            float acc = 0.f;
#pragma unroll 4
            for (int d8 = 0; d8 < 16; ++d8) { const u32x4 kv = kp[d8]; const f32x4 q0 = *(const LAS f32x4*)(qs + d8 * 8), q1 = *(const LAS f32x4*)(qs + d8 * 8 + 4);
                acc += q0[0] * blo(kv.x) + q0[1] * bhi(kv.x) + q0[2] * blo(kv.y) + q0[3] * bhi(kv.y) + q1[0] * blo(kv.z) + q1[1] * bhi(kv.z) + q1[2] * blo(kv.w) + q1[3] * bhi(kv.w); }
            s[kk] = acc + rpb[(h * 15 + (kr - r + 7)) * 31 + (kc - c + 15)];
        }
        const float mx = wave_max(fmaxf(s[0], s[1]));
        const float e0 = __expf(s[0] - mx), e1 = __expf(s[1] - mx);
        const float inv = 1.0f / wave_sum(e0 + e1);
        ps[lane] = e0 * inv; ps[lane + 64] = e1 * inv;
        __builtin_amdgcn_wave_barrier();
        float o0 = 0.f, o1 = 0.f;
        const bf16_t* vb = QKV + ((size_t)seq * SEQ) * 6144 + 4096 + h * 128 + 2 * lane;
#pragma unroll 4
        for (int j = 0; j < 128; ++j) { const int kr = r0 + (j >> 4), kc = c0 + (j & 15);
            const unsigned vv = *(const unsigned*)(vb + (size_t)(kr * 64 + kc) * 6144); const float p = ps[j]; o0 += p * blo(vv); o1 += p * bhi(vv); }
        *(unsigned*)(AO + trow * D + h * 128 + 2 * lane) = pk2(o0, o1);
        __builtin_amdgcn_wave_barrier();
    }
}

__device__ __forceinline__ void sgu_mix(ArgsCP a, LAS unsigned char* lds, const bf16_t* UV, const rs_t* rsv, bf16_t* MX) {
    const int tid = tidx(), G = gridDim.x;
    LAS float* WT = (LAS float*)lds;
    LAS float* VS = (LAS float*)(lds + 65536);
    const float* w_s = a->in[13]; const float* b_s = a->in[14]; const float* sgn = a->in[12];
    const int per = (5120 + G - 1) / G, u0 = blockIdx.x * per, u1 = min(5120, u0 + per);
    int gcur = -1;
    for (int u = u0; u < u1; ++u) {
        const int g = u / 320, sc = u - g * 320, seq = sc >> 5, n = sc & 31; const size_t row0 = (size_t)seq * SEQ + n * 128;
        __syncthreads();
        if (g != gcur) { gcur = g;
            for (int idx = tid; idx < 16384; idx += NTHR) { const int t = idx >> 7, s = idx & 127; WT[s * 128 + t] = w_s[(size_t)g * 16384 + idx]; } }
        { const int s = tid >> 2, c32 = (tid & 3) * 32; const float rsd = rstd_of(rsv[row0 + s]);
#pragma unroll
          for (int q = 0; q < 4; ++q) { float v[8]; unpack8(*(const u32x4*)(UV + (row0 + s) * 4096 + 2048 + g * 128 + c32 + q * 8), v);
#pragma unroll
              for (int j = 0; j < 8; ++j) VS[s * 128 + c32 + q * 8 + j] = v[j] * rsd * sgn[g * 128 + c32 + q * 8 + j]; } }
        __syncthreads();
        const int t0 = (tid >> 4) * 4, c0 = (tid & 15) * 8;
        float acc[4][8];
#pragma unroll
        for (int i = 0; i < 4; ++i)
#pragma unroll
            for (int j = 0; j < 8; ++j) acc[i][j] = 0.f;
#pragma unroll 4
        for (int s = 0; s < 128; ++s) {
            const f32x4 av = *(const LAS f32x4*)(WT + s * 128 + t0), v0 = *(const LAS f32x4*)(VS + s * 128 + c0), v1 = *(const LAS f32x4*)(VS + s * 128 + c0 + 4);
#pragma unroll
            for (int i = 0; i < 4; ++i) {
#pragma unroll
                for (int j = 0; j < 4; ++j) { acc[i][j] += av[i] * v0[j]; acc[i][4 + j] += av[i] * v1[j]; } }
        }
#pragma unroll
        for (int i = 0; i < 4; ++i) { const int t = t0 + i; const float bias = b_s[g * 128 + t]; const size_t row = row0 + t;
            float uv[8]; unpack8(*(const u32x4*)(UV + row * 4096 + g * 128 + c0), uv);
#pragma unroll
            for (int j = 0; j < 8; ++j) uv[j] *= (acc[i][j] + bias);
            *(u32x4*)(MX + row * D + g * 128 + c0) = pack8(uv); }
    }
}

__device__ __forceinline__ void ffn_convglu(ArgsCP a, int layer, const bf16_t* GU, bf16_t* HID, int rows) {
    const float* cw = a->in[32] + (size_t)layer * 3 * DFF; const float* cb = a->in[33] + (size_t)layer * DFF;
    const long total = (long)rows * 704;
    for (long i = (long)blockIdx.x * NTHR + tidx(); i < total; i += (long)gridDim.x * NTHR) {
        const int r = (int)(i / 704), cbk = (int)(i - (long)r * 704), ch = cbk * 8, pos = r & (SEQ - 1);
        const bf16_t* gp = GU + (size_t)r * (2 * DFF) + (cbk >> 4) * 256 + (cbk & 15) * 8;
        float g0[8], gm[8], gn[8], up[8];
        unpack8(*(const u32x4*)gp, g0); unpack8(*(const u32x4*)(gp + 128), up);
        if (pos > 0) unpack8(*(const u32x4*)(gp - 2 * DFF), gm); else {
#pragma unroll
            for (int j = 0; j < 8; ++j) gm[j] = 0.f; }
        if (pos < SEQ - 1) unpack8(*(const u32x4*)(gp + 2 * DFF), gn); else {
#pragma unroll
            for (int j = 0; j < 8; ++j) gn[j] = 0.f; }
        float o[8];
#pragma unroll
        for (int j = 0; j < 8; ++j) { const float gv = cw[ch + j] * gm[j] + cw[DFF + ch + j] * g0[j] + cw[2 * DFF + ch + j] * gn[j] + cb[ch + j]; o[j] = siluf_(gv) * up[j]; }
        *(u32x4*)(HID + (size_t)r * DFF + ch) = pack8(o);
    }
}

__device__ __forceinline__ void gdn_conv(ArgsCP a, const bf16_t* PROJ, const float* AB, bf16_t* QK, bf16_t* VP, float* GB, int rows) {
    const int tid = tidx(), ch0 = tid * 16;
    const float* cw = a->in[17];
    float w0[16], w1[16], w2[16];
#pragma unroll
    for (int j = 0; j < 16; ++j) { w0[j] = cw[ch0 + j]; w1[j] = cw[8192 + ch0 + j]; w2[j] = cw[16384 + ch0 + j]; }
    for (int r = blockIdx.x; r < rows; r += gridDim.x) {
        const int pos = r & (SEQ - 1);
        const bf16_t* p = PROJ + (size_t)r * 8192 + ch0;
        float x0[16], xm[16], xn[16];
        { float t[8]; unpack8(*(const u32x4*)p, t);
#pragma unroll
          for (int j = 0; j < 8; ++j) x0[j] = t[j];
          unpack8(*(const u32x4*)(p + 8), t);
#pragma unroll
          for (int j = 0; j < 8; ++j) x0[8 + j] = t[j]; }
        if (pos > 0) { float t[8]; unpack8(*(const u32x4*)(p - 8192), t);
#pragma unroll
          for (int j = 0; j < 8; ++j) xm[j] = t[j];
          unpack8(*(const u32x4*)(p - 8192 + 8), t);
#pragma unroll
          for (int j = 0; j < 8; ++j) xm[8 + j] = t[j]; } else {
#pragma unroll
          for (int j = 0; j < 16; ++j) xm[j] = 0.f; }
        if (pos < SEQ - 1) { float t[8]; unpack8(*(const u32x4*)(p + 8192), t);
#pragma unroll
          for (int j = 0; j < 8; ++j) xn[j] = t[j];
          unpack8(*(const u32x4*)(p + 8192 + 8), t);
#pragma unroll
          for (int j = 0; j < 8; ++j) xn[8 + j] = t[j]; } else {
#pragma unroll
          for (int j = 0; j < 16; ++j) xn[j] = 0.f; }
        float y[16], ss = 0.f;
#pragma unroll
        for (int j = 0; j < 16; ++j) { y[j] = siluf_(w0[j] * xm[j] + w1[j] * x0[j] + w2[j] * xn[j]); ss += y[j] * y[j]; }
        ss += __shfl_xor(ss, 1); ss += __shfl_xor(ss, 2); ss += __shfl_xor(ss, 4);
        float sc = 1.0f;
        if (ch0 < 4096) { sc = rsqrtf(ss + EPS); if (ch0 < 2048) sc *= 0.08838834764831845f; }
        float o0[8], o1[8];
#pragma unroll
        for (int j = 0; j < 8; ++j) { o0[j] = y[j] * sc; o1[j] = y[8 + j] * sc; }
        bf16_t* dst = ch0 < 4096 ? QK + (size_t)r * 4096 + ch0 : VP + (size_t)r * 4096 + (ch0 - 4096);
        *(u32x4*)dst = pack8(o0); *(u32x4*)(dst + 8) = pack8(o1);
        if (tid < 64) { const int dir = tid >> 5, head = tid & 31;
            const float av = AB[(size_t)r * 128 + dir * 64 + head], bv = AB[(size_t)r * 128 + dir * 64 + 32 + head];
            const float xx = av + a->in[19][dir * 32 + head];
            const float sp = xx > 20.f ? xx : log1pf(expf(xx));
            GB[(size_t)r * 128 + dir * 64 + head] = -expf(a->in[18][dir * 32 + head]) * sp;
            GB[(size_t)r * 128 + dir * 64 + 32 + head] = 1.0f / (1.0f + expf(-bv)); }
    }
}
__device__ __forceinline__ void gdn_scan_naive(LAS unsigned char* lds, const bf16_t* QK, const bf16_t* VP, const float* GB, bf16_t* OF, bf16_t* OB, int nseq) {
    const int tid = tidx(), vh = tid >> 8, j = (tid & 255) >> 1, half = tid & 1;
    LAS float* KQ = (LAS float*)lds;
    LAS float* VS = (LAS float*)(lds + 16384);
    LAS float* GS = (LAS float*)(lds + 32768);
    const int nunits = nseq * 32;
    for (int unit = blockIdx.x; unit < nunits; unit += gridDim.x) {
        const int seq = unit >> 5, hq = (unit >> 1) & 15, dir = unit & 1, head = 2 * hq + vh;
        bf16_t* OD = dir ? OB : OF;
        float S[64];
#pragma unroll
        for (int i = 0; i < 64; ++i) S[i] = 0.f;
        for (int blk = 0; blk < SEQ / 16; ++blk) {
            __syncthreads();
            { const int tok = tid >> 5, part = tid & 31, step = blk * 16 + tok, pos = dir ? SEQ - 1 - step : step; const size_t row = (size_t)seq * SEQ + pos;
              const bf16_t* src = part < 16 ? QK + row * 4096 + hq * 128 + part * 8 : QK + row * 4096 + 2048 + hq * 128 + (part - 16) * 8;
              float v[8]; unpack8(*(const u32x4*)src, v);
              *(LAS f32x4*)(KQ + tok * 256 + part * 8) = (f32x4){v[0], v[1], v[2], v[3]}; *(LAS f32x4*)(KQ + tok * 256 + part * 8 + 4) = (f32x4){v[4], v[5], v[6], v[7]};
              unpack8(*(const u32x4*)(VP + row * 4096 + hq * 256 + part * 8), v);
              *(LAS f32x4*)(VS + tok * 256 + part * 8) = (f32x4){v[0], v[1], v[2], v[3]}; *(LAS f32x4*)(VS + tok * 256 + part * 8 + 4) = (f32x4){v[4], v[5], v[6], v[7]};
              if (tid < 64) { const int tk = tid >> 2, which = tid & 3, hh = 2 * hq + (which & 1), isb = which >> 1, st = blk * 16 + tk, ps = dir ? SEQ - 1 - st : st;
                  const float gv = GB[((size_t)seq * SEQ + ps) * 128 + dir * 64 + isb * 32 + hh]; GS[tk * 4 + which] = isb ? gv : expf(gv); } }
            __syncthreads();
            for (int s = 0; s < 16; ++s) {
                const float av = GS[s * 4 + vh], bv = GS[s * 4 + 2 + vh], vt = VS[s * 256 + vh * 128 + j];
                const LAS float* kp = KQ + s * 256 + 128 + half * 64; const LAS float* qp = KQ + s * 256 + half * 64;
                float ks = 0.f;
#pragma unroll
                for (int i = 0; i < 64; i += 4) { const f32x4 k4 = *(const LAS f32x4*)(kp + i); ks += k4[0] * S[i] + k4[1] * S[i + 1] + k4[2] * S[i + 2] + k4[3] * S[i + 3]; }
                ks += __shfl_xor(ks, 1);
                const float uu = bv * (vt - av * ks);
                float os = 0.f;
#pragma unroll
                for (int i = 0; i < 64; i += 4) { const f32x4 k4 = *(const LAS f32x4*)(kp + i), q4 = *(const LAS f32x4*)(qp + i);
#pragma unroll
                    for (int e = 0; e < 4; ++e) { S[i + e] = av * S[i + e] + k4[e] * uu; os += q4[e] * S[i + e]; } }
                os += __shfl_xor(os, 1);
                if (half == 0) { const int step = blk * 16 + s, pos = dir ? SEQ - 1 - step : step; OD[((size_t)seq * SEQ + pos) * 4096 + head * 128 + j] = f2bf(os); }
            }
        }
    }
}
__device__ __forceinline__ void gdn_sumnorm(ArgsCP a, bf16_t* OF, const bf16_t* OB, int rows) {
    const int tid = tidx(), rsub = tid >> 8, c0 = (tid & 255) * 16;
    const float* on = a->in[20];
    for (int r = blockIdx.x * 2 + rsub; r < rows; r += gridDim.x * 2) {
        float x[16], t[8];
        unpack8(*(const u32x4*)(OF + (size_t)r * 4096 + c0), t);
#pragma unroll
        for (int q = 0; q < 8; ++q) x[q] = t[q];
        unpack8(*(const u32x4*)(OF + (size_t)r * 4096 + c0 + 8), t);
#pragma unroll
        for (int q = 0; q < 8; ++q) x[8 + q] = t[q];
        unpack8(*(const u32x4*)(OB + (size_t)r * 4096 + c0), t);
#pragma unroll
        for (int q = 0; q < 8; ++q) x[q] += t[q];
        unpack8(*(const u32x4*)(OB + (size_t)r * 4096 + c0 + 8), t);
#pragma unroll
        for (int q = 0; q < 8; ++q) x[8 + q] += t[q];
        float ss = 0.f;
#pragma unroll
        for (int q = 0; q < 16; ++q) ss += x[q] * x[q];
        ss += __shfl_xor(ss, 1); ss += __shfl_xor(ss, 2); ss += __shfl_xor(ss, 4);
        const float sc = rsqrtf(ss * (1.0f / 128.0f) + EPS);
        float o0[8], o1[8];
#pragma unroll
        for (int q = 0; q < 8; ++q) { o0[q] = x[q] * sc * on[(c0 & 127) + q]; o1[q] = x[8 + q] * sc * on[(c0 & 127) + 8 + q]; }
        *(u32x4*)(OF + (size_t)r * 4096 + c0) = pack8(o0); *(u32x4*)(OF + (size_t)r * 4096 + c0 + 8) = pack8(o1);
    }
}

__device__ __forceinline__ void s5_scan(ArgsCP a, LAS unsigned char* lds, const float* X, const rs_t* rs, float* YF, bf16_t* Y) {
    const int tid = tidx(), w = tid >> 6, lane = tid & 63;
    LAS float* U = (LAS float*)(lds + w * 9216);
    LAS float* XS = U + 256;
    const float* gmix = a->in[4] + 3 * D;
    for (int task = blockIdx.x * 8 + w; task < NSEQ * 128; task += gridDim.x * 8) {
        const int seq = task >> 7, gr = task & 127;
        for (int dir = 0; dir < 2; ++dir) {
            const int dg = dir * 128 + gr;
            const float are = a->in[22][dg * 64 + lane], aim = a->in[23][dg * 64 + lane], dt = expf(a->in[24][dg]);
            const float er = expf(are * dt); float sn, cs; sincosf(aim * dt, &sn, &cs);
            const float abr = er * cs, abi = er * sn;
            const float den = 1.0f / (are * are + aim * aim);
            const float cr = ((abr - 1.0f) * are + abi * aim) * den, ci = (abi * are - (abr - 1.0f) * aim) * den;
            float Br[16], Bi[16];
#pragma unroll
            for (int c = 0; c < 16; ++c) { const float bre = a->in[25][((size_t)dg * 64 + lane) * 16 + c], bim = a->in[26][((size_t)dg * 64 + lane) * 16 + c]; Br[c] = cr * bre - ci * bim; Bi[c] = cr * bim + ci * bre; }
            const int oc = lane & 15, tb = lane >> 4;
            float Cr[64], Ci[64];
#pragma unroll
            for (int p = 0; p < 64; ++p) { Cr[p] = a->in[27][((size_t)dg * 16 + oc) * 64 + p]; Ci[p] = a->in[28][((size_t)dg * 16 + oc) * 64 + p]; }
            const float dsk = a->in[29][gr * 16 + oc];
            float xr = 0.f, xi = 0.f;
            for (int blk = 0; blk < SEQ / 16; ++blk) {
                { const int tt = lane >> 2, c4 = (lane & 3) * 4, step = blk * 16 + tt, pos = dir ? SEQ - 1 - step : step; const size_t row = (size_t)seq * SEQ + pos;
                  const f32x4 xv = *(const f32x4*)(X + row * D + gr * 16 + c4); const f32x4 gm = *(const f32x4*)(gmix + gr * 16 + c4); const float rsd = rstd_of(rs[row]);
                  *(LAS f32x4*)(U + tt * 16 + c4) = xv * gm * rsd; }
                __builtin_amdgcn_wave_barrier();
                for (int tt = 0; tt < 16; ++tt) {
                    float bur = 0.f, bui = 0.f;
#pragma unroll
                    for (int c = 0; c < 16; c += 4) { const f32x4 u4 = *(const LAS f32x4*)(U + tt * 16 + c);
#pragma unroll
                        for (int e = 0; e < 4; ++e) { bur += Br[c + e] * u4[e]; bui += Bi[c + e] * u4[e]; } }
                    const float nr = abr * xr - abi * xi + bur, ni = abr * xi + abi * xr + bui; xr = nr; xi = ni;
                    XS[(tt * 64 + lane) * 2] = xr; XS[(tt * 64 + lane) * 2 + 1] = xi;
                }
                __builtin_amdgcn_wave_barrier();
                for (int i = 0; i < 4; ++i) {
                    const int t = tb * 4 + i; float y = 0.f;
#pragma unroll
                    for (int p = 0; p < 64; p += 2) { const f32x4 x2 = *(const LAS f32x4*)(XS + (t * 64 + p) * 2); y += Cr[p] * x2[0] - Ci[p] * x2[1] + Cr[p + 1] * x2[2] - Ci[p + 1] * x2[3]; }
                    const int step = blk * 16 + t, pos = dir ? SEQ - 1 - step : step; const size_t row = (size_t)seq * SEQ + pos;
                    if (dir == 0) YF[row * D + gr * 16 + oc] = y;
                    else { const float yt = y + YF[row * D + gr * 16 + oc] + dsk * U[t * 16 + oc]; Y[row * D + gr * 16 + oc] = f2bf(geluf_(yt)); }
                }
                __builtin_amdgcn_wave_barrier();
            }
        }
    }
}

__device__ __forceinline__ void final_norm(ArgsCP a, const rs_t* rs) {
    const int tid = tidx(), w = tid >> 6, lane = tid & 63; const float* g = a->in[7];
    for (int row = blockIdx.x * 8 + w; row < T; row += gridDim.x * 8) {
        const float s = rstd_of(rs[row]);
#pragma unroll
        for (int q = 0; q < 8; ++q) { const int c = (q * 64 + lane) * 4; f32x4 v = *(const f32x4*)(a->out + (size_t)row * D + c); const f32x4 gv = *(const f32x4*)(g + c); v = v * gv * s; *(f32x4*)(a->out + (size_t)row * D + c) = v; }
    }
}

#ifndef MK_SINGLE
#define MK_SINGLE 1
#endif
constexpr int NPH = 90;

__global__ void __launch_bounds__(NTHR, 2) mk_fwd(Args a_unused) {
    extern __shared__ __attribute__((aligned(16))) unsigned char lds_raw[];
    LAS unsigned char* lds = (LAS unsigned char*)lds_raw;
    int ph_lo, ph_hi;
    XcdBarrier bar;
    { ArgsCP a0 = argp(); ph_lo = a0->ph_lo; ph_hi = a0->ph_hi;
      bar.bar = (unsigned*)(a0->ws + WS_CTL); bar.x = 0; bar.st = (volatile LAS unsigned*)(lds + LDS_STAGE);
      if (ph_hi - ph_lo > 1) {
          if (threadIdx.x < 4) ((LAS unsigned*)(lds + LDS_STAGE))[threadIdx.x] = 0u;
          __syncthreads();
          bar = xcd_barrier_post((unsigned*)(a0->ws + WS_CTL), (volatile LAS unsigned*)(lds + LDS_STAGE));
      } }
    int ph = 0;
#define PH_BEGIN if (ph >= ph_lo && ph < ph_hi) { ArgsCP a = argp(); unsigned char* ws = a->ws; float* X = a->out; rs_t* RS = (rs_t*)(ws + WS_RS); \
        bf16_t* XB0 = (bf16_t*)(ws + WS_XB0); bf16_t* XB1 = (bf16_t*)(ws + WS_XB1); unsigned char* BIG = ws + WS_BIG; (void)X; (void)RS; (void)XB0; (void)XB1; (void)BIG;
#define PH_END   } if (ph >= ph_lo && ph + 1 < ph_hi) xcd_barrier(bar); ++ph;
#define RSB(k) (RS + (size_t)(k) * T)

    PH_BEGIN prologue(a, lds); PH_END

#define FFN_PLE(L, XBc, XBo) \
    _Pragma("unroll 1") for (int fg = 0; fg < NFG; ++fg) { \
        const size_t r0 = (size_t)fg * FG_ROWS; \
        PH_BEGIN { EpiScale E{(bf16_t*)(BIG + BIG_GU), 2 * DFF, RSB(3 * (L) + 1) + r0, nullptr, -1}; \
                   run_gemm(lds, XBc + r0 * D, (const bf16_t*)(ws + WS_WGU + (L) * SZ_WGU), FG_ROWS, 2 * DFF, D, E); } PH_END \
        PH_BEGIN ffn_convglu(a, (L), (const bf16_t*)(BIG + BIG_GU), (bf16_t*)(BIG + BIG_HID), FG_ROWS); PH_END \
        PH_BEGIN { EpiResid E{X + r0 * D, XBc + r0 * D, RSB(3 * (L) + 2) + r0}; \
                   run_gemm(lds, (const bf16_t*)(BIG + BIG_HID), (const bf16_t*)(ws + WS_WDN + (L) * SZ_WDN), FG_ROWS, D, DFF, E); } PH_END \
    } \
    PH_BEGIN { EpiScale E{(bf16_t*)BIG, D, nullptr, nullptr, -1}; \
               run_gemm(lds, (const bf16_t*)(ws + WS_PB) + (size_t)(L) * T * PLED, (const bf16_t*)(ws + WS_WPP + (L) * SZ_WPP), T, D, PLED, E); } PH_END \
    PH_BEGIN { EpiPle E{X, XBo, RSB(3 * (L) + 3), RSB(3 * (L) + 2), (const bf16_t*)BIG}; \
               run_gemm(lds, XBc, (const bf16_t*)(ws + WS_WPG + (L) * SZ_WPG), T, D, D, E); } PH_END

    PH_BEGIN { EpiScale E{(bf16_t*)BIG, 6144, RSB(0), nullptr, -1}; run_gemm(lds, XB0, (const bf16_t*)(ws + WS_NAQ), T, 6144, D, E); } PH_END
    PH_BEGIN na_attention(a, lds, (const bf16_t*)BIG, XB1); PH_END
    PH_BEGIN { EpiResid E{X, XB0, RSB(1)}; run_gemm(lds, XB1, (const bf16_t*)(ws + WS_NAO), T, D, D, E); } PH_END
    FFN_PLE(0, XB0, XB1)
    PH_BEGIN { EpiGelu E{(bf16_t*)BIG, 4096, RSB(3), RSB(13), 8}; run_gemm(lds, XB1, (const bf16_t*)(ws + WS_SGI), T, 4096, D, E); } PH_END
    PH_BEGIN sgu_mix(a, lds, (const bf16_t*)BIG, RSB(13), XB0); PH_END
    PH_BEGIN { EpiResid E{X, XB1, RSB(4)}; run_gemm(lds, XB0, (const bf16_t*)(ws + WS_SGO), T, D, D, E); } PH_END
    FFN_PLE(1, XB1, XB0)
#pragma unroll 1
    for (int gg = 0; gg < NGG; ++gg) {
        const size_t r0 = (size_t)gg * GG_ROWS;
#define GDN_PTRS bf16_t* PROJ = (bf16_t*)(BIG + BIG_PROJ); bf16_t* OF = PROJ; bf16_t* OB = (bf16_t*)(BIG + BIG_OB); bf16_t* VP = (bf16_t*)(BIG + BIG_VP); \
        float* AB = (float*)(BIG + BIG_AB); float* GB = (float*)(BIG + BIG_GB); bf16_t* QK = XB1; (void)PROJ; (void)OF; (void)OB; (void)VP; (void)AB; (void)GB; (void)QK;
        PH_BEGIN { GDN_PTRS EpiScale E{PROJ, 8192, RSB(6) + r0, AB, 32}; run_gemm(lds, XB0 + r0 * D, (const bf16_t*)(ws + WS_GDI), GG_ROWS, GDI_N1, D, E); } PH_END
        PH_BEGIN { GDN_PTRS gdn_conv(a, PROJ, AB, QK, VP, GB, GG_ROWS); } PH_END
        PH_BEGIN { GDN_PTRS gdn_scan_naive(lds, QK, VP, GB, OF, OB, GG_ROWS / SEQ); } PH_END
        PH_BEGIN { GDN_PTRS gdn_sumnorm(a, OF, OB, GG_ROWS); } PH_END
        PH_BEGIN { GDN_PTRS EpiGdnZ E{OF, 4096, RSB(6) + r0}; run_gemm(lds, XB0 + r0 * D, (const bf16_t*)(ws + WS_GDI) + (size_t)GDI_N1 * D, GG_ROWS, 4096, D, E); } PH_END
        PH_BEGIN { GDN_PTRS EpiResid E{X + r0 * D, XB0 + r0 * D, RSB(7) + r0}; run_gemm(lds, OF, (const bf16_t*)(ws + WS_GDO), GG_ROWS, D, 4096, E); } PH_END
    }
    FFN_PLE(2, XB0, XB1)
    PH_BEGIN s5_scan(a, lds, X, RSB(9), (float*)BIG, XB0); PH_END
    PH_BEGIN { EpiGlu E{X, XB1, RSB(10)}; run_gemm(lds, XB0, (const bf16_t*)(ws + WS_S5G), T, 4096, D, E); } PH_END
    FFN_PLE(3, XB1, XB0)
    PH_BEGIN final_norm(a, RSB(12)); PH_END
}
}

extern "C" void kernel_launch(void* const* d_in, const int* in_sizes, int n_in, void* d_out, int out_size, void* d_ws, size_t ws_size, hipStream_t stream) {
    using namespace mk;
    static int grid = 0;
    if (grid == 0) {
        if (n_in != 37 || out_size != T * D || ws_size < WS_END) { fprintf(stderr, "kernel_launch: unexpected problem (n_in %d, out %d, ws %zu < %zu)\n", n_in, out_size, ws_size, (size_t)WS_END); grid = -1; return; }
        int dev = 0, cus = 0;
        if (hipGetDevice(&dev) != hipSuccess || hipDeviceGetAttribute(&cus, hipDeviceAttributeMultiprocessorCount, dev) != hipSuccess) { grid = -1; return; }
        if (hipFuncSetAttribute((const void*)mk_fwd, hipFuncAttributeMaxDynamicSharedMemorySize, LDS_BYTES) != hipSuccess) { fprintf(stderr, "kernel_launch: hipFuncSetAttribute failed\n"); grid = -1; return; }
        int per_cu = 0;
        if (hipOccupancyMaxActiveBlocksPerMultiprocessor(&per_cu, (const void*)mk_fwd, NTHR, LDS_BYTES) != hipSuccess || per_cu < 1) fprintf(stderr, "kernel_launch: occupancy query says %d\n", per_cu);
        (void)hipGetLastError();
        grid = cus > 0 ? cus : 256;
    }
    if (grid < 0) return;
    (void)hipMemsetAsync(d_ws, 0, ZERO_BYTES, stream);
    Args a{};
    for (int i = 0; i < 37; ++i) a.in[i] = (const float*)d_in[i];
    a.out = (float*)d_out; a.ws = (unsigned char*)d_ws;
#if MK_SINGLE
    a.ph_lo = 0; a.ph_hi = NPH;
    hipLaunchKernelGGL(mk_fwd, dim3(grid), dim3(NTHR), LDS_BYTES, stream, a);
#else
    for (int p = 0; p < NPH; ++p) { a.ph_lo = p; a.ph_hi = p + 1; hipLaunchKernelGGL(mk_fwd, dim3(grid), dim3(NTHR), LDS_BYTES, stream, a); }
#endif
}
```

```cpp
#include <hip/hip_runtime.h>
#include <cstdio>
#include <cstdint>
#define XB_TMO      128
#define XB_XCNT(j)  (256  + 64 * (j))
#define XB_XSUB(j)  (1280 + 64 * (j))
#define XB_XGEN(j)  (2304 + 64 * (j))
#define XB_TOP      3328
#define XB_TOPGEN   3392
#define XCD_BAR_WORDS 3456
#define XB_SPIN_CAP (1u << 18)
#define LAS __attribute__((address_space(3)))

__device__ __forceinline__ unsigned xb_ld(unsigned* p)              { return __hip_atomic_load(p, __ATOMIC_RELAXED, __HIP_MEMORY_SCOPE_AGENT); }
__device__ __forceinline__ unsigned xb_add(unsigned* p, unsigned v) { return __hip_atomic_fetch_add(p, v, __ATOMIC_RELAXED, __HIP_MEMORY_SCOPE_AGENT); }
__device__ __forceinline__ unsigned xb_xcc_id() { return (unsigned)__builtin_amdgcn_s_getreg((3 << 11) | 20) & 0xFu; }
#define XB_SPIN(cond, bar) do { unsigned _sp = 0; while (cond) { __builtin_amdgcn_s_sleep(1); \
    if ((++_sp & 255u) == 0u) { if (xb_ld(&(bar)[XB_TMO])) break; if (_sp > XB_SPIN_CAP) { atomicAdd(&(bar)[XB_TMO], 1u); break; } } } } while (0)

struct XcdBarrier {
    unsigned* bar; unsigned x;
    volatile LAS unsigned* st;
};

__device__ __forceinline__ XcdBarrier xcd_barrier_post(unsigned* bar, volatile LAS unsigned* st) {
    XcdBarrier b; b.bar = bar; b.x = xb_xcc_id(); b.st = st;
    if (threadIdx.x == 0) (void)xb_add(&bar[XB_XCNT(b.x)], 1u);
    return b;
}
__device__ __forceinline__ void xcd_barrier_complete(unsigned* bar, unsigned x, unsigned& nloc, unsigned& nx) {
    const unsigned G = gridDim.x * gridDim.y * gridDim.z;
    unsigned sum, cnt, mine, sp = 0u;
    for (;;) {
        sum = 0u; cnt = 0u; mine = 0u;
#pragma unroll
        for (unsigned j = 0; j < 16; ++j) { const unsigned c = xb_ld(&bar[XB_XCNT(j)]); sum += c; cnt += (c > 0u) ? 1u : 0u; mine = (j == x) ? c : mine; }
        if (sum == G) break;
        __builtin_amdgcn_s_sleep(1);
        if ((++sp & 255u) == 0u) { if (xb_ld(&bar[XB_TMO])) break; if (sp > XB_SPIN_CAP) { atomicAdd(&bar[XB_TMO], 1u); break; } }
    }
    nloc = mine > 0u ? mine : 1u; nx = cnt > 0u ? cnt : 1u;
}

__device__ __forceinline__ void xcd_barrier(const XcdBarrier& b) {
    asm volatile("s_waitcnt vmcnt(0)" ::: "memory");
    __syncthreads();
    if (threadIdx.x == 0) {
        unsigned* bar = b.bar;
        __builtin_amdgcn_s_waitcnt(0);
        unsigned nloc = b.st[0], nx = b.st[1];
        if (nloc == 0u) { xcd_barrier_complete(bar, b.x, nloc, nx); b.st[0] = nloc; b.st[1] = nx; }
        const unsigned old = xb_add(&bar[XB_XSUB(b.x)], 1u);
        const unsigned gen = old / nloc;
        if (old + 1u == (gen + 1u) * nloc) {
            __builtin_amdgcn_fence(__ATOMIC_RELEASE, "agent");
            asm volatile("s_waitcnt vmcnt(0)" ::: "memory");
            const unsigned og = xb_add(&bar[XB_TOP], 1u);
            const unsigned tg = og / nx;
            if (og + 1u == (tg + 1u) * nx) xb_add(&bar[XB_TOPGEN], 1u);
            else XB_SPIN(xb_ld(&bar[XB_TOPGEN]) == tg, bar);
            __builtin_amdgcn_fence(__ATOMIC_ACQUIRE, "agent");
            xb_add(&bar[XB_XGEN(b.x)], 1u);
            asm volatile("s_waitcnt vmcnt(0)" ::: "memory");
        } else {
            XB_SPIN(xb_ld(&bar[XB_XGEN(b.x)]) == gen, bar);
            __builtin_amdgcn_fence(__ATOMIC_ACQUIRE, "agent");
            asm volatile("s_waitcnt vmcnt(0)" ::: "memory");
        }
    }
    __syncthreads();
}
namespace pg8 {
#define PG8_LAS __attribute__((address_space(3)))
typedef unsigned short bf16_t;
typedef short bf16x8 __attribute__((ext_vector_type(8)));
typedef float f32x4 __attribute__((ext_vector_type(4)));
typedef unsigned u32x4 __attribute__((ext_vector_type(4)));
constexpr int BM = 256, BK = 64, HALF = 128, HTB = HALF * BK * 2  , STAGE_BYTES = 8 * HTB, NXCD = 8, WGM = 8;

__host__ __device__ __forceinline__ int lds_byte(int r, int c) { const int st = (r >> 4) * 2 + (c >> 5), rr = r & 15, cc = c & 31, ob = rr * 64 + cc * 2; return st * 1024 + (ob ^ (((ob >> 9) & 1) << 5)); }
__host__ __device__ __forceinline__ void stage_rc(int b, int& R, int& C) { const int st = b / 1024, sb = b % 1024, swz = sb ^ (((sb >> 9) & 1) << 5); R = (st >> 1) * 16 + swz / 64; C = (st & 1) * 32 + (swz % 64) / 2; }
__host__ __device__ __forceinline__ int perm32(int rho) { const int n = rho >> 4, i = rho & 15; return 8 * (i >> 2) + 4 * n + (i & 3); }

struct Unit { int pm, pn; };
struct Gemm { const bf16_t* A; const bf16_t* Bt; int M, N, K; };

struct StaticOrder {
    int nM, nN, nwg, G, c;
    __host__ __device__ void init(int M, int N, int G_, int c_) { nM = M / BM; nN = N / BM; nwg = nM * nN; G = G_; c = c_; }
    __host__ __device__ bool next(int i, Unit& u) const {
        const long L = (long)i * G + c; if (L >= nwg) return false;
        int wgid = (int)L; { const int q = nwg / NXCD, r = nwg % NXCD, xcd = wgid % NXCD, off = wgid / NXCD; wgid = (xcd < r ? xcd * (q + 1) : r * (q + 1) + (xcd - r) * q) + off; }
        const int nig = WGM * nN, gid = wgid / nig, fm = gid * WGM, gsz = (nM - fm) < WGM ? (nM - fm) : WGM;
        u.pm = fm + ((wgid % nig) % gsz); u.pn = (wgid % nig) / gsz; return true;
    }
    __device__ __forceinline__ void a_ready(const Unit&) const {}
    __device__ __forceinline__ void done(const Unit&) const {}
};


__device__ __forceinline__ unsigned cvt_pk_bf16(float lo, float hi) { unsigned r; asm volatile("v_cvt_pk_bf16_f32 %0, %1, %2" : "=v"(r) : "v"(lo), "v"(hi)); return r; }

template <class Epi, class Sched, bool ALIGN_EPI = false, bool SP2 = false>
__device__ __forceinline__ void gemm_phase(PG8_LAS unsigned char* lds, const Gemm g, const Sched& S, const Epi& E) {
    int tid_ = threadIdx.x; asm volatile("" : "+v"(tid_)); const int tid = tid_, wid = __builtin_amdgcn_readfirstlane(tid >> 6), lane = tid & 63, wr = wid >> 2, wc = wid & 3, fr = lane & 15, fq = lane >> 4;
    const int K = g.K, nt = K / BK;
    unsigned voffA[2], voffB[2];
#pragma unroll
    for (int i = 0; i < 2; ++i) { int R, C; stage_rc(tid * 16 + i * 8192, R, C); const int Rb = Epi::PERM ? ((R & ~31) + perm32(R & 31)) : R;
        voffA[i] = (unsigned)(R * K + C) * 2u; voffB[i] = (unsigned)(Rb * K + C) * 2u; }
    const size_t kstep = (size_t)(BK * 2);
    const size_t hstep = (size_t)HALF * K * 2;
    const size_t tstep = 2 * hstep;
    const unsigned ldsw = (unsigned)wid * 1024u;
    const int aoff = lds_byte(wr * 64 + fr, fq * 8), boff = lds_byte(wc * 32 + fr, fq * 8);
#define PG8_SA(b, h) (((b) * 2 + (h)) * HTB)
#define PG8_SB(b, h) ((4 + (b) * 2 + (h)) * HTB)
#define PG8_STAGE(bufoff, gbase, voff) do { _Pragma("unroll") for (int _i = 0; _i < 2; ++_i) \
        __builtin_amdgcn_global_load_lds((const unsigned*)((const char*)(gbase) + (voff)[_i]), (PG8_LAS unsigned*)(lds + (bufoff) + ldsw + _i * 8192), 16, 0, 0); } while (0)
#define PG8_LDA(dst, b, h) do { _Pragma("unroll") for (int m = 0; m < 4; ++m) _Pragma("unroll") for (int k = 0; k < 2; ++k) dst[m][k] = *(const PG8_LAS bf16x8*)(lds + PG8_SA(b, h) + aoff + m * 2048 + k * 1024); } while (0)
#define PG8_LDB(dst, b, h) do { _Pragma("unroll") for (int n = 0; n < 2; ++n) _Pragma("unroll") for (int k = 0; k < 2; ++k) dst[n][k] = *(const PG8_LAS bf16x8*)(lds + PG8_SB(b, h) + boff + n * 2048 + k * 1024); } while (0)
#define PG8_MMA(ai, bj, At, Bt) do { __builtin_amdgcn_s_setprio(1); _Pragma("unroll") for (int m = 0; m < 4; ++m) _Pragma("unroll") for (int n = 0; n < 2; ++n) _Pragma("unroll") for (int k = 0; k < 2; ++k) \
        acc[ai][bj][m][n] = __builtin_amdgcn_mfma_f32_16x16x32_bf16(Bt[n][k], At[m][k], acc[ai][bj][m][n], 0, 0, 0); __builtin_amdgcn_s_setprio(0); } while (0)
#define PG8_WAIT_V(n) asm volatile("s_waitcnt vmcnt(" #n ")" ::: "memory")
#define PG8_WAIT_L(n) asm volatile("s_waitcnt lgkmcnt(" #n ")" ::: "memory")
#define PG8_BAR __builtin_amdgcn_s_barrier()
#define PG8_SCHED __builtin_amdgcn_sched_barrier(0)
    Unit cur, nxt; int ui = 0;
    if (!S.next(0, cur)) return;
    f32x4 acc[2][2][4][2];
#pragma unroll
    for (int a = 0; a < 2; ++a)
#pragma unroll
        for (int b = 0; b < 2; ++b)
#pragma unroll
            for (int m = 0; m < 4; ++m)
#pragma unroll
                for (int n = 0; n < 2; ++n) acc[a][b][m][n] = (f32x4){0.f, 0.f, 0.f, 0.f};
    bf16x8 At[4][2], B0[2][2], B1[2][2];
    const char* cA = (const char*)g.A + (size_t)cur.pm * tstep; const char* cB = (const char*)g.Bt + (size_t)cur.pn * tstep;
    S.a_ready(cur);
    if constexpr (SP2) {
        PG8_STAGE(PG8_SB(0, 0), cB, voffB); PG8_STAGE(PG8_SB(0, 1), cB + hstep, voffB); PG8_STAGE(PG8_SA(0, 0), cA, voffA); PG8_STAGE(PG8_SA(0, 1), cA + hstep, voffA);
        if (wr == 1) PG8_BAR;
        PG8_WAIT_V(2); PG8_BAR;
        PG8_STAGE(PG8_SB(1, 0), cB + kstep, voffB); PG8_STAGE(PG8_SA(1, 0), cA + kstep, voffA); PG8_STAGE(PG8_SB(1, 1), cB + hstep + kstep, voffB);
        PG8_WAIT_V(6); PG8_BAR;
    } else {
        PG8_STAGE(PG8_SB(0, 0), cB, voffB); PG8_STAGE(PG8_SA(0, 0), cA, voffA); PG8_STAGE(PG8_SB(0, 1), cB + hstep, voffB); PG8_STAGE(PG8_SA(0, 1), cA + hstep, voffA);
        if (wr == 1) PG8_BAR;
        PG8_WAIT_V(4); PG8_BAR;
        PG8_STAGE(PG8_SB(1, 0), cB + kstep, voffB); PG8_STAGE(PG8_SA(1, 0), cA + kstep, voffA); PG8_STAGE(PG8_SB(1, 1), cB + hstep + kstep, voffB);
        PG8_WAIT_V(6); PG8_BAR;
    }
    for (;;) {
        const bool has_next = S.next(ui + 1, nxt);
        const char* nA = has_next ? (const char*)g.A + (size_t)nxt.pm * tstep : cA; const char* nB = has_next ? (const char*)g.Bt + (size_t)nxt.pn * tstep : cB;
        for (int t = 0; t < nt; t += 2) {
            const bool last = (t == nt - 2);
            const char* a1 = cA + (size_t)(t + 1) * kstep;
            const char* a2 = last ? nA : cA + (size_t)(t + 2) * kstep; const char* b2 = last ? nB : cB + (size_t)(t + 2) * kstep;
            const char* a3 = a2 + kstep; const char* b3 = b2 + kstep;
            if (last && has_next) S.a_ready(nxt);
            if constexpr (SP2) {
            PG8_LDB(B0, 0, 0); PG8_LDB(B1, 0, 1); PG8_SCHED; PG8_LDA(At, 0, 0); PG8_STAGE(PG8_SA(1, 1), a1 + hstep, voffA);
            PG8_WAIT_V(8); PG8_WAIT_L(0); PG8_BAR; PG8_MMA(0, 0, At, B0); PG8_MMA(0, 1, At, B1); PG8_BAR; PG8_SCHED;
            PG8_LDA(At, 0, 1); PG8_STAGE(PG8_SB(0, 0), b2, voffB); PG8_STAGE(PG8_SB(0, 1), b2 + hstep, voffB); PG8_STAGE(PG8_SA(0, 0), a2, voffA);
            PG8_WAIT_V(8); PG8_WAIT_L(0); PG8_BAR; PG8_MMA(1, 0, At, B0); PG8_MMA(1, 1, At, B1); PG8_BAR; PG8_SCHED;
            PG8_LDB(B0, 1, 0); PG8_LDB(B1, 1, 1); PG8_SCHED; PG8_LDA(At, 1, 0); PG8_STAGE(PG8_SA(0, 1), a2 + hstep, voffA);
            PG8_WAIT_V(8); PG8_WAIT_L(0); PG8_BAR; PG8_MMA(0, 0, At, B0); PG8_MMA(0, 1, At, B1); PG8_BAR; PG8_SCHED;
            PG8_LDA(At, 1, 1); PG8_STAGE(PG8_SB(1, 0), b3, voffB); PG8_STAGE(PG8_SB(1, 1), b3 + hstep, voffB); PG8_STAGE(PG8_SA(1, 0), a3, voffA);
            PG8_WAIT_V(8); PG8_WAIT_L(0); PG8_BAR; PG8_MMA(1, 0, At, B0); PG8_MMA(1, 1, At, B1); PG8_BAR; PG8_SCHED;
            } else {
            PG8_LDB(B0, 0, 0); PG8_SCHED; PG8_LDA(At, 0, 0); PG8_STAGE(PG8_SA(1, 1), a1 + hstep, voffA);
            PG8_WAIT_L(8); PG8_BAR; PG8_WAIT_L(0); PG8_MMA(0, 0, At, B0); PG8_BAR; PG8_SCHED;
            PG8_LDB(B1, 0, 1); PG8_STAGE(PG8_SB(0, 0), b2, voffB);
            PG8_BAR; PG8_WAIT_L(0); PG8_MMA(0, 1, At, B1); PG8_BAR;
            PG8_LDA(At, 0, 1); PG8_STAGE(PG8_SA(0, 0), a2, voffA);
            PG8_BAR; PG8_WAIT_L(0); PG8_MMA(1, 0, At, B0); PG8_BAR; PG8_SCHED;
            PG8_STAGE(PG8_SB(0, 1), b2 + hstep, voffB);
            PG8_WAIT_V(6); PG8_BAR; PG8_MMA(1, 1, At, B1); PG8_BAR;
            PG8_LDB(B0, 1, 0); PG8_SCHED; PG8_LDA(At, 1, 0); PG8_STAGE(PG8_SA(0, 1), a2 + hstep, voffA);
            PG8_WAIT_L(8); PG8_BAR; PG8_WAIT_L(0); PG8_MMA(0, 0, At, B0); PG8_BAR; PG8_SCHED;
            PG8_LDB(B1, 1, 1); PG8_STAGE(PG8_SB(1, 0), b3, voffB);
            PG8_BAR; PG8_WAIT_L(0); PG8_MMA(0, 1, At, B1); PG8_BAR;
            PG8_LDA(At, 1, 1); PG8_STAGE(PG8_SA(1, 0), a3, voffA);
            PG8_BAR; PG8_WAIT_L(0); PG8_MMA(1, 0, At, B0); PG8_BAR; PG8_SCHED;
            PG8_STAGE(PG8_SB(1, 1), b3 + hstep, voffB);
            PG8_WAIT_V(6); PG8_BAR; PG8_MMA(1, 1, At, B1); PG8_BAR;
            }
        }
        if constexpr (ALIGN_EPI) { if (wr == 0) PG8_BAR; }
        if constexpr (!Epi::AFTER_DRAIN) { E(acc, cur, wr, wc, fr, fq); S.done(cur); }
        if (!has_next) break;
#pragma unroll
        for (int a = 0; a < 2; ++a)
#pragma unroll
            for (int b = 0; b < 2; ++b)
#pragma unroll
                for (int m = 0; m < 4; ++m)
#pragma unroll
                    for (int n = 0; n < 2; ++n) acc[a][b][m][n] = (f32x4){0.f, 0.f, 0.f, 0.f};
        cur = nxt; cA = nA; cB = nB; ++ui;
        if constexpr (ALIGN_EPI) { if (wr == 1) PG8_BAR; }
    }
    PG8_WAIT_V(0);
    if constexpr (!ALIGN_EPI) { if (wr == 0) PG8_BAR; }
    PG8_BAR;
    if constexpr (Epi::AFTER_DRAIN) { E.fused(acc, cur, wr, wc, fr, fq, lds, wid, lane); S.done(cur); }
#undef PG8_SA
#undef PG8_SB
#undef PG8_STAGE
#undef PG8_LDA
#undef PG8_LDB
#undef PG8_MMA
#undef PG8_WAIT_V
#undef PG8_WAIT_L
#undef PG8_BAR
#undef PG8_SCHED
}
}

namespace mk {
using pg8::bf16_t; using pg8::f32x4; using pg8::u32x4; using pg8::Unit;
typedef unsigned u32x2 __attribute__((ext_vector_type(2)));
constexpr int D = 2048, T = 40960, NSEQ = 10, SEQ = 4096, DFF = 5632, PLED = 256;
constexpr float EPS = 1e-6f;
constexpr int NTHR = 512;

constexpr size_t AL(size_t x) { return (x + 255) & ~size_t(255); }
constexpr size_t WS_CTL = 0, CTL_BYTES = 65536;
constexpr int NRS = 14;
constexpr size_t WS_RS = WS_CTL + CTL_BYTES, RS_BYTES = (size_t)NRS * T * 8;
constexpr size_t ZERO_BYTES = WS_RS + RS_BYTES;
constexpr size_t SZ_WGU = (size_t)2 * DFF * D * 2, SZ_WDN = (size_t)D * DFF * 2, SZ_WPG = (size_t)D * D * 2, SZ_WPP = (size_t)D * PLED * 2;
constexpr size_t WS_WGU = AL(ZERO_BYTES);
constexpr size_t WS_WDN = WS_WGU + 4 * SZ_WGU;
constexpr size_t WS_WPG = WS_WDN + 4 * SZ_WDN;
constexpr size_t WS_WPP = WS_WPG + 4 * SZ_WPG;
constexpr size_t WS_NAQ = WS_WPP + 4 * SZ_WPP;
constexpr size_t WS_NAO = WS_NAQ + (size_t)6144 * D * 2;
constexpr size_t WS_SGI = WS_NAO + (size_t)D * D * 2;
constexpr size_t WS_SGO = WS_SGI + (size_t)4096 * D * 2;
constexpr int    GDI_N = 12544, GDI_N1 = 8448;
constexpr size_t WS_GDI = WS_SGO + (size_t)D * D * 2;
constexpr size_t WS_GDO = WS_GDI + (size_t)GDI_N * D * 2;
constexpr size_t WS_S5G = WS_GDO + (size_t)D * 4096 * 2;
constexpr size_t WS_PB  = WS_S5G + (size_t)4096 * D * 2;
constexpr size_t WS_XB0 = WS_PB + (size_t)4 * T * PLED * 2;
constexpr size_t WS_XB1 = WS_XB0 + (size_t)T * D * 2;
constexpr size_t WS_BIG = WS_XB1 + (size_t)T * D * 2;
constexpr size_t BIG_BYTES = 524288000;
constexpr size_t WS_END = WS_BIG + BIG_BYTES;
constexpr int FG_ROWS = 8192, NFG = 5;
constexpr size_t BIG_GU = 0, BIG_HID = (size_t)FG_ROWS * 2 * DFF * 2;
constexpr int GG_ROWS = 20480, NGG = 2;
constexpr size_t BIG_PROJ = 0, BIG_OB = (size_t)GG_ROWS * 4096 * 2, BIG_VP = (size_t)GG_ROWS * 8192 * 2, BIG_AB = BIG_VP + (size_t)GG_ROWS * 4096 * 2, BIG_GB = BIG_AB + (size_t)GG_ROWS * 128 * 4;
static_assert(BIG_GB + (size_t)GG_ROWS * 128 * 4 <= BIG_BYTES, "BIG");
static_assert((size_t)T * 6144 * 2 <= BIG_BYTES, "BIG");

constexpr int LDS_STAGE = 131072, LDS_BYTES = LDS_STAGE + 1024;

struct Args { const float* in[37]; float* out; unsigned char* ws; int ph_lo, ph_hi; };
typedef const Args __attribute__((address_space(4)))* ArgsCP;
__device__ __forceinline__ ArgsCP argp() { ArgsCP p = (ArgsCP)__builtin_amdgcn_kernarg_segment_ptr(); asm volatile("" : "+s"(p)); return p; }
__device__ __forceinline__ int tidx() { int t = threadIdx.x; asm volatile("" : "+v"(t)); return t; }

__device__ __forceinline__ float bf2f(bf16_t b) { return __uint_as_float(((unsigned)b) << 16); }
__device__ __forceinline__ float blo(unsigned w) { return __uint_as_float(w << 16); }
__device__ __forceinline__ float bhi(unsigned w) { return __uint_as_float(w & 0xffff0000u); }
typedef float f32x2_t __attribute__((ext_vector_type(2))); typedef __bf16 bf16x2_t __attribute__((ext_vector_type(2)));
__device__ __forceinline__ unsigned pk2(float lo, float hi) { const f32x2_t v = {lo, hi}; const bf16x2_t b = __builtin_convertvector(v, bf16x2_t); return __builtin_bit_cast(unsigned, b); }
__device__ __forceinline__ bf16_t f2bf(float f) { return (bf16_t)(pk2(f, 0.f) & 0xffffu); }
typedef unsigned long long rs_t;
__device__ __forceinline__ float rs_val(rs_t v) { return (float)(unsigned)(v >> 24) + (float)(unsigned)(v & 0xffffffull) * (1.0f / 16777216.0f); }
__device__ __forceinline__ rs_t rs_fix(float ss) { return (rs_t)__float2ull_rn(ss * 16777216.0f); }
__device__ __forceinline__ void rs_add(rs_t* p, float ss) { atomicAdd(p, rs_fix(ss)); }
__device__ __forceinline__ float rstd_of(rs_t v) { return rsqrtf(rs_val(v) * (1.0f / (float)D) + EPS); }
__device__ __forceinline__ float sigmoidf_(float x) { return __builtin_amdgcn_rcpf(1.0f + __expf(-x)); }
__device__ __forceinline__ float siluf_(float x) { return x * sigmoidf_(x); }
__device__ __forceinline__ float geluf_(float x) { const float z = 1.5957691216f * (x + 0.044715f * x * x * x); return x * sigmoidf_(z); }
__device__ __forceinline__ void unpack8(const u32x4 w, float (&v)[8]) { v[0] = blo(w.x); v[1] = bhi(w.x); v[2] = blo(w.y); v[3] = bhi(w.y); v[4] = blo(w.z); v[5] = bhi(w.z); v[6] = blo(w.w); v[7] = bhi(w.w); }
__device__ __forceinline__ u32x4 pack8(const float (&v)[8]) { u32x4 w; w.x = pk2(v[0], v[1]); w.y = pk2(v[2], v[3]); w.z = pk2(v[4], v[5]); w.w = pk2(v[6], v[7]); return w; }
__device__ __forceinline__ float wave_sum(float v) {
#pragma unroll
    for (int o = 32; o > 0; o >>= 1) v += __shfl_xor(v, o);
    return v; }
__device__ __forceinline__ float wave_max(float v) {
#pragma unroll
    for (int o = 32; o > 0; o >>= 1) v = fmaxf(v, __shfl_xor(v, o));
    return v; }

typedef const f32x4 (&AccT)[2][2][4][2];

struct EpiScale {
    static constexpr bool PERM = true, AFTER_DRAIN = false;
    bf16_t* O; int ldc; const rs_t* rs; float* ab; int ab_pn;
    __device__ __forceinline__ void operator()(AccT acc, const Unit& u, int wr, int wc, int fr, int fq) const {
        const int row0 = u.pm * 256 + wr * 64 + fr, colw = wc * 32 + 8 * fq;
        const bool side = (ab != nullptr) && (u.pn == ab_pn);
#pragma unroll
        for (int ai = 0; ai < 2; ++ai)
#pragma unroll
            for (int m = 0; m < 4; ++m) {
                const int row = row0 + ai * 128 + m * 16;
                const float s = rs ? rstd_of(rs[row]) : 1.0f;
#pragma unroll
                for (int bj = 0; bj < 2; ++bj) {
                    const f32x4 v0 = acc[ai][bj][m][0] * s, v1 = acc[ai][bj][m][1] * s;
                    if (side) { if (bj == 0) { float* p = ab + (size_t)row * 128 + colw; *(f32x4*)p = v0; *(f32x4*)(p + 4) = v1; } }
                    else { u32x4 w; w.x = pk2(v0[0], v0[1]); w.y = pk2(v0[2], v0[3]); w.z = pk2(v1[0], v1[1]); w.w = pk2(v1[2], v1[3]);
                           *(u32x4*)(O + (size_t)row * ldc + u.pn * 256 + bj * 128 + colw) = w; }
                }
            }
    }
};
struct EpiGelu {
    static constexpr bool PERM = true, AFTER_DRAIN = false;
    bf16_t* O; int ldc; const rs_t* rs; rs_t* rsv; int vtile0;
    __device__ __forceinline__ void operator()(AccT acc, const Unit& u, int wr, int wc, int fr, int fq) const {
        const int row0 = u.pm * 256 + wr * 64 + fr, colw = wc * 32 + 8 * fq;
        const bool isv = u.pn >= vtile0;
#pragma unroll
        for (int ai = 0; ai < 2; ++ai)
#pragma unroll
            for (int m = 0; m < 4; ++m) {
                const int row = row0 + ai * 128 + m * 16;
                const float s = rstd_of(rs[row]); float ss = 0.f;
#pragma unroll
                for (int bj = 0; bj < 2; ++bj) {
                    float v[8];
#pragma unroll
                    for (int j = 0; j < 4; ++j) { v[j] = geluf_(acc[ai][bj][m][0][j] * s); v[4 + j] = geluf_(acc[ai][bj][m][1][j] * s); }
#pragma unroll
                    for (int j = 0; j < 8; ++j) ss += v[j] * v[j];
                    *(u32x4*)(O + (size_t)row * ldc + u.pn * 256 + bj * 128 + colw) = pack8(v);
                }
                if (isv) { ss += __shfl_xor(ss, 16); ss += __shfl_xor(ss, 32); if (fq == 0) rs_add(rsv + row, ss); }
            }
    }
};
__device__ __forceinline__ float put_x(float* X, bf16_t* XB, size_t off, const float (&xn)[8]) {
    *(f32x4*)(X + off) = (f32x4){xn[0], xn[1], xn[2], xn[3]}; *(f32x4*)(X + off + 4) = (f32x4){xn[4], xn[5], xn[6], xn[7]};
    *(u32x4*)(XB + off) = pack8(xn);
    float ss = 0.f;
#pragma unroll
    for (int j = 0; j < 8; ++j) ss += xn[j] * xn[j];
    return ss;
}
struct EpiResid {
    static constexpr bool PERM = true, AFTER_DRAIN = false;
    float* X; bf16_t* XB; rs_t* rsq;
    __device__ __forceinline__ void operator()(AccT acc, const Unit& u, int wr, int wc, int fr, int fq) const {
        const int row0 = u.pm * 256 + wr * 64 + fr, colw = wc * 32 + 8 * fq;
#pragma unroll
        for (int ai = 0; ai < 2; ++ai)
#pragma unroll
            for (int m = 0; m < 4; ++m) {
                const int row = row0 + ai * 128 + m * 16; float ss = 0.f;
#pragma unroll
                for (int bj = 0; bj < 2; ++bj) {
                    const size_t off = (size_t)row * D + u.pn * 256 + bj * 128 + colw;
                    const f32x4 x0 = *(const f32x4*)(X + off), x1 = *(const f32x4*)(X + off + 4);
                    float xn[8];
#pragma unroll
                    for (int j = 0; j < 4; ++j) { xn[j] = x0[j] + acc[ai][bj][m][0][j]; xn[4 + j] = x1[j] + acc[ai][bj][m][1][j]; }
                    ss += put_x(X, XB, off, xn);
                }
                ss += __shfl_xor(ss, 16); ss += __shfl_xor(ss, 32); if (fq == 0) rs_add(rsq + row, ss);
            }
    }
};
struct EpiPle {
    static constexpr bool PERM = true, AFTER_DRAIN = false;
    float* X; bf16_t* XB; rs_t* rsq; const rs_t* rs_in; const bf16_t* PP;
    __device__ __forceinline__ void operator()(AccT acc, const Unit& u, int wr, int wc, int fr, int fq) const {
        const int row0 = u.pm * 256 + wr * 64 + fr, colw = wc * 32 + 8 * fq;
#pragma unroll
        for (int ai = 0; ai < 2; ++ai)
#pragma unroll
            for (int m = 0; m < 4; ++m) {
                const int row = row0 + ai * 128 + m * 16; float ss = 0.f; const float s = rstd_of(rs_in[row]);
#pragma unroll
                for (int bj = 0; bj < 2; ++bj) {
                    const size_t off = (size_t)row * D + u.pn * 256 + bj * 128 + colw;
                    const f32x4 x0 = *(const f32x4*)(X + off), x1 = *(const f32x4*)(X + off + 4);
                    float pv[8]; unpack8(*(const u32x4*)(PP + off), pv);
                    float xn[8];
#pragma unroll
                    for (int j = 0; j < 4; ++j) { xn[j] = x0[j] + sigmoidf_(acc[ai][bj][m][0][j] * s) * pv[j]; xn[4 + j] = x1[j] + sigmoidf_(acc[ai][bj][m][1][j] * s) * pv[4 + j]; }
                    ss += put_x(X, XB, off, xn);
                }
                ss += __shfl_xor(ss, 16); ss += __shfl_xor(ss, 32); if (fq == 0) rs_add(rsq + row, ss);
            }
    }
};
struct EpiGlu {
    static constexpr bool PERM = true, AFTER_DRAIN = false;
    float* X; bf16_t* XB; rs_t* rsq;
    __device__ __forceinline__ void operator()(AccT acc, const Unit& u, int wr, int wc, int fr, int fq) const {
        const int row0 = u.pm * 256 + wr * 64 + fr, colw = wc * 32 + 8 * fq;
#pragma unroll
        for (int ai = 0; ai < 2; ++ai)
#pragma unroll
            for (int m = 0; m < 4; ++m) {
                const int row = row0 + ai * 128 + m * 16;
                const size_t off = (size_t)row * D + u.pn * 128 + colw;
                const f32x4 x0 = *(const f32x4*)(X + off), x1 = *(const f32x4*)(X + off + 4);
                float xn[8];
#pragma unroll
                for (int j = 0; j < 4; ++j) { xn[j] = x0[j] + acc[ai][0][m][0][j] * sigmoidf_(acc[ai][1][m][0][j]); xn[4 + j] = x1[j] + acc[ai][0][m][1][j] * sigmoidf_(acc[ai][1][m][1][j]); }
                float ss = put_x(X, XB, off, xn);
                ss += __shfl_xor(ss, 16); ss += __shfl_xor(ss, 32); if (fq == 0) rs_add(rsq + row, ss);
            }
    }
};
struct EpiGdnZ {
    static constexpr bool PERM = true, AFTER_DRAIN = false;
    bf16_t* O; int ldc; const rs_t* rs;
    __device__ __forceinline__ void operator()(AccT acc, const Unit& u, int wr, int wc, int fr, int fq) const {
        const int row0 = u.pm * 256 + wr * 64 + fr, colw = wc * 32 + 8 * fq;
#pragma unroll
        for (int ai = 0; ai < 2; ++ai)
#pragma unroll
            for (int m = 0; m < 4; ++m) {
                const int row = row0 + ai * 128 + m * 16; const float s = rstd_of(rs[row]);
#pragma unroll
                for (int bj = 0; bj < 2; ++bj) {
                    bf16_t* p = O + (size_t)row * ldc + u.pn * 256 + bj * 128 + colw;
                    float ov[8]; unpack8(*(const u32x4*)p, ov);
#pragma unroll
                    for (int j = 0; j < 4; ++j) { ov[j] *= siluf_(acc[ai][bj][m][0][j] * s); ov[4 + j] *= siluf_(acc[ai][bj][m][1][j] * s); }
                    *(u32x4*)p = pack8(ov);
                }
            }
    }
};

template <class Epi>
__device__ __forceinline__ void run_gemm(LAS unsigned char* lds, const bf16_t* A, const bf16_t* Bt, int M, int N, int K, const Epi& E) {
    pg8::Gemm g{A, Bt, M, N, K}; pg8::StaticOrder S; S.init(M, N, (int)gridDim.x, (int)blockIdx.x);
    pg8::gemm_phase<Epi, pg8::StaticOrder, true, true>(lds, g, S, E);
}

struct Job { const float* src; bf16_t* dst; const float* gain; int K, Nsrc, Ndst, map, qcols; };
__device__ __forceinline__ void get_job(ArgsCP a, int j, Job& J) {
    unsigned char* ws = a->ws; J.gain = nullptr; J.map = 0; J.qcols = 0;
    if (j < 16) { const int L = j >> 2, k = j & 3;
        if (k == 0)      { J.src = a->in[31] + (size_t)L * D * 2 * DFF; J.dst = (bf16_t*)(ws + WS_WGU + L * SZ_WGU); J.gain = a->in[5] + L * D; J.K = D; J.Nsrc = 2 * DFF; J.Ndst = 2 * DFF; J.map = 1; }
        else if (k == 1) { J.src = a->in[34] + (size_t)L * DFF * D;     J.dst = (bf16_t*)(ws + WS_WDN + L * SZ_WDN); J.K = DFF; J.Nsrc = D; J.Ndst = D; }
        else if (k == 2) { J.src = a->in[36] + (size_t)L * D * D;       J.dst = (bf16_t*)(ws + WS_WPG + L * SZ_WPG); J.gain = a->in[6] + L * D; J.K = D; J.Nsrc = D; J.Ndst = D; }
        else             { J.src = a->in[35] + (size_t)L * PLED * D;    J.dst = (bf16_t*)(ws + WS_WPP + L * SZ_WPP); J.K = PLED; J.Nsrc = D; J.Ndst = D; }
    } else switch (j) {
        case 16: J.src = a->in[8];  J.dst = (bf16_t*)(ws + WS_NAQ); J.gain = a->in[4] + 0 * D; J.K = D; J.Nsrc = 6144; J.Ndst = 6144; J.qcols = 2048; break;
        case 17: J.src = a->in[9];  J.dst = (bf16_t*)(ws + WS_NAO); J.K = D; J.Nsrc = D; J.Ndst = D; break;
        case 18: J.src = a->in[11]; J.dst = (bf16_t*)(ws + WS_SGI); J.gain = a->in[4] + 1 * D; J.K = D; J.Nsrc = 4096; J.Ndst = 4096; break;
        case 19: J.src = a->in[15]; J.dst = (bf16_t*)(ws + WS_SGO); J.K = D; J.Nsrc = D; J.Ndst = D; break;
        case 20: J.src = a->in[16]; J.dst = (bf16_t*)(ws + WS_GDI); J.gain = a->in[4] + 2 * D; J.K = D; J.Nsrc = 12416; J.Ndst = GDI_N; J.map = 2; break;
        case 21: J.src = a->in[21]; J.dst = (bf16_t*)(ws + WS_GDO); J.K = 4096; J.Nsrc = D; J.Ndst = D; break;
        default: J.src = a->in[30]; J.dst = (bf16_t*)(ws + WS_S5G); J.K = D; J.Nsrc = 4096; J.Ndst = 4096; J.map = 1; break;
    }
}
__device__ __forceinline__ int map_col(const Job& J, int n0) {
    if (J.map == 0) return n0;
    if (J.map == 1) { const int tile = n0 >> 8, w = n0 & 255, H = J.Nsrc >> 1; return w < 128 ? tile * 128 + w : H + tile * 128 + (w - 128); }
    if (n0 < 8192) return n0;
    if (n0 < 8320) return 12288 + (n0 - 8192);
    if (n0 < GDI_N1) return -1;
    return 8192 + (n0 - GDI_N1);
}
__device__ __forceinline__ void prologue(ArgsCP a, LAS unsigned char* lds) {
    const int tid = tidx(), G = gridDim.x, bid = blockIdx.x;
    LAS float* tile = (LAS float*)lds;
    int base = 0;
    for (int j = 0; j < 23; ++j) {
        Job J; get_job(a, j, J);
        const int kt = J.K >> 6, ntl = J.Ndst >> 6, nt = kt * ntl;
        int first = (bid - (base % G) + G) % G;
        for (int i = first; i < nt; i += G) {
            const int nb = i / kt, kb = i - nb * kt, n0 = nb * 64, k0 = kb * 64, s0 = map_col(J, n0);
            const float cs = (n0 < J.qcols) ? 0.08838834764831845f : 1.0f;
            const int kk = tid >> 4, nn4 = (tid & 15) * 4;
#pragma unroll
            for (int p = 0; p < 2; ++p) {
                const int k = k0 + kk + 32 * p;
                f32x4 v = (f32x4){0.f, 0.f, 0.f, 0.f};
                if (s0 >= 0) v = *(const f32x4*)(J.src + (size_t)k * J.Nsrc + s0 + nn4);
                const float sc = (J.gain ? J.gain[k] : 1.0f) * cs;
#pragma unroll
                for (int q = 0; q < 4; ++q) tile[(nn4 + q) * 65 + kk + 32 * p] = v[q] * sc;
            }
            __syncthreads();
            { const int nn = tid >> 3, kk8 = (tid & 7) * 8; float v[8];
#pragma unroll
              for (int q = 0; q < 8; ++q) v[q] = tile[nn * 65 + kk8 + q];
              *(u32x4*)(J.dst + (size_t)(n0 + nn) * J.K + k0 + kk8) = pack8(v); }
            __syncthreads();
        }
        base += nt;
    }
    { bf16_t* PB = (bf16_t*)(a->ws + WS_PB);
      const long total = (long)4 * T * 64;
      for (long i = (long)bid * NTHR + tid; i < total; i += (long)G * NTHR) {
          const int L = (int)(i / ((long)T * 64)); const int rem = (int)(i - (long)L * T * 64); const int row = rem >> 6, c4 = (rem & 63) * 4;
          const float* src = row < 8192 ? a->in[2] + ((size_t)L * 8192 + row) * PLED + c4 : a->in[3] + ((size_t)L * 32768 + (row - 8192)) * PLED + c4;
          const f32x4 v = *(const f32x4*)src; u32x2 w; w.x = pk2(v[0], v[1]); w.y = pk2(v[2], v[3]);
          *(u32x2*)(PB + ((size_t)L * T + row) * PLED + c4) = w; } }
    { bf16_t* XB = (bf16_t*)(a->ws + WS_XB0); rs_t* rs = (rs_t*)(a->ws + WS_RS);
      const int w = tid >> 6, lane = tid & 63;
      for (int row = bid * 8 + w; row < T; row += G * 8) {
          const float* src = row < 8192 ? a->in[0] + (size_t)row * D : a->in[1] + (size_t)(row - 8192) * D;
          float ss = 0.f;
#pragma unroll
          for (int q = 0; q < 8; ++q) { const int c = (q * 64 + lane) * 4; const f32x4 v = *(const f32x4*)(src + c);
              *(f32x4*)(a->out + (size_t)row * D + c) = v; u32x2 wv; wv.x = pk2(v[0], v[1]); wv.y = pk2(v[2], v[3]); *(u32x2*)(XB + (size_t)row * D + c) = wv;
              ss += v[0] * v[0] + v[1] * v[1] + v[2] * v[2] + v[3] * v[3]; }
          ss = wave_sum(ss); if (lane == 0) rs[row] = rs_fix(ss); } }
}

__device__ __forceinline__ void na_attention(ArgsCP a, LAS unsigned char* lds, const bf16_t* QKV, bf16_t* AO) {
    const int tid = tidx(), w = tid >> 6, lane = tid & 63;
    LAS float* qs = (LAS float*)(lds + w * 1024); LAS float* ps = qs + 128;
    const float* rpb = a->in[10];
    for (long task = (long)blockIdx.x * 8 + w; task < (long)T * 16; task += (long)gridDim.x * 8) {
        const int seq = (int)(task >> 16), rem = (int)(task & 65535), h = rem >> 12, pos = rem & 4095, r = pos >> 6, c = pos & 63;
        const int r0 = min(max(r - 4, 0), 56), c0 = min(max(c - 8, 0), 48);
        const size_t trow = (size_t)seq * SEQ + pos;
        { const unsigned qq = *(const unsigned*)(QKV + trow * 6144 + h * 128 + 2 * lane); qs[2 * lane] = blo(qq); qs[2 * lane + 1] = bhi(qq); }
        __builtin_amdgcn_wave_barrier();
        float s[2];
#pragma unroll
        for (int kk = 0; kk < 2; ++kk) {
            const int j = lane + 64 * kk, kr = r0 + (j >> 4), kc = c0 + (j & 15);
            const u32x4* kp = (const u32x4*)(QKV + ((size_t)seq * SEQ + kr * 64 + kc) * 6144 + 2048 + h * 128);
            float acc = 0.f;
#pragma unroll 4
            for (int d8 = 0; d8 < 16; ++d8) { const u32x4 kv = kp[d8]; const f32x4 q0 = *(const LAS f32x4*)(qs + d8 * 8), q1 = *(const LAS f32x4*)(qs + d8 * 8 + 4);
                acc += q0[0] * blo(kv.x) + q0[1] * bhi(kv.x) + q0[2] * blo(kv.y) + q0[3] * bhi(kv.y) + q1[0] * blo(kv.z) + q1[1] * bhi(kv.z) + q1[2] * blo(kv.w) + q1[3] * bhi(kv.w); }
            s[kk] = acc + rpb[(h * 15 + (kr - r + 7)) * 31 + (kc - c + 15)];
        }
        const float mx = wave_max(fmaxf(s[0], s[1]));
        const float e0 = __expf(s[0] - mx), e1 = __expf(s[1] - mx);
        const float inv = 1.0f / wave_sum(e0 + e1);
        ps[lane] = e0 * inv; ps[lane + 64] = e1 * inv;
        __builtin_amdgcn_wave_barrier();
        float o0 = 0.f, o1 = 0.f;
        const bf16_t* vb = QKV + ((size_t)seq * SEQ) * 6144 + 4096 + h * 128 + 2 * lane;
#pragma unroll 4
        for (int j = 0; j < 128; ++j) { const int kr = r0 + (j >> 4), kc = c0 + (j & 15);
            const unsigned vv = *(const unsigned*)(vb + (size_t)(kr * 64 + kc) * 6144); const float p = ps[j]; o0 += p * blo(vv); o1 += p * bhi(vv); }
        *(unsigned*)(AO + trow * D + h * 128 + 2 * lane) = pk2(o0, o1);
        __builtin_amdgcn_wave_barrier();
    }
}

__device__ __forceinline__ void sgu_mix(ArgsCP a, LAS unsigned char* lds, const bf16_t* UV, const rs_t* rsv, bf16_t* MX) {
    const int tid = tidx(), G = gridDim.x;
    LAS float* WT = (LAS float*)lds;
    LAS float* VS = (LAS float*)(lds + 65536);
    const float* w_s = a->in[13]; const float* b_s = a->in[14]; const float* sgn = a->in[12];
    const int per = (5120 + G - 1) / G, u0 = blockIdx.x * per, u1 = min(5120, u0 + per);
    int gcur = -1;
    for (int u = u0; u < u1; ++u) {
        const int g = u / 320, sc = u - g * 320, seq = sc >> 5, n = sc & 31; const size_t row0 = (size_t)seq * SEQ + n * 128;
        __syncthreads();
        if (g != gcur) { gcur = g;
            for (int idx = tid; idx < 16384; idx += NTHR) { const int t = idx >> 7, s = idx & 127; WT[s * 128 + t] = w_s[(size_t)g * 16384 + idx]; } }
        { const int s = tid >> 2, c32 = (tid & 3) * 32; const float rsd = rstd_of(rsv[row0 + s]);
#pragma unroll
          for (int q = 0; q < 4; ++q) { float v[8]; unpack8(*(const u32x4*)(UV + (row0 + s) * 4096 + 2048 + g * 128 + c32 + q * 8), v);
#pragma unroll
              for (int j = 0; j < 8; ++j) VS[s * 128 + c32 + q * 8 + j] = v[j] * rsd * sgn[g * 128 + c32 + q * 8 + j]; } }
        __syncthreads();
        const int t0 = (tid >> 4) * 4, c0 = (tid & 15) * 8;
        float acc[4][8];
#pragma unroll
        for (int i = 0; i < 4; ++i)
#pragma unroll
            for (int j = 0; j < 8; ++j) acc[i][j] = 0.f;
#pragma unroll 4
        for (int s = 0; s < 128; ++s) {
            const f32x4 av = *(const LAS f32x4*)(WT + s * 128 + t0), v0 = *(const LAS f32x4*)(VS + s * 128 + c0), v1 = *(const LAS f32x4*)(VS + s * 128 + c0 + 4);
#pragma unroll
            for (int i = 0; i < 4; ++i) {
#pragma unroll
                for (int j = 0; j < 4; ++j) { acc[i][j] += av[i] * v0[j]; acc[i][4 + j] += av[i] * v1[j]; } }
        }
#pragma unroll
        for (int i = 0; i < 4; ++i) { const int t = t0 + i; const float bias = b_s[g * 128 + t]; const size_t row = row0 + t;
            float uv[8]; unpack8(*(const u32x4*)(UV + row * 4096 + g * 128 + c0), uv);
#pragma unroll
            for (int j = 0; j < 8; ++j) uv[j] *= (acc[i][j] + bias);
            *(u32x4*)(MX + row * D + g * 128 + c0) = pack8(uv); }
    }
}

__device__ __forceinline__ void ffn_convglu(ArgsCP a, int layer, const bf16_t* GU, bf16_t* HID, int rows) {
    const float* cw = a->in[32] + (size_t)layer * 3 * DFF; const float* cb = a->in[33] + (size_t)layer * DFF;
    const long total = (long)rows * 704;
    for (long i = (long)blockIdx.x * NTHR + tidx(); i < total; i += (long)gridDim.x * NTHR) {
        const int r = (int)(i / 704), cbk = (int)(i - (long)r * 704), ch = cbk * 8, pos = r & (SEQ - 1);
        const bf16_t* gp = GU + (size_t)r * (2 * DFF) + (cbk >> 4) * 256 + (cbk & 15) * 8;
        float g0[8], gm[8], gn[8], up[8];
        unpack8(*(const u32x4*)gp, g0); unpack8(*(const u32x4*)(gp + 128), up);
        if (pos > 0) unpack8(*(const u32x4*)(gp - 2 * DFF), gm); else {
#pragma unroll
            for (int j = 0; j < 8; ++j) gm[j] = 0.f; }
        if (pos < SEQ - 1) unpack8(*(const u32x4*)(gp + 2 * DFF), gn); else {
#pragma unroll
            for (int j = 0; j < 8; ++j) gn[j] = 0.f; }
        float o[8];
#pragma unroll
        for (int j = 0; j < 8; ++j) { const float gv = cw[ch + j] * gm[j] + cw[DFF + ch + j] * g0[j] + cw[2 * DFF + ch + j] * gn[j] + cb[ch + j]; o[j] = siluf_(gv) * up[j]; }
        *(u32x4*)(HID + (size_t)r * DFF + ch) = pack8(o);
    }
}

__device__ __forceinline__ void gdn_conv(ArgsCP a, const bf16_t* PROJ, const float* AB, bf16_t* QK, bf16_t* VP, float* GB, int rows) {
    const int tid = tidx(), ch0 = tid * 16;
    const float* cw = a->in[17];
    float w0[16], w1[16], w2[16];
#pragma unroll
    for (int j = 0; j < 16; ++j) { w0[j] = cw[ch0 + j]; w1[j] = cw[8192 + ch0 + j]; w2[j] = cw[16384 + ch0 + j]; }
    for (int r = blockIdx.x; r < rows; r += gridDim.x) {
        const int pos = r & (SEQ - 1);
        const bf16_t* p = PROJ + (size_t)r * 8192 + ch0;
        float x0[16], xm[16], xn[16];
        { float t[8]; unpack8(*(const u32x4*)p, t);
#pragma unroll
          for (int j = 0; j < 8; ++j) x0[j] = t[j];
          unpack8(*(const u32x4*)(p + 8), t);
#pragma unroll
          for (int j = 0; j < 8; ++j) x0[8 + j] = t[j]; }
        if (pos > 0) { float t[8]; unpack8(*(const u32x4*)(p - 8192), t);
#pragma unroll
          for (int j = 0; j < 8; ++j) xm[j] = t[j];
          unpack8(*(const u32x4*)(p - 8192 + 8), t);
#pragma unroll
          for (int j = 0; j < 8; ++j) xm[8 + j] = t[j]; } else {
#pragma unroll
          for (int j = 0; j < 16; ++j) xm[j] = 0.f; }
        if (pos < SEQ - 1) { float t[8]; unpack8(*(const u32x4*)(p + 8192), t);
#pragma unroll
          for (int j = 0; j < 8; ++j) xn[j] = t[j];
          unpack8(*(const u32x4*)(p + 8192 + 8), t);
#pragma unroll
          for (int j = 0; j < 8; ++j) xn[8 + j] = t[j]; } else {
#pragma unroll
          for (int j = 0; j < 16; ++j) xn[j] = 0.f; }
        float y[16], ss = 0.f;
#pragma unroll
        for (int j = 0; j < 16; ++j) { y[j] = siluf_(w0[j] * xm[j] + w1[j] * x0[j] + w2[j] * xn[j]); ss += y[j] * y[j]; }
        ss += __shfl_xor(ss, 1); ss += __shfl_xor(ss, 2); ss += __shfl_xor(ss, 4);
        float sc = 1.0f;
        if (ch0 < 4096) { sc = rsqrtf(ss + EPS); if (ch0 < 2048) sc *= 0.08838834764831845f; }
        float o0[8], o1[8];
#pragma unroll
        for (int j = 0; j < 8; ++j) { o0[j] = y[j] * sc; o1[j] = y[8 + j] * sc; }
        bf16_t* dst = ch0 < 4096 ? QK + (size_t)r * 4096 + ch0 : VP + (size_t)r * 4096 + (ch0 - 4096);
        *(u32x4*)dst = pack8(o0); *(u32x4*)(dst + 8) = pack8(o1);
        if (tid < 64) { const int dir = tid >> 5, head = tid & 31;
            const float av = AB[(size_t)r * 128 + dir * 64 + head], bv = AB[(size_t)r * 128 + dir * 64 + 32 + head];
            const float xx = av + a->in[19][dir * 32 + head];
            const float sp = xx > 20.f ? xx : log1pf(expf(xx));
            GB[(size_t)r * 128 + dir * 64 + head] = -expf(a->in[18][dir * 32 + head]) * sp;
            GB[(size_t)r * 128 + dir * 64 + 32 + head] = 1.0f / (1.0f + expf(-bv)); }
    }
}
__device__ __forceinline__ void gdn_scan_naive(LAS unsigned char* lds, const bf16_t* QK, const bf16_t* VP, const float* GB, bf16_t* OF, bf16_t* OB, int nseq) {
    const int tid = tidx(), vh = tid >> 8, j = (tid & 255) >> 1, half = tid & 1;
    LAS float* KQ = (LAS float*)lds;
    LAS float* VS = (LAS float*)(lds + 16384);
    LAS float* GS = (LAS float*)(lds + 32768);
    const int nunits = nseq * 32;
    for (int unit = blockIdx.x; unit < nunits; unit += gridDim.x) {
        const int seq = unit >> 5, hq = (unit >> 1) & 15, dir = unit & 1, head = 2 * hq + vh;
        bf16_t* OD = dir ? OB : OF;
        float S[64];
#pragma unroll
        for (int i = 0; i < 64; ++i) S[i] = 0.f;
        for (int blk = 0; blk < SEQ / 16; ++blk) {
            __syncthreads();
            { const int tok = tid >> 5, part = tid & 31, step = blk * 16 + tok, pos = dir ? SEQ - 1 - step : step; const size_t row = (size_t)seq * SEQ + pos;
              const bf16_t* src = part < 16 ? QK + row * 4096 + hq * 128 + part * 8 : QK + row * 4096 + 2048 + hq * 128 + (part - 16) * 8;
              float v[8]; unpack8(*(const u32x4*)src, v);
              *(LAS f32x4*)(KQ + tok * 256 + part * 8) = (f32x4){v[0], v[1], v[2], v[3]}; *(LAS f32x4*)(KQ + tok * 256 + part * 8 + 4) = (f32x4){v[4], v[5], v[6], v[7]};
              unpack8(*(const u32x4*)(VP + row * 4096 + hq * 256 + part * 8), v);
              *(LAS f32x4*)(VS + tok * 256 + part * 8) = (f32x4){v[0], v[1], v[2], v[3]}; *(LAS f32x4*)(VS + tok * 256 + part * 8 + 4) = (f32x4){v[4], v[5], v[6], v[7]};
              if (tid < 64) { const int tk = tid >> 2, which = tid & 3, hh = 2 * hq + (which & 1), isb = which >> 1, st = blk * 16 + tk, ps = dir ? SEQ - 1 - st : st;
                  const float gv = GB[((size_t)seq * SEQ + ps) * 128 + dir * 64 + isb * 32 + hh]; GS[tk * 4 + which] = isb ? gv : expf(gv); } }
            __syncthreads();
            for (int s = 0; s < 16; ++s) {
                const float av = GS[s * 4 + vh], bv = GS[s * 4 + 2 + vh], vt = VS[s * 256 + vh * 128 + j];
                const LAS float* kp = KQ + s * 256 + 128 + half * 64; const LAS float* qp = KQ + s * 256 + half * 64;
                float ks = 0.f;
#pragma unroll
                for (int i = 0; i < 64; i += 4) { const f32x4 k4 = *(const LAS f32x4*)(kp + i); ks += k4[0] * S[i] + k4[1] * S[i + 1] + k4[2] * S[i + 2] + k4[3] * S[i + 3]; }
                ks += __shfl_xor(ks, 1);
                const float uu = bv * (vt - av * ks);
                float os = 0.f;
#pragma unroll
                for (int i = 0; i < 64; i += 4) { const f32x4 k4 = *(const LAS f32x4*)(kp + i), q4 = *(const LAS f32x4*)(qp + i);
#pragma unroll
                    for (int e = 0; e < 4; ++e) { S[i + e] = av * S[i + e] + k4[e] * uu; os += q4[e] * S[i + e]; } }
                os += __shfl_xor(os, 1);
                if (half == 0) { const int step = blk * 16 + s, pos = dir ? SEQ - 1 - step : step; OD[((size_t)seq * SEQ + pos) * 4096 + head * 128 + j] = f2bf(os); }
            }
        }
    }
}
__device__ __forceinline__ void gdn_sumnorm(ArgsCP a, bf16_t* OF, const bf16_t* OB, int rows) {
    const int tid = tidx(), rsub = tid >> 8, c0 = (tid & 255) * 16;
    const float* on = a->in[20];
    for (int r = blockIdx.x * 2 + rsub; r < rows; r += gridDim.x * 2) {
        float x[16], t[8];
        unpack8(*(const u32x4*)(OF + (size_t)r * 4096 + c0), t);
#pragma unroll
        for (int q = 0; q < 8; ++q) x[q] = t[q];
        unpack8(*(const u32x4*)(OF + (size_t)r * 4096 + c0 + 8), t);
#pragma unroll
        for (int q = 0; q < 8; ++q) x[8 + q] = t[q];
        unpack8(*(const u32x4*)(OB + (size_t)r * 4096 + c0), t);
#pragma unroll
        for (int q = 0; q < 8; ++q) x[q] += t[q];
        unpack8(*(const u32x4*)(OB + (size_t)r * 4096 + c0 + 8), t);
#pragma unroll
        for (int q = 0; q < 8; ++q) x[8 + q] += t[q];
        float ss = 0.f;
#pragma unroll
        for (int q = 0; q < 16; ++q) ss += x[q] * x[q];
        ss += __shfl_xor(ss, 1); ss += __shfl_xor(ss, 2); ss += __shfl_xor(ss, 4);
        const float sc = rsqrtf(ss * (1.0f / 128.0f) + EPS);
        float o0[8], o1[8];
#pragma unroll
        for (int q = 0; q < 8; ++q) { o0[q] = x[q] * sc * on[(c0 & 127) + q]; o1[q] = x[8 + q] * sc * on[(c0 & 127) + 8 + q]; }
        *(u32x4*)(OF + (size_t)r * 4096 + c0) = pack8(o0); *(u32x4*)(OF + (size_t)r * 4096 + c0 + 8) = pack8(o1);
    }
}

__device__ __forceinline__ void s5_scan(ArgsCP a, LAS unsigned char* lds, const float* X, const rs_t* rs, float* YF, bf16_t* Y) {
    const int tid = tidx(), w = tid >> 6, lane = tid & 63;
    LAS float* U = (LAS float*)(lds + w * 9216);
    LAS float* XS = U + 256;
    const float* gmix = a->in[4] + 3 * D;
    for (int task = blockIdx.x * 8 + w; task < NSEQ * 128; task += gridDim.x * 8) {
        const int seq = task >> 7, gr = task & 127;
        for (int dir = 0; dir < 2; ++dir) {
            const int dg = dir * 128 + gr;
            const float are = a->in[22][dg * 64 + lane], aim = a->in[23][dg * 64 + lane], dt = expf(a->in[24][dg]);
            const float er = expf(are * dt); float sn, cs; sincosf(aim * dt, &sn, &cs);
            const float abr = er * cs, abi = er * sn;
            const float den = 1.0f / (are * are + aim * aim);
            const float cr = ((abr - 1.0f) * are + abi * aim) * den, ci = (abi * are - (abr - 1.0f) * aim) * den;
            float Br[16], Bi[16];
#pragma unroll
            for (int c = 0; c < 16; ++c) { const float bre = a->in[25][((size_t)dg * 64 + lane) * 16 + c], bim = a->in[26][((size_t)dg * 64 + lane) * 16 + c]; Br[c] = cr * bre - ci * bim; Bi[c] = cr * bim + ci * bre; }
            const int oc = lane & 15, tb = lane >> 4;
            float Cr[64], Ci[64];
#pragma unroll
            for (int p = 0; p < 64; ++p) { Cr[p] = a->in[27][((size_t)dg * 16 + oc) * 64 + p]; Ci[p] = a->in[28][((size_t)dg * 16 + oc) * 64 + p]; }
            const float dsk = a->in[29][gr * 16 + oc];
            float xr = 0.f, xi = 0.f;
            for (int blk = 0; blk < SEQ / 16; ++blk) {
                { const int tt = lane >> 2, c4 = (lane & 3) * 4, step = blk * 16 + tt, pos = dir ? SEQ - 1 - step : step; const size_t row = (size_t)seq * SEQ + pos;
                  const f32x4 xv = *(const f32x4*)(X + row * D + gr * 16 + c4); const f32x4 gm = *(const f32x4*)(gmix + gr * 16 + c4); const float rsd = rstd_of(rs[row]);
                  *(LAS f32x4*)(U + tt * 16 + c4) = xv * gm * rsd; }
                __builtin_amdgcn_wave_barrier();
                for (int tt = 0; tt < 16; ++tt) {
                    float bur = 0.f, bui = 0.f;
#pragma unroll
                    for (int c = 0; c < 16; c += 4) { const f32x4 u4 = *(const LAS f32x4*)(U + tt * 16 + c);
#pragma unroll
                        for (int e = 0; e < 4; ++e) { bur += Br[c + e] * u4[e]; bui += Bi[c + e] * u4[e]; } }
                    const float nr = abr * xr - abi * xi + bur, ni = abr * xi + abi * xr + bui; xr = nr; xi = ni;
                    XS[(tt * 64 + lane) * 2] = xr; XS[(tt * 64 + lane) * 2 + 1] = xi;
                }
                __builtin_amdgcn_wave_barrier();
                for (int i = 0; i < 4; ++i) {
                    const int t = tb * 4 + i; float y = 0.f;
#pragma unroll
                    for (int p = 0; p < 64; p += 2) { const f32x4 x2 = *(const LAS f32x4*)(XS + (t * 64 + p) * 2); y += Cr[p] * x2[0] - Ci[p] * x2[1] + Cr[p + 1] * x2[2] - Ci[p + 1] * x2[3]; }
                    const int step = blk * 16 + t, pos = dir ? SEQ - 1 - step : step; const size_t row = (size_t)seq * SEQ + pos;
                    if (dir == 0) YF[row * D + gr * 16 + oc] = y;
                    else { const float yt = y + YF[row * D + gr * 16 + oc] + dsk * U[t * 16 + oc]; Y[row * D + gr * 16 + oc] = f2bf(geluf_(yt)); }
                }
                __builtin_amdgcn_wave_barrier();
            }
        }
    }
}

__device__ __forceinline__ void final_norm(ArgsCP a, const rs_t* rs) {
    const int tid = tidx(), w = tid >> 6, lane = tid & 63; const float* g = a->in[7];
    for (int row = blockIdx.x * 8 + w; row < T; row += gridDim.x * 8) {
        const float s = rstd_of(rs[row]);
#pragma unroll
        for (int q = 0; q < 8; ++q) { const int c = (q * 64 + lane) * 4; f32x4 v = *(const f32x4*)(a->out + (size_t)row * D + c); const f32x4 gv = *(const f32x4*)(g + c); v = v * gv * s; *(f32x4*)(a->out + (size_t)row * D + c) = v; }
    }
}


namespace gdn {
typedef short s16x8 __attribute__((ext_vector_type(8)));
typedef short s16x4 __attribute__((ext_vector_type(4)));
constexpr int QS = 0, QPITCH = 272;
constexpr int KS = QS + 64 * QPITCH;
constexpr int VS = KS + 64 * QPITCH;
constexpr int WS_ = VS + 64 * QPITCH;
constexpr int KT = WS_ + 64 * QPITCH, KTPITCH = 144;
constexpr int MB = KT + 128 * KTPITCH, MPITCH = 144;
constexpr int A2 = MB + 64 * MPITCH;
constexpr int MD = A2 + 64 * MPITCH;
constexpr int DV = MD + 4 * 16 * 17 * 4, DVPITCH = 40;
constexpr int TB = DV + 4 * 16 * DVPITCH;
constexpr int LDS_END = TB + 5 * 256;
static_assert(LDS_END <= LDS_STAGE, "gdn lds");

__device__ __forceinline__ s16x8 mk8(unsigned a, unsigned b, unsigned c, unsigned d) { u32x4 v; v.x = a; v.y = b; v.z = c; v.w = d; return __builtin_bit_cast(s16x8, v); }
__device__ __forceinline__ s16x8 cat8(u32x2 lo, u32x2 hi) { return mk8(lo.x, lo.y, hi.x, hi.y); }
__device__ __forceinline__ s16x4 mk4(unsigned a, unsigned b) { u32x2 v; v.x = a; v.y = b; return __builtin_bit_cast(s16x4, v); }

__device__ __forceinline__ void scan(LAS unsigned char* lds, const bf16_t* QK, const bf16_t* VP, const float* GB, bf16_t* OF, bf16_t* OB, int nseq) {
    const int tid = tidx(), w = __builtin_amdgcn_readfirstlane(tid >> 6), lane = tid & 63;
#define GDN_FRESH() int ln_ = lane; asm volatile("" : "+v"(ln_)); const int g = ln_ >> 4, n = ln_ & 15;
    LAS float* gam = (LAS float*)(lds + TB); LAS float* eg = gam + 64; LAS float* bg = gam + 128; LAS float* bt = gam + 192; LAS float* dl = gam + 256;
    const int nunits = nseq * 64;
    for (int unit = blockIdx.x; unit < nunits; unit += gridDim.x) {
        const int seq = unit >> 6, h = (unit >> 1) & 31, dir = unit & 1, hq = h >> 1;
        bf16_t* OD = dir ? OB : OF;
        f32x4 S[8];
#pragma unroll
        for (int i = 0; i < 8; ++i) S[i] = (f32x4){0.f, 0.f, 0.f, 0.f};
        u32x4 pq[2], pk[2], pv[2]; float pg = 0.f, pb = 0.f;
#define GDN_LOADG(c) do { _Pragma("unroll") for (int i_ = 0; i_ < 2; ++i_) { const int p_ = tid + 512 * i_, ir_ = p_ >> 4, c16_ = (p_ & 15) * 8; \
            const int st_ = (c) * 64 + ir_, pos_ = dir ? SEQ - 1 - st_ : st_; const size_t row_ = (size_t)seq * SEQ + pos_; \
            pq[i_] = *(const u32x4*)(QK + row_ * 4096 + hq * 128 + c16_); pk[i_] = *(const u32x4*)(QK + row_ * 4096 + 2048 + hq * 128 + c16_); pv[i_] = *(const u32x4*)(VP + row_ * 4096 + h * 128 + c16_); } \
            if (tid < 64) { const int st_ = (c) * 64 + tid, pos_ = dir ? SEQ - 1 - st_ : st_; const size_t row_ = (size_t)seq * SEQ + pos_; pg = GB[row_ * 128 + dir * 64 + h]; pb = GB[row_ * 128 + dir * 64 + 32 + h]; } } while (0)
#define GDN_STORE() do { _Pragma("unroll") for (int i_ = 0; i_ < 2; ++i_) { const int p_ = tid + 512 * i_, ir_ = p_ >> 4, c16_ = (p_ & 15) * 8; \
            *(LAS u32x4*)(lds + QS + ir_ * QPITCH + c16_ * 2) = pq[i_]; *(LAS u32x4*)(lds + KS + ir_ * QPITCH + c16_ * 2) = pk[i_]; *(LAS u32x4*)(lds + VS + ir_ * QPITCH + c16_ * 2) = pv[i_]; \
            const unsigned kw_[4] = {pk[i_].x, pk[i_].y, pk[i_].z, pk[i_].w}; \
            _Pragma("unroll") for (int e_ = 0; e_ < 4; ++e_) { *(LAS bf16_t*)(lds + KT + (c16_ + 2 * e_) * KTPITCH + ir_ * 2) = (bf16_t)(kw_[e_] & 0xffffu); *(LAS bf16_t*)(lds + KT + (c16_ + 2 * e_ + 1) * KTPITCH + ir_ * 2) = (bf16_t)(kw_[e_] >> 16); } } \
            if (tid < 64) { float gs_ = pg; _Pragma("unroll") for (int o_ = 1; o_ < 64; o_ <<= 1) { const float t_ = __shfl_up(gs_, o_); if (lane >= o_) gs_ += t_; } \
                const float gl_ = __shfl(gs_, 63), e_ = __expf(gs_); gam[tid] = gs_; eg[tid] = e_; bg[tid] = pb * e_; bt[tid] = pb; dl[tid] = __expf(gl_ - gs_); } } while (0)
        GDN_LOADG(0);
        __syncthreads();
        GDN_STORE();
        __syncthreads();
        for (int c = 0; c < 64; ++c) {
            { GDN_FRESH() const int rb = w & 3, cbp = w >> 2;
#pragma unroll
              for (int cc = 0; cc < 2; ++cc) { const int cb = cbp * 2 + cc;
                  f32x4 a1 = (f32x4){0.f, 0.f, 0.f, 0.f}, a2 = a1;
#pragma unroll
                  for (int ks = 0; ks < 4; ++ks) {
                      const s16x8 ak = *(const LAS s16x8*)(lds + KS + (16 * rb + n) * QPITCH + (32 * ks + 8 * g) * 2);
                      const s16x8 aq = *(const LAS s16x8*)(lds + QS + (16 * rb + n) * QPITCH + (32 * ks + 8 * g) * 2);
                      const s16x8 bk = *(const LAS s16x8*)(lds + KS + (16 * cb + n) * QPITCH + (32 * ks + 8 * g) * 2);
                      a1 = __builtin_amdgcn_mfma_f32_16x16x32_bf16(ak, bk, a1, 0, 0, 0);
                      a2 = __builtin_amdgcn_mfma_f32_16x16x32_bf16(aq, bk, a2, 0, 0, 0); }
                  const int j = 16 * cb + n; const float gj = gam[j];
#pragma unroll
                  for (int e = 0; e < 4; ++e) { const int i = 16 * rb + 4 * g + e; const float d = __expf(fminf(gam[i] - gj, 0.f));
                      const float mm = (j < i) ? a1[e] * d * bt[i] : 0.f, am = (j <= i) ? a2[e] * d : 0.f;
                      *(LAS bf16_t*)(lds + MB + i * MPITCH + j * 2) = f2bf(mm); *(LAS bf16_t*)(lds + A2 + i * MPITCH + j * 2) = f2bf(am);
                      if (cb == rb) *(LAS float*)(lds + MD + ((rb * 16 + 4 * g + e) * 17 + n) * 4) = mm; } } }
            __syncthreads();
            if (w < 4) { GDN_FRESH() const LAS float* N = (const LAS float*)(lds + MD + w * 16 * 17 * 4); float y[16];
#pragma unroll
                for (int j = 15; j >= 0; --j) { float s = (j == n) ? 1.f : 0.f;
#pragma unroll
                    for (int i = j + 1; i < 16; ++i) s -= y[i] * N[i * 17 + j];
                    y[j] = s; }
                float y4[4];
#pragma unroll
                for (int e = 0; e < 4; ++e) { float v = y[0];
#pragma unroll
                    for (int q = 1; q < 16; ++q) v = (4 * g + e == q) ? y[q] : v;
                    y4[e] = v; }
                u32x2 dv; dv.x = pk2(y4[0], y4[1]); dv.y = pk2(y4[2], y4[3]);
                *(LAS u32x2*)(lds + DV + (w * 16 + n) * DVPITCH + 4 * g * 2) = dv; }
            __syncthreads();
            f32x4 xw[4], u[4];
            { GDN_FRESH()
#pragma unroll
            for (int b = 0; b < 4; ++b) {
                f32x4 aw, au;
#pragma unroll
                for (int e = 0; e < 4; ++e) { const int i = 16 * b + 4 * g + e;
                    aw[e] = bf2f(*(const LAS bf16_t*)(lds + KS + i * QPITCH + (16 * w + n) * 2)) * bg[i];
                    au[e] = bf2f(*(const LAS bf16_t*)(lds + VS + i * QPITCH + (16 * w + n) * 2)) * bt[i]; }
#pragma unroll
                for (int j = 0; j < 4; ++j) if (j < b) {
                    const s16x4 am = *(const LAS s16x4*)(lds + MB + (16 * b + n) * MPITCH + (16 * j + 4 * g) * 2);
                    const s16x4 bw = mk4(pk2(xw[j][0], xw[j][1]) ^ 0x80008000u, pk2(xw[j][2], xw[j][3]) ^ 0x80008000u);
                    const s16x4 bu = mk4(pk2(u[j][0], u[j][1]) ^ 0x80008000u, pk2(u[j][2], u[j][3]) ^ 0x80008000u);
                    aw = __builtin_amdgcn_mfma_f32_16x16x16bf16_1k(am, bw, aw, 0, 0, 0);
                    au = __builtin_amdgcn_mfma_f32_16x16x16bf16_1k(am, bu, au, 0, 0, 0); }
                const s16x4 ad = *(const LAS s16x4*)(lds + DV + (b * 16 + n) * DVPITCH + 4 * g * 2);
                xw[b] = __builtin_amdgcn_mfma_f32_16x16x16bf16_1k(ad, mk4(pk2(aw[0], aw[1]), pk2(aw[2], aw[3])), (f32x4){0.f, 0.f, 0.f, 0.f}, 0, 0, 0);
                u[b]  = __builtin_amdgcn_mfma_f32_16x16x16bf16_1k(ad, mk4(pk2(au[0], au[1]), pk2(au[2], au[3])), (f32x4){0.f, 0.f, 0.f, 0.f}, 0, 0, 0);
#pragma unroll
                for (int e = 0; e < 4; ++e) *(LAS bf16_t*)(lds + WS_ + (16 * b + 4 * g + e) * QPITCH + (16 * w + n) * 2) = f2bf(xw[b][e]);
                __builtin_amdgcn_sched_barrier(0);
            } }
            __syncthreads();
            if (c + 1 < 64) GDN_LOADG(c + 1);
            s16x8 Sb[4];
#pragma unroll
            for (int ks = 0; ks < 4; ++ks) Sb[ks] = mk8(pk2(S[2 * ks][0], S[2 * ks][1]), pk2(S[2 * ks][2], S[2 * ks][3]), pk2(S[2 * ks + 1][0], S[2 * ks + 1][1]), pk2(S[2 * ks + 1][2], S[2 * ks + 1][3]));
            { GDN_FRESH()
#pragma unroll
            for (int rb = 0; rb < 4; ++rb) {
#pragma unroll
                for (int ks = 0; ks < 4; ++ks) {
                    const LAS unsigned char* wp = lds + WS_ + (16 * rb + n) * QPITCH + (32 * ks + 4 * g) * 2;
                    const s16x8 aw = cat8(*(const LAS u32x2*)wp, *(const LAS u32x2*)(wp + 32));
                    const u32x4 sv = __builtin_bit_cast(u32x4, Sb[ks]);
                    const s16x8 sneg = mk8(sv.x ^ 0x80008000u, sv.y ^ 0x80008000u, sv.z ^ 0x80008000u, sv.w ^ 0x80008000u);
                    u[rb] = __builtin_amdgcn_mfma_f32_16x16x32_bf16(aw, sneg, u[rb], 0, 0, 0); }
                __builtin_amdgcn_sched_barrier(0); } }
            s16x8 Ub[2], Ud[2];
            { GDN_FRESH()
#pragma unroll
            for (int ks = 0; ks < 2; ++ks) {
                Ub[ks] = mk8(pk2(u[2 * ks][0], u[2 * ks][1]), pk2(u[2 * ks][2], u[2 * ks][3]), pk2(u[2 * ks + 1][0], u[2 * ks + 1][1]), pk2(u[2 * ks + 1][2], u[2 * ks + 1][3]));
                const f32x4 d0 = *(const LAS f32x4*)(dl + 32 * ks + 4 * g), d1 = *(const LAS f32x4*)(dl + 32 * ks + 16 + 4 * g);
                Ud[ks] = mk8(pk2(u[2 * ks][0] * d0[0], u[2 * ks][1] * d0[1]), pk2(u[2 * ks][2] * d0[2], u[2 * ks][3] * d0[3]),
                             pk2(u[2 * ks + 1][0] * d1[0], u[2 * ks + 1][1] * d1[1]), pk2(u[2 * ks + 1][2] * d1[2], u[2 * ks + 1][3] * d1[3])); } }
            { GDN_FRESH()
#pragma unroll
            for (int rb = 0; rb < 4; ++rb) { f32x4 oa = (f32x4){0.f, 0.f, 0.f, 0.f}, o2 = oa;
#pragma unroll
                for (int ks = 0; ks < 4; ++ks) { const LAS unsigned char* qp = lds + QS + (16 * rb + n) * QPITCH + (32 * ks + 4 * g) * 2;
                    o2 = __builtin_amdgcn_mfma_f32_16x16x32_bf16(cat8(*(const LAS u32x2*)qp, *(const LAS u32x2*)(qp + 32)), Sb[ks], o2, 0, 0, 0); }
#pragma unroll
                for (int ks = 0; ks < 2; ++ks) { const LAS unsigned char* ap = lds + A2 + (16 * rb + n) * MPITCH + (32 * ks + 4 * g) * 2;
                    oa = __builtin_amdgcn_mfma_f32_16x16x32_bf16(cat8(*(const LAS u32x2*)ap, *(const LAS u32x2*)(ap + 32)), Ub[ks], oa, 0, 0, 0); }
#pragma unroll
                for (int e = 0; e < 4; ++e) { const int i = 16 * rb + 4 * g + e, st = c * 64 + i, pos = dir ? SEQ - 1 - st : st;
                    OD[((size_t)seq * SEQ + pos) * 4096 + h * 128 + 16 * w + n] = f2bf(eg[i] * o2[e] + oa[e]); }
                __builtin_amdgcn_sched_barrier(0); } }
            { GDN_FRESH() const float egl = eg[63];
#pragma unroll
              for (int sb = 0; sb < 8; ++sb) { f32x4 acc = S[sb] * egl;
#pragma unroll
                  for (int ks = 0; ks < 2; ++ks) { const LAS unsigned char* kp = lds + KT + (16 * sb + n) * KTPITCH + (32 * ks + 4 * g) * 2;
                      acc = __builtin_amdgcn_mfma_f32_16x16x32_bf16(cat8(*(const LAS u32x2*)kp, *(const LAS u32x2*)(kp + 32)), Ud[ks], acc, 0, 0, 0); }
                  S[sb] = acc; __builtin_amdgcn_sched_barrier(0); } }
            __syncthreads();
            if (c + 1 < 64) GDN_STORE();
            __syncthreads();
        }
#undef GDN_LOADG
#undef GDN_STORE
#undef GDN_FRESH
    }
}
}
#ifndef MK_SINGLE
#define MK_SINGLE 1
#endif
constexpr int NPH = 90;

__global__ void __launch_bounds__(NTHR, 2) mk_fwd(Args a_unused) {
    extern __shared__ __attribute__((aligned(16))) unsigned char lds_raw[];
    LAS unsigned char* lds = (LAS unsigned char*)lds_raw;
    int ph_lo, ph_hi;
    XcdBarrier bar;
    { ArgsCP a0 = argp(); ph_lo = a0->ph_lo; ph_hi = a0->ph_hi;
      bar.bar = (unsigned*)(a0->ws + WS_CTL); bar.x = 0; bar.st = (volatile LAS unsigned*)(lds + LDS_STAGE);
      if (ph_hi - ph_lo > 1) {
          if (threadIdx.x < 4) ((LAS unsigned*)(lds + LDS_STAGE))[threadIdx.x] = 0u;
          __syncthreads();
          bar = xcd_barrier_post((unsigned*)(a0->ws + WS_CTL), (volatile LAS unsigned*)(lds + LDS_STAGE));
      } }
    int ph = 0;
#define PH_BEGIN if (ph >= ph_lo && ph < ph_hi) { ArgsCP a = argp(); unsigned char* ws = a->ws; float* X = a->out; rs_t* RS = (rs_t*)(ws + WS_RS); \
        bf16_t* XB0 = (bf16_t*)(ws + WS_XB0); bf16_t* XB1 = (bf16_t*)(ws + WS_XB1); unsigned char* BIG = ws + WS_BIG; (void)X; (void)RS; (void)XB0; (void)XB1; (void)BIG;
#define PH_END   } if (ph >= ph_lo && ph + 1 < ph_hi) xcd_barrier(bar); ++ph;
#define RSB(k) (RS + (size_t)(k) * T)

    PH_BEGIN prologue(a, lds); PH_END

#define FFN_PLE(L, XBc, XBo) \
    _Pragma("unroll 1") for (int fg = 0; fg < NFG; ++fg) { \
        const size_t r0 = (size_t)fg * FG_ROWS; \
        PH_BEGIN { EpiScale E{(bf16_t*)(BIG + BIG_GU), 2 * DFF, RSB(3 * (L) + 1) + r0, nullptr, -1}; \
                   run_gemm(lds, XBc + r0 * D, (const bf16_t*)(ws + WS_WGU + (L) * SZ_WGU), FG_ROWS, 2 * DFF, D, E); } PH_END \
        PH_BEGIN ffn_convglu(a, (L), (const bf16_t*)(BIG + BIG_GU), (bf16_t*)(BIG + BIG_HID), FG_ROWS); PH_END \
        PH_BEGIN { EpiResid E{X + r0 * D, XBc + r0 * D, RSB(3 * (L) + 2) + r0}; \
                   run_gemm(lds, (const bf16_t*)(BIG + BIG_HID), (const bf16_t*)(ws + WS_WDN + (L) * SZ_WDN), FG_ROWS, D, DFF, E); } PH_END \
    } \
    PH_BEGIN { EpiScale E{(bf16_t*)BIG, D, nullptr, nullptr, -1}; \
               run_gemm(lds, (const bf16_t*)(ws + WS_PB) + (size_t)(L) * T * PLED, (const bf16_t*)(ws + WS_WPP + (L) * SZ_WPP), T, D, PLED, E); } PH_END \
    PH_BEGIN { EpiPle E{X, XBo, RSB(3 * (L) + 3), RSB(3 * (L) + 2), (const bf16_t*)BIG}; \
               run_gemm(lds, XBc, (const bf16_t*)(ws + WS_WPG + (L) * SZ_WPG), T, D, D, E); } PH_END

    PH_BEGIN { EpiScale E{(bf16_t*)BIG, 6144, RSB(0), nullptr, -1}; run_gemm(lds, XB0, (const bf16_t*)(ws + WS_NAQ), T, 6144, D, E); } PH_END
    PH_BEGIN na_attention(a, lds, (const bf16_t*)BIG, XB1); PH_END
    PH_BEGIN { EpiResid E{X, XB0, RSB(1)}; run_gemm(lds, XB1, (const bf16_t*)(ws + WS_NAO), T, D, D, E); } PH_END
    FFN_PLE(0, XB0, XB1)
    PH_BEGIN { EpiGelu E{(bf16_t*)BIG, 4096, RSB(3), RSB(13), 8}; run_gemm(lds, XB1, (const bf16_t*)(ws + WS_SGI), T, 4096, D, E); } PH_END
    PH_BEGIN sgu_mix(a, lds, (const bf16_t*)BIG, RSB(13), XB0); PH_END
    PH_BEGIN { EpiResid E{X, XB1, RSB(4)}; run_gemm(lds, XB0, (const bf16_t*)(ws + WS_SGO), T, D, D, E); } PH_END
    FFN_PLE(1, XB1, XB0)
#pragma unroll 1
    for (int gg = 0; gg < NGG; ++gg) {
        const size_t r0 = (size_t)gg * GG_ROWS;
#define GDN_PTRS bf16_t* PROJ = (bf16_t*)(BIG + BIG_PROJ); bf16_t* OF = PROJ; bf16_t* OB = (bf16_t*)(BIG + BIG_OB); bf16_t* VP = (bf16_t*)(BIG + BIG_VP); \
        float* AB = (float*)(BIG + BIG_AB); float* GB = (float*)(BIG + BIG_GB); bf16_t* QK = XB1; (void)PROJ; (void)OF; (void)OB; (void)VP; (void)AB; (void)GB; (void)QK;
        PH_BEGIN { GDN_PTRS EpiScale E{PROJ, 8192, RSB(6) + r0, AB, 32}; run_gemm(lds, XB0 + r0 * D, (const bf16_t*)(ws + WS_GDI), GG_ROWS, GDI_N1, D, E); } PH_END
        PH_BEGIN { GDN_PTRS gdn_conv(a, PROJ, AB, QK, VP, GB, GG_ROWS); } PH_END
        PH_BEGIN { GDN_PTRS gdn::scan(lds, QK, VP, GB, OF, OB, GG_ROWS / SEQ); } PH_END
        PH_BEGIN { GDN_PTRS gdn_sumnorm(a, OF, OB, GG_ROWS); } PH_END
        PH_BEGIN { GDN_PTRS EpiGdnZ E{OF, 4096, RSB(6) + r0}; run_gemm(lds, XB0 + r0 * D, (const bf16_t*)(ws + WS_GDI) + (size_t)GDI_N1 * D, GG_ROWS, 4096, D, E); } PH_END
        PH_BEGIN { GDN_PTRS EpiResid E{X + r0 * D, XB0 + r0 * D, RSB(7) + r0}; run_gemm(lds, OF, (const bf16_t*)(ws + WS_GDO), GG_ROWS, D, 4096, E); } PH_END
    }
    FFN_PLE(2, XB0, XB1)
    PH_BEGIN s5_scan(a, lds, X, RSB(9), (float*)BIG, XB0); PH_END
    PH_BEGIN { EpiGlu E{X, XB1, RSB(10)}; run_gemm(lds, XB0, (const bf16_t*)(ws + WS_S5G), T, 4096, D, E); } PH_END
    FFN_PLE(3, XB1, XB0)
    PH_BEGIN final_norm(a, RSB(12)); PH_END
}
}

extern "C" void kernel_launch(void* const* d_in, const int* in_sizes, int n_in, void* d_out, int out_size, void* d_ws, size_t ws_size, hipStream_t stream) {
    using namespace mk;
    static int grid = 0;
    if (grid == 0) {
        if (n_in != 37 || out_size != T * D || ws_size < WS_END) { fprintf(stderr, "kernel_launch: unexpected problem (n_in %d, out %d, ws %zu < %zu)\n", n_in, out_size, ws_size, (size_t)WS_END); grid = -1; return; }
        int dev = 0, cus = 0;
        if (hipGetDevice(&dev) != hipSuccess || hipDeviceGetAttribute(&cus, hipDeviceAttributeMultiprocessorCount, dev) != hipSuccess) { grid = -1; return; }
        if (hipFuncSetAttribute((const void*)mk_fwd, hipFuncAttributeMaxDynamicSharedMemorySize, LDS_BYTES) != hipSuccess) { fprintf(stderr, "kernel_launch: hipFuncSetAttribute failed\n"); grid = -1; return; }
        int per_cu = 0;
        if (hipOccupancyMaxActiveBlocksPerMultiprocessor(&per_cu, (const void*)mk_fwd, NTHR, LDS_BYTES) != hipSuccess || per_cu < 1) fprintf(stderr, "kernel_launch: occupancy query says %d\n", per_cu);
        (void)hipGetLastError();
        grid = cus > 0 ? cus : 256;
    }
    if (grid < 0) return;
    (void)hipMemsetAsync(d_ws, 0, ZERO_BYTES, stream);
    Args a{};
    for (int i = 0; i < 37; ++i) a.in[i] = (const float*)d_in[i];
    a.out = (float*)d_out; a.ws = (unsigned char*)d_ws;
#if MK_SINGLE
    a.ph_lo = 0; a.ph_hi = NPH;
    hipLaunchKernelGGL(mk_fwd, dim3(grid), dim3(NTHR), LDS_BYTES, stream, a);
#else
    for (int p = 0; p < NPH; ++p) { a.ph_lo = p; a.ph_hi = p + 1; hipLaunchKernelGGL(mk_fwd, dim3(grid), dim3(NTHR), LDS_BYTES, stream, a); }
#endif
}
```

```cpp
#include <hip/hip_runtime.h>
#include <cstdio>
#include <cstdint>
#define XB_TMO      128
#define XB_XCNT(j)  (256  + 64 * (j))
#define XB_XSUB(j)  (1280 + 64 * (j))
#define XB_XGEN(j)  (2304 + 64 * (j))
#define XB_TOP      3328
#define XB_TOPGEN   3392
#define XCD_BAR_WORDS 3456
#define XB_SPIN_CAP (1u << 18)
#define LAS __attribute__((address_space(3)))

__device__ __forceinline__ unsigned xb_ld(unsigned* p)              { return __hip_atomic_load(p, __ATOMIC_RELAXED, __HIP_MEMORY_SCOPE_AGENT); }
__device__ __forceinline__ unsigned xb_add(unsigned* p, unsigned v) { return __hip_atomic_fetch_add(p, v, __ATOMIC_RELAXED, __HIP_MEMORY_SCOPE_AGENT); }
__device__ __forceinline__ unsigned xb_xcc_id() { return (unsigned)__builtin_amdgcn_s_getreg((3 << 11) | 20) & 0xFu; }
#define XB_SPIN(cond, bar) do { unsigned _sp = 0; while (cond) { __builtin_amdgcn_s_sleep(1); \
    if ((++_sp & 255u) == 0u) { if (xb_ld(&(bar)[XB_TMO])) break; if (_sp > XB_SPIN_CAP) { atomicAdd(&(bar)[XB_TMO], 1u); break; } } } } while (0)

struct XcdBarrier {
    unsigned* bar; unsigned x;
    volatile LAS unsigned* st;
};

__device__ __forceinline__ XcdBarrier xcd_barrier_post(unsigned* bar, volatile LAS unsigned* st) {
    XcdBarrier b; b.bar = bar; b.x = xb_xcc_id(); b.st = st;
    if (threadIdx.x == 0) (void)xb_add(&bar[XB_XCNT(b.x)], 1u);
    return b;
}
__device__ __forceinline__ void xcd_barrier_complete(unsigned* bar, unsigned x, unsigned& nloc, unsigned& nx) {
    const unsigned G = gridDim.x * gridDim.y * gridDim.z;
    unsigned sum, cnt, mine, sp = 0u;
    for (;;) {
        sum = 0u; cnt = 0u; mine = 0u;
#pragma unroll
        for (unsigned j = 0; j < 16; ++j) { const unsigned c = xb_ld(&bar[XB_XCNT(j)]); sum += c; cnt += (c > 0u) ? 1u : 0u; mine = (j == x) ? c : mine; }
        if (sum == G) break;
        __builtin_amdgcn_s_sleep(1);
        if ((++sp & 255u) == 0u) { if (xb_ld(&bar[XB_TMO])) break; if (sp > XB_SPIN_CAP) { atomicAdd(&bar[XB_TMO], 1u); break; } }
    }
    nloc = mine > 0u ? mine : 1u; nx = cnt > 0u ? cnt : 1u;
}

__device__ __forceinline__ void xcd_barrier(const XcdBarrier& b) {
    asm volatile("s_waitcnt vmcnt(0)" ::: "memory");
    __syncthreads();
    if (threadIdx.x == 0) {
        unsigned* bar = b.bar;
        __builtin_amdgcn_s_waitcnt(0);
        unsigned nloc = b.st[0], nx = b.st[1];
        if (nloc == 0u) { xcd_barrier_complete(bar, b.x, nloc, nx); b.st[0] = nloc; b.st[1] = nx; }
        const unsigned old = xb_add(&bar[XB_XSUB(b.x)], 1u);
        const unsigned gen = old / nloc;
        if (old + 1u == (gen + 1u) * nloc) {
            __builtin_amdgcn_fence(__ATOMIC_RELEASE, "agent");
            asm volatile("s_waitcnt vmcnt(0)" ::: "memory");
            const unsigned og = xb_add(&bar[XB_TOP], 1u);
            const unsigned tg = og / nx;
            if (og + 1u == (tg + 1u) * nx) xb_add(&bar[XB_TOPGEN], 1u);
            else XB_SPIN(xb_ld(&bar[XB_TOPGEN]) == tg, bar);
            __builtin_amdgcn_fence(__ATOMIC_ACQUIRE, "agent");
            xb_add(&bar[XB_XGEN(b.x)], 1u);
            asm volatile("s_waitcnt vmcnt(0)" ::: "memory");
        } else {
            XB_SPIN(xb_ld(&bar[XB_XGEN(b.x)]) == gen, bar);
            __builtin_amdgcn_fence(__ATOMIC_ACQUIRE, "agent");
            asm volatile("s_waitcnt vmcnt(0)" ::: "memory");
        }
    }
    __syncthreads();
}
namespace pg8 {
#define PG8_LAS __attribute__((address_space(3)))
typedef unsigned short bf16_t;
typedef short bf16x8 __attribute__((ext_vector_type(8)));
typedef float f32x4 __attribute__((ext_vector_type(4)));
typedef unsigned u32x4 __attribute__((ext_vector_type(4)));
constexpr int BM = 256, BK = 64, HALF = 128, HTB = HALF * BK * 2  , STAGE_BYTES = 8 * HTB, NXCD = 8, WGM = 8;

__host__ __device__ __forceinline__ int lds_byte(int r, int c) { const int st = (r >> 4) * 2 + (c >> 5), rr = r & 15, cc = c & 31, ob = rr * 64 + cc * 2; return st * 1024 + (ob ^ (((ob >> 9) & 1) << 5)); }
__host__ __device__ __forceinline__ void stage_rc(int b, int& R, int& C) { const int st = b / 1024, sb = b % 1024, swz = sb ^ (((sb >> 9) & 1) << 5); R = (st >> 1) * 16 + swz / 64; C = (st & 1) * 32 + (swz % 64) / 2; }
__host__ __device__ __forceinline__ int perm32(int rho) { const int n = rho >> 4, i = rho & 15; return 8 * (i >> 2) + 4 * n + (i & 3); }

struct Unit { int pm, pn; };
struct Gemm { const bf16_t* A; const bf16_t* Bt; int M, N, K; };

struct StaticOrder {
    int nM, nN, nwg, G, c;
    __host__ __device__ void init(int M, int N, int G_, int c_) { nM = M / BM; nN = N / BM; nwg = nM * nN; G = G_; c = c_; }
    __host__ __device__ bool next(int i, Unit& u) const {
        const long L = (long)i * G + c; if (L >= nwg) return false;
        int wgid = (int)L; { const int q = nwg / NXCD, r = nwg % NXCD, xcd = wgid % NXCD, off = wgid / NXCD; wgid = (xcd < r ? xcd * (q + 1) : r * (q + 1) + (xcd - r) * q) + off; }
        const int nig = WGM * nN, gid = wgid / nig, fm = gid * WGM, gsz = (nM - fm) < WGM ? (nM - fm) : WGM;
        u.pm = fm + ((wgid % nig) % gsz); u.pn = (wgid % nig) / gsz; return true;
    }
    __device__ __forceinline__ void a_ready(const Unit&) const {}
    __device__ __forceinline__ void done(const Unit&) const {}
};


__device__ __forceinline__ unsigned cvt_pk_bf16(float lo, float hi) { unsigned r; asm volatile("v_cvt_pk_bf16_f32 %0, %1, %2" : "=v"(r) : "v"(lo), "v"(hi)); return r; }

template <class Epi, class Sched, bool ALIGN_EPI = false, bool SP2 = false>
__device__ __forceinline__ void gemm_phase(PG8_LAS unsigned char* lds, const Gemm g, const Sched& S, const Epi& E) {
    int tid_ = threadIdx.x; asm volatile("" : "+v"(tid_)); const int tid = tid_, wid = __builtin_amdgcn_readfirstlane(tid >> 6), lane = tid & 63, wr = wid >> 2, wc = wid & 3, fr = lane & 15, fq = lane >> 4;
    const int K = g.K, nt = K / BK;
    unsigned voffA[2], voffB[2];
#pragma unroll
    for (int i = 0; i < 2; ++i) { int R, C; stage_rc(tid * 16 + i * 8192, R, C); const int Rb = Epi::PERM ? ((R & ~31) + perm32(R & 31)) : R;
        voffA[i] = (unsigned)(R * K + C) * 2u; voffB[i] = (unsigned)(Rb * K + C) * 2u; }
    const size_t kstep = (size_t)(BK * 2);
    const size_t hstep = (size_t)HALF * K * 2;
    const size_t tstep = 2 * hstep;
    const unsigned ldsw = (unsigned)wid * 1024u;
    const int aoff = lds_byte(wr * 64 + fr, fq * 8), boff = lds_byte(wc * 32 + fr, fq * 8);
#define PG8_SA(b, h) (((b) * 2 + (h)) * HTB)
#define PG8_SB(b, h) ((4 + (b) * 2 + (h)) * HTB)
#define PG8_STAGE(bufoff, gbase, voff) do { _Pragma("unroll") for (int _i = 0; _i < 2; ++_i) \
        __builtin_amdgcn_global_load_lds((const unsigned*)((const char*)(gbase) + (voff)[_i]), (PG8_LAS unsigned*)(lds + (bufoff) + ldsw + _i * 8192), 16, 0, 0); } while (0)
#define PG8_LDA(dst, b, h) do { _Pragma("unroll") for (int m = 0; m < 4; ++m) _Pragma("unroll") for (int k = 0; k < 2; ++k) dst[m][k] = *(const PG8_LAS bf16x8*)(lds + PG8_SA(b, h) + aoff + m * 2048 + k * 1024); } while (0)
#define PG8_LDB(dst, b, h) do { _Pragma("unroll") for (int n = 0; n < 2; ++n) _Pragma("unroll") for (int k = 0; k < 2; ++k) dst[n][k] = *(const PG8_LAS bf16x8*)(lds + PG8_SB(b, h) + boff + n * 2048 + k * 1024); } while (0)
#define PG8_MMA(ai, bj, At, Bt) do { __builtin_amdgcn_s_setprio(1); _Pragma("unroll") for (int m = 0; m < 4; ++m) _Pragma("unroll") for (int n = 0; n < 2; ++n) _Pragma("unroll") for (int k = 0; k < 2; ++k) \
        acc[ai][bj][m][n] = __builtin_amdgcn_mfma_f32_16x16x32_bf16(Bt[n][k], At[m][k], acc[ai][bj][m][n], 0, 0, 0); __builtin_amdgcn_s_setprio(0); } while (0)
#define PG8_WAIT_V(n) asm volatile("s_waitcnt vmcnt(" #n ")" ::: "memory")
#define PG8_WAIT_L(n) asm volatile("s_waitcnt lgkmcnt(" #n ")" ::: "memory")
#define PG8_BAR __builtin_amdgcn_s_barrier()
#define PG8_SCHED __builtin_amdgcn_sched_barrier(0)
    Unit cur, nxt; int ui = 0;
    if (!S.next(0, cur)) return;
    f32x4 acc[2][2][4][2];
#pragma unroll
    for (int a = 0; a < 2; ++a)
#pragma unroll
        for (int b = 0; b < 2; ++b)
#pragma unroll
            for (int m = 0; m < 4; ++m)
#pragma unroll
                for (int n = 0; n < 2; ++n) acc[a][b][m][n] = (f32x4){0.f, 0.f, 0.f, 0.f};
    bf16x8 At[4][2], B0[2][2], B1[2][2];
    const char* cA = (const char*)g.A + (size_t)cur.pm * tstep; const char* cB = (const char*)g.Bt + (size_t)cur.pn * tstep;
    S.a_ready(cur);
    if constexpr (SP2) {
        PG8_STAGE(PG8_SB(0, 0), cB, voffB); PG8_STAGE(PG8_SB(0, 1), cB + hstep, voffB); PG8_STAGE(PG8_SA(0, 0), cA, voffA); PG8_STAGE(PG8_SA(0, 1), cA + hstep, voffA);
        if (wr == 1) PG8_BAR;
        PG8_WAIT_V(2); PG8_BAR;
        PG8_STAGE(PG8_SB(1, 0), cB + kstep, voffB); PG8_STAGE(PG8_SA(1, 0), cA + kstep, voffA); PG8_STAGE(PG8_SB(1, 1), cB + hstep + kstep, voffB);
        PG8_WAIT_V(6); PG8_BAR;
    } else {
        PG8_STAGE(PG8_SB(0, 0), cB, voffB); PG8_STAGE(PG8_SA(0, 0), cA, voffA); PG8_STAGE(PG8_SB(0, 1), cB + hstep, voffB); PG8_STAGE(PG8_SA(0, 1), cA + hstep, voffA);
        if (wr == 1) PG8_BAR;
        PG8_WAIT_V(4); PG8_BAR;
        PG8_STAGE(PG8_SB(1, 0), cB + kstep, voffB); PG8_STAGE(PG8_SA(1, 0), cA + kstep, voffA); PG8_STAGE(PG8_SB(1, 1), cB + hstep + kstep, voffB);
        PG8_WAIT_V(6); PG8_BAR;
    }
    for (;;) {
        const bool has_next = S.next(ui + 1, nxt);
        const char* nA = has_next ? (const char*)g.A + (size_t)nxt.pm * tstep : cA; const char* nB = has_next ? (const char*)g.Bt + (size_t)nxt.pn * tstep : cB;
        for (int t = 0; t < nt; t += 2) {
            const bool last = (t == nt - 2);
            const char* a1 = cA + (size_t)(t + 1) * kstep;
            const char* a2 = last ? nA : cA + (size_t)(t + 2) * kstep; const char* b2 = last ? nB : cB + (size_t)(t + 2) * kstep;
            const char* a3 = a2 + kstep; const char* b3 = b2 + kstep;
            if (last && has_next) S.a_ready(nxt);
            if constexpr (SP2) {
            PG8_LDB(B0, 0, 0); PG8_LDB(B1, 0, 1); PG8_SCHED; PG8_LDA(At, 0, 0); PG8_STAGE(PG8_SA(1, 1), a1 + hstep, voffA);
            PG8_WAIT_V(8); PG8_WAIT_L(0); PG8_BAR; PG8_MMA(0, 0, At, B0); PG8_MMA(0, 1, At, B1); PG8_BAR; PG8_SCHED;
            PG8_LDA(At, 0, 1); PG8_STAGE(PG8_SB(0, 0), b2, voffB); PG8_STAGE(PG8_SB(0, 1), b2 + hstep, voffB); PG8_STAGE(PG8_SA(0, 0), a2, voffA);
            PG8_WAIT_V(8); PG8_WAIT_L(0); PG8_BAR; PG8_MMA(1, 0, At, B0); PG8_MMA(1, 1, At, B1); PG8_BAR; PG8_SCHED;
            PG8_LDB(B0, 1, 0); PG8_LDB(B1, 1, 1); PG8_SCHED; PG8_LDA(At, 1, 0); PG8_STAGE(PG8_SA(0, 1), a2 + hstep, voffA);
            PG8_WAIT_V(8); PG8_WAIT_L(0); PG8_BAR; PG8_MMA(0, 0, At, B0); PG8_MMA(0, 1, At, B1); PG8_BAR; PG8_SCHED;
            PG8_LDA(At, 1, 1); PG8_STAGE(PG8_SB(1, 0), b3, voffB); PG8_STAGE(PG8_SB(1, 1), b3 + hstep, voffB); PG8_STAGE(PG8_SA(1, 0), a3, voffA);
            PG8_WAIT_V(8); PG8_WAIT_L(0); PG8_BAR; PG8_MMA(1, 0, At, B0); PG8_MMA(1, 1, At, B1); PG8_BAR; PG8_SCHED;
            } else {
            PG8_LDB(B0, 0, 0); PG8_SCHED; PG8_LDA(At, 0, 0); PG8_STAGE(PG8_SA(1, 1), a1 + hstep, voffA);
            PG8_WAIT_L(8); PG8_BAR; PG8_WAIT_L(0); PG8_MMA(0, 0, At, B0); PG8_BAR; PG8_SCHED;
            PG8_LDB(B1, 0, 1); PG8_STAGE(PG8_SB(0, 0), b2, voffB);
            PG8_BAR; PG8_WAIT_L(0); PG8_MMA(0, 1, At, B1); PG8_BAR;
            PG8_LDA(At, 0, 1); PG8_STAGE(PG8_SA(0, 0), a2, voffA);
            PG8_BAR; PG8_WAIT_L(0); PG8_MMA(1, 0, At, B0); PG8_BAR; PG8_SCHED;
            PG8_STAGE(PG8_SB(0, 1), b2 + hstep, voffB);
            PG8_WAIT_V(6); PG8_BAR; PG8_MMA(1, 1, At, B1); PG8_BAR;
            PG8_LDB(B0, 1, 0); PG8_SCHED; PG8_LDA(At, 1, 0); PG8_STAGE(PG8_SA(0, 1), a2 + hstep, voffA);
            PG8_WAIT_L(8); PG8_BAR; PG8_WAIT_L(0); PG8_MMA(0, 0, At, B0); PG8_BAR; PG8_SCHED;
            PG8_LDB(B1, 1, 1); PG8_STAGE(PG8_SB(1, 0), b3, voffB);
            PG8_BAR; PG8_WAIT_L(0); PG8_MMA(0, 1, At, B1); PG8_BAR;
            PG8_LDA(At, 1, 1); PG8_STAGE(PG8_SA(1, 0), a3, voffA);
            PG8_BAR; PG8_WAIT_L(0); PG8_MMA(1, 0, At, B0); PG8_BAR; PG8_SCHED;
            PG8_STAGE(PG8_SB(1, 1), b3 + hstep, voffB);
            PG8_WAIT_V(6); PG8_BAR; PG8_MMA(1, 1, At, B1); PG8_BAR;
            }
        }
        if constexpr (ALIGN_EPI) { if (wr == 0) PG8_BAR; }
        if constexpr (!Epi::AFTER_DRAIN) { E(acc, cur, wr, wc, fr, fq); S.done(cur); }
        if (!has_next) break;
#pragma unroll
        for (int a = 0; a < 2; ++a)
#pragma unroll
            for (int b = 0; b < 2; ++b)
#pragma unroll
                for (int m = 0; m < 4; ++m)
#pragma unroll
                    for (int n = 0; n < 2; ++n) acc[a][b][m][n] = (f32x4){0.f, 0.f, 0.f, 0.f};
        cur = nxt; cA = nA; cB = nB; ++ui;
        if constexpr (ALIGN_EPI) { if (wr == 1) PG8_BAR; }
    }
    PG8_WAIT_V(0);
    if constexpr (!ALIGN_EPI) { if (wr == 0) PG8_BAR; }
    PG8_BAR;
    if constexpr (Epi::AFTER_DRAIN) { E.fused(acc, cur, wr, wc, fr, fq, lds, wid, lane); S.done(cur); }
#undef PG8_SA
#undef PG8_SB
#undef PG8_STAGE
#undef PG8_LDA
#undef PG8_LDB
#undef PG8_MMA
#undef PG8_WAIT_V
#undef PG8_WAIT_L
#undef PG8_BAR
#undef PG8_SCHED
}
}

namespace mk {
using pg8::bf16_t; using pg8::f32x4; using pg8::u32x4; using pg8::Unit;
typedef unsigned u32x2 __attribute__((ext_vector_type(2)));
constexpr int D = 2048, T = 40960, NSEQ = 10, SEQ = 4096, DFF = 5632, PLED = 256;
constexpr float EPS = 1e-6f;
constexpr int NTHR = 512;

constexpr size_t AL(size_t x) { return (x + 255) & ~size_t(255); }
constexpr size_t WS_CTL = 0, CTL_BYTES = 65536;
constexpr int NRS = 14;
constexpr size_t WS_RS = WS_CTL + CTL_BYTES, RS_BYTES = (size_t)NRS * T * 8;
constexpr size_t ZERO_BYTES = WS_RS + RS_BYTES;
constexpr size_t SZ_WGU = (size_t)2 * DFF * D * 2, SZ_WDN = (size_t)D * DFF * 2, SZ_WPG = (size_t)D * D * 2, SZ_WPP = (size_t)D * PLED * 2;
constexpr size_t WS_WGU = AL(ZERO_BYTES);
constexpr size_t WS_WDN = WS_WGU + 4 * SZ_WGU;
constexpr size_t WS_WPG = WS_WDN + 4 * SZ_WDN;
constexpr size_t WS_WPP = WS_WPG + 4 * SZ_WPG;
constexpr size_t WS_NAQ = WS_WPP + 4 * SZ_WPP;
constexpr size_t WS_NAO = WS_NAQ + (size_t)6144 * D * 2;
constexpr size_t WS_SGI = WS_NAO + (size_t)D * D * 2;
constexpr size_t WS_SGO = WS_SGI + (size_t)4096 * D * 2;
constexpr int    GDI_N = 12544, GDI_N1 = 8448;
constexpr size_t WS_GDI = WS_SGO + (size_t)D * D * 2;
constexpr size_t WS_GDO = WS_GDI + (size_t)GDI_N * D * 2;
constexpr size_t WS_S5G = WS_GDO + (size_t)D * 4096 * 2;
constexpr size_t WS_PB  = WS_S5G + (size_t)4096 * D * 2;
constexpr size_t WS_XB0 = WS_PB + (size_t)4 * T * PLED * 2;
constexpr size_t WS_XB1 = WS_XB0 + (size_t)T * D * 2;
constexpr size_t WS_BIG = WS_XB1 + (size_t)T * D * 2;
constexpr size_t BIG_BYTES = 524288000;
constexpr size_t WS_END = WS_BIG + BIG_BYTES;
constexpr int FG_ROWS = 8192, NFG = 5;
constexpr size_t BIG_GU = 0, BIG_HID = (size_t)FG_ROWS * 2 * DFF * 2;
constexpr size_t BIG_HID2 = 0, BIG_EDGE = (size_t)T * DFF * 2;
static_assert(BIG_EDGE + (size_t)(T / 256) * 16 * 2 * DFF * 2 <= BIG_BYTES, "BIG");
constexpr int GG_ROWS = 20480, NGG = 2;
constexpr size_t BIG_PROJ = 0, BIG_OB = (size_t)GG_ROWS * 4096 * 2, BIG_VP = (size_t)GG_ROWS * 8192 * 2, BIG_AB = BIG_VP + (size_t)GG_ROWS * 4096 * 2, BIG_GB = BIG_AB + (size_t)GG_ROWS * 128 * 4;
static_assert(BIG_GB + (size_t)GG_ROWS * 128 * 4 <= BIG_BYTES, "BIG");
static_assert((size_t)T * 6144 * 2 <= BIG_BYTES, "BIG");

constexpr int LDS_STAGE = 131072, LDS_BYTES = LDS_STAGE + 1024;

struct Args { const float* in[37]; float* out; unsigned char* ws; int ph_lo, ph_hi; };
typedef const Args __attribute__((address_space(4)))* ArgsCP;
__device__ __forceinline__ ArgsCP argp() { ArgsCP p = (ArgsCP)__builtin_amdgcn_kernarg_segment_ptr(); asm volatile("" : "+s"(p)); return p; }
__device__ __forceinline__ int tidx() { int t = threadIdx.x; asm volatile("" : "+v"(t)); return t; }

__device__ __forceinline__ float bf2f(bf16_t b) { return __uint_as_float(((unsigned)b) << 16); }
__device__ __forceinline__ float blo(unsigned w) { return __uint_as_float(w << 16); }
__device__ __forceinline__ float bhi(unsigned w) { return __uint_as_float(w & 0xffff0000u); }
typedef float f32x2_t __attribute__((ext_vector_type(2))); typedef __bf16 bf16x2_t __attribute__((ext_vector_type(2)));
__device__ __forceinline__ unsigned pk2(float lo, float hi) { const f32x2_t v = {lo, hi}; const bf16x2_t b = __builtin_convertvector(v, bf16x2_t); return __builtin_bit_cast(unsigned, b); }
__device__ __forceinline__ bf16_t f2bf(float f) { return (bf16_t)(pk2(f, 0.f) & 0xffffu); }
typedef unsigned long long rs_t;
__device__ __forceinline__ float rs_val(rs_t v) { return (float)(unsigned)(v >> 24) + (float)(unsigned)(v & 0xffffffull) * (1.0f / 16777216.0f); }
__device__ __forceinline__ rs_t rs_fix(float ss) { return (rs_t)__float2ull_rn(ss * 16777216.0f); }
__device__ __forceinline__ void rs_add(rs_t* p, float ss) { atomicAdd(p, rs_fix(ss)); }
__device__ __forceinline__ float rstd_of(rs_t v) { return rsqrtf(rs_val(v) * (1.0f / (float)D) + EPS); }
__device__ __forceinline__ float sigmoidf_(float x) { return __builtin_amdgcn_rcpf(1.0f + __expf(-x)); }
__device__ __forceinline__ float siluf_(float x) { return x * sigmoidf_(x); }
__device__ __forceinline__ float geluf_(float x) { const float z = 1.5957691216f * (x + 0.044715f * x * x * x); return x * sigmoidf_(z); }
__device__ __forceinline__ void unpack8(const u32x4 w, float (&v)[8]) { v[0] = blo(w.x); v[1] = bhi(w.x); v[2] = blo(w.y); v[3] = bhi(w.y); v[4] = blo(w.z); v[5] = bhi(w.z); v[6] = blo(w.w); v[7] = bhi(w.w); }
__device__ __forceinline__ u32x4 pack8(const float (&v)[8]) { u32x4 w; w.x = pk2(v[0], v[1]); w.y = pk2(v[2], v[3]); w.z = pk2(v[4], v[5]); w.w = pk2(v[6], v[7]); return w; }
__device__ __forceinline__ float wave_sum(float v) {
#pragma unroll
    for (int o = 32; o > 0; o >>= 1) v += __shfl_xor(v, o);
    return v; }
__device__ __forceinline__ float wave_max(float v) {
#pragma unroll
    for (int o = 32; o > 0; o >>= 1) v = fmaxf(v, __shfl_xor(v, o));
    return v; }

typedef const f32x4 (&AccT)[2][2][4][2];

struct EpiScale {
    static constexpr bool PERM = true, AFTER_DRAIN = false;
    bf16_t* O; int ldc; const rs_t* rs; float* ab; int ab_pn;
    __device__ __forceinline__ void operator()(AccT acc, const Unit& u, int wr, int wc, int fr, int fq) const {
        const int row0 = u.pm * 256 + wr * 64 + fr, colw = wc * 32 + 8 * fq;
        const bool side = (ab != nullptr) && (u.pn == ab_pn);
#pragma unroll
        for (int ai = 0; ai < 2; ++ai)
#pragma unroll
            for (int m = 0; m < 4; ++m) {
                const int row = row0 + ai * 128 + m * 16;
                const float s = rs ? rstd_of(rs[row]) : 1.0f;
#pragma unroll
                for (int bj = 0; bj < 2; ++bj) {
                    const f32x4 v0 = acc[ai][bj][m][0] * s, v1 = acc[ai][bj][m][1] * s;
                    if (side) { if (bj == 0) { float* p = ab + (size_t)row * 128 + colw; *(f32x4*)p = v0; *(f32x4*)(p + 4) = v1; } }
                    else { u32x4 w; w.x = pk2(v0[0], v0[1]); w.y = pk2(v0[2], v0[3]); w.z = pk2(v1[0], v1[1]); w.w = pk2(v1[2], v1[3]);
                           *(u32x4*)(O + (size_t)row * ldc + u.pn * 256 + bj * 128 + colw) = w; }
                }
            }
    }
};
struct EpiGelu {
    static constexpr bool PERM = true, AFTER_DRAIN = false;
    bf16_t* O; int ldc; const rs_t* rs; rs_t* rsv; int vtile0;
    __device__ __forceinline__ void operator()(AccT acc, const Unit& u, int wr, int wc, int fr, int fq) const {
        const int row0 = u.pm * 256 + wr * 64 + fr, colw = wc * 32 + 8 * fq;
        const bool isv = u.pn >= vtile0;
#pragma unroll
        for (int ai = 0; ai < 2; ++ai)
#pragma unroll
            for (int m = 0; m < 4; ++m) {
                const int row = row0 + ai * 128 + m * 16;
                const float s = rstd_of(rs[row]); float ss = 0.f;
#pragma unroll
                for (int bj = 0; bj < 2; ++bj) {
                    float v[8];
#pragma unroll
                    for (int j = 0; j < 4; ++j) { v[j] = geluf_(acc[ai][bj][m][0][j] * s); v[4 + j] = geluf_(acc[ai][bj][m][1][j] * s); }
#pragma unroll
                    for (int j = 0; j < 8; ++j) ss += v[j] * v[j];
                    *(u32x4*)(O + (size_t)row * ldc + u.pn * 256 + bj * 128 + colw) = pack8(v);
                }
                if (isv) { ss += __shfl_xor(ss, 16); ss += __shfl_xor(ss, 32); if (fq == 0) rs_add(rsv + row, ss); }
            }
    }
};
__device__ __forceinline__ float put_x(float* X, bf16_t* XB, size_t off, const float (&xn)[8]) {
    *(f32x4*)(X + off) = (f32x4){xn[0], xn[1], xn[2], xn[3]}; *(f32x4*)(X + off + 4) = (f32x4){xn[4], xn[5], xn[6], xn[7]};
    *(u32x4*)(XB + off) = pack8(xn);
    float ss = 0.f;
#pragma unroll
    for (int j = 0; j < 8; ++j) ss += xn[j] * xn[j];
    return ss;
}
struct EpiResid {
    static constexpr bool PERM = true, AFTER_DRAIN = false;
    float* X; bf16_t* XB; rs_t* rsq;
    __device__ __forceinline__ void operator()(AccT acc, const Unit& u, int wr, int wc, int fr, int fq) const {
        const int row0 = u.pm * 256 + wr * 64 + fr, colw = wc * 32 + 8 * fq;
#pragma unroll
        for (int ai = 0; ai < 2; ++ai)
#pragma unroll
            for (int m = 0; m < 4; ++m) {
                const int row = row0 + ai * 128 + m * 16; float ss = 0.f;
#pragma unroll
                for (int bj = 0; bj < 2; ++bj) {
                    const size_t off = (size_t)row * D + u.pn * 256 + bj * 128 + colw;
                    const f32x4 x0 = *(const f32x4*)(X + off), x1 = *(const f32x4*)(X + off + 4);
                    float xn[8];
#pragma unroll
                    for (int j = 0; j < 4; ++j) { xn[j] = x0[j] + acc[ai][bj][m][0][j]; xn[4 + j] = x1[j] + acc[ai][bj][m][1][j]; }
                    ss += put_x(X, XB, off, xn);
                }
                ss += __shfl_xor(ss, 16); ss += __shfl_xor(ss, 32); if (fq == 0) rs_add(rsq + row, ss);
            }
    }
};
struct EpiPle {
    static constexpr bool PERM = true, AFTER_DRAIN = false;
    float* X; bf16_t* XB; rs_t* rsq; const rs_t* rs_in; const bf16_t* PP;
    __device__ __forceinline__ void operator()(AccT acc, const Unit& u, int wr, int wc, int fr, int fq) const {
        const int row0 = u.pm * 256 + wr * 64 + fr, colw = wc * 32 + 8 * fq;
#pragma unroll
        for (int ai = 0; ai < 2; ++ai)
#pragma unroll
            for (int m = 0; m < 4; ++m) {
                const int row = row0 + ai * 128 + m * 16; float ss = 0.f; const float s = rstd_of(rs_in[row]);
#pragma unroll
                for (int bj = 0; bj < 2; ++bj) {
                    const size_t off = (size_t)row * D + u.pn * 256 + bj * 128 + colw;
                    const f32x4 x0 = *(const f32x4*)(X + off), x1 = *(const f32x4*)(X + off + 4);
                    float pv[8]; unpack8(*(const u32x4*)(PP + off), pv);
                    float xn[8];
#pragma unroll
                    for (int j = 0; j < 4; ++j) { xn[j] = x0[j] + sigmoidf_(acc[ai][bj][m][0][j] * s) * pv[j]; xn[4 + j] = x1[j] + sigmoidf_(acc[ai][bj][m][1][j] * s) * pv[4 + j]; }
                    ss += put_x(X, XB, off, xn);
                }
                ss += __shfl_xor(ss, 16); ss += __shfl_xor(ss, 32); if (fq == 0) rs_add(rsq + row, ss);
            }
    }
};
struct EpiGlu {
    static constexpr bool PERM = true, AFTER_DRAIN = false;
    float* X; bf16_t* XB; rs_t* rsq;
    __device__ __forceinline__ void operator()(AccT acc, const Unit& u, int wr, int wc, int fr, int fq) const {
        const int row0 = u.pm * 256 + wr * 64 + fr, colw = wc * 32 + 8 * fq;
#pragma unroll
        for (int ai = 0; ai < 2; ++ai)
#pragma unroll
            for (int m = 0; m < 4; ++m) {
                const int row = row0 + ai * 128 + m * 16;
                const size_t off = (size_t)row * D + u.pn * 128 + colw;
                const f32x4 x0 = *(const f32x4*)(X + off), x1 = *(const f32x4*)(X + off + 4);
                float xn[8];
#pragma unroll
                for (int j = 0; j < 4; ++j) { xn[j] = x0[j] + acc[ai][0][m][0][j] * sigmoidf_(acc[ai][1][m][0][j]); xn[4 + j] = x1[j] + acc[ai][0][m][1][j] * sigmoidf_(acc[ai][1][m][1][j]); }
                float ss = put_x(X, XB, off, xn);
                ss += __shfl_xor(ss, 16); ss += __shfl_xor(ss, 32); if (fq == 0) rs_add(rsq + row, ss);
            }
    }
};
struct EpiGdnZ {
    static constexpr bool PERM = true, AFTER_DRAIN = false;
    bf16_t* O; int ldc; const rs_t* rs;
    __device__ __forceinline__ void operator()(AccT acc, const Unit& u, int wr, int wc, int fr, int fq) const {
        const int row0 = u.pm * 256 + wr * 64 + fr, colw = wc * 32 + 8 * fq;
#pragma unroll
        for (int ai = 0; ai < 2; ++ai)
#pragma unroll
            for (int m = 0; m < 4; ++m) {
                const int row = row0 + ai * 128 + m * 16; const float s = rstd_of(rs[row]);
#pragma unroll
                for (int bj = 0; bj < 2; ++bj) {
                    bf16_t* p = O + (size_t)row * ldc + u.pn * 256 + bj * 128 + colw;
                    float ov[8]; unpack8(*(const u32x4*)p, ov);
#pragma unroll
                    for (int j = 0; j < 4; ++j) { ov[j] *= siluf_(acc[ai][bj][m][0][j] * s); ov[4 + j] *= siluf_(acc[ai][bj][m][1][j] * s); }
                    *(u32x4*)p = pack8(ov);
                }
            }
    }
};

struct EpiFfn {
    static constexpr bool PERM = true, AFTER_DRAIN = false;
    bf16_t* HID; bf16_t* EDGE; const rs_t* rs; const float* cw; const float* cb;
    __device__ __forceinline__ void operator()(AccT acc, const Unit& u, int wr, int wc, int fr, int fq) const {
        const int lane = fq * 16 + fr, ch = u.pn * 128 + wc * 32 + 8 * fq;
        const int srcUp = (lane & 48) | ((lane + 1) & 15), srcDn = (lane & 48) | ((lane + 15) & 15);
        float w0[8], w1[8], w2[8], bb[8];
#pragma unroll
        for (int q = 0; q < 2; ++q) { const f32x4 a0 = *(const f32x4*)(cw + ch + 4 * q), a1 = *(const f32x4*)(cw + DFF + ch + 4 * q), a2 = *(const f32x4*)(cw + 2 * DFF + ch + 4 * q), a3 = *(const f32x4*)(cb + ch + 4 * q);
#pragma unroll
            for (int j = 0; j < 4; ++j) { w0[4 * q + j] = a0[j]; w1[4 * q + j] = a1[j]; w2[4 * q + j] = a2[j]; bb[4 * q + j] = a3[j]; } }
#pragma unroll
        for (int ai = 0; ai < 2; ++ai) {
            const int row0 = u.pm * 256 + ai * 128 + wr * 64 + fr;
            float G[4][8], sc[4];
#pragma unroll
            for (int m = 0; m < 4; ++m) { sc[m] = rstd_of(rs[row0 + m * 16]);
#pragma unroll
                for (int j = 0; j < 4; ++j) { G[m][j] = acc[ai][0][m][0][j] * sc[m]; G[m][4 + j] = acc[ai][0][m][1][j] * sc[m]; } }
            float ruc[8], rdp[8];
#pragma unroll
            for (int j = 0; j < 8; ++j) { ruc[j] = __shfl(G[0][j], srcUp); rdp[j] = 0.f; }
#pragma unroll
            for (int m = 0; m < 4; ++m) {
                float run[8], rdc[8];
#pragma unroll
                for (int j = 0; j < 8; ++j) { run[j] = (m < 3) ? __shfl(G[m < 3 ? m + 1 : 3][j], srcUp) : 0.f; rdc[j] = __shfl(G[m][j], srcDn); }
                float hv[8], uv[8];
#pragma unroll
                for (int j = 0; j < 8; ++j) { const float up = (fr < 15) ? ruc[j] : run[j], dn = (fr > 0) ? rdc[j] : rdp[j];
                    uv[j] = (j < 4 ? acc[ai][1][m][0][j] : acc[ai][1][m][1][j - 4]) * sc[m];
                    hv[j] = siluf_(w0[j] * dn + w1[j] * G[m][j] + w2[j] * up + bb[j]) * uv[j]; }
                const int row = row0 + m * 16;
                *(u32x4*)(HID + (size_t)row * DFF + ch) = pack8(hv);
                if ((m == 0 && fr < 2) || (m == 3 && fr >= 14)) { const int e = 4 * (2 * ai + wr) + (m == 0 ? fr : fr - 12);
                    bf16_t* ep = EDGE + ((size_t)(u.pm * 16 + e) * 2) * DFF + ch;
                    *(u32x4*)ep = pack8(G[m]); *(u32x4*)(ep + DFF) = pack8(uv); }
#pragma unroll
                for (int j = 0; j < 8; ++j) { rdp[j] = rdc[j]; ruc[j] = run[j]; }
            }
        }
    }
};

template <class Epi>
__device__ __forceinline__ void run_gemm(LAS unsigned char* lds, const bf16_t* A, const bf16_t* Bt, int M, int N, int K, const Epi& E) {
    pg8::Gemm g{A, Bt, M, N, K}; pg8::StaticOrder S; S.init(M, N, (int)gridDim.x, (int)blockIdx.x);
    pg8::gemm_phase<Epi, pg8::StaticOrder, true, true>(lds, g, S, E);
}

struct Job { const float* src; bf16_t* dst; const float* gain; int K, Nsrc, Ndst, map, qcols; };
__device__ __forceinline__ void get_job(ArgsCP a, int j, Job& J) {
    unsigned char* ws = a->ws; J.gain = nullptr; J.map = 0; J.qcols = 0;
    if (j < 16) { const int L = j >> 2, k = j & 3;
        if (k == 0)      { J.src = a->in[31] + (size_t)L * D * 2 * DFF; J.dst = (bf16_t*)(ws + WS_WGU + L * SZ_WGU); J.gain = a->in[5] + L * D; J.K = D; J.Nsrc = 2 * DFF; J.Ndst = 2 * DFF; J.map = 1; }
        else if (k == 1) { J.src = a->in[34] + (size_t)L * DFF * D;     J.dst = (bf16_t*)(ws + WS_WDN + L * SZ_WDN); J.K = DFF; J.Nsrc = D; J.Ndst = D; }
        else if (k == 2) { J.src = a->in[36] + (size_t)L * D * D;       J.dst = (bf16_t*)(ws + WS_WPG + L * SZ_WPG); J.gain = a->in[6] + L * D; J.K = D; J.Nsrc = D; J.Ndst = D; }
        else             { J.src = a->in[35] + (size_t)L * PLED * D;    J.dst = (bf16_t*)(ws + WS_WPP + L * SZ_WPP); J.K = PLED; J.Nsrc = D; J.Ndst = D; }
    } else switch (j) {
        case 16: J.src = a->in[8];  J.dst = (bf16_t*)(ws + WS_NAQ); J.gain = a->in[4] + 0 * D; J.K = D; J.Nsrc = 6144; J.Ndst = 6144; J.qcols = 2048; break;
        case 17: J.src = a->in[9];  J.dst = (bf16_t*)(ws + WS_NAO); J.K = D; J.Nsrc = D; J.Ndst = D; break;
        case 18: J.src = a->in[11]; J.dst = (bf16_t*)(ws + WS_SGI); J.gain = a->in[4] + 1 * D; J.K = D; J.Nsrc = 4096; J.Ndst = 4096; break;
        case 19: J.src = a->in[15]; J.dst = (bf16_t*)(ws + WS_SGO); J.K = D; J.Nsrc = D; J.Ndst = D; break;
        case 20: J.src = a->in[16]; J.dst = (bf16_t*)(ws + WS_GDI); J.gain = a->in[4] + 2 * D; J.K = D; J.Nsrc = 12416; J.Ndst = GDI_N; J.map = 2; break;
        case 21: J.src = a->in[21]; J.dst = (bf16_t*)(ws + WS_GDO); J.K = 4096; J.Nsrc = D; J.Ndst = D; break;
        default: J.src = a->in[30]; J.dst = (bf16_t*)(ws + WS_S5G); J.K = D; J.Nsrc = 4096; J.Ndst = 4096; J.map = 1; break;
    }
}
__device__ __forceinline__ int map_col(const Job& J, int n0) {
    if (J.map == 0) return n0;
    if (J.map == 1) { const int tile = n0 >> 8, w = n0 & 255, H = J.Nsrc >> 1; return w < 128 ? tile * 128 + w : H + tile * 128 + (w - 128); }
    if (n0 < 8192) return n0;
    if (n0 < 8320) return 12288 + (n0 - 8192);
    if (n0 < GDI_N1) return -1;
    return 8192 + (n0 - GDI_N1);
}
__device__ __forceinline__ void prologue(ArgsCP a, LAS unsigned char* lds) {
    const int tid = tidx(), G = gridDim.x, bid = blockIdx.x;
    LAS float* tile = (LAS float*)lds;
    int base = 0;
    for (int j = 0; j < 23; ++j) {
        Job J; get_job(a, j, J);
        const int kt = J.K >> 6, ntl = J.Ndst >> 6, nt = kt * ntl;
        int first = (bid - (base % G) + G) % G;
        for (int i = first; i < nt; i += G) {
            const int nb = i / kt, kb = i - nb * kt, n0 = nb * 64, k0 = kb * 64, s0 = map_col(J, n0);
            const float cs = (n0 < J.qcols) ? 0.08838834764831845f : 1.0f;
            const int kk = tid >> 4, nn4 = (tid & 15) * 4;
#pragma unroll
            for (int p = 0; p < 2; ++p) {
                const int k = k0 + kk + 32 * p;
                f32x4 v = (f32x4){0.f, 0.f, 0.f, 0.f};
                if (s0 >= 0) v = *(const f32x4*)(J.src + (size_t)k * J.Nsrc + s0 + nn4);
                const float sc = (J.gain ? J.gain[k] : 1.0f) * cs;
#pragma unroll
                for (int q = 0; q < 4; ++q) tile[(nn4 + q) * 65 + kk + 32 * p] = v[q] * sc;
            }
            __syncthreads();
            { const int nn = tid >> 3, kk8 = (tid & 7) * 8; float v[8];
#pragma unroll
              for (int q = 0; q < 8; ++q) v[q] = tile[nn * 65 + kk8 + q];
              *(u32x4*)(J.dst + (size_t)(n0 + nn) * J.K + k0 + kk8) = pack8(v); }
            __syncthreads();
        }
        base += nt;
    }
    { bf16_t* PB = (bf16_t*)(a->ws + WS_PB);
      const long total = (long)4 * T * 64;
      for (long i = (long)bid * NTHR + tid; i < total; i += (long)G * NTHR) {
          const int L = (int)(i / ((long)T * 64)); const int rem = (int)(i - (long)L * T * 64); const int row = rem >> 6, c4 = (rem & 63) * 4;
          const float* src = row < 8192 ? a->in[2] + ((size_t)L * 8192 + row) * PLED + c4 : a->in[3] + ((size_t)L * 32768 + (row - 8192)) * PLED + c4;
          const f32x4 v = *(const f32x4*)src; u32x2 w; w.x = pk2(v[0], v[1]); w.y = pk2(v[2], v[3]);
          *(u32x2*)(PB + ((size_t)L * T + row) * PLED + c4) = w; } }
    { bf16_t* XB = (bf16_t*)(a->ws + WS_XB0); rs_t* rs = (rs_t*)(a->ws + WS_RS);
      const int w = tid >> 6, lane = tid & 63;
      for (int row = bid * 8 + w; row < T; row += G * 8) {
          const float* src = row < 8192 ? a->in[0] + (size_t)row * D : a->in[1] + (size_t)(row - 8192) * D;
          float ss = 0.f;
#pragma unroll
          for (int q = 0; q < 8; ++q) { const int c = (q * 64 + lane) * 4; const f32x4 v = *(const f32x4*)(src + c);
              *(f32x4*)(a->out + (size_t)row * D + c) = v; u32x2 wv; wv.x = pk2(v[0], v[1]); wv.y = pk2(v[2], v[3]); *(u32x2*)(XB + (size_t)row * D + c) = wv;
              ss += v[0] * v[0] + v[1] * v[1] + v[2] * v[2] + v[3] * v[3]; }
          ss = wave_sum(ss); if (lane == 0) rs[row] = rs_fix(ss); } }
}

__device__ __forceinline__ void na_attention(ArgsCP a, LAS unsigned char* lds, const bf16_t* QKV, bf16_t* AO) {
    const int tid = tidx(), w = tid >> 6, lane = tid & 63;
    LAS float* qs = (LAS float*)(lds + w * 1024); LAS float* ps = qs + 128;
    const float* rpb = a->in[10];
    for (long task = (long)blockIdx.x * 8 + w; task < (long)T * 16; task += (long)gridDim.x * 8) {
        const int seq = (int)(task >> 16), rem = (int)(task & 65535), h = rem >> 12, pos = rem & 4095, r = pos >> 6, c = pos & 63;
        const int r0 = min(max(r - 4, 0), 56), c0 = min(max(c - 8, 0), 48);
        const size_t trow = (size_t)seq * SEQ + pos;
        { const unsigned qq = *(const unsigned*)(QKV + trow * 6144 + h * 128 + 2 * lane); qs[2 * lane] = blo(qq); qs[2 * lane + 1] = bhi(qq); }
        __builtin_amdgcn_wave_barrier();
        float s[2];
#pragma unroll
        for (int kk = 0; kk < 2; ++kk) {
            const int j = lane + 64 * kk, kr = r0 + (j >> 4), kc = c0 + (j & 15);
            const u32x4* kp = (const u32x4*)(QKV + ((size_t)seq * SEQ + kr * 64 + kc) * 6144 + 2048 + h * 128);
            float acc = 0.f;
#pragma unroll 4
            for (int d8 = 0; d8 < 16; ++d8) { const u32x4 kv = kp[d8]; const f32x4 q0 = *(const LAS f32x4*)(qs + d8 * 8), q1 = *(const LAS f32x4*)(qs + d8 * 8 + 4);
                acc += q0[0] * blo(kv.x) + q0[1] * bhi(kv.x) + q0[2] * blo(kv.y) + q0[3] * bhi(kv.y) + q1[0] * blo(kv.z) + q1[1] * bhi(kv.z) + q1[2] * blo(kv.w) + q1[3] * bhi(kv.w); }
            s[kk] = acc + rpb[(h * 15 + (kr - r + 7)) * 31 + (kc - c + 15)];
        }
        const float mx = wave_max(fmaxf(s[0], s[1]));
        const float e0 = __expf(s[0] - mx), e1 = __expf(s[1] - mx);
        const float inv = 1.0f / wave_sum(e0 + e1);
        ps[lane] = e0 * inv; ps[lane + 64] = e1 * inv;
        __builtin_amdgcn_wave_barrier();
        float o0 = 0.f, o1 = 0.f;
        const bf16_t* vb = QKV + ((size_t)seq * SEQ) * 6144 + 4096 + h * 128 + 2 * lane;
#pragma unroll 4
        for (int j = 0; j < 128; ++j) { const int kr = r0 + (j >> 4), kc = c0 + (j & 15);
            const unsigned vv = *(const unsigned*)(vb + (size_t)(kr * 64 + kc) * 6144); const float p = ps[j]; o0 += p * blo(vv); o1 += p * bhi(vv); }
        *(unsigned*)(AO + trow * D + h * 128 + 2 * lane) = pk2(o0, o1);
        __builtin_amdgcn_wave_barrier();
    }
}

__device__ __forceinline__ void sgu_mix(ArgsCP a, LAS unsigned char* lds, const bf16_t* UV, const rs_t* rsv, bf16_t* MX) {
    const int tid = tidx(), G = gridDim.x;
    LAS float* WT = (LAS float*)lds;
    LAS float* VS = (LAS float*)(lds + 65536);
    const float* w_s = a->in[13]; const float* b_s = a->in[14]; const float* sgn = a->in[12];
    const int per = (5120 + G - 1) / G, u0 = blockIdx.x * per, u1 = min(5120, u0 + per);
    int gcur = -1;
    for (int u = u0; u < u1; ++u) {
        const int g = u / 320, sc = u - g * 320, seq = sc >> 5, n = sc & 31; const size_t row0 = (size_t)seq * SEQ + n * 128;
        __syncthreads();
        if (g != gcur) { gcur = g;
            for (int idx = tid; idx < 16384; idx += NTHR) { const int t = idx >> 7, s = idx & 127; WT[s * 128 + t] = w_s[(size_t)g * 16384 + idx]; } }
        { const int s = tid >> 2, c32 = (tid & 3) * 32; const float rsd = rstd_of(rsv[row0 + s]);
#pragma unroll
          for (int q = 0; q < 4; ++q) { float v[8]; unpack8(*(const u32x4*)(UV + (row0 + s) * 4096 + 2048 + g * 128 + c32 + q * 8), v);
#pragma unroll
              for (int j = 0; j < 8; ++j) VS[s * 128 + c32 + q * 8 + j] = v[j] * rsd * sgn[g * 128 + c32 + q * 8 + j]; } }
        __syncthreads();
        const int t0 = (tid >> 4) * 4, c0 = (tid & 15) * 8;
        float acc[4][8];
#pragma unroll
        for (int i = 0; i < 4; ++i)
#pragma unroll
            for (int j = 0; j < 8; ++j) acc[i][j] = 0.f;
#pragma unroll 4
        for (int s = 0; s < 128; ++s) {
            const f32x4 av = *(const LAS f32x4*)(WT + s * 128 + t0), v0 = *(const LAS f32x4*)(VS + s * 128 + c0), v1 = *(const LAS f32x4*)(VS + s * 128 + c0 + 4);
#pragma unroll
            for (int i = 0; i < 4; ++i) {
#pragma unroll
                for (int j = 0; j < 4; ++j) { acc[i][j] += av[i] * v0[j]; acc[i][4 + j] += av[i] * v1[j]; } }
        }
#pragma unroll
        for (int i = 0; i < 4; ++i) { const int t = t0 + i; const float bias = b_s[g * 128 + t]; const size_t row = row0 + t;
            float uv[8]; unpack8(*(const u32x4*)(UV + row * 4096 + g * 128 + c0), uv);
#pragma unroll
            for (int j = 0; j < 8; ++j) uv[j] *= (acc[i][j] + bias);
            *(u32x4*)(MX + row * D + g * 128 + c0) = pack8(uv); }
    }
}

__device__ __forceinline__ void ffn_convglu(ArgsCP a, int layer, const bf16_t* GU, bf16_t* HID, int rows) {
    const float* cw = a->in[32] + (size_t)layer * 3 * DFF; const float* cb = a->in[33] + (size_t)layer * DFF;
    const long total = (long)rows * 704;
    for (long i = (long)blockIdx.x * NTHR + tidx(); i < total; i += (long)gridDim.x * NTHR) {
        const int r = (int)(i / 704), cbk = (int)(i - (long)r * 704), ch = cbk * 8, pos = r & (SEQ - 1);
        const bf16_t* gp = GU + (size_t)r * (2 * DFF) + (cbk >> 4) * 256 + (cbk & 15) * 8;
        float g0[8], gm[8], gn[8], up[8];
        unpack8(*(const u32x4*)gp, g0); unpack8(*(const u32x4*)(gp + 128), up);
        if (pos > 0) unpack8(*(const u32x4*)(gp - 2 * DFF), gm); else {
#pragma unroll
            for (int j = 0; j < 8; ++j) gm[j] = 0.f; }
        if (pos < SEQ - 1) unpack8(*(const u32x4*)(gp + 2 * DFF), gn); else {
#pragma unroll
            for (int j = 0; j < 8; ++j) gn[j] = 0.f; }
        float o[8];
#pragma unroll
        for (int j = 0; j < 8; ++j) { const float gv = cw[ch + j] * gm[j] + cw[DFF + ch + j] * g0[j] + cw[2 * DFF + ch + j] * gn[j] + cb[ch + j]; o[j] = siluf_(gv) * up[j]; }
        *(u32x4*)(HID + (size_t)r * DFF + ch) = pack8(o);
    }
}

__device__ __forceinline__ void ffn_fixup(ArgsCP a, int layer, const bf16_t* EDGE, bf16_t* HID) {
    const float* cw = a->in[32] + (size_t)layer * 3 * DFF; const float* cb = a->in[33] + (size_t)layer * DFF;
    const int total = (T / 256) * 8 * 704;
    for (int it = blockIdx.x * NTHR + tidx(); it < total; it += gridDim.x * NTHR) {
        const int cbk = it % 704, rr = (it / 704) & 7, tile = it / (704 * 8), s = rr >> 1, last = rr & 1, ch = cbk * 8;
        const bf16_t* eb = EDGE + (size_t)tile * 16 * 2 * DFF + ch;
        float gc[8], uc[8], gi[8], go[8];
        unpack8(*(const u32x4*)(eb + (size_t)((4 * s + (last ? 3 : 0)) * 2) * DFF), gc);
        unpack8(*(const u32x4*)(eb + (size_t)((4 * s + (last ? 3 : 0)) * 2 + 1) * DFF), uc);
        unpack8(*(const u32x4*)(eb + (size_t)((4 * s + (last ? 2 : 1)) * 2) * DFF), gi);
        const bf16_t* op = nullptr;
        if (last) { if (s < 3) op = eb + (size_t)((4 * (s + 1)) * 2) * DFF; else if ((tile & 15) != 15) op = eb + (size_t)16 * 2 * DFF; }
        else      { if (s > 0) op = eb + (size_t)((4 * (s - 1) + 3) * 2) * DFF; else if ((tile & 15) != 0) op = eb - (size_t)16 * 2 * DFF + (size_t)(15 * 2) * DFF; }
        if (op) unpack8(*(const u32x4*)op, go); else {
#pragma unroll
            for (int j = 0; j < 8; ++j) go[j] = 0.f; }
        float hv[8];
#pragma unroll
        for (int j = 0; j < 8; ++j) { const float dn = last ? gi[j] : go[j], up = last ? go[j] : gi[j];
            hv[j] = siluf_(cw[ch + j] * dn + cw[DFF + ch + j] * gc[j] + cw[2 * DFF + ch + j] * up + cb[ch + j]) * uc[j]; }
        *(u32x4*)(HID + ((size_t)tile * 256 + 64 * s + 63 * last) * DFF + ch) = pack8(hv);
    }
}

__device__ __forceinline__ void gdn_conv(ArgsCP a, const bf16_t* PROJ, const float* AB, bf16_t* QK, bf16_t* VP, float* GB, int rows) {
    const int tid = tidx(), ch0 = tid * 16;
    const float* cw = a->in[17];
    float w0[16], w1[16], w2[16];
#pragma unroll
    for (int j = 0; j < 16; ++j) { w0[j] = cw[ch0 + j]; w1[j] = cw[8192 + ch0 + j]; w2[j] = cw[16384 + ch0 + j]; }
    for (int r = blockIdx.x; r < rows; r += gridDim.x) {
        const int pos = r & (SEQ - 1);
        const bf16_t* p = PROJ + (size_t)r * 8192 + ch0;
        float x0[16], xm[16], xn[16];
        { float t[8]; unpack8(*(const u32x4*)p, t);
#pragma unroll
          for (int j = 0; j < 8; ++j) x0[j] = t[j];
          unpack8(*(const u32x4*)(p + 8), t);
#pragma unroll
          for (int j = 0; j < 8; ++j) x0[8 + j] = t[j]; }
        if (pos > 0) { float t[8]; unpack8(*(const u32x4*)(p - 8192), t);
#pragma unroll
          for (int j = 0; j < 8; ++j) xm[j] = t[j];
          unpack8(*(const u32x4*)(p - 8192 + 8), t);
#pragma unroll
          for (int j = 0; j < 8; ++j) xm[8 + j] = t[j]; } else {
#pragma unroll
          for (int j = 0; j < 16; ++j) xm[j] = 0.f; }
        if (pos < SEQ - 1) { float t[8]; unpack8(*(const u32x4*)(p + 8192), t);
#pragma unroll
          for (int j = 0; j < 8; ++j) xn[j] = t[j];
          unpack8(*(const u32x4*)(p + 8192 + 8), t);
#pragma unroll
          for (int j = 0; j < 8; ++j) xn[8 + j] = t[j]; } else {
#pragma unroll
          for (int j = 0; j < 16; ++j) xn[j] = 0.f; }
        float y[16], ss = 0.f;
#pragma unroll
        for (int j = 0; j < 16; ++j) { y[j] = siluf_(w0[j] * xm[j] + w1[j] * x0[j] + w2[j] * xn[j]); ss += y[j] * y[j]; }
        ss += __shfl_xor(ss, 1); ss += __shfl_xor(ss, 2); ss += __shfl_xor(ss, 4);
        float sc = 1.0f;
        if (ch0 < 4096) { sc = rsqrtf(ss + EPS); if (ch0 < 2048) sc *= 0.08838834764831845f; }
        float o0[8], o1[8];
#pragma unroll
        for (int j = 0; j < 8; ++j) { o0[j] = y[j] * sc; o1[j] = y[8 + j] * sc; }
        bf16_t* dst = ch0 < 4096 ? QK + (size_t)r * 4096 + ch0 : VP + (size_t)r * 4096 + (ch0 - 4096);
        *(u32x4*)dst = pack8(o0); *(u32x4*)(dst + 8) = pack8(o1);
        if (tid < 64) { const int dir = tid >> 5, head = tid & 31;
            const float av = AB[(size_t)r * 128 + dir * 64 + head], bv = AB[(size_t)r * 128 + dir * 64 + 32 + head];
            const float xx = av + a->in[19][dir * 32 + head];
            const float sp = xx > 20.f ? xx : log1pf(expf(xx));
            GB[(size_t)r * 128 + dir * 64 + head] = -expf(a->in[18][dir * 32 + head]) * sp;
            GB[(size_t)r * 128 + dir * 64 + 32 + head] = 1.0f / (1.0f + expf(-bv)); }
    }
}
__device__ __forceinline__ void gdn_scan_naive(LAS unsigned char* lds, const bf16_t* QK, const bf16_t* VP, const float* GB, bf16_t* OF, bf16_t* OB, int nseq) {
    const int tid = tidx(), vh = tid >> 8, j = (tid & 255) >> 1, half = tid & 1;
    LAS float* KQ = (LAS float*)lds;
    LAS float* VS = (LAS float*)(lds + 16384);
    LAS float* GS = (LAS float*)(lds + 32768);
    const int nunits = nseq * 32;
    for (int unit = blockIdx.x; unit < nunits; unit += gridDim.x) {
        const int seq = unit >> 5, hq = (unit >> 1) & 15, dir = unit & 1, head = 2 * hq + vh;
        bf16_t* OD = dir ? OB : OF;
        float S[64];
#pragma unroll
        for (int i = 0; i < 64; ++i) S[i] = 0.f;
        for (int blk = 0; blk < SEQ / 16; ++blk) {
            __syncthreads();
            { const int tok = tid >> 5, part = tid & 31, step = blk * 16 + tok, pos = dir ? SEQ - 1 - step : step; const size_t row = (size_t)seq * SEQ + pos;
              const bf16_t* src = part < 16 ? QK + row * 4096 + hq * 128 + part * 8 : QK + row * 4096 + 2048 + hq * 128 + (part - 16) * 8;
              float v[8]; unpack8(*(const u32x4*)src, v);
              *(LAS f32x4*)(KQ + tok * 256 + part * 8) = (f32x4){v[0], v[1], v[2], v[3]}; *(LAS f32x4*)(KQ + tok * 256 + part * 8 + 4) = (f32x4){v[4], v[5], v[6], v[7]};
              unpack8(*(const u32x4*)(VP + row * 4096 + hq * 256 + part * 8), v);
              *(LAS f32x4*)(VS + tok * 256 + part * 8) = (f32x4){v[0], v[1], v[2], v[3]}; *(LAS f32x4*)(VS + tok * 256 + part * 8 + 4) = (f32x4){v[4], v[5], v[6], v[7]};
              if (tid < 64) { const int tk = tid >> 2, which = tid & 3, hh = 2 * hq + (which & 1), isb = which >> 1, st = blk * 16 + tk, ps = dir ? SEQ - 1 - st : st;
                  const float gv = GB[((size_t)seq * SEQ + ps) * 128 + dir * 64 + isb * 32 + hh]; GS[tk * 4 + which] = isb ? gv : expf(gv); } }
            __syncthreads();
            for (int s = 0; s < 16; ++s) {
                const float av = GS[s * 4 + vh], bv = GS[s * 4 + 2 + vh], vt = VS[s * 256 + vh * 128 + j];
                const LAS float* kp = KQ + s * 256 + 128 + half * 64; const LAS float* qp = KQ + s * 256 + half * 64;
                float ks = 0.f;
#pragma unroll
                for (int i = 0; i < 64; i += 4) { const f32x4 k4 = *(const LAS f32x4*)(kp + i); ks += k4[0] * S[i] + k4[1] * S[i + 1] + k4[2] * S[i + 2] + k4[3] * S[i + 3]; }
                ks += __shfl_xor(ks, 1);
                const float uu = bv * (vt - av * ks);
                float os = 0.f;
#pragma unroll
                for (int i = 0; i < 64; i += 4) { const f32x4 k4 = *(const LAS f32x4*)(kp + i), q4 = *(const LAS f32x4*)(qp + i);
#pragma unroll
                    for (int e = 0; e < 4; ++e) { S[i + e] = av * S[i + e] + k4[e] * uu; os += q4[e] * S[i + e]; } }
                os += __shfl_xor(os, 1);
                if (half == 0) { const int step = blk * 16 + s, pos = dir ? SEQ - 1 - step : step; OD[((size_t)seq * SEQ + pos) * 4096 + head * 128 + j] = f2bf(os); }
            }
        }
    }
}
__device__ __forceinline__ void gdn_sumnorm(ArgsCP a, bf16_t* OF, const bf16_t* OB, int rows) {
    const int tid = tidx(), rsub = tid >> 8, c0 = (tid & 255) * 16;
    const float* on = a->in[20];
    for (int r = blockIdx.x * 2 + rsub; r < rows; r += gridDim.x * 2) {
        float x[16], t[8];
        unpack8(*(const u32x4*)(OF + (size_t)r * 4096 + c0), t);
#pragma unroll
        for (int q = 0; q < 8; ++q) x[q] = t[q];
        unpack8(*(const u32x4*)(OF + (size_t)r * 4096 + c0 + 8), t);
#pragma unroll
        for (int q = 0; q < 8; ++q) x[8 + q] = t[q];
        unpack8(*(const u32x4*)(OB + (size_t)r * 4096 + c0), t);
#pragma unroll
        for (int q = 0; q < 8; ++q) x[q] += t[q];
        unpack8(*(const u32x4*)(OB + (size_t)r * 4096 + c0 + 8), t);
#pragma unroll
        for (int q = 0; q < 8; ++q) x[8 + q] += t[q];
        float ss = 0.f;
#pragma unroll
        for (int q = 0; q < 16; ++q) ss += x[q] * x[q];
        ss += __shfl_xor(ss, 1); ss += __shfl_xor(ss, 2); ss += __shfl_xor(ss, 4);
        const float sc = rsqrtf(ss * (1.0f / 128.0f) + EPS);
        float o0[8], o1[8];
#pragma unroll
        for (int q = 0; q < 8; ++q) { o0[q] = x[q] * sc * on[(c0 & 127) + q]; o1[q] = x[8 + q] * sc * on[(c0 & 127) + 8 + q]; }
        *(u32x4*)(OF + (size_t)r * 4096 + c0) = pack8(o0); *(u32x4*)(OF + (size_t)r * 4096 + c0 + 8) = pack8(o1);
    }
}

__device__ __forceinline__ void s5_scan(ArgsCP a, LAS unsigned char* lds, const float* X, const rs_t* rs, float* YF, bf16_t* Y) {
    const int tid = tidx(), w = tid >> 6, lane = tid & 63;
    LAS float* U = (LAS float*)(lds + w * 9216);
    LAS float* XS = U + 256;
    const float* gmix = a->in[4] + 3 * D;
    for (int task = blockIdx.x * 8 + w; task < NSEQ * 128; task += gridDim.x * 8) {
        const int seq = task >> 7, gr = task & 127;
        for (int dir = 0; dir < 2; ++dir) {
            const int dg = dir * 128 + gr;
            const float are = a->in[22][dg * 64 + lane], aim = a->in[23][dg * 64 + lane], dt = expf(a->in[24][dg]);
            const float er = expf(are * dt); float sn, cs; sincosf(aim * dt, &sn, &cs);
            const float abr = er * cs, abi = er * sn;
            const float den = 1.0f / (are * are + aim * aim);
            const float cr = ((abr - 1.0f) * are + abi * aim) * den, ci = (abi * are - (abr - 1.0f) * aim) * den;
            float Br[16], Bi[16];
#pragma unroll
            for (int c = 0; c < 16; ++c) { const float bre = a->in[25][((size_t)dg * 64 + lane) * 16 + c], bim = a->in[26][((size_t)dg * 64 + lane) * 16 + c]; Br[c] = cr * bre - ci * bim; Bi[c] = cr * bim + ci * bre; }
            const int oc = lane & 15, tb = lane >> 4;
            float Cr[64], Ci[64];
#pragma unroll
            for (int p = 0; p < 64; ++p) { Cr[p] = a->in[27][((size_t)dg * 16 + oc) * 64 + p]; Ci[p] = a->in[28][((size_t)dg * 16 + oc) * 64 + p]; }
            const float dsk = a->in[29][gr * 16 + oc];
            float xr = 0.f, xi = 0.f;
            for (int blk = 0; blk < SEQ / 16; ++blk) {
                { const int tt = lane >> 2, c4 = (lane & 3) * 4, step = blk * 16 + tt, pos = dir ? SEQ - 1 - step : step; const size_t row = (size_t)seq * SEQ + pos;
                  const f32x4 xv = *(const f32x4*)(X + row * D + gr * 16 + c4); const f32x4 gm = *(const f32x4*)(gmix + gr * 16 + c4); const float rsd = rstd_of(rs[row]);
                  *(LAS f32x4*)(U + tt * 16 + c4) = xv * gm * rsd; }
                __builtin_amdgcn_wave_barrier();
                for (int tt = 0; tt < 16; ++tt) {
                    float bur = 0.f, bui = 0.f;
#pragma unroll
                    for (int c = 0; c < 16; c += 4) { const f32x4 u4 = *(const LAS f32x4*)(U + tt * 16 + c);
#pragma unroll
                        for (int e = 0; e < 4; ++e) { bur += Br[c + e] * u4[e]; bui += Bi[c + e] * u4[e]; } }
                    const float nr = abr * xr - abi * xi + bur, ni = abr * xi + abi * xr + bui; xr = nr; xi = ni;
                    XS[(tt * 64 + lane) * 2] = xr; XS[(tt * 64 + lane) * 2 + 1] = xi;
                }
                __builtin_amdgcn_wave_barrier();
                for (int i = 0; i < 4; ++i) {
                    const int t = tb * 4 + i; float y = 0.f;
#pragma unroll
                    for (int p = 0; p < 64; p += 2) { const f32x4 x2 = *(const LAS f32x4*)(XS + (t * 64 + p) * 2); y += Cr[p] * x2[0] - Ci[p] * x2[1] + Cr[p + 1] * x2[2] - Ci[p + 1] * x2[3]; }
                    const int step = blk * 16 + t, pos = dir ? SEQ - 1 - step : step; const size_t row = (size_t)seq * SEQ + pos;
                    if (dir == 0) YF[row * D + gr * 16 + oc] = y;
                    else { const float yt = y + YF[row * D + gr * 16 + oc] + dsk * U[t * 16 + oc]; Y[row * D + gr * 16 + oc] = f2bf(geluf_(yt)); }
                }
                __builtin_amdgcn_wave_barrier();
            }
        }
    }
}

__device__ __forceinline__ void final_norm(ArgsCP a, const rs_t* rs) {
    const int tid = tidx(), w = tid >> 6, lane = tid & 63; const float* g = a->in[7];
    for (int row = blockIdx.x * 8 + w; row < T; row += gridDim.x * 8) {
        const float s = rstd_of(rs[row]);
#pragma unroll
        for (int q = 0; q < 8; ++q) { const int c = (q * 64 + lane) * 4; f32x4 v = *(const f32x4*)(a->out + (size_t)row * D + c); const f32x4 gv = *(const f32x4*)(g + c); v = v * gv * s; *(f32x4*)(a->out + (size_t)row * D + c) = v; }
    }
}


namespace gdn {
typedef short s16x8 __attribute__((ext_vector_type(8)));
typedef short s16x4 __attribute__((ext_vector_type(4)));
constexpr int QS = 0, QPITCH = 272;
constexpr int KS = QS + 64 * QPITCH;
constexpr int VS = KS + 64 * QPITCH;
constexpr int WS_ = VS + 64 * QPITCH;
constexpr int KT = WS_ + 64 * QPITCH, KTPITCH = 144;
constexpr int MB = KT + 128 * KTPITCH, MPITCH = 144;
constexpr int A2 = MB + 64 * MPITCH;
constexpr int MD = A2 + 64 * MPITCH;
constexpr int DV = MD + 4 * 16 * 17 * 4, DVPITCH = 40;
constexpr int TB = DV + 4 * 16 * DVPITCH;
constexpr int LDS_END = TB + 5 * 256;
static_assert(LDS_END <= LDS_STAGE, "gdn lds");

__device__ __forceinline__ s16x8 mk8(unsigned a, unsigned b, unsigned c, unsigned d) { u32x4 v; v.x = a; v.y = b; v.z = c; v.w = d; return __builtin_bit_cast(s16x8, v); }
__device__ __forceinline__ s16x8 cat8(u32x2 lo, u32x2 hi) { return mk8(lo.x, lo.y, hi.x, hi.y); }
__device__ __forceinline__ s16x4 mk4(unsigned a, unsigned b) { u32x2 v; v.x = a; v.y = b; return __builtin_bit_cast(s16x4, v); }

__device__ __forceinline__ void scan(LAS unsigned char* lds, const bf16_t* QK, const bf16_t* VP, const float* GB, bf16_t* OF, bf16_t* OB, int nseq) {
    const int tid = tidx(), w = __builtin_amdgcn_readfirstlane(tid >> 6), lane = tid & 63;
#define GDN_FRESH() int ln_ = lane; asm volatile("" : "+v"(ln_)); const int g = ln_ >> 4, n = ln_ & 15;
    LAS float* gam = (LAS float*)(lds + TB); LAS float* eg = gam + 64; LAS float* bg = gam + 128; LAS float* bt = gam + 192; LAS float* dl = gam + 256;
    const int nunits = nseq * 64;
    for (int unit = blockIdx.x; unit < nunits; unit += gridDim.x) {
        const int seq = unit >> 6, h = (unit >> 1) & 31, dir = unit & 1, hq = h >> 1;
        bf16_t* OD = dir ? OB : OF;
        f32x4 S[8];
#pragma unroll
        for (int i = 0; i < 8; ++i) S[i] = (f32x4){0.f, 0.f, 0.f, 0.f};
        u32x4 pq[2], pk[2], pv[2]; float pg = 0.f, pb = 0.f;
#define GDN_LOADG(c) do { _Pragma("unroll") for (int i_ = 0; i_ < 2; ++i_) { const int p_ = tid + 512 * i_, ir_ = p_ >> 4, c16_ = (p_ & 15) * 8; \
            const int st_ = (c) * 64 + ir_, pos_ = dir ? SEQ - 1 - st_ : st_; const size_t row_ = (size_t)seq * SEQ + pos_; \
            pq[i_] = *(const u32x4*)(QK + row_ * 4096 + hq * 128 + c16_); pk[i_] = *(const u32x4*)(QK + row_ * 4096 + 2048 + hq * 128 + c16_); pv[i_] = *(const u32x4*)(VP + row_ * 4096 + h * 128 + c16_); } \
            if (tid < 64) { const int st_ = (c) * 64 + tid, pos_ = dir ? SEQ - 1 - st_ : st_; const size_t row_ = (size_t)seq * SEQ + pos_; pg = GB[row_ * 128 + dir * 64 + h]; pb = GB[row_ * 128 + dir * 64 + 32 + h]; } } while (0)
#define GDN_STORE() do { _Pragma("unroll") for (int i_ = 0; i_ < 2; ++i_) { const int p_ = tid + 512 * i_, ir_ = p_ >> 4, c16_ = (p_ & 15) * 8; \
            *(LAS u32x4*)(lds + QS + ir_ * QPITCH + c16_ * 2) = pq[i_]; *(LAS u32x4*)(lds + KS + ir_ * QPITCH + c16_ * 2) = pk[i_]; *(LAS u32x4*)(lds + VS + ir_ * QPITCH + c16_ * 2) = pv[i_]; \
            const unsigned kw_[4] = {pk[i_].x, pk[i_].y, pk[i_].z, pk[i_].w}; \
            _Pragma("unroll") for (int e_ = 0; e_ < 4; ++e_) { *(LAS bf16_t*)(lds + KT + (c16_ + 2 * e_) * KTPITCH + ir_ * 2) = (bf16_t)(kw_[e_] & 0xffffu); *(LAS bf16_t*)(lds + KT + (c16_ + 2 * e_ + 1) * KTPITCH + ir_ * 2) = (bf16_t)(kw_[e_] >> 16); } } \
            if (tid < 64) { float gs_ = pg; _Pragma("unroll") for (int o_ = 1; o_ < 64; o_ <<= 1) { const float t_ = __shfl_up(gs_, o_); if (lane >= o_) gs_ += t_; } \
                const float gl_ = __shfl(gs_, 63), e_ = __expf(gs_); gam[tid] = gs_; eg[tid] = e_; bg[tid] = pb * e_; bt[tid] = pb; dl[tid] = __expf(gl_ - gs_); } } while (0)
        GDN_LOADG(0);
        __syncthreads();
        GDN_STORE();
        __syncthreads();
        for (int c = 0; c < 64; ++c) {
            { GDN_FRESH() const int rb = w & 3, cbp = w >> 2;
#pragma unroll
              for (int cc = 0; cc < 2; ++cc) { const int cb = cbp * 2 + cc;
                  f32x4 a1 = (f32x4){0.f, 0.f, 0.f, 0.f}, a2 = a1;
#pragma unroll
                  for (int ks = 0; ks < 4; ++ks) {
                      const s16x8 ak = *(const LAS s16x8*)(lds + KS + (16 * rb + n) * QPITCH + (32 * ks + 8 * g) * 2);
                      const s16x8 aq = *(const LAS s16x8*)(lds + QS + (16 * rb + n) * QPITCH + (32 * ks + 8 * g) * 2);
                      const s16x8 bk = *(const LAS s16x8*)(lds + KS + (16 * cb + n) * QPITCH + (32 * ks + 8 * g) * 2);
                      a1 = __builtin_amdgcn_mfma_f32_16x16x32_bf16(ak, bk, a1, 0, 0, 0);
                      a2 = __builtin_amdgcn_mfma_f32_16x16x32_bf16(aq, bk, a2, 0, 0, 0); }
                  const int j = 16 * cb + n; const float gj = gam[j];
#pragma unroll
                  for (int e = 0; e < 4; ++e) { const int i = 16 * rb + 4 * g + e; const float d = __expf(fminf(gam[i] - gj, 0.f));
                      const float mm = (j < i) ? a1[e] * d * bt[i] : 0.f, am = (j <= i) ? a2[e] * d : 0.f;
                      *(LAS bf16_t*)(lds + MB + i * MPITCH + j * 2) = f2bf(mm); *(LAS bf16_t*)(lds + A2 + i * MPITCH + j * 2) = f2bf(am);
                      if (cb == rb) *(LAS float*)(lds + MD + ((rb * 16 + 4 * g + e) * 17 + n) * 4) = mm; } } }
            __syncthreads();
            if (w < 4) { GDN_FRESH() const LAS float* N = (const LAS float*)(lds + MD + w * 16 * 17 * 4); float y[16];
#pragma unroll
                for (int j = 15; j >= 0; --j) { float s = (j == n) ? 1.f : 0.f;
#pragma unroll
                    for (int i = j + 1; i < 16; ++i) s -= y[i] * N[i * 17 + j];
                    y[j] = s; }
                float y4[4];
#pragma unroll
                for (int e = 0; e < 4; ++e) { float v = y[0];
#pragma unroll
                    for (int q = 1; q < 16; ++q) v = (4 * g + e == q) ? y[q] : v;
                    y4[e] = v; }
                u32x2 dv; dv.x = pk2(y4[0], y4[1]); dv.y = pk2(y4[2], y4[3]);
                *(LAS u32x2*)(lds + DV + (w * 16 + n) * DVPITCH + 4 * g * 2) = dv; }
            __syncthreads();
            f32x4 xw[4], u[4];
            { GDN_FRESH()
#pragma unroll
            for (int b = 0; b < 4; ++b) {
                f32x4 aw, au;
#pragma unroll
                for (int e = 0; e < 4; ++e) { const int i = 16 * b + 4 * g + e;
                    aw[e] = bf2f(*(const LAS bf16_t*)(lds + KS + i * QPITCH + (16 * w + n) * 2)) * bg[i];
                    au[e] = bf2f(*(const LAS bf16_t*)(lds + VS + i * QPITCH + (16 * w + n) * 2)) * bt[i]; }
#pragma unroll
                for (int j = 0; j < 4; ++j) if (j < b) {
                    const s16x4 am = *(const LAS s16x4*)(lds + MB + (16 * b + n) * MPITCH + (16 * j + 4 * g) * 2);
                    const s16x4 bw = mk4(pk2(xw[j][0], xw[j][1]) ^ 0x80008000u, pk2(xw[j][2], xw[j][3]) ^ 0x80008000u);
                    const s16x4 bu = mk4(pk2(u[j][0], u[j][1]) ^ 0x80008000u, pk2(u[j][2], u[j][3]) ^ 0x80008000u);
                    aw = __builtin_amdgcn_mfma_f32_16x16x16bf16_1k(am, bw, aw, 0, 0, 0);
                    au = __builtin_amdgcn_mfma_f32_16x16x16bf16_1k(am, bu, au, 0, 0, 0); }
                const s16x4 ad = *(const LAS s16x4*)(lds + DV + (b * 16 + n) * DVPITCH + 4 * g * 2);
                xw[b] = __builtin_amdgcn_mfma_f32_16x16x16bf16_1k(ad, mk4(pk2(aw[0], aw[1]), pk2(aw[2], aw[3])), (f32x4){0.f, 0.f, 0.f, 0.f}, 0, 0, 0);
                u[b]  = __builtin_amdgcn_mfma_f32_16x16x16bf16_1k(ad, mk4(pk2(au[0], au[1]), pk2(au[2], au[3])), (f32x4){0.f, 0.f, 0.f, 0.f}, 0, 0, 0);
#pragma unroll
                for (int e = 0; e < 4; ++e) *(LAS bf16_t*)(lds + WS_ + (16 * b + 4 * g + e) * QPITCH + (16 * w + n) * 2) = f2bf(xw[b][e]);
                __builtin_amdgcn_sched_barrier(0);
            } }
            __syncthreads();
            if (c + 1 < 64) GDN_LOADG(c + 1);
            s16x8 Sb[4];
#pragma unroll
            for (int ks = 0; ks < 4; ++ks) Sb[ks] = mk8(pk2(S[2 * ks][0], S[2 * ks][1]), pk2(S[2 * ks][2], S[2 * ks][3]), pk2(S[2 * ks + 1][0], S[2 * ks + 1][1]), pk2(S[2 * ks + 1][2], S[2 * ks + 1][3]));
            { GDN_FRESH()
#pragma unroll
            for (int rb = 0; rb < 4; ++rb) {
#pragma unroll
                for (int ks = 0; ks < 4; ++ks) {
                    const LAS unsigned char* wp = lds + WS_ + (16 * rb + n) * QPITCH + (32 * ks + 4 * g) * 2;
                    const s16x8 aw = cat8(*(const LAS u32x2*)wp, *(const LAS u32x2*)(wp + 32));
                    const u32x4 sv = __builtin_bit_cast(u32x4, Sb[ks]);
                    const s16x8 sneg = mk8(sv.x ^ 0x80008000u, sv.y ^ 0x80008000u, sv.z ^ 0x80008000u, sv.w ^ 0x80008000u);
                    u[rb] = __builtin_amdgcn_mfma_f32_16x16x32_bf16(aw, sneg, u[rb], 0, 0, 0); }
                __builtin_amdgcn_sched_barrier(0); } }
            s16x8 Ub[2], Ud[2];
            { GDN_FRESH()
#pragma unroll
            for (int ks = 0; ks < 2; ++ks) {
                Ub[ks] = mk8(pk2(u[2 * ks][0], u[2 * ks][1]), pk2(u[2 * ks][2], u[2 * ks][3]), pk2(u[2 * ks + 1][0], u[2 * ks + 1][1]), pk2(u[2 * ks + 1][2], u[2 * ks + 1][3]));
                const f32x4 d0 = *(const LAS f32x4*)(dl + 32 * ks + 4 * g), d1 = *(const LAS f32x4*)(dl + 32 * ks + 16 + 4 * g);
                Ud[ks] = mk8(pk2(u[2 * ks][0] * d0[0], u[2 * ks][1] * d0[1]), pk2(u[2 * ks][2] * d0[2], u[2 * ks][3] * d0[3]),
                             pk2(u[2 * ks + 1][0] * d1[0], u[2 * ks + 1][1] * d1[1]), pk2(u[2 * ks + 1][2] * d1[2], u[2 * ks + 1][3] * d1[3])); } }
            { GDN_FRESH()
#pragma unroll
            for (int rb = 0; rb < 4; ++rb) { f32x4 oa = (f32x4){0.f, 0.f, 0.f, 0.f}, o2 = oa;
#pragma unroll
                for (int ks = 0; ks < 4; ++ks) { const LAS unsigned char* qp = lds + QS + (16 * rb + n) * QPITCH + (32 * ks + 4 * g) * 2;
                    o2 = __builtin_amdgcn_mfma_f32_16x16x32_bf16(cat8(*(const LAS u32x2*)qp, *(const LAS u32x2*)(qp + 32)), Sb[ks], o2, 0, 0, 0); }
#pragma unroll
                for (int ks = 0; ks < 2; ++ks) { const LAS unsigned char* ap = lds + A2 + (16 * rb + n) * MPITCH + (32 * ks + 4 * g) * 2;
                    oa = __builtin_amdgcn_mfma_f32_16x16x32_bf16(cat8(*(const LAS u32x2*)ap, *(const LAS u32x2*)(ap + 32)), Ub[ks], oa, 0, 0, 0); }
#pragma unroll
                for (int e = 0; e < 4; ++e) { const int i = 16 * rb + 4 * g + e, st = c * 64 + i, pos = dir ? SEQ - 1 - st : st;
                    OD[((size_t)seq * SEQ + pos) * 4096 + h * 128 + 16 * w + n] = f2bf(eg[i] * o2[e] + oa[e]); }
                __builtin_amdgcn_sched_barrier(0); } }
            { GDN_FRESH() const float egl = eg[63];
#pragma unroll
              for (int sb = 0; sb < 8; ++sb) { f32x4 acc = S[sb] * egl;
#pragma unroll
                  for (int ks = 0; ks < 2; ++ks) { const LAS unsigned char* kp = lds + KT + (16 * sb + n) * KTPITCH + (32 * ks + 4 * g) * 2;
                      acc = __builtin_amdgcn_mfma_f32_16x16x32_bf16(cat8(*(const LAS u32x2*)kp, *(const LAS u32x2*)(kp + 32)), Ud[ks], acc, 0, 0, 0); }
                  S[sb] = acc; __builtin_amdgcn_sched_barrier(0); } }
            __syncthreads();
            if (c + 1 < 64) GDN_STORE();
            __syncthreads();
        }
#undef GDN_LOADG
#undef GDN_STORE
#undef GDN_FRESH
    }
}
}
#ifndef MK_SINGLE
#define MK_SINGLE 1
#endif
constexpr int NPH = 38;

__global__ void __launch_bounds__(NTHR, 2) mk_fwd(Args a_unused) {
    extern __shared__ __attribute__((aligned(16))) unsigned char lds_raw[];
    LAS unsigned char* lds = (LAS unsigned char*)lds_raw;
    int ph_lo, ph_hi;
    XcdBarrier bar;
    { ArgsCP a0 = argp(); ph_lo = a0->ph_lo; ph_hi = a0->ph_hi;
      bar.bar = (unsigned*)(a0->ws + WS_CTL); bar.x = 0; bar.st = (volatile LAS unsigned*)(lds + LDS_STAGE);
      if (ph_hi - ph_lo > 1) {
          if (threadIdx.x < 4) ((LAS unsigned*)(lds + LDS_STAGE))[threadIdx.x] = 0u;
          __syncthreads();
          bar = xcd_barrier_post((unsigned*)(a0->ws + WS_CTL), (volatile LAS unsigned*)(lds + LDS_STAGE));
      } }
    int ph = 0;
#define PH_BEGIN if (ph >= ph_lo && ph < ph_hi) { ArgsCP a = argp(); unsigned char* ws = a->ws; float* X = a->out; rs_t* RS = (rs_t*)(ws + WS_RS); \
        bf16_t* XB0 = (bf16_t*)(ws + WS_XB0); bf16_t* XB1 = (bf16_t*)(ws + WS_XB1); unsigned char* BIG = ws + WS_BIG; (void)X; (void)RS; (void)XB0; (void)XB1; (void)BIG;
#define PH_END   } if (ph >= ph_lo && ph + 1 < ph_hi) xcd_barrier(bar); ++ph;
#define RSB(k) (RS + (size_t)(k) * T)

    PH_BEGIN prologue(a, lds); PH_END

#define FFN_PLE(L, XBc, XBo) \
    PH_BEGIN { EpiFfn E{(bf16_t*)(BIG + BIG_HID2), (bf16_t*)(BIG + BIG_EDGE), RSB(3 * (L) + 1), a->in[32] + (size_t)(L) * 3 * DFF, a->in[33] + (size_t)(L) * DFF}; \
               run_gemm(lds, XBc, (const bf16_t*)(ws + WS_WGU + (L) * SZ_WGU), T, 2 * DFF, D, E); } PH_END \
    PH_BEGIN { ffn_fixup(a, (L), (const bf16_t*)(BIG + BIG_EDGE), (bf16_t*)(BIG + BIG_HID2)); \
               EpiScale E{XBo, D, nullptr, nullptr, -1}; \
               run_gemm(lds, (const bf16_t*)(ws + WS_PB) + (size_t)(L) * T * PLED, (const bf16_t*)(ws + WS_WPP + (L) * SZ_WPP), T, D, PLED, E); } PH_END \
    PH_BEGIN { EpiResid E{X, XBc, RSB(3 * (L) + 2)}; \
               run_gemm(lds, (const bf16_t*)(BIG + BIG_HID2), (const bf16_t*)(ws + WS_WDN + (L) * SZ_WDN), T, D, DFF, E); } PH_END \
    PH_BEGIN { EpiPle E{X, XBo, RSB(3 * (L) + 3), RSB(3 * (L) + 2), XBo}; \
               run_gemm(lds, XBc, (const bf16_t*)(ws + WS_WPG + (L) * SZ_WPG), T, D, D, E); } PH_END

    PH_BEGIN { EpiScale E{(bf16_t*)BIG, 6144, RSB(0), nullptr, -1}; run_gemm(lds, XB0, (const bf16_t*)(ws + WS_NAQ), T, 6144, D, E); } PH_END
    PH_BEGIN na_attention(a, lds, (const bf16_t*)BIG, XB1); PH_END
    PH_BEGIN { EpiResid E{X, XB0, RSB(1)}; run_gemm(lds, XB1, (const bf16_t*)(ws + WS_NAO), T, D, D, E); } PH_END
    FFN_PLE(0, XB0, XB1)
    PH_BEGIN { EpiGelu E{(bf16_t*)BIG, 4096, RSB(3), RSB(13), 8}; run_gemm(lds, XB1, (const bf16_t*)(ws + WS_SGI), T, 4096, D, E); } PH_END
    PH_BEGIN sgu_mix(a, lds, (const bf16_t*)BIG, RSB(13), XB0); PH_END
    PH_BEGIN { EpiResid E{X, XB1, RSB(4)}; run_gemm(lds, XB0, (const bf16_t*)(ws + WS_SGO), T, D, D, E); } PH_END
    FFN_PLE(1, XB1, XB0)
#pragma unroll 1
    for (int gg = 0; gg < NGG; ++gg) {
        const size_t r0 = (size_t)gg * GG_ROWS;
#define GDN_PTRS bf16_t* PROJ = (bf16_t*)(BIG + BIG_PROJ); bf16_t* OF = PROJ; bf16_t* OB = (bf16_t*)(BIG + BIG_OB); bf16_t* VP = (bf16_t*)(BIG + BIG_VP); \
        float* AB = (float*)(BIG + BIG_AB); float* GB = (float*)(BIG + BIG_GB); bf16_t* QK = XB1; (void)PROJ; (void)OF; (void)OB; (void)VP; (void)AB; (void)GB; (void)QK;
        PH_BEGIN { GDN_PTRS EpiScale E{PROJ, 8192, RSB(6) + r0, AB, 32}; run_gemm(lds, XB0 + r0 * D, (const bf16_t*)(ws + WS_GDI), GG_ROWS, GDI_N1, D, E); } PH_END
        PH_BEGIN { GDN_PTRS gdn_conv(a, PROJ, AB, QK, VP, GB, GG_ROWS); } PH_END
        PH_BEGIN { GDN_PTRS gdn::scan(lds, QK, VP, GB, OF, OB, GG_ROWS / SEQ); } PH_END
        PH_BEGIN { GDN_PTRS gdn_sumnorm(a, OF, OB, GG_ROWS); } PH_END
        PH_BEGIN { GDN_PTRS EpiGdnZ E{OF, 4096, RSB(6) + r0}; run_gemm(lds, XB0 + r0 * D, (const bf16_t*)(ws + WS_GDI) + (size_t)GDI_N1 * D, GG_ROWS, 4096, D, E); } PH_END
        PH_BEGIN { GDN_PTRS EpiResid E{X + r0 * D, XB0 + r0 * D, RSB(7) + r0}; run_gemm(lds, OF, (const bf16_t*)(ws + WS_GDO), GG_ROWS, D, 4096, E); } PH_END
    }
    FFN_PLE(2, XB0, XB1)
    PH_BEGIN s5_scan(a, lds, X, RSB(9), (float*)BIG, XB0); PH_END
    PH_BEGIN { EpiGlu E{X, XB1, RSB(10)}; run_gemm(lds, XB0, (const bf16_t*)(ws + WS_S5G), T, 4096, D, E); } PH_END
    FFN_PLE(3, XB1, XB0)
    PH_BEGIN final_norm(a, RSB(12)); PH_END
}
}

extern "C" void kernel_launch(void* const* d_in, const int* in_sizes, int n_in, void* d_out, int out_size, void* d_ws, size_t ws_size, hipStream_t stream) {
    using namespace mk;
    static int grid = 0;
    if (grid == 0) {
        if (n_in != 37 || out_size != T * D || ws_size < WS_END) { fprintf(stderr, "kernel_launch: unexpected problem (n_in %d, out %d, ws %zu < %zu)\n", n_in, out_size, ws_size, (size_t)WS_END); grid = -1; return; }
        int dev = 0, cus = 0;
        if (hipGetDevice(&dev) != hipSuccess || hipDeviceGetAttribute(&cus, hipDeviceAttributeMultiprocessorCount, dev) != hipSuccess) { grid = -1; return; }
        if (hipFuncSetAttribute((const void*)mk_fwd, hipFuncAttributeMaxDynamicSharedMemorySize, LDS_BYTES) != hipSuccess) { fprintf(stderr, "kernel_launch: hipFuncSetAttribute failed\n"); grid = -1; return; }
        int per_cu = 0;
        if (hipOccupancyMaxActiveBlocksPerMultiprocessor(&per_cu, (const void*)mk_fwd, NTHR, LDS_BYTES) != hipSuccess || per_cu < 1) fprintf(stderr, "kernel_launch: occupancy query says %d\n", per_cu);
        (void)hipGetLastError();
        grid = cus > 0 ? cus : 256;
    }
    if (grid < 0) return;
    (void)hipMemsetAsync(d_ws, 0, ZERO_BYTES, stream);
    Args a{};
    for (int i = 0; i < 37; ++i) a.in[i] = (const float*)d_in[i];
    a.out = (float*)d_out; a.ws = (unsigned char*)d_ws;
#if MK_SINGLE
    a.ph_lo = 0; a.ph_hi = NPH;
    hipLaunchKernelGGL(mk_fwd, dim3(grid), dim3(NTHR), LDS_BYTES, stream, a);
#else
    for (int p = 0; p < NPH; ++p) { a.ph_lo = p; a.ph_hi = p + 1; hipLaunchKernelGGL(mk_fwd, dim3(grid), dim3(NTHR), LDS_BYTES, stream, a); }
#endif
}
```

```cpp
#include <hip/hip_runtime.h>
#include <cstdio>
#include <cstdint>
#define XB_TMO      128
#define XB_XCNT(j)  (256  + 64 * (j))
#define XB_XSUB(j)  (1280 + 64 * (j))
#define XB_XGEN(j)  (2304 + 64 * (j))
#define XB_TOP      3328
#define XB_TOPGEN   3392
#define XCD_BAR_WORDS 3456
#define XB_SPIN_CAP (1u << 18)
#define LAS __attribute__((address_space(3)))

__device__ __forceinline__ unsigned xb_ld(unsigned* p)              { return __hip_atomic_load(p, __ATOMIC_RELAXED, __HIP_MEMORY_SCOPE_AGENT); }
__device__ __forceinline__ unsigned xb_add(unsigned* p, unsigned v) { return __hip_atomic_fetch_add(p, v, __ATOMIC_RELAXED, __HIP_MEMORY_SCOPE_AGENT); }
__device__ __forceinline__ unsigned xb_xcc_id() { return (unsigned)__builtin_amdgcn_s_getreg((3 << 11) | 20) & 0xFu; }
#define XB_SPIN(cond, bar) do { unsigned _sp = 0; while (cond) { __builtin_amdgcn_s_sleep(1); \
    if ((++_sp & 255u) == 0u) { if (xb_ld(&(bar)[XB_TMO])) break; if (_sp > XB_SPIN_CAP) { atomicAdd(&(bar)[XB_TMO], 1u); break; } } } } while (0)

struct XcdBarrier {
    unsigned* bar; unsigned x;
    volatile LAS unsigned* st;
};

__device__ __forceinline__ XcdBarrier xcd_barrier_post(unsigned* bar, volatile LAS unsigned* st) {
    XcdBarrier b; b.bar = bar; b.x = xb_xcc_id(); b.st = st;
    if (threadIdx.x == 0) (void)xb_add(&bar[XB_XCNT(b.x)], 1u);
    return b;
}
__device__ __forceinline__ void xcd_barrier_complete(unsigned* bar, unsigned x, unsigned& nloc, unsigned& nx) {
    const unsigned G = gridDim.x * gridDim.y * gridDim.z;
    unsigned sum, cnt, mine, sp = 0u;
    for (;;) {
        sum = 0u; cnt = 0u; mine = 0u;
#pragma unroll
        for (unsigned j = 0; j < 16; ++j) { const unsigned c = xb_ld(&bar[XB_XCNT(j)]); sum += c; cnt += (c > 0u) ? 1u : 0u; mine = (j == x) ? c : mine; }
        if (sum == G) break;
        __builtin_amdgcn_s_sleep(1);
        if ((++sp & 255u) == 0u) { if (xb_ld(&bar[XB_TMO])) break; if (sp > XB_SPIN_CAP) { atomicAdd(&bar[XB_TMO], 1u); break; } }
    }
    nloc = mine > 0u ? mine : 1u; nx = cnt > 0u ? cnt : 1u;
}

__device__ __forceinline__ void xcd_barrier(const XcdBarrier& b) {
    asm volatile("s_waitcnt vmcnt(0)" ::: "memory");
    __syncthreads();
    if (threadIdx.x == 0) {
        unsigned* bar = b.bar;
        __builtin_amdgcn_s_waitcnt(0);
        unsigned nloc = b.st[0], nx = b.st[1];
        if (nloc == 0u) { xcd_barrier_complete(bar, b.x, nloc, nx); b.st[0] = nloc; b.st[1] = nx; }
        const unsigned old = xb_add(&bar[XB_XSUB(b.x)], 1u);
        const unsigned gen = old / nloc;
        if (old + 1u == (gen + 1u) * nloc) {
            __builtin_amdgcn_fence(__ATOMIC_RELEASE, "agent");
            asm volatile("s_waitcnt vmcnt(0)" ::: "memory");
            const unsigned og = xb_add(&bar[XB_TOP], 1u);
            const unsigned tg = og / nx;
            if (og + 1u == (tg + 1u) * nx) xb_add(&bar[XB_TOPGEN], 1u);
            else XB_SPIN(xb_ld(&bar[XB_TOPGEN]) == tg, bar);
            __builtin_amdgcn_fence(__ATOMIC_ACQUIRE, "agent");
            xb_add(&bar[XB_XGEN(b.x)], 1u);
            asm volatile("s_waitcnt vmcnt(0)" ::: "memory");
        } else {
            XB_SPIN(xb_ld(&bar[XB_XGEN(b.x)]) == gen, bar);
            __builtin_amdgcn_fence(__ATOMIC_ACQUIRE, "agent");
            asm volatile("s_waitcnt vmcnt(0)" ::: "memory");
        }
    }
    __syncthreads();
}
namespace pg8 {
#define PG8_LAS __attribute__((address_space(3)))
typedef unsigned short bf16_t;
typedef short bf16x8 __attribute__((ext_vector_type(8)));
typedef float f32x4 __attribute__((ext_vector_type(4)));
typedef unsigned u32x4 __attribute__((ext_vector_type(4)));
constexpr int BM = 256, BK = 64, HALF = 128, HTB = HALF * BK * 2  , STAGE_BYTES = 8 * HTB, NXCD = 8, WGM = 8;

__host__ __device__ __forceinline__ int lds_byte(int r, int c) { const int st = (r >> 4) * 2 + (c >> 5), rr = r & 15, cc = c & 31, ob = rr * 64 + cc * 2; return st * 1024 + (ob ^ (((ob >> 9) & 1) << 5)); }
__host__ __device__ __forceinline__ void stage_rc(int b, int& R, int& C) { const int st = b / 1024, sb = b % 1024, swz = sb ^ (((sb >> 9) & 1) << 5); R = (st >> 1) * 16 + swz / 64; C = (st & 1) * 32 + (swz % 64) / 2; }
__host__ __device__ __forceinline__ int perm32(int rho) { const int n = rho >> 4, i = rho & 15; return 8 * (i >> 2) + 4 * n + (i & 3); }

struct Unit { int pm, pn; };
struct Gemm { const bf16_t* A; const bf16_t* Bt; int M, N, K; };

struct StaticOrder {
    int nM, nN, nwg, G, c;
    __host__ __device__ void init(int M, int N, int G_, int c_) { nM = M / BM; nN = N / BM; nwg = nM * nN; G = G_; c = c_; }
    __host__ __device__ bool next(int i, Unit& u) const {
        const long L = (long)i * G + c; if (L >= nwg) return false;
        int wgid = (int)L; { const int q = nwg / NXCD, r = nwg % NXCD, xcd = wgid % NXCD, off = wgid / NXCD; wgid = (xcd < r ? xcd * (q + 1) : r * (q + 1) + (xcd - r) * q) + off; }
        const int nig = WGM * nN, gid = wgid / nig, fm = gid * WGM, gsz = (nM - fm) < WGM ? (nM - fm) : WGM;
        u.pm = fm + ((wgid % nig) % gsz); u.pn = (wgid % nig) / gsz; return true;
    }
    __device__ __forceinline__ void a_ready(const Unit&) const {}
    __device__ __forceinline__ void done(const Unit&) const {}
};


__device__ __forceinline__ unsigned cvt_pk_bf16(float lo, float hi) { unsigned r; asm volatile("v_cvt_pk_bf16_f32 %0, %1, %2" : "=v"(r) : "v"(lo), "v"(hi)); return r; }

template <class Epi, class Sched, bool ALIGN_EPI = false, bool SP2 = false>
__device__ __forceinline__ void gemm_phase(PG8_LAS unsigned char* lds, const Gemm g, const Sched& S, const Epi& E) {
    int tid_ = threadIdx.x; asm volatile("" : "+v"(tid_)); const int tid = tid_, wid = __builtin_amdgcn_readfirstlane(tid >> 6), lane = tid & 63, wr = wid >> 2, wc = wid & 3, fr = lane & 15, fq = lane >> 4;
    const int K = g.K, nt = K / BK;
    unsigned voffA[2], voffB[2];
#pragma unroll
    for (int i = 0; i < 2; ++i) { int R, C; stage_rc(tid * 16 + i * 8192, R, C); const int Rb = Epi::PERM ? ((R & ~31) + perm32(R & 31)) : R;
        voffA[i] = (unsigned)(R * K + C) * 2u; voffB[i] = (unsigned)(Rb * K + C) * 2u; }
    const size_t kstep = (size_t)(BK * 2);
    const size_t hstep = (size_t)HALF * K * 2;
    const size_t tstep = 2 * hstep;
    const unsigned ldsw = (unsigned)wid * 1024u;
    const int aoff = lds_byte(wr * 64 + fr, fq * 8), boff = lds_byte(wc * 32 + fr, fq * 8);
#define PG8_SA(b, h) (((b) * 2 + (h)) * HTB)
#define PG8_SB(b, h) ((4 + (b) * 2 + (h)) * HTB)
#define PG8_STAGE(bufoff, gbase, voff) do { _Pragma("unroll") for (int _i = 0; _i < 2; ++_i) \
        __builtin_amdgcn_global_load_lds((const unsigned*)((const char*)(gbase) + (voff)[_i]), (PG8_LAS unsigned*)(lds + (bufoff) + ldsw + _i * 8192), 16, 0, 0); } while (0)
#define PG8_LDA(dst, b, h) do { _Pragma("unroll") for (int m = 0; m < 4; ++m) _Pragma("unroll") for (int k = 0; k < 2; ++k) dst[m][k] = *(const PG8_LAS bf16x8*)(lds + PG8_SA(b, h) + aoff + m * 2048 + k * 1024); } while (0)
#define PG8_LDB(dst, b, h) do { _Pragma("unroll") for (int n = 0; n < 2; ++n) _Pragma("unroll") for (int k = 0; k < 2; ++k) dst[n][k] = *(const PG8_LAS bf16x8*)(lds + PG8_SB(b, h) + boff + n * 2048 + k * 1024); } while (0)
#define PG8_MMA(ai, bj, At, Bt) do { __builtin_amdgcn_s_setprio(1); _Pragma("unroll") for (int m = 0; m < 4; ++m) _Pragma("unroll") for (int n = 0; n < 2; ++n) _Pragma("unroll") for (int k = 0; k < 2; ++k) \
        acc[ai][bj][m][n] = __builtin_amdgcn_mfma_f32_16x16x32_bf16(Bt[n][k], At[m][k], acc[ai][bj][m][n], 0, 0, 0); __builtin_amdgcn_s_setprio(0); } while (0)
#define PG8_WAIT_V(n) asm volatile("s_waitcnt vmcnt(" #n ")" ::: "memory")
#define PG8_WAIT_L(n) asm volatile("s_waitcnt lgkmcnt(" #n ")" ::: "memory")
#define PG8_BAR __builtin_amdgcn_s_barrier()
#define PG8_SCHED __builtin_amdgcn_sched_barrier(0)
    Unit cur, nxt; int ui = 0;
    if (!S.next(0, cur)) return;
    f32x4 acc[2][2][4][2];
#pragma unroll
    for (int a = 0; a < 2; ++a)
#pragma unroll
        for (int b = 0; b < 2; ++b)
#pragma unroll
            for (int m = 0; m < 4; ++m)
#pragma unroll
                for (int n = 0; n < 2; ++n) acc[a][b][m][n] = (f32x4){0.f, 0.f, 0.f, 0.f};
    bf16x8 At[4][2], B0[2][2], B1[2][2];
    const char* cA = (const char*)g.A + (size_t)cur.pm * tstep; const char* cB = (const char*)g.Bt + (size_t)cur.pn * tstep;
    S.a_ready(cur);
    if constexpr (SP2) {
        PG8_STAGE(PG8_SB(0, 0), cB, voffB); PG8_STAGE(PG8_SB(0, 1), cB + hstep, voffB); PG8_STAGE(PG8_SA(0, 0), cA, voffA); PG8_STAGE(PG8_SA(0, 1), cA + hstep, voffA);
        if (wr == 1) PG8_BAR;
        PG8_WAIT_V(2); PG8_BAR;
        PG8_STAGE(PG8_SB(1, 0), cB + kstep, voffB); PG8_STAGE(PG8_SA(1, 0), cA + kstep, voffA); PG8_STAGE(PG8_SB(1, 1), cB + hstep + kstep, voffB);
        PG8_WAIT_V(6); PG8_BAR;
    } else {
        PG8_STAGE(PG8_SB(0, 0), cB, voffB); PG8_STAGE(PG8_SA(0, 0), cA, voffA); PG8_STAGE(PG8_SB(0, 1), cB + hstep, voffB); PG8_STAGE(PG8_SA(0, 1), cA + hstep, voffA);
        if (wr == 1) PG8_BAR;
        PG8_WAIT_V(4); PG8_BAR;
        PG8_STAGE(PG8_SB(1, 0), cB + kstep, voffB); PG8_STAGE(PG8_SA(1, 0), cA + kstep, voffA); PG8_STAGE(PG8_SB(1, 1), cB + hstep + kstep, voffB);
        PG8_WAIT_V(6); PG8_BAR;
    }
    for (;;) {
        const bool has_next = S.next(ui + 1, nxt);
        const char* nA = has_next ? (const char*)g.A + (size_t)nxt.pm * tstep : cA; const char* nB = has_next ? (const char*)g.Bt + (size_t)nxt.pn * tstep : cB;
        for (int t = 0; t < nt; t += 2) {
            const bool last = (t == nt - 2);
            const char* a1 = cA + (size_t)(t + 1) * kstep;
            const char* a2 = last ? nA : cA + (size_t)(t + 2) * kstep; const char* b2 = last ? nB : cB + (size_t)(t + 2) * kstep;
            const char* a3 = a2 + kstep; const char* b3 = b2 + kstep;
            if (last && has_next) S.a_ready(nxt);
            if constexpr (SP2) {
            PG8_LDB(B0, 0, 0); PG8_LDB(B1, 0, 1); PG8_SCHED; PG8_LDA(At, 0, 0); PG8_STAGE(PG8_SA(1, 1), a1 + hstep, voffA);
            PG8_WAIT_V(8); PG8_WAIT_L(0); PG8_BAR; PG8_MMA(0, 0, At, B0); PG8_MMA(0, 1, At, B1); PG8_BAR; PG8_SCHED;
            PG8_LDA(At, 0, 1); PG8_STAGE(PG8_SB(0, 0), b2, voffB); PG8_STAGE(PG8_SB(0, 1), b2 + hstep, voffB); PG8_STAGE(PG8_SA(0, 0), a2, voffA);
            PG8_WAIT_V(8); PG8_WAIT_L(0); PG8_BAR; PG8_MMA(1, 0, At, B0); PG8_MMA(1, 1, At, B1); PG8_BAR; PG8_SCHED;
            PG8_LDB(B0, 1, 0); PG8_LDB(B1, 1, 1); PG8_SCHED; PG8_LDA(At, 1, 0); PG8_STAGE(PG8_SA(0, 1), a2 + hstep, voffA);
            PG8_WAIT_V(8); PG8_WAIT_L(0); PG8_BAR; PG8_MMA(0, 0, At, B0); PG8_MMA(0, 1, At, B1); PG8_BAR; PG8_SCHED;
            PG8_LDA(At, 1, 1); PG8_STAGE(PG8_SB(1, 0), b3, voffB); PG8_STAGE(PG8_SB(1, 1), b3 + hstep, voffB); PG8_STAGE(PG8_SA(1, 0), a3, voffA);
            PG8_WAIT_V(8); PG8_WAIT_L(0); PG8_BAR; PG8_MMA(1, 0, At, B0); PG8_MMA(1, 1, At, B1); PG8_BAR; PG8_SCHED;
            } else {
            PG8_LDB(B0, 0, 0); PG8_SCHED; PG8_LDA(At, 0, 0); PG8_STAGE(PG8_SA(1, 1), a1 + hstep, voffA);
            PG8_WAIT_L(8); PG8_BAR; PG8_WAIT_L(0); PG8_MMA(0, 0, At, B0); PG8_BAR; PG8_SCHED;
            PG8_LDB(B1, 0, 1); PG8_STAGE(PG8_SB(0, 0), b2, voffB);
            PG8_BAR; PG8_WAIT_L(0); PG8_MMA(0, 1, At, B1); PG8_BAR;
            PG8_LDA(At, 0, 1); PG8_STAGE(PG8_SA(0, 0), a2, voffA);
            PG8_BAR; PG8_WAIT_L(0); PG8_MMA(1, 0, At, B0); PG8_BAR; PG8_SCHED;
            PG8_STAGE(PG8_SB(0, 1), b2 + hstep, voffB);
            PG8_WAIT_V(6); PG8_BAR; PG8_MMA(1, 1, At, B1); PG8_BAR;
            PG8_LDB(B0, 1, 0); PG8_SCHED; PG8_LDA(At, 1, 0); PG8_STAGE(PG8_SA(0, 1), a2 + hstep, voffA);
            PG8_WAIT_L(8); PG8_BAR; PG8_WAIT_L(0); PG8_MMA(0, 0, At, B0); PG8_BAR; PG8_SCHED;
            PG8_LDB(B1, 1, 1); PG8_STAGE(PG8_SB(1, 0), b3, voffB);
            PG8_BAR; PG8_WAIT_L(0); PG8_MMA(0, 1, At, B1); PG8_BAR;
            PG8_LDA(At, 1, 1); PG8_STAGE(PG8_SA(1, 0), a3, voffA);
            PG8_BAR; PG8_WAIT_L(0); PG8_MMA(1, 0, At, B0); PG8_BAR; PG8_SCHED;
            PG8_STAGE(PG8_SB(1, 1), b3 + hstep, voffB);
            PG8_WAIT_V(6); PG8_BAR; PG8_MMA(1, 1, At, B1); PG8_BAR;
            }
        }
        if constexpr (ALIGN_EPI) { if (wr == 0) PG8_BAR; }
        if constexpr (!Epi::AFTER_DRAIN) { E(acc, cur, wr, wc, fr, fq); S.done(cur); }
        if (!has_next) break;
#pragma unroll
        for (int a = 0; a < 2; ++a)
#pragma unroll
            for (int b = 0; b < 2; ++b)
#pragma unroll
                for (int m = 0; m < 4; ++m)
#pragma unroll
                    for (int n = 0; n < 2; ++n) acc[a][b][m][n] = (f32x4){0.f, 0.f, 0.f, 0.f};
        cur = nxt; cA = nA; cB = nB; ++ui;
        if constexpr (ALIGN_EPI) { if (wr == 1) PG8_BAR; }
    }
    PG8_WAIT_V(0);
    if constexpr (!ALIGN_EPI) { if (wr == 0) PG8_BAR; }
    PG8_BAR;
    if constexpr (Epi::AFTER_DRAIN) { E.fused(acc, cur, wr, wc, fr, fq, lds, wid, lane); S.done(cur); }
#undef PG8_SA
#undef PG8_SB
#undef PG8_STAGE
#undef PG8_LDA
#undef PG8_LDB
#undef PG8_MMA
#undef PG8_WAIT_V
#undef PG8_WAIT_L
#undef PG8_BAR
#undef PG8_SCHED
}
}

namespace mk {
using pg8::bf16_t; using pg8::f32x4; using pg8::u32x4; using pg8::Unit;
typedef unsigned u32x2 __attribute__((ext_vector_type(2)));
constexpr int D = 2048, T = 40960, NSEQ = 10, SEQ = 4096, DFF = 5632, PLED = 256;
constexpr float EPS = 1e-6f;
constexpr int NTHR = 512;

constexpr size_t AL(size_t x) { return (x + 255) & ~size_t(255); }
constexpr size_t WS_CTL = 0, CTL_BYTES = 65536;
constexpr int NRS = 14;
constexpr size_t WS_RS = WS_CTL + CTL_BYTES, RS_BYTES = (size_t)NRS * T * 8;
constexpr size_t ZERO_BYTES = WS_RS + RS_BYTES;
constexpr size_t SZ_WGU = (size_t)2 * DFF * D * 2, SZ_WDN = (size_t)D * DFF * 2, SZ_WPG = (size_t)D * D * 2, SZ_WPP = (size_t)D * PLED * 2;
constexpr size_t WS_WGU = AL(ZERO_BYTES);
constexpr size_t WS_WDN = WS_WGU + 4 * SZ_WGU;
constexpr size_t WS_WPG = WS_WDN + 4 * SZ_WDN;
constexpr size_t WS_WPP = WS_WPG + 4 * SZ_WPG;
constexpr size_t WS_NAQ = WS_WPP + 4 * SZ_WPP;
constexpr size_t WS_NAO = WS_NAQ + (size_t)6144 * D * 2;
constexpr size_t WS_SGI = WS_NAO + (size_t)D * D * 2;
constexpr size_t WS_SGO = WS_SGI + (size_t)4096 * D * 2;
constexpr int    GDI_N = 12544, GDI_N1 = 8448;
constexpr size_t WS_GDI = WS_SGO + (size_t)D * D * 2;
constexpr size_t WS_GDO = WS_GDI + (size_t)GDI_N * D * 2;
constexpr size_t WS_S5G = WS_GDO + (size_t)D * 4096 * 2;
constexpr size_t WS_PB  = WS_S5G + (size_t)4096 * D * 2;
constexpr size_t WS_XB0 = WS_PB + (size_t)4 * T * PLED * 2;
constexpr size_t WS_XB1 = WS_XB0 + (size_t)T * D * 2;
constexpr size_t WS_BIG = WS_XB1 + (size_t)T * D * 2;
constexpr size_t BIG_BYTES = 524288000;
constexpr size_t WS_END = WS_BIG + BIG_BYTES;
constexpr int FG_ROWS = 8192, NFG = 5;
constexpr size_t BIG_GU = 0, BIG_HID = (size_t)FG_ROWS * 2 * DFF * 2;
constexpr size_t BIG_HID2 = 0, BIG_EDGE = (size_t)T * DFF * 2;
static_assert(BIG_EDGE + (size_t)(T / 256) * 16 * 2 * DFF * 2 <= BIG_BYTES, "BIG");
constexpr int GG_ROWS = 20480, NGG = 2;
constexpr size_t BIG_PROJ = 0, BIG_OB = (size_t)GG_ROWS * 4096 * 2, BIG_VP = (size_t)GG_ROWS * 8192 * 2, BIG_AB = BIG_VP + (size_t)GG_ROWS * 4096 * 2, BIG_GB = BIG_AB + (size_t)GG_ROWS * 128 * 4;
static_assert(BIG_GB + (size_t)GG_ROWS * 128 * 4 <= BIG_BYTES, "BIG");
static_assert((size_t)T * 6144 * 2 <= BIG_BYTES, "BIG");

constexpr int LDS_STAGE = 131072, LDS_BYTES = 163840, LDS_BAR = LDS_BYTES - 16;

struct Args { const float* in[37]; float* out; unsigned char* ws; int ph_lo, ph_hi; };
typedef const Args __attribute__((address_space(4)))* ArgsCP;
__device__ __forceinline__ ArgsCP argp() { ArgsCP p = (ArgsCP)__builtin_amdgcn_kernarg_segment_ptr(); asm volatile("" : "+s"(p)); return p; }
__device__ __forceinline__ int tidx() { int t = threadIdx.x; asm volatile("" : "+v"(t)); return t; }

__device__ __forceinline__ float bf2f(bf16_t b) { return __uint_as_float(((unsigned)b) << 16); }
__device__ __forceinline__ float blo(unsigned w) { return __uint_as_float(w << 16); }
__device__ __forceinline__ float bhi(unsigned w) { return __uint_as_float(w & 0xffff0000u); }
typedef float f32x2_t __attribute__((ext_vector_type(2))); typedef __bf16 bf16x2_t __attribute__((ext_vector_type(2)));
__device__ __forceinline__ unsigned pk2(float lo, float hi) { const f32x2_t v = {lo, hi}; const bf16x2_t b = __builtin_convertvector(v, bf16x2_t); return __builtin_bit_cast(unsigned, b); }
__device__ __forceinline__ bf16_t f2bf(float f) { return (bf16_t)(pk2(f, 0.f) & 0xffffu); }
typedef unsigned long long rs_t;
__device__ __forceinline__ float rs_val(rs_t v) { return (float)(unsigned)(v >> 24) + (float)(unsigned)(v & 0xffffffull) * (1.0f / 16777216.0f); }
__device__ __forceinline__ rs_t rs_fix(float ss) { return (rs_t)__float2ull_rn(ss * 16777216.0f); }
__device__ __forceinline__ void rs_add(rs_t* p, float ss) { atomicAdd(p, rs_fix(ss)); }
__device__ __forceinline__ float rstd_of(rs_t v) { return rsqrtf(rs_val(v) * (1.0f / (float)D) + EPS); }
__device__ __forceinline__ float sigmoidf_(float x) { return __builtin_amdgcn_rcpf(1.0f + __expf(-x)); }
__device__ __forceinline__ float siluf_(float x) { return x * sigmoidf_(x); }
__device__ __forceinline__ float geluf_(float x) { const float z = 1.5957691216f * (x + 0.044715f * x * x * x); return x * sigmoidf_(z); }
__device__ __forceinline__ void unpack8(const u32x4 w, float (&v)[8]) { v[0] = blo(w.x); v[1] = bhi(w.x); v[2] = blo(w.y); v[3] = bhi(w.y); v[4] = blo(w.z); v[5] = bhi(w.z); v[6] = blo(w.w); v[7] = bhi(w.w); }
__device__ __forceinline__ u32x4 pack8(const float (&v)[8]) { u32x4 w; w.x = pk2(v[0], v[1]); w.y = pk2(v[2], v[3]); w.z = pk2(v[4], v[5]); w.w = pk2(v[6], v[7]); return w; }
__device__ __forceinline__ float wave_sum(float v) {
#pragma unroll
    for (int o = 32; o > 0; o >>= 1) v += __shfl_xor(v, o);
    return v; }
__device__ __forceinline__ float wave_max(float v) {
#pragma unroll
    for (int o = 32; o > 0; o >>= 1) v = fmaxf(v, __shfl_xor(v, o));
    return v; }

typedef const f32x4 (&AccT)[2][2][4][2];

struct EpiScale {
    static constexpr bool PERM = true, AFTER_DRAIN = false;
    bf16_t* O; int ldc; const rs_t* rs; float* ab; int ab_pn;
    __device__ __forceinline__ void operator()(AccT acc, const Unit& u, int wr, int wc, int fr, int fq) const {
        const int row0 = u.pm * 256 + wr * 64 + fr, colw = wc * 32 + 8 * fq;
        const bool side = (ab != nullptr) && (u.pn == ab_pn);
#pragma unroll
        for (int ai = 0; ai < 2; ++ai)
#pragma unroll
            for (int m = 0; m < 4; ++m) {
                const int row = row0 + ai * 128 + m * 16;
                const float s = rs ? rstd_of(rs[row]) : 1.0f;
#pragma unroll
                for (int bj = 0; bj < 2; ++bj) {
                    const f32x4 v0 = acc[ai][bj][m][0] * s, v1 = acc[ai][bj][m][1] * s;
                    if (side) { if (bj == 0) { float* p = ab + (size_t)row * 128 + colw; *(f32x4*)p = v0; *(f32x4*)(p + 4) = v1; } }
                    else { u32x4 w; w.x = pk2(v0[0], v0[1]); w.y = pk2(v0[2], v0[3]); w.z = pk2(v1[0], v1[1]); w.w = pk2(v1[2], v1[3]);
                           *(u32x4*)(O + (size_t)row * ldc + u.pn * 256 + bj * 128 + colw) = w; }
                }
            }
    }
};
struct EpiGelu {
    static constexpr bool PERM = true, AFTER_DRAIN = false;
    bf16_t* O; int ldc; const rs_t* rs; rs_t* rsv; int vtile0;
    __device__ __forceinline__ void operator()(AccT acc, const Unit& u, int wr, int wc, int fr, int fq) const {
        const int row0 = u.pm * 256 + wr * 64 + fr, colw = wc * 32 + 8 * fq;
        const bool isv = u.pn >= vtile0;
#pragma unroll
        for (int ai = 0; ai < 2; ++ai)
#pragma unroll
            for (int m = 0; m < 4; ++m) {
                const int row = row0 + ai * 128 + m * 16;
                const float s = rstd_of(rs[row]); float ss = 0.f;
#pragma unroll
                for (int bj = 0; bj < 2; ++bj) {
                    float v[8];
#pragma unroll
                    for (int j = 0; j < 4; ++j) { v[j] = geluf_(acc[ai][bj][m][0][j] * s); v[4 + j] = geluf_(acc[ai][bj][m][1][j] * s); }
#pragma unroll
                    for (int j = 0; j < 8; ++j) ss += v[j] * v[j];
                    *(u32x4*)(O + (size_t)row * ldc + u.pn * 256 + bj * 128 + colw) = pack8(v);
                }
                if (isv) { ss += __shfl_xor(ss, 16); ss += __shfl_xor(ss, 32); if (fq == 0) rs_add(rsv + row, ss); }
            }
    }
};
__device__ __forceinline__ float put_x(float* X, bf16_t* XB, size_t off, const float (&xn)[8]) {
    *(f32x4*)(X + off) = (f32x4){xn[0], xn[1], xn[2], xn[3]}; *(f32x4*)(X + off + 4) = (f32x4){xn[4], xn[5], xn[6], xn[7]};
    *(u32x4*)(XB + off) = pack8(xn);
    float ss = 0.f;
#pragma unroll
    for (int j = 0; j < 8; ++j) ss += xn[j] * xn[j];
    return ss;
}
struct EpiResid {
    static constexpr bool PERM = true, AFTER_DRAIN = false;
    float* X; bf16_t* XB; rs_t* rsq;
    __device__ __forceinline__ void operator()(AccT acc, const Unit& u, int wr, int wc, int fr, int fq) const {
        const int row0 = u.pm * 256 + wr * 64 + fr, colw = wc * 32 + 8 * fq;
#pragma unroll
        for (int ai = 0; ai < 2; ++ai)
#pragma unroll
            for (int m = 0; m < 4; ++m) {
                const int row = row0 + ai * 128 + m * 16; float ss = 0.f;
#pragma unroll
                for (int bj = 0; bj < 2; ++bj) {
                    const size_t off = (size_t)row * D + u.pn * 256 + bj * 128 + colw;
                    const f32x4 x0 = *(const f32x4*)(X + off), x1 = *(const f32x4*)(X + off + 4);
                    float xn[8];
#pragma unroll
                    for (int j = 0; j < 4; ++j) { xn[j] = x0[j] + acc[ai][bj][m][0][j]; xn[4 + j] = x1[j] + acc[ai][bj][m][1][j]; }
                    ss += put_x(X, XB, off, xn);
                }
                ss += __shfl_xor(ss, 16); ss += __shfl_xor(ss, 32); if (fq == 0) rs_add(rsq + row, ss);
            }
    }
};
struct EpiPle {
    static constexpr bool PERM = true, AFTER_DRAIN = false;
    float* X; bf16_t* XB; rs_t* rsq; const rs_t* rs_in; const bf16_t* PP;
    __device__ __forceinline__ void operator()(AccT acc, const Unit& u, int wr, int wc, int fr, int fq) const {
        const int row0 = u.pm * 256 + wr * 64 + fr, colw = wc * 32 + 8 * fq;
#pragma unroll
        for (int ai = 0; ai < 2; ++ai)
#pragma unroll
            for (int m = 0; m < 4; ++m) {
                const int row = row0 + ai * 128 + m * 16; float ss = 0.f; const float s = rstd_of(rs_in[row]);
#pragma unroll
                for (int bj = 0; bj < 2; ++bj) {
                    const size_t off = (size_t)row * D + u.pn * 256 + bj * 128 + colw;
                    const f32x4 x0 = *(const f32x4*)(X + off), x1 = *(const f32x4*)(X + off + 4);
                    float pv[8]; unpack8(*(const u32x4*)(PP + off), pv);
                    float xn[8];
#pragma unroll
                    for (int j = 0; j < 4; ++j) { xn[j] = x0[j] + sigmoidf_(acc[ai][bj][m][0][j] * s) * pv[j]; xn[4 + j] = x1[j] + sigmoidf_(acc[ai][bj][m][1][j] * s) * pv[4 + j]; }
                    ss += put_x(X, XB, off, xn);
                }
                ss += __shfl_xor(ss, 16); ss += __shfl_xor(ss, 32); if (fq == 0) rs_add(rsq + row, ss);
            }
    }
};
struct EpiGlu {
    static constexpr bool PERM = true, AFTER_DRAIN = false;
    float* X; bf16_t* XB; rs_t* rsq;
    __device__ __forceinline__ void operator()(AccT acc, const Unit& u, int wr, int wc, int fr, int fq) const {
        const int row0 = u.pm * 256 + wr * 64 + fr, colw = wc * 32 + 8 * fq;
#pragma unroll
        for (int ai = 0; ai < 2; ++ai)
#pragma unroll
            for (int m = 0; m < 4; ++m) {
                const int row = row0 + ai * 128 + m * 16;
                const size_t off = (size_t)row * D + u.pn * 128 + colw;
                const f32x4 x0 = *(const f32x4*)(X + off), x1 = *(const f32x4*)(X + off + 4);
                float xn[8];
#pragma unroll
                for (int j = 0; j < 4; ++j) { xn[j] = x0[j] + acc[ai][0][m][0][j] * sigmoidf_(acc[ai][1][m][0][j]); xn[4 + j] = x1[j] + acc[ai][0][m][1][j] * sigmoidf_(acc[ai][1][m][1][j]); }
                float ss = put_x(X, XB, off, xn);
                ss += __shfl_xor(ss, 16); ss += __shfl_xor(ss, 32); if (fq == 0) rs_add(rsq + row, ss);
            }
    }
};
struct EpiGdnZ {
    static constexpr bool PERM = true, AFTER_DRAIN = false;
    bf16_t* O; int ldc; const rs_t* rs;
    __device__ __forceinline__ void operator()(AccT acc, const Unit& u, int wr, int wc, int fr, int fq) const {
        const int row0 = u.pm * 256 + wr * 64 + fr, colw = wc * 32 + 8 * fq;
#pragma unroll
        for (int ai = 0; ai < 2; ++ai)
#pragma unroll
            for (int m = 0; m < 4; ++m) {
                const int row = row0 + ai * 128 + m * 16; const float s = rstd_of(rs[row]);
#pragma unroll
                for (int bj = 0; bj < 2; ++bj) {
                    bf16_t* p = O + (size_t)row * ldc + u.pn * 256 + bj * 128 + colw;
                    float ov[8]; unpack8(*(const u32x4*)p, ov);
#pragma unroll
                    for (int j = 0; j < 4; ++j) { ov[j] *= siluf_(acc[ai][bj][m][0][j] * s); ov[4 + j] *= siluf_(acc[ai][bj][m][1][j] * s); }
                    *(u32x4*)p = pack8(ov);
                }
            }
    }
};

struct EpiFfn {
    static constexpr bool PERM = true, AFTER_DRAIN = false;
    bf16_t* HID; bf16_t* EDGE; const rs_t* rs; const float* cw; const float* cb;
    __device__ __forceinline__ void operator()(AccT acc, const Unit& u, int wr, int wc, int fr, int fq) const {
        const int lane = fq * 16 + fr, ch = u.pn * 128 + wc * 32 + 8 * fq;
        const int srcUp = (lane & 48) | ((lane + 1) & 15), srcDn = (lane & 48) | ((lane + 15) & 15);
        float w0[8], w1[8], w2[8], bb[8];
#pragma unroll
        for (int q = 0; q < 2; ++q) { const f32x4 a0 = *(const f32x4*)(cw + ch + 4 * q), a1 = *(const f32x4*)(cw + DFF + ch + 4 * q), a2 = *(const f32x4*)(cw + 2 * DFF + ch + 4 * q), a3 = *(const f32x4*)(cb + ch + 4 * q);
#pragma unroll
            for (int j = 0; j < 4; ++j) { w0[4 * q + j] = a0[j]; w1[4 * q + j] = a1[j]; w2[4 * q + j] = a2[j]; bb[4 * q + j] = a3[j]; } }
#pragma unroll
        for (int ai = 0; ai < 2; ++ai) {
            const int row0 = u.pm * 256 + ai * 128 + wr * 64 + fr;
            float G[4][8], sc[4];
#pragma unroll
            for (int m = 0; m < 4; ++m) { sc[m] = rstd_of(rs[row0 + m * 16]);
#pragma unroll
                for (int j = 0; j < 4; ++j) { G[m][j] = acc[ai][0][m][0][j] * sc[m]; G[m][4 + j] = acc[ai][0][m][1][j] * sc[m]; } }
            float ruc[8], rdp[8];
#pragma unroll
            for (int j = 0; j < 8; ++j) { ruc[j] = __shfl(G[0][j], srcUp); rdp[j] = 0.f; }
#pragma unroll
            for (int m = 0; m < 4; ++m) {
                float run[8], rdc[8];
#pragma unroll
                for (int j = 0; j < 8; ++j) { run[j] = (m < 3) ? __shfl(G[m < 3 ? m + 1 : 3][j], srcUp) : 0.f; rdc[j] = __shfl(G[m][j], srcDn); }
                float hv[8], uv[8];
#pragma unroll
                for (int j = 0; j < 8; ++j) { const float up = (fr < 15) ? ruc[j] : run[j], dn = (fr > 0) ? rdc[j] : rdp[j];
                    uv[j] = (j < 4 ? acc[ai][1][m][0][j] : acc[ai][1][m][1][j - 4]) * sc[m];
                    hv[j] = siluf_(w0[j] * dn + w1[j] * G[m][j] + w2[j] * up + bb[j]) * uv[j]; }
                const int row = row0 + m * 16;
                *(u32x4*)(HID + (size_t)row * DFF + ch) = pack8(hv);
                if ((m == 0 && fr < 2) || (m == 3 && fr >= 14)) { const int e = 4 * (2 * ai + wr) + (m == 0 ? fr : fr - 12);
                    bf16_t* ep = EDGE + ((size_t)(u.pm * 16 + e) * 2) * DFF + ch;
                    *(u32x4*)ep = pack8(G[m]); *(u32x4*)(ep + DFF) = pack8(uv); }
#pragma unroll
                for (int j = 0; j < 8; ++j) { rdp[j] = rdc[j]; ruc[j] = run[j]; }
            }
        }
    }
};

template <class Epi>
__device__ __forceinline__ void run_gemm(LAS unsigned char* lds, const bf16_t* A, const bf16_t* Bt, int M, int N, int K, const Epi& E) {
    pg8::Gemm g{A, Bt, M, N, K}; pg8::StaticOrder S; S.init(M, N, (int)gridDim.x, (int)blockIdx.x);
    pg8::gemm_phase<Epi, pg8::StaticOrder, true, true>(lds, g, S, E);
}

struct Job { const float* src; bf16_t* dst; const float* gain; int K, Nsrc, Ndst, map, qcols; };
__device__ __forceinline__ void get_job(ArgsCP a, int j, Job& J) {
    unsigned char* ws = a->ws; J.gain = nullptr; J.map = 0; J.qcols = 0;
    if (j < 16) { const int L = j >> 2, k = j & 3;
        if (k == 0)      { J.src = a->in[31] + (size_t)L * D * 2 * DFF; J.dst = (bf16_t*)(ws + WS_WGU + L * SZ_WGU); J.gain = a->in[5] + L * D; J.K = D; J.Nsrc = 2 * DFF; J.Ndst = 2 * DFF; J.map = 1; }
        else if (k == 1) { J.src = a->in[34] + (size_t)L * DFF * D;     J.dst = (bf16_t*)(ws + WS_WDN + L * SZ_WDN); J.K = DFF; J.Nsrc = D; J.Ndst = D; }
        else if (k == 2) { J.src = a->in[36] + (size_t)L * D * D;       J.dst = (bf16_t*)(ws + WS_WPG + L * SZ_WPG); J.gain = a->in[6] + L * D; J.K = D; J.Nsrc = D; J.Ndst = D; }
        else             { J.src = a->in[35] + (size_t)L * PLED * D;    J.dst = (bf16_t*)(ws + WS_WPP + L * SZ_WPP); J.K = PLED; J.Nsrc = D; J.Ndst = D; }
    } else switch (j) {
        case 16: J.src = a->in[8];  J.dst = (bf16_t*)(ws + WS_NAQ); J.gain = a->in[4] + 0 * D; J.K = D; J.Nsrc = 6144; J.Ndst = 6144; J.qcols = 2048; break;
        case 17: J.src = a->in[9];  J.dst = (bf16_t*)(ws + WS_NAO); J.K = D; J.Nsrc = D; J.Ndst = D; break;
        case 18: J.src = a->in[11]; J.dst = (bf16_t*)(ws + WS_SGI); J.gain = a->in[4] + 1 * D; J.K = D; J.Nsrc = 4096; J.Ndst = 4096; break;
        case 19: J.src = a->in[15]; J.dst = (bf16_t*)(ws + WS_SGO); J.K = D; J.Nsrc = D; J.Ndst = D; break;
        case 20: J.src = a->in[16]; J.dst = (bf16_t*)(ws + WS_GDI); J.gain = a->in[4] + 2 * D; J.K = D; J.Nsrc = 12416; J.Ndst = GDI_N; J.map = 2; break;
        case 21: J.src = a->in[21]; J.dst = (bf16_t*)(ws + WS_GDO); J.K = 4096; J.Nsrc = D; J.Ndst = D; break;
        default: J.src = a->in[30]; J.dst = (bf16_t*)(ws + WS_S5G); J.K = D; J.Nsrc = 4096; J.Ndst = 4096; J.map = 1; break;
    }
}
__device__ __forceinline__ int map_col(const Job& J, int n0) {
    if (J.map == 0) return n0;
    if (J.map == 1) { const int tile = n0 >> 8, w = n0 & 255, H = J.Nsrc >> 1; return w < 128 ? tile * 128 + w : H + tile * 128 + (w - 128); }
    if (n0 < 8192) return n0;
    if (n0 < 8320) return 12288 + (n0 - 8192);
    if (n0 < GDI_N1) return -1;
    return 8192 + (n0 - GDI_N1);
}
__device__ __forceinline__ void prologue(ArgsCP a, LAS unsigned char* lds) {
    const int tid = tidx(), G = gridDim.x, bid = blockIdx.x;
    LAS float* tile = (LAS float*)lds;
    int base = 0;
    for (int j = 0; j < 23; ++j) {
        Job J; get_job(a, j, J);
        const int kt = J.K >> 6, ntl = J.Ndst >> 6, nt = kt * ntl;
        int first = (bid - (base % G) + G) % G;
        for (int i = first; i < nt; i += G) {
            const int nb = i / kt, kb = i - nb * kt, n0 = nb * 64, k0 = kb * 64, s0 = map_col(J, n0);
            const float cs = (n0 < J.qcols) ? 0.08838834764831845f : 1.0f;
            const int kk = tid >> 4, nn4 = (tid & 15) * 4;
#pragma unroll
            for (int p = 0; p < 2; ++p) {
                const int k = k0 + kk + 32 * p;
                f32x4 v = (f32x4){0.f, 0.f, 0.f, 0.f};
                if (s0 >= 0) v = *(const f32x4*)(J.src + (size_t)k * J.Nsrc + s0 + nn4);
                const float sc = (J.gain ? J.gain[k] : 1.0f) * cs;
#pragma unroll
                for (int q = 0; q < 4; ++q) tile[(nn4 + q) * 65 + kk + 32 * p] = v[q] * sc;
            }
            __syncthreads();
            { const int nn = tid >> 3, kk8 = (tid & 7) * 8; float v[8];
#pragma unroll
              for (int q = 0; q < 8; ++q) v[q] = tile[nn * 65 + kk8 + q];
              *(u32x4*)(J.dst + (size_t)(n0 + nn) * J.K + k0 + kk8) = pack8(v); }
            __syncthreads();
        }
        base += nt;
    }
    { bf16_t* PB = (bf16_t*)(a->ws + WS_PB);
      const long total = (long)4 * T * 64;
      for (long i = (long)bid * NTHR + tid; i < total; i += (long)G * NTHR) {
          const int L = (int)(i / ((long)T * 64)); const int rem = (int)(i - (long)L * T * 64); const int row = rem >> 6, c4 = (rem & 63) * 4;
          const float* src = row < 8192 ? a->in[2] + ((size_t)L * 8192 + row) * PLED + c4 : a->in[3] + ((size_t)L * 32768 + (row - 8192)) * PLED + c4;
          const f32x4 v = *(const f32x4*)src; u32x2 w; w.x = pk2(v[0], v[1]); w.y = pk2(v[2], v[3]);
          *(u32x2*)(PB + ((size_t)L * T + row) * PLED + c4) = w; } }
    { bf16_t* XB = (bf16_t*)(a->ws + WS_XB0); rs_t* rs = (rs_t*)(a->ws + WS_RS);
      const int w = tid >> 6, lane = tid & 63;
      for (int row = bid * 8 + w; row < T; row += G * 8) {
          const float* src = row < 8192 ? a->in[0] + (size_t)row * D : a->in[1] + (size_t)(row - 8192) * D;
          float ss = 0.f;
#pragma unroll
          for (int q = 0; q < 8; ++q) { const int c = (q * 64 + lane) * 4; const f32x4 v = *(const f32x4*)(src + c);
              *(f32x4*)(a->out + (size_t)row * D + c) = v; u32x2 wv; wv.x = pk2(v[0], v[1]); wv.y = pk2(v[2], v[3]); *(u32x2*)(XB + (size_t)row * D + c) = wv;
              ss += v[0] * v[0] + v[1] * v[1] + v[2] * v[2] + v[3] * v[3]; }
          ss = wave_sum(ss); if (lane == 0) rs[row] = rs_fix(ss); } }
}

__device__ __forceinline__ void na_attention(ArgsCP a, LAS unsigned char* lds, const bf16_t* QKV, bf16_t* AO) {
    const int tid = tidx(), w = tid >> 6, lane = tid & 63;
    LAS float* qs = (LAS float*)(lds + w * 1024); LAS float* ps = qs + 128;
    const float* rpb = a->in[10];
    for (long task = (long)blockIdx.x * 8 + w; task < (long)T * 16; task += (long)gridDim.x * 8) {
        const int seq = (int)(task >> 16), rem = (int)(task & 65535), h = rem >> 12, pos = rem & 4095, r = pos >> 6, c = pos & 63;
        const int r0 = min(max(r - 4, 0), 56), c0 = min(max(c - 8, 0), 48);
        const size_t trow = (size_t)seq * SEQ + pos;
        { const unsigned qq = *(const unsigned*)(QKV + trow * 6144 + h * 128 + 2 * lane); qs[2 * lane] = blo(qq); qs[2 * lane + 1] = bhi(qq); }
        __builtin_amdgcn_wave_barrier();
        float s[2];
#pragma unroll
        for (int kk = 0; kk < 2; ++kk) {
            const int j = lane + 64 * kk, kr = r0 + (j >> 4), kc = c0 + (j & 15);
            const u32x4* kp = (const u32x4*)(QKV + ((size_t)seq * SEQ + kr * 64 + kc) * 6144 + 2048 + h * 128);
            float acc = 0.f;
#pragma unroll 4
            for (int d8 = 0; d8 < 16; ++d8) { const u32x4 kv = kp[d8]; const f32x4 q0 = *(const LAS f32x4*)(qs + d8 * 8), q1 = *(const LAS f32x4*)(qs + d8 * 8 + 4);
                acc += q0[0] * blo(kv.x) + q0[1] * bhi(kv.x) + q0[2] * blo(kv.y) + q0[3] * bhi(kv.y) + q1[0] * blo(kv.z) + q1[1] * bhi(kv.z) + q1[2] * blo(kv.w) + q1[3] * bhi(kv.w); }
            s[kk] = acc + rpb[(h * 15 + (kr - r + 7)) * 31 + (kc - c + 15)];
        }
        const float mx = wave_max(fmaxf(s[0], s[1]));
        const float e0 = __expf(s[0] - mx), e1 = __expf(s[1] - mx);
        const float inv = 1.0f / wave_sum(e0 + e1);
        ps[lane] = e0 * inv; ps[lane + 64] = e1 * inv;
        __builtin_amdgcn_wave_barrier();
        float o0 = 0.f, o1 = 0.f;
        const bf16_t* vb = QKV + ((size_t)seq * SEQ) * 6144 + 4096 + h * 128 + 2 * lane;
#pragma unroll 4
        for (int j = 0; j < 128; ++j) { const int kr = r0 + (j >> 4), kc = c0 + (j & 15);
            const unsigned vv = *(const unsigned*)(vb + (size_t)(kr * 64 + kc) * 6144); const float p = ps[j]; o0 += p * blo(vv); o1 += p * bhi(vv); }
        *(unsigned*)(AO + trow * D + h * 128 + 2 * lane) = pk2(o0, o1);
        __builtin_amdgcn_wave_barrier();
    }
}

__device__ __forceinline__ void sgu_mix(ArgsCP a, LAS unsigned char* lds, const bf16_t* UV, const rs_t* rsv, bf16_t* MX) {
    const int tid = tidx(), G = gridDim.x;
    LAS float* WT = (LAS float*)lds;
    LAS float* VS = (LAS float*)(lds + 65536);
    const float* w_s = a->in[13]; const float* b_s = a->in[14]; const float* sgn = a->in[12];
    const int per = (5120 + G - 1) / G, u0 = blockIdx.x * per, u1 = min(5120, u0 + per);
    int gcur = -1;
    for (int u = u0; u < u1; ++u) {
        const int g = u / 320, sc = u - g * 320, seq = sc >> 5, n = sc & 31; const size_t row0 = (size_t)seq * SEQ + n * 128;
        __syncthreads();
        if (g != gcur) { gcur = g;
            for (int idx = tid; idx < 16384; idx += NTHR) { const int t = idx >> 7, s = idx & 127; WT[s * 128 + t] = w_s[(size_t)g * 16384 + idx]; } }
        { const int s = tid >> 2, c32 = (tid & 3) * 32; const float rsd = rstd_of(rsv[row0 + s]);
#pragma unroll
          for (int q = 0; q < 4; ++q) { float v[8]; unpack8(*(const u32x4*)(UV + (row0 + s) * 4096 + 2048 + g * 128 + c32 + q * 8), v);
#pragma unroll
              for (int j = 0; j < 8; ++j) VS[s * 128 + c32 + q * 8 + j] = v[j] * rsd * sgn[g * 128 + c32 + q * 8 + j]; } }
        __syncthreads();
        const int t0 = (tid >> 4) * 4, c0 = (tid & 15) * 8;
        float acc[4][8];
#pragma unroll
        for (int i = 0; i < 4; ++i)
#pragma unroll
            for (int j = 0; j < 8; ++j) acc[i][j] = 0.f;
#pragma unroll 4
        for (int s = 0; s < 128; ++s) {
            const f32x4 av = *(const LAS f32x4*)(WT + s * 128 + t0), v0 = *(const LAS f32x4*)(VS + s * 128 + c0), v1 = *(const LAS f32x4*)(VS + s * 128 + c0 + 4);
#pragma unroll
            for (int i = 0; i < 4; ++i) {
#pragma unroll
                for (int j = 0; j < 4; ++j) { acc[i][j] += av[i] * v0[j]; acc[i][4 + j] += av[i] * v1[j]; } }
        }
#pragma unroll
        for (int i = 0; i < 4; ++i) { const int t = t0 + i; const float bias = b_s[g * 128 + t]; const size_t row = row0 + t;
            float uv[8]; unpack8(*(const u32x4*)(UV + row * 4096 + g * 128 + c0), uv);
#pragma unroll
            for (int j = 0; j < 8; ++j) uv[j] *= (acc[i][j] + bias);
            *(u32x4*)(MX + row * D + g * 128 + c0) = pack8(uv); }
    }
}

__device__ __forceinline__ void ffn_convglu(ArgsCP a, int layer, const bf16_t* GU, bf16_t* HID, int rows) {
    const float* cw = a->in[32] + (size_t)layer * 3 * DFF; const float* cb = a->in[33] + (size_t)layer * DFF;
    const long total = (long)rows * 704;
    for (long i = (long)blockIdx.x * NTHR + tidx(); i < total; i += (long)gridDim.x * NTHR) {
        const int r = (int)(i / 704), cbk = (int)(i - (long)r * 704), ch = cbk * 8, pos = r & (SEQ - 1);
        const bf16_t* gp = GU + (size_t)r * (2 * DFF) + (cbk >> 4) * 256 + (cbk & 15) * 8;
        float g0[8], gm[8], gn[8], up[8];
        unpack8(*(const u32x4*)gp, g0); unpack8(*(const u32x4*)(gp + 128), up);
        if (pos > 0) unpack8(*(const u32x4*)(gp - 2 * DFF), gm); else {
#pragma unroll
            for (int j = 0; j < 8; ++j) gm[j] = 0.f; }
        if (pos < SEQ - 1) unpack8(*(const u32x4*)(gp + 2 * DFF), gn); else {
#pragma unroll
            for (int j = 0; j < 8; ++j) gn[j] = 0.f; }
        float o[8];
#pragma unroll
        for (int j = 0; j < 8; ++j) { const float gv = cw[ch + j] * gm[j] + cw[DFF + ch + j] * g0[j] + cw[2 * DFF + ch + j] * gn[j] + cb[ch + j]; o[j] = siluf_(gv) * up[j]; }
        *(u32x4*)(HID + (size_t)r * DFF + ch) = pack8(o);
    }
}

__device__ __forceinline__ void ffn_fixup(ArgsCP a, int layer, const bf16_t* EDGE, bf16_t* HID) {
    const float* cw = a->in[32] + (size_t)layer * 3 * DFF; const float* cb = a->in[33] + (size_t)layer * DFF;
    const int total = (T / 256) * 8 * 704;
    for (int it = blockIdx.x * NTHR + tidx(); it < total; it += gridDim.x * NTHR) {
        const int cbk = it % 704, rr = (it / 704) & 7, tile = it / (704 * 8), s = rr >> 1, last = rr & 1, ch = cbk * 8;
        const bf16_t* eb = EDGE + (size_t)tile * 16 * 2 * DFF + ch;
        float gc[8], uc[8], gi[8], go[8];
        unpack8(*(const u32x4*)(eb + (size_t)((4 * s + (last ? 3 : 0)) * 2) * DFF), gc);
        unpack8(*(const u32x4*)(eb + (size_t)((4 * s + (last ? 3 : 0)) * 2 + 1) * DFF), uc);
        unpack8(*(const u32x4*)(eb + (size_t)((4 * s + (last ? 2 : 1)) * 2) * DFF), gi);
        const bf16_t* op = nullptr;
        if (last) { if (s < 3) op = eb + (size_t)((4 * (s + 1)) * 2) * DFF; else if ((tile & 15) != 15) op = eb + (size_t)16 * 2 * DFF; }
        else      { if (s > 0) op = eb + (size_t)((4 * (s - 1) + 3) * 2) * DFF; else if ((tile & 15) != 0) op = eb - (size_t)16 * 2 * DFF + (size_t)(15 * 2) * DFF; }
        if (op) unpack8(*(const u32x4*)op, go); else {
#pragma unroll
            for (int j = 0; j < 8; ++j) go[j] = 0.f; }
        float hv[8];
#pragma unroll
        for (int j = 0; j < 8; ++j) { const float dn = last ? gi[j] : go[j], up = last ? go[j] : gi[j];
            hv[j] = siluf_(cw[ch + j] * dn + cw[DFF + ch + j] * gc[j] + cw[2 * DFF + ch + j] * up + cb[ch + j]) * uc[j]; }
        *(u32x4*)(HID + ((size_t)tile * 256 + 64 * s + 63 * last) * DFF + ch) = pack8(hv);
    }
}

__device__ __forceinline__ void gdn_conv(ArgsCP a, const bf16_t* PROJ, const float* AB, bf16_t* QK, bf16_t* VP, float* GB, int rows) {
    const int tid = tidx(), ch0 = tid * 16;
    const float* cw = a->in[17];
    float w0[16], w1[16], w2[16];
#pragma unroll
    for (int j = 0; j < 16; ++j) { w0[j] = cw[ch0 + j]; w1[j] = cw[8192 + ch0 + j]; w2[j] = cw[16384 + ch0 + j]; }
    for (int r = blockIdx.x; r < rows; r += gridDim.x) {
        const int pos = r & (SEQ - 1);
        const bf16_t* p = PROJ + (size_t)r * 8192 + ch0;
        float x0[16], xm[16], xn[16];
        { float t[8]; unpack8(*(const u32x4*)p, t);
#pragma unroll
          for (int j = 0; j < 8; ++j) x0[j] = t[j];
          unpack8(*(const u32x4*)(p + 8), t);
#pragma unroll
          for (int j = 0; j < 8; ++j) x0[8 + j] = t[j]; }
        if (pos > 0) { float t[8]; unpack8(*(const u32x4*)(p - 8192), t);
#pragma unroll
          for (int j = 0; j < 8; ++j) xm[j] = t[j];
          unpack8(*(const u32x4*)(p - 8192 + 8), t);
#pragma unroll
          for (int j = 0; j < 8; ++j) xm[8 + j] = t[j]; } else {
#pragma unroll
          for (int j = 0; j < 16; ++j) xm[j] = 0.f; }
        if (pos < SEQ - 1) { float t[8]; unpack8(*(const u32x4*)(p + 8192), t);
#pragma unroll
          for (int j = 0; j < 8; ++j) xn[j] = t[j];
          unpack8(*(const u32x4*)(p + 8192 + 8), t);
#pragma unroll
          for (int j = 0; j < 8; ++j) xn[8 + j] = t[j]; } else {
#pragma unroll
          for (int j = 0; j < 16; ++j) xn[j] = 0.f; }
        float y[16], ss = 0.f;
#pragma unroll
        for (int j = 0; j < 16; ++j) { y[j] = siluf_(w0[j] * xm[j] + w1[j] * x0[j] + w2[j] * xn[j]); ss += y[j] * y[j]; }
        ss += __shfl_xor(ss, 1); ss += __shfl_xor(ss, 2); ss += __shfl_xor(ss, 4);
        float sc = 1.0f;
        if (ch0 < 4096) { sc = rsqrtf(ss + EPS); if (ch0 < 2048) sc *= 0.08838834764831845f; }
        float o0[8], o1[8];
#pragma unroll
        for (int j = 0; j < 8; ++j) { o0[j] = y[j] * sc; o1[j] = y[8 + j] * sc; }
        bf16_t* dst = ch0 < 4096 ? QK + (size_t)r * 4096 + ch0 : VP + (size_t)r * 4096 + (ch0 - 4096);
        *(u32x4*)dst = pack8(o0); *(u32x4*)(dst + 8) = pack8(o1);
        if (tid < 64) { const int dir = tid >> 5, head = tid & 31;
            const float av = AB[(size_t)r * 128 + dir * 64 + head], bv = AB[(size_t)r * 128 + dir * 64 + 32 + head];
            const float xx = av + a->in[19][dir * 32 + head];
            const float sp = xx > 20.f ? xx : log1pf(expf(xx));
            GB[(size_t)r * 128 + dir * 64 + head] = -expf(a->in[18][dir * 32 + head]) * sp;
            GB[(size_t)r * 128 + dir * 64 + 32 + head] = 1.0f / (1.0f + expf(-bv)); }
    }
}
__device__ __forceinline__ void gdn_scan_naive(LAS unsigned char* lds, const bf16_t* QK, const bf16_t* VP, const float* GB, bf16_t* OF, bf16_t* OB, int nseq) {
    const int tid = tidx(), vh = tid >> 8, j = (tid & 255) >> 1, half = tid & 1;
    LAS float* KQ = (LAS float*)lds;
    LAS float* VS = (LAS float*)(lds + 16384);
    LAS float* GS = (LAS float*)(lds + 32768);
    const int nunits = nseq * 32;
    for (int unit = blockIdx.x; unit < nunits; unit += gridDim.x) {
        const int seq = unit >> 5, hq = (unit >> 1) & 15, dir = unit & 1, head = 2 * hq + vh;
        bf16_t* OD = dir ? OB : OF;
        float S[64];
#pragma unroll
        for (int i = 0; i < 64; ++i) S[i] = 0.f;
        for (int blk = 0; blk < SEQ / 16; ++blk) {
            __syncthreads();
            { const int tok = tid >> 5, part = tid & 31, step = blk * 16 + tok, pos = dir ? SEQ - 1 - step : step; const size_t row = (size_t)seq * SEQ + pos;
              const bf16_t* src = part < 16 ? QK + row * 4096 + hq * 128 + part * 8 : QK + row * 4096 + 2048 + hq * 128 + (part - 16) * 8;
              float v[8]; unpack8(*(const u32x4*)src, v);
              *(LAS f32x4*)(KQ + tok * 256 + part * 8) = (f32x4){v[0], v[1], v[2], v[3]}; *(LAS f32x4*)(KQ + tok * 256 + part * 8 + 4) = (f32x4){v[4], v[5], v[6], v[7]};
              unpack8(*(const u32x4*)(VP + row * 4096 + hq * 256 + part * 8), v);
              *(LAS f32x4*)(VS + tok * 256 + part * 8) = (f32x4){v[0], v[1], v[2], v[3]}; *(LAS f32x4*)(VS + tok * 256 + part * 8 + 4) = (f32x4){v[4], v[5], v[6], v[7]};
              if (tid < 64) { const int tk = tid >> 2, which = tid & 3, hh = 2 * hq + (which & 1), isb = which >> 1, st = blk * 16 + tk, ps = dir ? SEQ - 1 - st : st;
                  const float gv = GB[((size_t)seq * SEQ + ps) * 128 + dir * 64 + isb * 32 + hh]; GS[tk * 4 + which] = isb ? gv : expf(gv); } }
            __syncthreads();
            for (int s = 0; s < 16; ++s) {
                const float av = GS[s * 4 + vh], bv = GS[s * 4 + 2 + vh], vt = VS[s * 256 + vh * 128 + j];
                const LAS float* kp = KQ + s * 256 + 128 + half * 64; const LAS float* qp = KQ + s * 256 + half * 64;
                float ks = 0.f;
#pragma unroll
                for (int i = 0; i < 64; i += 4) { const f32x4 k4 = *(const LAS f32x4*)(kp + i); ks += k4[0] * S[i] + k4[1] * S[i + 1] + k4[2] * S[i + 2] + k4[3] * S[i + 3]; }
                ks += __shfl_xor(ks, 1);
                const float uu = bv * (vt - av * ks);
                float os = 0.f;
#pragma unroll
                for (int i = 0; i < 64; i += 4) { const f32x4 k4 = *(const LAS f32x4*)(kp + i), q4 = *(const LAS f32x4*)(qp + i);
#pragma unroll
                    for (int e = 0; e < 4; ++e) { S[i + e] = av * S[i + e] + k4[e] * uu; os += q4[e] * S[i + e]; } }
                os += __shfl_xor(os, 1);
                if (half == 0) { const int step = blk * 16 + s, pos = dir ? SEQ - 1 - step : step; OD[((size_t)seq * SEQ + pos) * 4096 + head * 128 + j] = f2bf(os); }
            }
        }
    }
}
__device__ __forceinline__ void gdn_sumnorm(ArgsCP a, bf16_t* OF, const bf16_t* OB, int rows) {
    const int tid = tidx(), rsub = tid >> 8, c0 = (tid & 255) * 16;
    const float* on = a->in[20];
    for (int r = blockIdx.x * 2 + rsub; r < rows; r += gridDim.x * 2) {
        float x[16], t[8];
        unpack8(*(const u32x4*)(OF + (size_t)r * 4096 + c0), t);
#pragma unroll
        for (int q = 0; q < 8; ++q) x[q] = t[q];
        unpack8(*(const u32x4*)(OF + (size_t)r * 4096 + c0 + 8), t);
#pragma unroll
        for (int q = 0; q < 8; ++q) x[8 + q] = t[q];
        unpack8(*(const u32x4*)(OB + (size_t)r * 4096 + c0), t);
#pragma unroll
        for (int q = 0; q < 8; ++q) x[q] += t[q];
        unpack8(*(const u32x4*)(OB + (size_t)r * 4096 + c0 + 8), t);
#pragma unroll
        for (int q = 0; q < 8; ++q) x[8 + q] += t[q];
        float ss = 0.f;
#pragma unroll
        for (int q = 0; q < 16; ++q) ss += x[q] * x[q];
        ss += __shfl_xor(ss, 1); ss += __shfl_xor(ss, 2); ss += __shfl_xor(ss, 4);
        const float sc = rsqrtf(ss * (1.0f / 128.0f) + EPS);
        float o0[8], o1[8];
#pragma unroll
        for (int q = 0; q < 8; ++q) { o0[q] = x[q] * sc * on[(c0 & 127) + q]; o1[q] = x[8 + q] * sc * on[(c0 & 127) + 8 + q]; }
        *(u32x4*)(OF + (size_t)r * 4096 + c0) = pack8(o0); *(u32x4*)(OF + (size_t)r * 4096 + c0 + 8) = pack8(o1);
    }
}

__device__ __forceinline__ void s5_scan(ArgsCP a, LAS unsigned char* lds, const float* X, const rs_t* rs, float* YF, bf16_t* Y) {
    const int tid = tidx(), w = tid >> 6, lane = tid & 63;
    LAS float* U = (LAS float*)(lds + w * 9216);
    LAS float* XS = U + 256;
    const float* gmix = a->in[4] + 3 * D;
    for (int task = blockIdx.x * 8 + w; task < NSEQ * 128; task += gridDim.x * 8) {
        const int seq = task >> 7, gr = task & 127;
        for (int dir = 0; dir < 2; ++dir) {
            const int dg = dir * 128 + gr;
            const float are = a->in[22][dg * 64 + lane], aim = a->in[23][dg * 64 + lane], dt = expf(a->in[24][dg]);
            const float er = expf(are * dt); float sn, cs; sincosf(aim * dt, &sn, &cs);
            const float abr = er * cs, abi = er * sn;
            const float den = 1.0f / (are * are + aim * aim);
            const float cr = ((abr - 1.0f) * are + abi * aim) * den, ci = (abi * are - (abr - 1.0f) * aim) * den;
            float Br[16], Bi[16];
#pragma unroll
            for (int c = 0; c < 16; ++c) { const float bre = a->in[25][((size_t)dg * 64 + lane) * 16 + c], bim = a->in[26][((size_t)dg * 64 + lane) * 16 + c]; Br[c] = cr * bre - ci * bim; Bi[c] = cr * bim + ci * bre; }
            const int oc = lane & 15, tb = lane >> 4;
            float Cr[64], Ci[64];
#pragma unroll
            for (int p = 0; p < 64; ++p) { Cr[p] = a->in[27][((size_t)dg * 16 + oc) * 64 + p]; Ci[p] = a->in[28][((size_t)dg * 16 + oc) * 64 + p]; }
            const float dsk = a->in[29][gr * 16 + oc];
            float xr = 0.f, xi = 0.f;
            for (int blk = 0; blk < SEQ / 16; ++blk) {
                { const int tt = lane >> 2, c4 = (lane & 3) * 4, step = blk * 16 + tt, pos = dir ? SEQ - 1 - step : step; const size_t row = (size_t)seq * SEQ + pos;
                  const f32x4 xv = *(const f32x4*)(X + row * D + gr * 16 + c4); const f32x4 gm = *(const f32x4*)(gmix + gr * 16 + c4); const float rsd = rstd_of(rs[row]);
                  *(LAS f32x4*)(U + tt * 16 + c4) = xv * gm * rsd; }
                __builtin_amdgcn_wave_barrier();
                for (int tt = 0; tt < 16; ++tt) {
                    float bur = 0.f, bui = 0.f;
#pragma unroll
                    for (int c = 0; c < 16; c += 4) { const f32x4 u4 = *(const LAS f32x4*)(U + tt * 16 + c);
#pragma unroll
                        for (int e = 0; e < 4; ++e) { bur += Br[c + e] * u4[e]; bui += Bi[c + e] * u4[e]; } }
                    const float nr = abr * xr - abi * xi + bur, ni = abr * xi + abi * xr + bui; xr = nr; xi = ni;
                    XS[(tt * 64 + lane) * 2] = xr; XS[(tt * 64 + lane) * 2 + 1] = xi;
                }
                __builtin_amdgcn_wave_barrier();
                for (int i = 0; i < 4; ++i) {
                    const int t = tb * 4 + i; float y = 0.f;
#pragma unroll
                    for (int p = 0; p < 64; p += 2) { const f32x4 x2 = *(const LAS f32x4*)(XS + (t * 64 + p) * 2); y += Cr[p] * x2[0] - Ci[p] * x2[1] + Cr[p + 1] * x2[2] - Ci[p + 1] * x2[3]; }
                    const int step = blk * 16 + t, pos = dir ? SEQ - 1 - step : step; const size_t row = (size_t)seq * SEQ + pos;
                    if (dir == 0) YF[row * D + gr * 16 + oc] = y;
                    else { const float yt = y + YF[row * D + gr * 16 + oc] + dsk * U[t * 16 + oc]; Y[row * D + gr * 16 + oc] = f2bf(geluf_(yt)); }
                }
                __builtin_amdgcn_wave_barrier();
            }
        }
    }
}

__device__ __forceinline__ void final_norm(ArgsCP a, const rs_t* rs) {
    const int tid = tidx(), w = tid >> 6, lane = tid & 63; const float* g = a->in[7];
    for (int row = blockIdx.x * 8 + w; row < T; row += gridDim.x * 8) {
        const float s = rstd_of(rs[row]);
#pragma unroll
        for (int q = 0; q < 8; ++q) { const int c = (q * 64 + lane) * 4; f32x4 v = *(const f32x4*)(a->out + (size_t)row * D + c); const f32x4 gv = *(const f32x4*)(g + c); v = v * gv * s; *(f32x4*)(a->out + (size_t)row * D + c) = v; }
    }
}


namespace gdn {
typedef short s16x8 __attribute__((ext_vector_type(8)));
typedef short s16x4 __attribute__((ext_vector_type(4)));
constexpr int QS = 0, QPITCH = 272;
constexpr int KS = QS + 64 * QPITCH;
constexpr int VS = KS + 64 * QPITCH;
constexpr int WS_ = VS + 64 * QPITCH;
constexpr int KT = WS_ + 64 * QPITCH, KTPITCH = 144;
constexpr int MB = KT + 128 * KTPITCH, MPITCH = 144;
constexpr int A2 = MB + 64 * MPITCH;
constexpr int MD = A2 + 64 * MPITCH;
constexpr int DV = MD + 4 * 16 * 17 * 4, DVPITCH = 40;
constexpr int TB = DV + 4 * 16 * DVPITCH;
constexpr int LDS_END = TB + 5 * 256;
static_assert(LDS_END <= LDS_STAGE, "gdn lds");

__device__ __forceinline__ s16x8 mk8(unsigned a, unsigned b, unsigned c, unsigned d) { u32x4 v; v.x = a; v.y = b; v.z = c; v.w = d; return __builtin_bit_cast(s16x8, v); }
__device__ __forceinline__ s16x8 cat8(u32x2 lo, u32x2 hi) { return mk8(lo.x, lo.y, hi.x, hi.y); }
__device__ __forceinline__ s16x4 mk4(unsigned a, unsigned b) { u32x2 v; v.x = a; v.y = b; return __builtin_bit_cast(s16x4, v); }

__device__ __forceinline__ void scan(LAS unsigned char* lds, const bf16_t* QK, const bf16_t* VP, const float* GB, bf16_t* OF, bf16_t* OB, int nseq) {
    const int tid = tidx(), w = __builtin_amdgcn_readfirstlane(tid >> 6), lane = tid & 63;
#define GDN_FRESH() int ln_ = lane; asm volatile("" : "+v"(ln_)); const int g = ln_ >> 4, n = ln_ & 15;
    LAS float* gam = (LAS float*)(lds + TB); LAS float* eg = gam + 64; LAS float* bg = gam + 128; LAS float* bt = gam + 192; LAS float* dl = gam + 256;
    const int nunits = nseq * 64;
    for (int unit = blockIdx.x; unit < nunits; unit += gridDim.x) {
        const int seq = unit >> 6, h = (unit >> 1) & 31, dir = unit & 1, hq = h >> 1;
        bf16_t* OD = dir ? OB : OF;
        f32x4 S[8];
#pragma unroll
        for (int i = 0; i < 8; ++i) S[i] = (f32x4){0.f, 0.f, 0.f, 0.f};
        u32x4 pq[2], pk[2], pv[2]; float pg = 0.f, pb = 0.f;
#define GDN_LOADG(c) do { _Pragma("unroll") for (int i_ = 0; i_ < 2; ++i_) { const int p_ = tid + 512 * i_, ir_ = p_ >> 4, c16_ = (p_ & 15) * 8; \
            const int st_ = (c) * 64 + ir_, pos_ = dir ? SEQ - 1 - st_ : st_; const size_t row_ = (size_t)seq * SEQ + pos_; \
            pq[i_] = *(const u32x4*)(QK + row_ * 4096 + hq * 128 + c16_); pk[i_] = *(const u32x4*)(QK + row_ * 4096 + 2048 + hq * 128 + c16_); pv[i_] = *(const u32x4*)(VP + row_ * 4096 + h * 128 + c16_); } \
            if (tid < 64) { const int st_ = (c) * 64 + tid, pos_ = dir ? SEQ - 1 - st_ : st_; const size_t row_ = (size_t)seq * SEQ + pos_; pg = GB[row_ * 128 + dir * 64 + h]; pb = GB[row_ * 128 + dir * 64 + 32 + h]; } } while (0)
#define GDN_STORE() do { _Pragma("unroll") for (int i_ = 0; i_ < 2; ++i_) { const int p_ = tid + 512 * i_, ir_ = p_ >> 4, c16_ = (p_ & 15) * 8; \
            *(LAS u32x4*)(lds + QS + ir_ * QPITCH + c16_ * 2) = pq[i_]; *(LAS u32x4*)(lds + KS + ir_ * QPITCH + c16_ * 2) = pk[i_]; *(LAS u32x4*)(lds + VS + ir_ * QPITCH + c16_ * 2) = pv[i_]; \
            const unsigned kw_[4] = {pk[i_].x, pk[i_].y, pk[i_].z, pk[i_].w}; \
            _Pragma("unroll") for (int e_ = 0; e_ < 4; ++e_) { *(LAS bf16_t*)(lds + KT + (c16_ + 2 * e_) * KTPITCH + ir_ * 2) = (bf16_t)(kw_[e_] & 0xffffu); *(LAS bf16_t*)(lds + KT + (c16_ + 2 * e_ + 1) * KTPITCH + ir_ * 2) = (bf16_t)(kw_[e_] >> 16); } } \
            if (tid < 64) { float gs_ = pg; _Pragma("unroll") for (int o_ = 1; o_ < 64; o_ <<= 1) { const float t_ = __shfl_up(gs_, o_); if (lane >= o_) gs_ += t_; } \
                const float gl_ = __shfl(gs_, 63), e_ = __expf(gs_); gam[tid] = gs_; eg[tid] = e_; bg[tid] = pb * e_; bt[tid] = pb; dl[tid] = __expf(gl_ - gs_); } } while (0)
        GDN_LOADG(0);
        __syncthreads();
        GDN_STORE();
        __syncthreads();
        for (int c = 0; c < 64; ++c) {
            { GDN_FRESH() const int rb = w & 3, cbp = w >> 2;
#pragma unroll
              for (int cc = 0; cc < 2; ++cc) { const int cb = cbp * 2 + cc;
                  f32x4 a1 = (f32x4){0.f, 0.f, 0.f, 0.f}, a2 = a1;
#pragma unroll
                  for (int ks = 0; ks < 4; ++ks) {
                      const s16x8 ak = *(const LAS s16x8*)(lds + KS + (16 * rb + n) * QPITCH + (32 * ks + 8 * g) * 2);
                      const s16x8 aq = *(const LAS s16x8*)(lds + QS + (16 * rb + n) * QPITCH + (32 * ks + 8 * g) * 2);
                      const s16x8 bk = *(const LAS s16x8*)(lds + KS + (16 * cb + n) * QPITCH + (32 * ks + 8 * g) * 2);
                      a1 = __builtin_amdgcn_mfma_f32_16x16x32_bf16(ak, bk, a1, 0, 0, 0);
                      a2 = __builtin_amdgcn_mfma_f32_16x16x32_bf16(aq, bk, a2, 0, 0, 0); }
                  const int j = 16 * cb + n; const float gj = gam[j];
#pragma unroll
                  for (int e = 0; e < 4; ++e) { const int i = 16 * rb + 4 * g + e; const float d = __expf(fminf(gam[i] - gj, 0.f));
                      const float mm = (j < i) ? a1[e] * d * bt[i] : 0.f, am = (j <= i) ? a2[e] * d : 0.f;
                      *(LAS bf16_t*)(lds + MB + i * MPITCH + j * 2) = f2bf(mm); *(LAS bf16_t*)(lds + A2 + i * MPITCH + j * 2) = f2bf(am);
                      if (cb == rb) *(LAS float*)(lds + MD + ((rb * 16 + 4 * g + e) * 17 + n) * 4) = mm; } } }
            __syncthreads();
            if (w < 4) { GDN_FRESH() const LAS float* N = (const LAS float*)(lds + MD + w * 16 * 17 * 4); float y[16];
#pragma unroll
                for (int j = 15; j >= 0; --j) { float s = (j == n) ? 1.f : 0.f;
#pragma unroll
                    for (int i = j + 1; i < 16; ++i) s -= y[i] * N[i * 17 + j];
                    y[j] = s; }
                float y4[4];
#pragma unroll
                for (int e = 0; e < 4; ++e) { float v = y[0];
#pragma unroll
                    for (int q = 1; q < 16; ++q) v = (4 * g + e == q) ? y[q] : v;
                    y4[e] = v; }
                u32x2 dv; dv.x = pk2(y4[0], y4[1]); dv.y = pk2(y4[2], y4[3]);
                *(LAS u32x2*)(lds + DV + (w * 16 + n) * DVPITCH + 4 * g * 2) = dv; }
            __syncthreads();
            f32x4 xw[4], u[4];
            { GDN_FRESH()
#pragma unroll
            for (int b = 0; b < 4; ++b) {
                f32x4 aw, au;
#pragma unroll
                for (int e = 0; e < 4; ++e) { const int i = 16 * b + 4 * g + e;
                    aw[e] = bf2f(*(const LAS bf16_t*)(lds + KS + i * QPITCH + (16 * w + n) * 2)) * bg[i];
                    au[e] = bf2f(*(const LAS bf16_t*)(lds + VS + i * QPITCH + (16 * w + n) * 2)) * bt[i]; }
#pragma unroll
                for (int j = 0; j < 4; ++j) if (j < b) {
                    const s16x4 am = *(const LAS s16x4*)(lds + MB + (16 * b + n) * MPITCH + (16 * j + 4 * g) * 2);
                    const s16x4 bw = mk4(pk2(xw[j][0], xw[j][1]) ^ 0x80008000u, pk2(xw[j][2], xw[j][3]) ^ 0x80008000u);
                    const s16x4 bu = mk4(pk2(u[j][0], u[j][1]) ^ 0x80008000u, pk2(u[j][2], u[j][3]) ^ 0x80008000u);
                    aw = __builtin_amdgcn_mfma_f32_16x16x16bf16_1k(am, bw, aw, 0, 0, 0);
                    au = __builtin_amdgcn_mfma_f32_16x16x16bf16_1k(am, bu, au, 0, 0, 0); }
                const s16x4 ad = *(const LAS s16x4*)(lds + DV + (b * 16 + n) * DVPITCH + 4 * g * 2);
                xw[b] = __builtin_amdgcn_mfma_f32_16x16x16bf16_1k(ad, mk4(pk2(aw[0], aw[1]), pk2(aw[2], aw[3])), (f32x4){0.f, 0.f, 0.f, 0.f}, 0, 0, 0);
                u[b]  = __builtin_amdgcn_mfma_f32_16x16x16bf16_1k(ad, mk4(pk2(au[0], au[1]), pk2(au[2], au[3])), (f32x4){0.f, 0.f, 0.f, 0.f}, 0, 0, 0);
#pragma unroll
                for (int e = 0; e < 4; ++e) *(LAS bf16_t*)(lds + WS_ + (16 * b + 4 * g + e) * QPITCH + (16 * w + n) * 2) = f2bf(xw[b][e]);
                __builtin_amdgcn_sched_barrier(0);
            } }
            __syncthreads();
            if (c + 1 < 64) GDN_LOADG(c + 1);
            s16x8 Sb[4];
#pragma unroll
            for (int ks = 0; ks < 4; ++ks) Sb[ks] = mk8(pk2(S[2 * ks][0], S[2 * ks][1]), pk2(S[2 * ks][2], S[2 * ks][3]), pk2(S[2 * ks + 1][0], S[2 * ks + 1][1]), pk2(S[2 * ks + 1][2], S[2 * ks + 1][3]));
            { GDN_FRESH()
#pragma unroll
            for (int rb = 0; rb < 4; ++rb) {
#pragma unroll
                for (int ks = 0; ks < 4; ++ks) {
                    const LAS unsigned char* wp = lds + WS_ + (16 * rb + n) * QPITCH + (32 * ks + 4 * g) * 2;
                    const s16x8 aw = cat8(*(const LAS u32x2*)wp, *(const LAS u32x2*)(wp + 32));
                    const u32x4 sv = __builtin_bit_cast(u32x4, Sb[ks]);
                    const s16x8 sneg = mk8(sv.x ^ 0x80008000u, sv.y ^ 0x80008000u, sv.z ^ 0x80008000u, sv.w ^ 0x80008000u);
                    u[rb] = __builtin_amdgcn_mfma_f32_16x16x32_bf16(aw, sneg, u[rb], 0, 0, 0); }
                __builtin_amdgcn_sched_barrier(0); } }
            s16x8 Ub[2], Ud[2];
            { GDN_FRESH()
#pragma unroll
            for (int ks = 0; ks < 2; ++ks) {
                Ub[ks] = mk8(pk2(u[2 * ks][0], u[2 * ks][1]), pk2(u[2 * ks][2], u[2 * ks][3]), pk2(u[2 * ks + 1][0], u[2 * ks + 1][1]), pk2(u[2 * ks + 1][2], u[2 * ks + 1][3]));
                const f32x4 d0 = *(const LAS f32x4*)(dl + 32 * ks + 4 * g), d1 = *(const LAS f32x4*)(dl + 32 * ks + 16 + 4 * g);
                Ud[ks] = mk8(pk2(u[2 * ks][0] * d0[0], u[2 * ks][1] * d0[1]), pk2(u[2 * ks][2] * d0[2], u[2 * ks][3] * d0[3]),
                             pk2(u[2 * ks + 1][0] * d1[0], u[2 * ks + 1][1] * d1[1]), pk2(u[2 * ks + 1][2] * d1[2], u[2 * ks + 1][3] * d1[3])); } }
            { GDN_FRESH()
#pragma unroll
            for (int rb = 0; rb < 4; ++rb) { f32x4 oa = (f32x4){0.f, 0.f, 0.f, 0.f}, o2 = oa;
#pragma unroll
                for (int ks = 0; ks < 4; ++ks) { const LAS unsigned char* qp = lds + QS + (16 * rb + n) * QPITCH + (32 * ks + 4 * g) * 2;
                    o2 = __builtin_amdgcn_mfma_f32_16x16x32_bf16(cat8(*(const LAS u32x2*)qp, *(const LAS u32x2*)(qp + 32)), Sb[ks], o2, 0, 0, 0); }
#pragma unroll
                for (int ks = 0; ks < 2; ++ks) { const LAS unsigned char* ap = lds + A2 + (16 * rb + n) * MPITCH + (32 * ks + 4 * g) * 2;
                    oa = __builtin_amdgcn_mfma_f32_16x16x32_bf16(cat8(*(const LAS u32x2*)ap, *(const LAS u32x2*)(ap + 32)), Ub[ks], oa, 0, 0, 0); }
#pragma unroll
                for (int e = 0; e < 4; ++e) { const int i = 16 * rb + 4 * g + e, st = c * 64 + i, pos = dir ? SEQ - 1 - st : st;
                    OD[((size_t)seq * SEQ + pos) * 4096 + h * 128 + 16 * w + n] = f2bf(eg[i] * o2[e] + oa[e]); }
                __builtin_amdgcn_sched_barrier(0); } }
            { GDN_FRESH() const float egl = eg[63];
#pragma unroll
              for (int sb = 0; sb < 8; ++sb) { f32x4 acc = S[sb] * egl;
#pragma unroll
                  for (int ks = 0; ks < 2; ++ks) { const LAS unsigned char* kp = lds + KT + (16 * sb + n) * KTPITCH + (32 * ks + 4 * g) * 2;
                      acc = __builtin_amdgcn_mfma_f32_16x16x32_bf16(cat8(*(const LAS u32x2*)kp, *(const LAS u32x2*)(kp + 32)), Ud[ks], acc, 0, 0, 0); }
                  S[sb] = acc; __builtin_amdgcn_sched_barrier(0); } }
            __syncthreads();
            if (c + 1 < 64) GDN_STORE();
            __syncthreads();
        }
#undef GDN_LOADG
#undef GDN_STORE
#undef GDN_FRESH
    }
}
}

namespace na {
typedef short s16x8 __attribute__((ext_vector_type(8)));
constexpr int VPITCH = 288;
constexpr int VRING = 0, RPB = 512 * VPITCH;
constexpr int LDS_END = RPB + 15 * 31 * 4 + 4;
__device__ __forceinline__ s16x8 mk8(unsigned a, unsigned b, unsigned c, unsigned d) { u32x4 v; v.x = a; v.y = b; v.z = c; v.w = d; return __builtin_bit_cast(s16x8, v); }

__device__ __forceinline__ void attention(ArgsCP a, LAS unsigned char* lds, const bf16_t* QKV, bf16_t* AO) {
    const int tid = tidx(), w = __builtin_amdgcn_readfirstlane(tid >> 6), lane = tid & 63, g = lane >> 4, n = lane & 15;
    const int j = w & 3, hh = w >> 2;
    const int c0 = min(max(16 * j - 8, 0), 32), qcol = 16 * j + n, cs = min(max(qcol - 8, 0), 48);
    LAS float* rpbs = (LAS float*)(lds + RPB);
    const int nitems = NSEQ * 16 * 64, G = gridDim.x;
    const int per = (nitems + G - 1) / G, it0 = blockIdx.x * per, it1 = min(nitems, it0 + per);
    int cur_sh = -1, have_lo = 0, have_hi = 0;
    const unsigned vbase = (unsigned)(size_t)(lds + VRING);
    for (int it = it0; it < it1; ++it) {
        const int sh = it >> 6, r = it & 63, seq = sh >> 4, h = sh & 15, r0 = min(max(r - 4, 0), 56);
        const size_t tbase = (size_t)seq * SEQ;
        __syncthreads();
        if (sh != cur_sh) { cur_sh = sh; have_lo = have_hi = 0; for (int i = tid; i < 15 * 31; i += NTHR) rpbs[i] = a->in[10][h * 465 + i]; }
        { int lo = r0, hi = r0 + 8; if (have_hi > lo && have_lo <= lo) lo = have_hi;
          for (int kr = lo; kr < hi; ++kr) {
#pragma unroll
              for (int i = 0; i < 2; ++i) { const int p = tid + 512 * i, col = p >> 4, c16 = (p & 15) * 8;
                  const u32x4 v = *(const u32x4*)(QKV + (tbase + kr * 64 + col) * 6144 + 4096 + h * 128 + c16);
                  *(LAS u32x4*)(lds + VRING + ((kr & 7) * 64 + col) * VPITCH + c16 * 2) = v; } }
          have_lo = r0; have_hi = r0 + 8; }
        s16x8 qf[4];
        { const bf16_t* qp = QKV + (tbase + r * 64 + qcol) * 6144 + h * 128 + 8 * g;
#pragma unroll
          for (int ks = 0; ks < 4; ++ks) qf[ks] = *(const s16x8*)(qp + 32 * ks); }
        f32x4 sacc[16];
        const bf16_t* kp0 = QKV + (tbase + r0 * 64 + c0 + n) * 6144 + 2048 + h * 128 + 8 * g;
#pragma unroll
        for (int kb = 0; kb < 16; ++kb) {
            const bf16_t* kp = kp0 + (size_t)((kb >> 1) * 64 + (kb & 1) * 16) * 6144;
            s16x8 kf[4];
#pragma unroll
            for (int ks = 0; ks < 4; ++ks) kf[ks] = *(const s16x8*)(kp + 32 * ks);
            f32x4 acc = (f32x4){0.f, 0.f, 0.f, 0.f};
#pragma unroll
            for (int ks = 0; ks < 4; ++ks) acc = __builtin_amdgcn_mfma_f32_16x16x32_bf16(kf[ks], qf[ks], acc, 0, 0, 0);
            sacc[kb] = acc;
        }
        __syncthreads();
        float mx = -1e30f;
#pragma unroll
        for (int kb = 0; kb < 16; ++kb) { const int aw = kb >> 1, dr = r0 + aw - r + 7;
#pragma unroll
            for (int e = 0; e < 4; ++e) { const int kc = c0 + 16 * (kb & 1) + 4 * g + e; const bool valid = (kc >= cs) && (kc < cs + 16);
                const int dc = min(max(kc - qcol + 15, 0), 30);
                const float s = valid ? sacc[kb][e] + rpbs[dr * 31 + dc] : -1e30f; sacc[kb][e] = s; mx = fmaxf(mx, s); } }
        mx = fmaxf(mx, __shfl_xor(mx, 16)); mx = fmaxf(mx, __shfl_xor(mx, 32));
        float sum = 0.f;
#pragma unroll
        for (int kb = 0; kb < 16; ++kb)
#pragma unroll
            for (int e = 0; e < 4; ++e) { const float p = __expf(sacc[kb][e] - mx); sacc[kb][e] = p; sum += p; }
        sum += __shfl_xor(sum, 16); sum += __shfl_xor(sum, 32);
        const float inv = 1.0f / sum;
        s16x8 pb[8];
#pragma unroll
        for (int kp = 0; kp < 8; ++kp) pb[kp] = mk8(pk2(sacc[2 * kp][0], sacc[2 * kp][1]), pk2(sacc[2 * kp][2], sacc[2 * kp][3]), pk2(sacc[2 * kp + 1][0], sacc[2 * kp + 1][1]), pk2(sacc[2 * kp + 1][2], sacc[2 * kp + 1][3]));
#pragma unroll
        for (int ci = 0; ci < 4; ++ci) { const int c = 4 * hh + ci;
            u32x2 vt[16];
            { const unsigned lanepart = (unsigned)((4 * g + (n >> 2)) * VPITCH + (16 * c + 4 * (n & 3)) * 2);
              unsigned ad[8];
#pragma unroll
              for (int kp = 0; kp < 8; ++kp) ad[kp] = vbase + (unsigned)((((r0 + kp) & 7) * 64 + c0) * VPITCH) + lanepart;
              asm volatile("ds_read_b64_tr_b16 %0, %16\n\tds_read_b64_tr_b16 %1, %16 offset:4608\n\tds_read_b64_tr_b16 %2, %17\n\tds_read_b64_tr_b16 %3, %17 offset:4608\n\t"
                           "ds_read_b64_tr_b16 %4, %18\n\tds_read_b64_tr_b16 %5, %18 offset:4608\n\tds_read_b64_tr_b16 %6, %19\n\tds_read_b64_tr_b16 %7, %19 offset:4608\n\t"
                           "ds_read_b64_tr_b16 %8, %20\n\tds_read_b64_tr_b16 %9, %20 offset:4608\n\tds_read_b64_tr_b16 %10, %21\n\tds_read_b64_tr_b16 %11, %21 offset:4608\n\t"
                           "ds_read_b64_tr_b16 %12, %22\n\tds_read_b64_tr_b16 %13, %22 offset:4608\n\tds_read_b64_tr_b16 %14, %23\n\tds_read_b64_tr_b16 %15, %23 offset:4608\n\t"
                           "s_waitcnt lgkmcnt(0)"
                           : "=&v"(vt[0]), "=&v"(vt[1]), "=&v"(vt[2]), "=&v"(vt[3]), "=&v"(vt[4]), "=&v"(vt[5]), "=&v"(vt[6]), "=&v"(vt[7]),
                             "=&v"(vt[8]), "=&v"(vt[9]), "=&v"(vt[10]), "=&v"(vt[11]), "=&v"(vt[12]), "=&v"(vt[13]), "=&v"(vt[14]), "=&v"(vt[15])
                           : "v"(ad[0]), "v"(ad[1]), "v"(ad[2]), "v"(ad[3]), "v"(ad[4]), "v"(ad[5]), "v"(ad[6]), "v"(ad[7]) : "memory"); }
            f32x4 oacc = (f32x4){0.f, 0.f, 0.f, 0.f};
#pragma unroll
            for (int kp = 0; kp < 8; ++kp) oacc = __builtin_amdgcn_mfma_f32_16x16x32_bf16(mk8(vt[2 * kp].x, vt[2 * kp].y, vt[2 * kp + 1].x, vt[2 * kp + 1].y), pb[kp], oacc, 0, 0, 0);
            u32x2 ov; ov.x = pk2(oacc[0] * inv, oacc[1] * inv); ov.y = pk2(oacc[2] * inv, oacc[3] * inv);
            *(u32x2*)(AO + (tbase + r * 64 + qcol) * D + h * 128 + 16 * c + 4 * g) = ov;
        }
    }
}
}
#ifndef MK_SINGLE
#define MK_SINGLE 1
#endif
constexpr int NPH = 38;

__global__ void __launch_bounds__(NTHR, 2) mk_fwd(Args a_unused) {
    extern __shared__ __attribute__((aligned(16))) unsigned char lds_raw[];
    LAS unsigned char* lds = (LAS unsigned char*)lds_raw;
    int ph_lo, ph_hi;
    XcdBarrier bar;
    { ArgsCP a0 = argp(); ph_lo = a0->ph_lo; ph_hi = a0->ph_hi;
      bar.bar = (unsigned*)(a0->ws + WS_CTL); bar.x = 0; bar.st = (volatile LAS unsigned*)(lds + LDS_BAR);
      if (ph_hi - ph_lo > 1) {
          if (threadIdx.x < 4) ((LAS unsigned*)(lds + LDS_BAR))[threadIdx.x] = 0u;
          __syncthreads();
          bar = xcd_barrier_post((unsigned*)(a0->ws + WS_CTL), (volatile LAS unsigned*)(lds + LDS_BAR));
      } }
    int ph = 0;
#define PH_BEGIN if (ph >= ph_lo && ph < ph_hi) { ArgsCP a = argp(); unsigned char* ws = a->ws; float* X = a->out; rs_t* RS = (rs_t*)(ws + WS_RS); \
        bf16_t* XB0 = (bf16_t*)(ws + WS_XB0); bf16_t* XB1 = (bf16_t*)(ws + WS_XB1); unsigned char* BIG = ws + WS_BIG; (void)X; (void)RS; (void)XB0; (void)XB1; (void)BIG;
#define PH_END   } if (ph >= ph_lo && ph + 1 < ph_hi) xcd_barrier(bar); ++ph;
#define RSB(k) (RS + (size_t)(k) * T)

    PH_BEGIN prologue(a, lds); PH_END

#define FFN_PLE(L, XBc, XBo) \
    PH_BEGIN { EpiFfn E{(bf16_t*)(BIG + BIG_HID2), (bf16_t*)(BIG + BIG_EDGE), RSB(3 * (L) + 1), a->in[32] + (size_t)(L) * 3 * DFF, a->in[33] + (size_t)(L) * DFF}; \
               run_gemm(lds, XBc, (const bf16_t*)(ws + WS_WGU + (L) * SZ_WGU), T, 2 * DFF, D, E); } PH_END \
    PH_BEGIN { ffn_fixup(a, (L), (const bf16_t*)(BIG + BIG_EDGE), (bf16_t*)(BIG + BIG_HID2)); \
               EpiScale E{XBo, D, nullptr, nullptr, -1}; \
               run_gemm(lds, (const bf16_t*)(ws + WS_PB) + (size_t)(L) * T * PLED, (const bf16_t*)(ws + WS_WPP + (L) * SZ_WPP), T, D, PLED, E); } PH_END \
    PH_BEGIN { EpiResid E{X, XBc, RSB(3 * (L) + 2)}; \
               run_gemm(lds, (const bf16_t*)(BIG + BIG_HID2), (const bf16_t*)(ws + WS_WDN + (L) * SZ_WDN), T, D, DFF, E); } PH_END \
    PH_BEGIN { EpiPle E{X, XBo, RSB(3 * (L) + 3), RSB(3 * (L) + 2), XBo}; \
               run_gemm(lds, XBc, (const bf16_t*)(ws + WS_WPG + (L) * SZ_WPG), T, D, D, E); } PH_END

    PH_BEGIN { EpiScale E{(bf16_t*)BIG, 6144, RSB(0), nullptr, -1}; run_gemm(lds, XB0, (const bf16_t*)(ws + WS_NAQ), T, 6144, D, E); } PH_END
    PH_BEGIN na::attention(a, lds, (const bf16_t*)BIG, XB1); PH_END
    PH_BEGIN { EpiResid E{X, XB0, RSB(1)}; run_gemm(lds, XB1, (const bf16_t*)(ws + WS_NAO), T, D, D, E); } PH_END
    FFN_PLE(0, XB0, XB1)
    PH_BEGIN { EpiGelu E{(bf16_t*)BIG, 4096, RSB(3), RSB(13), 8}; run_gemm(lds, XB1, (const bf16_t*)(ws + WS_SGI), T, 4096, D, E); } PH_END
    PH_BEGIN sgu_mix(a, lds, (const bf16_t*)BIG, RSB(13), XB0); PH_END
    PH_BEGIN { EpiResid E{X, XB1, RSB(4)}; run_gemm(lds, XB0, (const bf16_t*)(ws + WS_SGO), T, D, D, E); } PH_END
    FFN_PLE(1, XB1, XB0)
#pragma unroll 1
    for (int gg = 0; gg < NGG; ++gg) {
        const size_t r0 = (size_t)gg * GG_ROWS;
#define GDN_PTRS bf16_t* PROJ = (bf16_t*)(BIG + BIG_PROJ); bf16_t* OF = PROJ; bf16_t* OB = (bf16_t*)(BIG + BIG_OB); bf16_t* VP = (bf16_t*)(BIG + BIG_VP); \
        float* AB = (float*)(BIG + BIG_AB); float* GB = (float*)(BIG + BIG_GB); bf16_t* QK = XB1; (void)PROJ; (void)OF; (void)OB; (void)VP; (void)AB; (void)GB; (void)QK;
        PH_BEGIN { GDN_PTRS EpiScale E{PROJ, 8192, RSB(6) + r0, AB, 32}; run_gemm(lds, XB0 + r0 * D, (const bf16_t*)(ws + WS_GDI), GG_ROWS, GDI_N1, D, E); } PH_END
        PH_BEGIN { GDN_PTRS gdn_conv(a, PROJ, AB, QK, VP, GB, GG_ROWS); } PH_END
        PH_BEGIN { GDN_PTRS gdn::scan(lds, QK, VP, GB, OF, OB, GG_ROWS / SEQ); } PH_END
        PH_BEGIN { GDN_PTRS gdn_sumnorm(a, OF, OB, GG_ROWS); } PH_END
        PH_BEGIN { GDN_PTRS EpiGdnZ E{OF, 4096, RSB(6) + r0}; run_gemm(lds, XB0 + r0 * D, (const bf16_t*)(ws + WS_GDI) + (size_t)GDI_N1 * D, GG_ROWS, 4096, D, E); } PH_END
        PH_BEGIN { GDN_PTRS EpiResid E{X + r0 * D, XB0 + r0 * D, RSB(7) + r0}; run_gemm(lds, OF, (const bf16_t*)(ws + WS_GDO), GG_ROWS, D, 4096, E); } PH_END
    }
    FFN_PLE(2, XB0, XB1)
    PH_BEGIN s5_scan(a, lds, X, RSB(9), (float*)BIG, XB0); PH_END
    PH_BEGIN { EpiGlu E{X, XB1, RSB(10)}; run_gemm(lds, XB0, (const bf16_t*)(ws + WS_S5G), T, 4096, D, E); } PH_END
    FFN_PLE(3, XB1, XB0)
    PH_BEGIN final_norm(a, RSB(12)); PH_END
}
}

extern "C" void kernel_launch(void* const* d_in, const int* in_sizes, int n_in, void* d_out, int out_size, void* d_ws, size_t ws_size, hipStream_t stream) {
    using namespace mk;
    static int grid = 0;
    if (grid == 0) {
        if (n_in != 37 || out_size != T * D || ws_size < WS_END) { fprintf(stderr, "kernel_launch: unexpected problem (n_in %d, out %d, ws %zu < %zu)\n", n_in, out_size, ws_size, (size_t)WS_END); grid = -1; return; }
        int dev = 0, cus = 0;
        if (hipGetDevice(&dev) != hipSuccess || hipDeviceGetAttribute(&cus, hipDeviceAttributeMultiprocessorCount, dev) != hipSuccess) { grid = -1; return; }
        if (hipFuncSetAttribute((const void*)mk_fwd, hipFuncAttributeMaxDynamicSharedMemorySize, LDS_BYTES) != hipSuccess) { fprintf(stderr, "kernel_launch: hipFuncSetAttribute failed\n"); grid = -1; return; }
        int per_cu = 0;
        if (hipOccupancyMaxActiveBlocksPerMultiprocessor(&per_cu, (const void*)mk_fwd, NTHR, LDS_BYTES) != hipSuccess || per_cu < 1) fprintf(stderr, "kernel_launch: occupancy query says %d\n", per_cu);
        (void)hipGetLastError();
        grid = cus > 0 ? cus : 256;
    }
    if (grid < 0) return;
    (void)hipMemsetAsync(d_ws, 0, ZERO_BYTES, stream);
    Args a{};
    for (int i = 0; i < 37; ++i) a.in[i] = (const float*)d_in[i];
    a.out = (float*)d_out; a.ws = (unsigned char*)d_ws;
#if MK_SINGLE
    a.ph_lo = 0; a.ph_hi = NPH;
    hipLaunchKernelGGL(mk_fwd, dim3(grid), dim3(NTHR), LDS_BYTES, stream, a);
#else
    for (int p = 0; p < NPH; ++p) { a.ph_lo = p; a.ph_hi = p + 1; hipLaunchKernelGGL(mk_fwd, dim3(grid), dim3(NTHR), LDS_BYTES, stream, a); }
#endif
}
```

```cpp
#include <hip/hip_runtime.h>
#include <cstdio>
#include <cstdint>
#define XB_TMO      128
#define XB_XCNT(j)  (256  + 64 * (j))
#define XB_XSUB(j)  (1280 + 64 * (j))
#define XB_XGEN(j)  (2304 + 64 * (j))
#define XB_TOP      3328
#define XB_TOPGEN   3392
#define XCD_BAR_WORDS 3456
#define XB_SPIN_CAP (1u << 18)
#define LAS __attribute__((address_space(3)))

__device__ __forceinline__ unsigned xb_ld(unsigned* p)              { return __hip_atomic_load(p, __ATOMIC_RELAXED, __HIP_MEMORY_SCOPE_AGENT); }
__device__ __forceinline__ unsigned xb_add(unsigned* p, unsigned v) { return __hip_atomic_fetch_add(p, v, __ATOMIC_RELAXED, __HIP_MEMORY_SCOPE_AGENT); }
__device__ __forceinline__ unsigned xb_xcc_id() { return (unsigned)__builtin_amdgcn_s_getreg((3 << 11) | 20) & 0xFu; }
#define XB_SPIN(cond, bar) do { unsigned _sp = 0; while (cond) { __builtin_amdgcn_s_sleep(1); \
    if ((++_sp & 255u) == 0u) { if (xb_ld(&(bar)[XB_TMO])) break; if (_sp > XB_SPIN_CAP) { atomicAdd(&(bar)[XB_TMO], 1u); break; } } } } while (0)

struct XcdBarrier {
    unsigned* bar; unsigned x;
    volatile LAS unsigned* st;
};

__device__ __forceinline__ XcdBarrier xcd_barrier_post(unsigned* bar, volatile LAS unsigned* st) {
    XcdBarrier b; b.bar = bar; b.x = xb_xcc_id(); b.st = st;
    if (threadIdx.x == 0) (void)xb_add(&bar[XB_XCNT(b.x)], 1u);
    return b;
}
__device__ __forceinline__ void xcd_barrier_complete(unsigned* bar, unsigned x, unsigned& nloc, unsigned& nx) {
    const unsigned G = gridDim.x * gridDim.y * gridDim.z;
    unsigned sum, cnt, mine, sp = 0u;
    for (;;) {
        sum = 0u; cnt = 0u; mine = 0u;
#pragma unroll
        for (unsigned j = 0; j < 16; ++j) { const unsigned c = xb_ld(&bar[XB_XCNT(j)]); sum += c; cnt += (c > 0u) ? 1u : 0u; mine = (j == x) ? c : mine; }
        if (sum == G) break;
        __builtin_amdgcn_s_sleep(1);
        if ((++sp & 255u) == 0u) { if (xb_ld(&bar[XB_TMO])) break; if (sp > XB_SPIN_CAP) { atomicAdd(&bar[XB_TMO], 1u); break; } }
    }
    nloc = mine > 0u ? mine : 1u; nx = cnt > 0u ? cnt : 1u;
}

__device__ __forceinline__ void xcd_barrier(const XcdBarrier& b) {
    asm volatile("s_waitcnt vmcnt(0)" ::: "memory");
    __syncthreads();
    if (threadIdx.x == 0) {
        unsigned* bar = b.bar;
        __builtin_amdgcn_s_waitcnt(0);
        unsigned nloc = b.st[0], nx = b.st[1];
        if (nloc == 0u) { xcd_barrier_complete(bar, b.x, nloc, nx); b.st[0] = nloc; b.st[1] = nx; }
        const unsigned old = xb_add(&bar[XB_XSUB(b.x)], 1u);
        const unsigned gen = old / nloc;
        if (old + 1u == (gen + 1u) * nloc) {
            __builtin_amdgcn_fence(__ATOMIC_RELEASE, "agent");
            asm volatile("s_waitcnt vmcnt(0)" ::: "memory");
            const unsigned og = xb_add(&bar[XB_TOP], 1u);
            const unsigned tg = og / nx;
            if (og + 1u == (tg + 1u) * nx) xb_add(&bar[XB_TOPGEN], 1u);
            else XB_SPIN(xb_ld(&bar[XB_TOPGEN]) == tg, bar);
            __builtin_amdgcn_fence(__ATOMIC_ACQUIRE, "agent");
            xb_add(&bar[XB_XGEN(b.x)], 1u);
            asm volatile("s_waitcnt vmcnt(0)" ::: "memory");
        } else {
            XB_SPIN(xb_ld(&bar[XB_XGEN(b.x)]) == gen, bar);
            __builtin_amdgcn_fence(__ATOMIC_ACQUIRE, "agent");
            asm volatile("s_waitcnt vmcnt(0)" ::: "memory");
        }
    }
    __syncthreads();
}
namespace pg8 {
#define PG8_LAS __attribute__((address_space(3)))
typedef unsigned short bf16_t;
typedef short bf16x8 __attribute__((ext_vector_type(8)));
typedef float f32x4 __attribute__((ext_vector_type(4)));
typedef unsigned u32x4 __attribute__((ext_vector_type(4)));
constexpr int BM = 256, BK = 64, HALF = 128, HTB = HALF * BK * 2  , STAGE_BYTES = 8 * HTB, NXCD = 8, WGM = 8;

__host__ __device__ __forceinline__ int lds_byte(int r, int c) { const int st = (r >> 4) * 2 + (c >> 5), rr = r & 15, cc = c & 31, ob = rr * 64 + cc * 2; return st * 1024 + (ob ^ (((ob >> 9) & 1) << 5)); }
__host__ __device__ __forceinline__ void stage_rc(int b, int& R, int& C) { const int st = b / 1024, sb = b % 1024, swz = sb ^ (((sb >> 9) & 1) << 5); R = (st >> 1) * 16 + swz / 64; C = (st & 1) * 32 + (swz % 64) / 2; }
__host__ __device__ __forceinline__ int perm32(int rho) { const int n = rho >> 4, i = rho & 15; return 8 * (i >> 2) + 4 * n + (i & 3); }

struct Unit { int pm, pn; };
struct Gemm { const bf16_t* A; const bf16_t* Bt; int M, N, K; };

struct StaticOrder {
    int nM, nN, nwg, G, c;
    __host__ __device__ void init(int M, int N, int G_, int c_) { nM = M / BM; nN = N / BM; nwg = nM * nN; G = G_; c = c_; }
    __host__ __device__ bool next(int i, Unit& u) const {
        const long L = (long)i * G + c; if (L >= nwg) return false;
        int wgid = (int)L; { const int q = nwg / NXCD, r = nwg % NXCD, xcd = wgid % NXCD, off = wgid / NXCD; wgid = (xcd < r ? xcd * (q + 1) : r * (q + 1) + (xcd - r) * q) + off; }
        const int nig = WGM * nN, gid = wgid / nig, fm = gid * WGM, gsz = (nM - fm) < WGM ? (nM - fm) : WGM;
        u.pm = fm + ((wgid % nig) % gsz); u.pn = (wgid % nig) / gsz; return true;
    }
    __device__ __forceinline__ void a_ready(const Unit&) const {}
    __device__ __forceinline__ void done(const Unit&) const {}
};


__device__ __forceinline__ unsigned cvt_pk_bf16(float lo, float hi) { unsigned r; asm volatile("v_cvt_pk_bf16_f32 %0, %1, %2" : "=v"(r) : "v"(lo), "v"(hi)); return r; }

template <class Epi, class Sched, bool ALIGN_EPI = false, bool SP2 = false>
__device__ __forceinline__ void gemm_phase(PG8_LAS unsigned char* lds, const Gemm g, const Sched& S, const Epi& E) {
    int tid_ = threadIdx.x; asm volatile("" : "+v"(tid_)); const int tid = tid_, wid = __builtin_amdgcn_readfirstlane(tid >> 6), lane = tid & 63, wr = wid >> 2, wc = wid & 3, fr = lane & 15, fq = lane >> 4;
    const int K = g.K, nt = K / BK;
    unsigned voffA[2], voffB[2];
#pragma unroll
    for (int i = 0; i < 2; ++i) { int R, C; stage_rc(tid * 16 + i * 8192, R, C); const int Rb = Epi::PERM ? ((R & ~31) + perm32(R & 31)) : R;
        voffA[i] = (unsigned)(R * K + C) * 2u; voffB[i] = (unsigned)(Rb * K + C) * 2u; }
    const size_t kstep = (size_t)(BK * 2);
    const size_t hstep = (size_t)HALF * K * 2;
    const size_t tstep = 2 * hstep;
    const unsigned ldsw = (unsigned)wid * 1024u;
    const int aoff = lds_byte(wr * 64 + fr, fq * 8), boff = lds_byte(wc * 32 + fr, fq * 8);
#define PG8_SA(b, h) (((b) * 2 + (h)) * HTB)
#define PG8_SB(b, h) ((4 + (b) * 2 + (h)) * HTB)
#define PG8_STAGE(bufoff, gbase, voff) do { _Pragma("unroll") for (int _i = 0; _i < 2; ++_i) \
        __builtin_amdgcn_global_load_lds((const unsigned*)((const char*)(gbase) + (voff)[_i]), (PG8_LAS unsigned*)(lds + (bufoff) + ldsw + _i * 8192), 16, 0, 0); } while (0)
#define PG8_LDA(dst, b, h) do { _Pragma("unroll") for (int m = 0; m < 4; ++m) _Pragma("unroll") for (int k = 0; k < 2; ++k) dst[m][k] = *(const PG8_LAS bf16x8*)(lds + PG8_SA(b, h) + aoff + m * 2048 + k * 1024); } while (0)
#define PG8_LDB(dst, b, h) do { _Pragma("unroll") for (int n = 0; n < 2; ++n) _Pragma("unroll") for (int k = 0; k < 2; ++k) dst[n][k] = *(const PG8_LAS bf16x8*)(lds + PG8_SB(b, h) + boff + n * 2048 + k * 1024); } while (0)
#define PG8_MMA(ai, bj, At, Bt) do { __builtin_amdgcn_s_setprio(1); _Pragma("unroll") for (int m = 0; m < 4; ++m) _Pragma("unroll") for (int n = 0; n < 2; ++n) _Pragma("unroll") for (int k = 0; k < 2; ++k) \
        acc[ai][bj][m][n] = __builtin_amdgcn_mfma_f32_16x16x32_bf16(Bt[n][k], At[m][k], acc[ai][bj][m][n], 0, 0, 0); __builtin_amdgcn_s_setprio(0); } while (0)
#define PG8_WAIT_V(n) asm volatile("s_waitcnt vmcnt(" #n ")" ::: "memory")
#define PG8_WAIT_L(n) asm volatile("s_waitcnt lgkmcnt(" #n ")" ::: "memory")
#define PG8_BAR __builtin_amdgcn_s_barrier()
#define PG8_SCHED __builtin_amdgcn_sched_barrier(0)
    Unit cur, nxt; int ui = 0;
    if (!S.next(0, cur)) return;
    f32x4 acc[2][2][4][2];
#pragma unroll
    for (int a = 0; a < 2; ++a)
#pragma unroll
        for (int b = 0; b < 2; ++b)
#pragma unroll
            for (int m = 0; m < 4; ++m)
#pragma unroll
                for (int n = 0; n < 2; ++n) acc[a][b][m][n] = (f32x4){0.f, 0.f, 0.f, 0.f};
    bf16x8 At[4][2], B0[2][2], B1[2][2];
    const char* cA = (const char*)g.A + (size_t)cur.pm * tstep; const char* cB = (const char*)g.Bt + (size_t)cur.pn * tstep;
    S.a_ready(cur);
    if constexpr (SP2) {
        PG8_STAGE(PG8_SB(0, 0), cB, voffB); PG8_STAGE(PG8_SB(0, 1), cB + hstep, voffB); PG8_STAGE(PG8_SA(0, 0), cA, voffA); PG8_STAGE(PG8_SA(0, 1), cA + hstep, voffA);
        if (wr == 1) PG8_BAR;
        PG8_WAIT_V(2); PG8_BAR;
        PG8_STAGE(PG8_SB(1, 0), cB + kstep, voffB); PG8_STAGE(PG8_SA(1, 0), cA + kstep, voffA); PG8_STAGE(PG8_SB(1, 1), cB + hstep + kstep, voffB);
        PG8_WAIT_V(6); PG8_BAR;
    } else {
        PG8_STAGE(PG8_SB(0, 0), cB, voffB); PG8_STAGE(PG8_SA(0, 0), cA, voffA); PG8_STAGE(PG8_SB(0, 1), cB + hstep, voffB); PG8_STAGE(PG8_SA(0, 1), cA + hstep, voffA);
        if (wr == 1) PG8_BAR;
        PG8_WAIT_V(4); PG8_BAR;
        PG8_STAGE(PG8_SB(1, 0), cB + kstep, voffB); PG8_STAGE(PG8_SA(1, 0), cA + kstep, voffA); PG8_STAGE(PG8_SB(1, 1), cB + hstep + kstep, voffB);
        PG8_WAIT_V(6); PG8_BAR;
    }
    for (;;) {
        const bool has_next = S.next(ui + 1, nxt);
        const char* nA = has_next ? (const char*)g.A + (size_t)nxt.pm * tstep : cA; const char* nB = has_next ? (const char*)g.Bt + (size_t)nxt.pn * tstep : cB;
        for (int t = 0; t < nt; t += 2) {
            const bool last = (t == nt - 2);
            const char* a1 = cA + (size_t)(t + 1) * kstep;
            const char* a2 = last ? nA : cA + (size_t)(t + 2) * kstep; const char* b2 = last ? nB : cB + (size_t)(t + 2) * kstep;
            const char* a3 = a2 + kstep; const char* b3 = b2 + kstep;
            if (last && has_next) S.a_ready(nxt);
            if constexpr (SP2) {
            PG8_LDB(B0, 0, 0); PG8_LDB(B1, 0, 1); PG8_SCHED; PG8_LDA(At, 0, 0); PG8_STAGE(PG8_SA(1, 1), a1 + hstep, voffA);
            PG8_WAIT_V(8); PG8_WAIT_L(0); PG8_BAR; PG8_MMA(0, 0, At, B0); PG8_MMA(0, 1, At, B1); PG8_BAR; PG8_SCHED;
            PG8_LDA(At, 0, 1); PG8_STAGE(PG8_SB(0, 0), b2, voffB); PG8_STAGE(PG8_SB(0, 1), b2 + hstep, voffB); PG8_STAGE(PG8_SA(0, 0), a2, voffA);
            PG8_WAIT_V(8); PG8_WAIT_L(0); PG8_BAR; PG8_MMA(1, 0, At, B0); PG8_MMA(1, 1, At, B1); PG8_BAR; PG8_SCHED;
            PG8_LDB(B0, 1, 0); PG8_LDB(B1, 1, 1); PG8_SCHED; PG8_LDA(At, 1, 0); PG8_STAGE(PG8_SA(0, 1), a2 + hstep, voffA);
            PG8_WAIT_V(8); PG8_WAIT_L(0); PG8_BAR; PG8_MMA(0, 0, At, B0); PG8_MMA(0, 1, At, B1); PG8_BAR; PG8_SCHED;
            PG8_LDA(At, 1, 1); PG8_STAGE(PG8_SB(1, 0), b3, voffB); PG8_STAGE(PG8_SB(1, 1), b3 + hstep, voffB); PG8_STAGE(PG8_SA(1, 0), a3, voffA);
            PG8_WAIT_V(8); PG8_WAIT_L(0); PG8_BAR; PG8_MMA(1, 0, At, B0); PG8_MMA(1, 1, At, B1); PG8_BAR; PG8_SCHED;
            } else {
            PG8_LDB(B0, 0, 0); PG8_SCHED; PG8_LDA(At, 0, 0); PG8_STAGE(PG8_SA(1, 1), a1 + hstep, voffA);
            PG8_WAIT_L(8); PG8_BAR; PG8_WAIT_L(0); PG8_MMA(0, 0, At, B0); PG8_BAR; PG8_SCHED;
            PG8_LDB(B1, 0, 1); PG8_STAGE(PG8_SB(0, 0), b2, voffB);
            PG8_BAR; PG8_WAIT_L(0); PG8_MMA(0, 1, At, B1); PG8_BAR;
            PG8_LDA(At, 0, 1); PG8_STAGE(PG8_SA(0, 0), a2, voffA);
            PG8_BAR; PG8_WAIT_L(0); PG8_MMA(1, 0, At, B0); PG8_BAR; PG8_SCHED;
            PG8_STAGE(PG8_SB(0, 1), b2 + hstep, voffB);
            PG8_WAIT_V(6); PG8_BAR; PG8_MMA(1, 1, At, B1); PG8_BAR;
            PG8_LDB(B0, 1, 0); PG8_SCHED; PG8_LDA(At, 1, 0); PG8_STAGE(PG8_SA(0, 1), a2 + hstep, voffA);
            PG8_WAIT_L(8); PG8_BAR; PG8_WAIT_L(0); PG8_MMA(0, 0, At, B0); PG8_BAR; PG8_SCHED;
            PG8_LDB(B1, 1, 1); PG8_STAGE(PG8_SB(1, 0), b3, voffB);
            PG8_BAR; PG8_WAIT_L(0); PG8_MMA(0, 1, At, B1); PG8_BAR;
            PG8_LDA(At, 1, 1); PG8_STAGE(PG8_SA(1, 0), a3, voffA);
            PG8_BAR; PG8_WAIT_L(0); PG8_MMA(1, 0, At, B0); PG8_BAR; PG8_SCHED;
            PG8_STAGE(PG8_SB(1, 1), b3 + hstep, voffB);
            PG8_WAIT_V(6); PG8_BAR; PG8_MMA(1, 1, At, B1); PG8_BAR;
            }
        }
        if constexpr (ALIGN_EPI) { if (wr == 0) PG8_BAR; }
        if constexpr (!Epi::AFTER_DRAIN) { E(acc, cur, wr, wc, fr, fq); S.done(cur); }
        if (!has_next) break;
#pragma unroll
        for (int a = 0; a < 2; ++a)
#pragma unroll
            for (int b = 0; b < 2; ++b)
#pragma unroll
                for (int m = 0; m < 4; ++m)
#pragma unroll
                    for (int n = 0; n < 2; ++n) acc[a][b][m][n] = (f32x4){0.f, 0.f, 0.f, 0.f};
        cur = nxt; cA = nA; cB = nB; ++ui;
        if constexpr (ALIGN_EPI) { if (wr == 1) PG8_BAR; }
    }
    PG8_WAIT_V(0);
    if constexpr (!ALIGN_EPI) { if (wr == 0) PG8_BAR; }
    PG8_BAR;
    if constexpr (Epi::AFTER_DRAIN) { E.fused(acc, cur, wr, wc, fr, fq, lds, wid, lane); S.done(cur); }
#undef PG8_SA
#undef PG8_SB
#undef PG8_STAGE
#undef PG8_LDA
#undef PG8_LDB
#undef PG8_MMA
#undef PG8_WAIT_V
#undef PG8_WAIT_L
#undef PG8_BAR
#undef PG8_SCHED
}
}

namespace mk {
using pg8::bf16_t; using pg8::f32x4; using pg8::u32x4; using pg8::Unit;
typedef unsigned u32x2 __attribute__((ext_vector_type(2)));
constexpr int D = 2048, T = 40960, NSEQ = 10, SEQ = 4096, DFF = 5632, PLED = 256;
constexpr float EPS = 1e-6f;
constexpr int NTHR = 512;

constexpr size_t AL(size_t x) { return (x + 255) & ~size_t(255); }
constexpr size_t WS_CTL = 0, CTL_BYTES = 65536;
constexpr int NRS = 14;
constexpr size_t WS_RS = WS_CTL + CTL_BYTES, RS_BYTES = (size_t)NRS * T * 8;
constexpr size_t ZERO_BYTES = WS_RS + RS_BYTES;
constexpr size_t SZ_WGU = (size_t)2 * DFF * D * 2, SZ_WDN = (size_t)D * DFF * 2, SZ_WPG = (size_t)D * D * 2, SZ_WPP = (size_t)D * PLED * 2;
constexpr size_t WS_WGU = AL(ZERO_BYTES);
constexpr size_t WS_WDN = WS_WGU + 4 * SZ_WGU;
constexpr size_t WS_WPG = WS_WDN + 4 * SZ_WDN;
constexpr size_t WS_WPP = WS_WPG + 4 * SZ_WPG;
constexpr size_t WS_NAQ = WS_WPP + 4 * SZ_WPP;
constexpr size_t WS_NAO = WS_NAQ + (size_t)6144 * D * 2;
constexpr size_t WS_SGI = WS_NAO + (size_t)D * D * 2;
constexpr size_t WS_SGO = WS_SGI + (size_t)4096 * D * 2;
constexpr int    GDI_N = 12544, GDI_N1 = 8448;
constexpr size_t WS_GDI = WS_SGO + (size_t)D * D * 2;
constexpr size_t WS_GDO = WS_GDI + (size_t)GDI_N * D * 2;
constexpr size_t WS_S5G = WS_GDO + (size_t)D * 4096 * 2;
constexpr size_t WS_PB  = WS_S5G + (size_t)4096 * D * 2;
constexpr size_t WS_XB0 = WS_PB + (size_t)4 * T * PLED * 2;
constexpr size_t WS_XB1 = WS_XB0 + (size_t)T * D * 2;
constexpr size_t WS_BIG = WS_XB1 + (size_t)T * D * 2;
constexpr size_t BIG_BYTES = 524288000;
constexpr size_t WS_END = WS_BIG + BIG_BYTES;
constexpr int FG_ROWS = 8192, NFG = 5;
constexpr size_t BIG_GU = 0, BIG_HID = (size_t)FG_ROWS * 2 * DFF * 2;
constexpr size_t BIG_HID2 = 0, BIG_EDGE = (size_t)T * DFF * 2;
static_assert(BIG_EDGE + (size_t)(T / 256) * 16 * 2 * DFF * 2 <= BIG_BYTES, "BIG");
constexpr int GG_ROWS = 20480, NGG = 2;
constexpr size_t BIG_PROJ = 0, BIG_OB = (size_t)GG_ROWS * 4096 * 2, BIG_VP = (size_t)GG_ROWS * 8192 * 2, BIG_AB = BIG_VP + (size_t)GG_ROWS * 4096 * 2, BIG_GB = BIG_AB + (size_t)GG_ROWS * 128 * 4;
static_assert(BIG_GB + (size_t)GG_ROWS * 128 * 4 <= BIG_BYTES, "BIG");
static_assert((size_t)T * 6144 * 2 <= BIG_BYTES, "BIG");

constexpr int LDS_STAGE = 131072, LDS_BYTES = 163840, LDS_BAR = LDS_BYTES - 16;

struct Args { const float* in[37]; float* out; unsigned char* ws; int ph_lo, ph_hi; };
typedef const Args __attribute__((address_space(4)))* ArgsCP;
__device__ __forceinline__ ArgsCP argp() { ArgsCP p = (ArgsCP)__builtin_amdgcn_kernarg_segment_ptr(); asm volatile("" : "+s"(p)); return p; }
__device__ __forceinline__ int tidx() { int t = threadIdx.x; asm volatile("" : "+v"(t)); return t; }

__device__ __forceinline__ float bf2f(bf16_t b) { return __uint_as_float(((unsigned)b) << 16); }
__device__ __forceinline__ float blo(unsigned w) { return __uint_as_float(w << 16); }
__device__ __forceinline__ float bhi(unsigned w) { return __uint_as_float(w & 0xffff0000u); }
typedef float f32x2_t __attribute__((ext_vector_type(2))); typedef __bf16 bf16x2_t __attribute__((ext_vector_type(2)));
__device__ __forceinline__ unsigned pk2(float lo, float hi) { const f32x2_t v = {lo, hi}; const bf16x2_t b = __builtin_convertvector(v, bf16x2_t); return __builtin_bit_cast(unsigned, b); }
__device__ __forceinline__ bf16_t f2bf(float f) { return (bf16_t)(pk2(f, 0.f) & 0xffffu); }
typedef unsigned long long rs_t;
__device__ __forceinline__ float rs_val(rs_t v) { return (float)(unsigned)(v >> 24) + (float)(unsigned)(v & 0xffffffull) * (1.0f / 16777216.0f); }
__device__ __forceinline__ rs_t rs_fix(float ss) { return (rs_t)__float2ull_rn(ss * 16777216.0f); }
__device__ __forceinline__ void rs_add(rs_t* p, float ss) { atomicAdd(p, rs_fix(ss)); }
__device__ __forceinline__ float rstd_of(rs_t v) { return rsqrtf(rs_val(v) * (1.0f / (float)D) + EPS); }
__device__ __forceinline__ float sigmoidf_(float x) { return __builtin_amdgcn_rcpf(1.0f + __expf(-x)); }
__device__ __forceinline__ float siluf_(float x) { return x * sigmoidf_(x); }
__device__ __forceinline__ float geluf_(float x) { const float z = 1.5957691216f * (x + 0.044715f * x * x * x); return x * sigmoidf_(z); }
__device__ __forceinline__ void unpack8(const u32x4 w, float (&v)[8]) { v[0] = blo(w.x); v[1] = bhi(w.x); v[2] = blo(w.y); v[3] = bhi(w.y); v[4] = blo(w.z); v[5] = bhi(w.z); v[6] = blo(w.w); v[7] = bhi(w.w); }
__device__ __forceinline__ u32x4 pack8(const float (&v)[8]) { u32x4 w; w.x = pk2(v[0], v[1]); w.y = pk2(v[2], v[3]); w.z = pk2(v[4], v[5]); w.w = pk2(v[6], v[7]); return w; }
__device__ __forceinline__ float wave_sum(float v) {
#pragma unroll
    for (int o = 32; o > 0; o >>= 1) v += __shfl_xor(v, o);
    return v; }
__device__ __forceinline__ float wave_max(float v) {
#pragma unroll
    for (int o = 32; o > 0; o >>= 1) v = fmaxf(v, __shfl_xor(v, o));
    return v; }

typedef const f32x4 (&AccT)[2][2][4][2];

struct EpiScale {
    static constexpr bool PERM = true, AFTER_DRAIN = false;
    bf16_t* O; int ldc; const rs_t* rs; float* ab; int ab_pn;
    __device__ __forceinline__ void operator()(AccT acc, const Unit& u, int wr, int wc, int fr, int fq) const {
        const int row0 = u.pm * 256 + wr * 64 + fr, colw = wc * 32 + 8 * fq;
        const bool side = (ab != nullptr) && (u.pn == ab_pn);
#pragma unroll
        for (int ai = 0; ai < 2; ++ai)
#pragma unroll
            for (int m = 0; m < 4; ++m) {
                const int row = row0 + ai * 128 + m * 16;
                const float s = rs ? rstd_of(rs[row]) : 1.0f;
#pragma unroll
                for (int bj = 0; bj < 2; ++bj) {
                    const f32x4 v0 = acc[ai][bj][m][0] * s, v1 = acc[ai][bj][m][1] * s;
                    if (side) { if (bj == 0) { float* p = ab + (size_t)row * 128 + colw; *(f32x4*)p = v0; *(f32x4*)(p + 4) = v1; } }
                    else { u32x4 w; w.x = pk2(v0[0], v0[1]); w.y = pk2(v0[2], v0[3]); w.z = pk2(v1[0], v1[1]); w.w = pk2(v1[2], v1[3]);
                           *(u32x4*)(O + (size_t)row * ldc + u.pn * 256 + bj * 128 + colw) = w; }
                }
            }
    }
};
struct EpiGelu {
    static constexpr bool PERM = true, AFTER_DRAIN = false;
    bf16_t* O; int ldc; const rs_t* rs; rs_t* rsv; int vtile0;
    __device__ __forceinline__ void operator()(AccT acc, const Unit& u, int wr, int wc, int fr, int fq) const {
        const int row0 = u.pm * 256 + wr * 64 + fr, colw = wc * 32 + 8 * fq;
        const bool isv = u.pn >= vtile0;
#pragma unroll
        for (int ai = 0; ai < 2; ++ai)
#pragma unroll
            for (int m = 0; m < 4; ++m) {
                const int row = row0 + ai * 128 + m * 16;
                const float s = rstd_of(rs[row]); float ss = 0.f;
#pragma unroll
                for (int bj = 0; bj < 2; ++bj) {
                    float v[8];
#pragma unroll
                    for (int j = 0; j < 4; ++j) { v[j] = geluf_(acc[ai][bj][m][0][j] * s); v[4 + j] = geluf_(acc[ai][bj][m][1][j] * s); }
#pragma unroll
                    for (int j = 0; j < 8; ++j) ss += v[j] * v[j];
                    *(u32x4*)(O + (size_t)row * ldc + u.pn * 256 + bj * 128 + colw) = pack8(v);
                }
                if (isv) { ss += __shfl_xor(ss, 16); ss += __shfl_xor(ss, 32); if (fq == 0) rs_add(rsv + row, ss); }
            }
    }
};
__device__ __forceinline__ float put_x(float* X, bf16_t* XB, size_t off, const float (&xn)[8]) {
    *(f32x4*)(X + off) = (f32x4){xn[0], xn[1], xn[2], xn[3]}; *(f32x4*)(X + off + 4) = (f32x4){xn[4], xn[5], xn[6], xn[7]};
    *(u32x4*)(XB + off) = pack8(xn);
    float ss = 0.f;
#pragma unroll
    for (int j = 0; j < 8; ++j) ss += xn[j] * xn[j];
    return ss;
}
struct EpiResid {
    static constexpr bool PERM = true, AFTER_DRAIN = false;
    float* X; bf16_t* XB; rs_t* rsq;
    __device__ __forceinline__ void operator()(AccT acc, const Unit& u, int wr, int wc, int fr, int fq) const {
        const int row0 = u.pm * 256 + wr * 64 + fr, colw = wc * 32 + 8 * fq;
#pragma unroll
        for (int ai = 0; ai < 2; ++ai)
#pragma unroll
            for (int m = 0; m < 4; ++m) {
                const int row = row0 + ai * 128 + m * 16; float ss = 0.f;
#pragma unroll
                for (int bj = 0; bj < 2; ++bj) {
                    const size_t off = (size_t)row * D + u.pn * 256 + bj * 128 + colw;
                    const f32x4 x0 = *(const f32x4*)(X + off), x1 = *(const f32x4*)(X + off + 4);
                    float xn[8];
#pragma unroll
                    for (int j = 0; j < 4; ++j) { xn[j] = x0[j] + acc[ai][bj][m][0][j]; xn[4 + j] = x1[j] + acc[ai][bj][m][1][j]; }
                    ss += put_x(X, XB, off, xn);
                }
                ss += __shfl_xor(ss, 16); ss += __shfl_xor(ss, 32); if (fq == 0) rs_add(rsq + row, ss);
            }
    }
};
struct EpiPle {
    static constexpr bool PERM = true, AFTER_DRAIN = false;
    float* X; bf16_t* XB; rs_t* rsq; const rs_t* rs_in; const bf16_t* PP;
    __device__ __forceinline__ void operator()(AccT acc, const Unit& u, int wr, int wc, int fr, int fq) const {
        const int row0 = u.pm * 256 + wr * 64 + fr, colw = wc * 32 + 8 * fq;
#pragma unroll
        for (int ai = 0; ai < 2; ++ai)
#pragma unroll
            for (int m = 0; m < 4; ++m) {
                const int row = row0 + ai * 128 + m * 16; float ss = 0.f; const float s = rstd_of(rs_in[row]);
#pragma unroll
                for (int bj = 0; bj < 2; ++bj) {
                    const size_t off = (size_t)row * D + u.pn * 256 + bj * 128 + colw;
                    const f32x4 x0 = *(const f32x4*)(X + off), x1 = *(const f32x4*)(X + off + 4);
                    float pv[8]; unpack8(*(const u32x4*)(PP + off), pv);
                    float xn[8];
#pragma unroll
                    for (int j = 0; j < 4; ++j) { xn[j] = x0[j] + sigmoidf_(acc[ai][bj][m][0][j] * s) * pv[j]; xn[4 + j] = x1[j] + sigmoidf_(acc[ai][bj][m][1][j] * s) * pv[4 + j]; }
                    ss += put_x(X, XB, off, xn);
                }
                ss += __shfl_xor(ss, 16); ss += __shfl_xor(ss, 32); if (fq == 0) rs_add(rsq + row, ss);
            }
    }
};
struct EpiGlu {
    static constexpr bool PERM = true, AFTER_DRAIN = false;
    float* X; bf16_t* XB; rs_t* rsq;
    __device__ __forceinline__ void operator()(AccT acc, const Unit& u, int wr, int wc, int fr, int fq) const {
        const int row0 = u.pm * 256 + wr * 64 + fr, colw = wc * 32 + 8 * fq;
#pragma unroll
        for (int ai = 0; ai < 2; ++ai)
#pragma unroll
            for (int m = 0; m < 4; ++m) {
                const int row = row0 + ai * 128 + m * 16;
                const size_t off = (size_t)row * D + u.pn * 128 + colw;
                const f32x4 x0 = *(const f32x4*)(X + off), x1 = *(const f32x4*)(X + off + 4);
                float xn[8];
#pragma unroll
                for (int j = 0; j < 4; ++j) { xn[j] = x0[j] + acc[ai][0][m][0][j] * sigmoidf_(acc[ai][1][m][0][j]); xn[4 + j] = x1[j] + acc[ai][0][m][1][j] * sigmoidf_(acc[ai][1][m][1][j]); }
                float ss = put_x(X, XB, off, xn);
                ss += __shfl_xor(ss, 16); ss += __shfl_xor(ss, 32); if (fq == 0) rs_add(rsq + row, ss);
            }
    }
};
struct EpiGdnZ {
    static constexpr bool PERM = true, AFTER_DRAIN = false;
    bf16_t* O; int ldc; const rs_t* rs;
    __device__ __forceinline__ void operator()(AccT acc, const Unit& u, int wr, int wc, int fr, int fq) const {
        const int row0 = u.pm * 256 + wr * 64 + fr, colw = wc * 32 + 8 * fq;
#pragma unroll
        for (int ai = 0; ai < 2; ++ai)
#pragma unroll
            for (int m = 0; m < 4; ++m) {
                const int row = row0 + ai * 128 + m * 16; const float s = rstd_of(rs[row]);
#pragma unroll
                for (int bj = 0; bj < 2; ++bj) {
                    bf16_t* p = O + (size_t)row * ldc + u.pn * 256 + bj * 128 + colw;
                    float ov[8]; unpack8(*(const u32x4*)p, ov);
#pragma unroll
                    for (int j = 0; j < 4; ++j) { ov[j] *= siluf_(acc[ai][bj][m][0][j] * s); ov[4 + j] *= siluf_(acc[ai][bj][m][1][j] * s); }
                    *(u32x4*)p = pack8(ov);
                }
            }
    }
};

struct EpiFfn {
    static constexpr bool PERM = true, AFTER_DRAIN = false;
    bf16_t* HID; bf16_t* EDGE; const rs_t* rs; const float* cw; const float* cb;
    __device__ __forceinline__ void operator()(AccT acc, const Unit& u, int wr, int wc, int fr, int fq) const {
        const int lane = fq * 16 + fr, ch = u.pn * 128 + wc * 32 + 8 * fq;
        const int srcUp = (lane & 48) | ((lane + 1) & 15), srcDn = (lane & 48) | ((lane + 15) & 15);
        float w0[8], w1[8], w2[8], bb[8];
#pragma unroll
        for (int q = 0; q < 2; ++q) { const f32x4 a0 = *(const f32x4*)(cw + ch + 4 * q), a1 = *(const f32x4*)(cw + DFF + ch + 4 * q), a2 = *(const f32x4*)(cw + 2 * DFF + ch + 4 * q), a3 = *(const f32x4*)(cb + ch + 4 * q);
#pragma unroll
            for (int j = 0; j < 4; ++j) { w0[4 * q + j] = a0[j]; w1[4 * q + j] = a1[j]; w2[4 * q + j] = a2[j]; bb[4 * q + j] = a3[j]; } }
#pragma unroll
        for (int ai = 0; ai < 2; ++ai) {
            const int row0 = u.pm * 256 + ai * 128 + wr * 64 + fr;
            float G[4][8], sc[4];
#pragma unroll
            for (int m = 0; m < 4; ++m) { sc[m] = rstd_of(rs[row0 + m * 16]);
#pragma unroll
                for (int j = 0; j < 4; ++j) { G[m][j] = acc[ai][0][m][0][j] * sc[m]; G[m][4 + j] = acc[ai][0][m][1][j] * sc[m]; } }
            float ruc[8], rdp[8];
#pragma unroll
            for (int j = 0; j < 8; ++j) { ruc[j] = __shfl(G[0][j], srcUp); rdp[j] = 0.f; }
#pragma unroll
            for (int m = 0; m < 4; ++m) {
                float run[8], rdc[8];
#pragma unroll
                for (int j = 0; j < 8; ++j) { run[j] = (m < 3) ? __shfl(G[m < 3 ? m + 1 : 3][j], srcUp) : 0.f; rdc[j] = __shfl(G[m][j], srcDn); }
                float hv[8], uv[8];
#pragma unroll
                for (int j = 0; j < 8; ++j) { const float up = (fr < 15) ? ruc[j] : run[j], dn = (fr > 0) ? rdc[j] : rdp[j];
                    uv[j] = (j < 4 ? acc[ai][1][m][0][j] : acc[ai][1][m][1][j - 4]) * sc[m];
                    hv[j] = siluf_(w0[j] * dn + w1[j] * G[m][j] + w2[j] * up + bb[j]) * uv[j]; }
                const int row = row0 + m * 16;
                *(u32x4*)(HID + (size_t)row * DFF + ch) = pack8(hv);
                if ((m == 0 && fr < 2) || (m == 3 && fr >= 14)) { const int e = 4 * (2 * ai + wr) + (m == 0 ? fr : fr - 12);
                    bf16_t* ep = EDGE + ((size_t)(u.pm * 16 + e) * 2) * DFF + ch;
                    *(u32x4*)ep = pack8(G[m]); *(u32x4*)(ep + DFF) = pack8(uv); }
#pragma unroll
                for (int j = 0; j < 8; ++j) { rdp[j] = rdc[j]; ruc[j] = run[j]; }
            }
        }
    }
};

template <class Epi>
__device__ __forceinline__ void run_gemm(LAS unsigned char* lds, const bf16_t* A, const bf16_t* Bt, int M, int N, int K, const Epi& E) {
    pg8::Gemm g{A, Bt, M, N, K}; pg8::StaticOrder S; S.init(M, N, (int)gridDim.x, (int)blockIdx.x);
    pg8::gemm_phase<Epi, pg8::StaticOrder, true, true>(lds, g, S, E);
}

struct Job { const float* src; bf16_t* dst; const float* gain; int K, Nsrc, Ndst, map, qcols; };
__device__ __forceinline__ void get_job(ArgsCP a, int j, Job& J) {
    unsigned char* ws = a->ws; J.gain = nullptr; J.map = 0; J.qcols = 0;
    if (j < 16) { const int L = j >> 2, k = j & 3;
        if (k == 0)      { J.src = a->in[31] + (size_t)L * D * 2 * DFF; J.dst = (bf16_t*)(ws + WS_WGU + L * SZ_WGU); J.gain = a->in[5] + L * D; J.K = D; J.Nsrc = 2 * DFF; J.Ndst = 2 * DFF; J.map = 1; }
        else if (k == 1) { J.src = a->in[34] + (size_t)L * DFF * D;     J.dst = (bf16_t*)(ws + WS_WDN + L * SZ_WDN); J.K = DFF; J.Nsrc = D; J.Ndst = D; }
        else if (k == 2) { J.src = a->in[36] + (size_t)L * D * D;       J.dst = (bf16_t*)(ws + WS_WPG + L * SZ_WPG); J.gain = a->in[6] + L * D; J.K = D; J.Nsrc = D; J.Ndst = D; }
        else             { J.src = a->in[35] + (size_t)L * PLED * D;    J.dst = (bf16_t*)(ws + WS_WPP + L * SZ_WPP); J.K = PLED; J.Nsrc = D; J.Ndst = D; }
    } else switch (j) {
        case 16: J.src = a->in[8];  J.dst = (bf16_t*)(ws + WS_NAQ); J.gain = a->in[4] + 0 * D; J.K = D; J.Nsrc = 6144; J.Ndst = 6144; J.qcols = 2048; break;
        case 17: J.src = a->in[9];  J.dst = (bf16_t*)(ws + WS_NAO); J.K = D; J.Nsrc = D; J.Ndst = D; break;
        case 18: J.src = a->in[11]; J.dst = (bf16_t*)(ws + WS_SGI); J.gain = a->in[4] + 1 * D; J.K = D; J.Nsrc = 4096; J.Ndst = 4096; break;
        case 19: J.src = a->in[15]; J.dst = (bf16_t*)(ws + WS_SGO); J.K = D; J.Nsrc = D; J.Ndst = D; break;
        case 20: J.src = a->in[16]; J.dst = (bf16_t*)(ws + WS_GDI); J.gain = a->in[4] + 2 * D; J.K = D; J.Nsrc = 12416; J.Ndst = GDI_N; J.map = 2; break;
        case 21: J.src = a->in[21]; J.dst = (bf16_t*)(ws + WS_GDO); J.K = 4096; J.Nsrc = D; J.Ndst = D; break;
        default: J.src = a->in[30]; J.dst = (bf16_t*)(ws + WS_S5G); J.K = D; J.Nsrc = 4096; J.Ndst = 4096; J.map = 1; break;
    }
}
__device__ __forceinline__ int map_col(const Job& J, int n0) {
    if (J.map == 0) return n0;
    if (J.map == 1) { const int tile = n0 >> 8, w = n0 & 255, H = J.Nsrc >> 1; return w < 128 ? tile * 128 + w : H + tile * 128 + (w - 128); }
    if (n0 < 8192) return n0;
    if (n0 < 8320) return 12288 + (n0 - 8192);
    if (n0 < GDI_N1) return -1;
    return 8192 + (n0 - GDI_N1);
}
__device__ __forceinline__ void prologue(ArgsCP a, LAS unsigned char* lds) {
    const int tid = tidx(), G = gridDim.x, bid = blockIdx.x;
    LAS float* tile = (LAS float*)lds;
    int base = 0;
    for (int j = 0; j < 23; ++j) {
        Job J; get_job(a, j, J);
        const int kt = J.K >> 6, ntl = J.Ndst >> 6, nt = kt * ntl;
        int first = (bid - (base % G) + G) % G;
        for (int i = first; i < nt; i += G) {
            const int nb = i / kt, kb = i - nb * kt, n0 = nb * 64, k0 = kb * 64, s0 = map_col(J, n0);
            const float cs = (n0 < J.qcols) ? 0.08838834764831845f : 1.0f;
            const int kk = tid >> 4, nn4 = (tid & 15) * 4;
#pragma unroll
            for (int p = 0; p < 2; ++p) {
                const int k = k0 + kk + 32 * p;
                f32x4 v = (f32x4){0.f, 0.f, 0.f, 0.f};
                if (s0 >= 0) v = *(const f32x4*)(J.src + (size_t)k * J.Nsrc + s0 + nn4);
                const float sc = (J.gain ? J.gain[k] : 1.0f) * cs;
#pragma unroll
                for (int q = 0; q < 4; ++q) tile[(nn4 + q) * 65 + kk + 32 * p] = v[q] * sc;
            }
            __syncthreads();
            { const int nn = tid >> 3, kk8 = (tid & 7) * 8; float v[8];
#pragma unroll
              for (int q = 0; q < 8; ++q) v[q] = tile[nn * 65 + kk8 + q];
              *(u32x4*)(J.dst + (size_t)(n0 + nn) * J.K + k0 + kk8) = pack8(v); }
            __syncthreads();
        }
        base += nt;
    }
    { bf16_t* PB = (bf16_t*)(a->ws + WS_PB);
      const long total = (long)4 * T * 64;
      for (long i = (long)bid * NTHR + tid; i < total; i += (long)G * NTHR) {
          const int L = (int)(i / ((long)T * 64)); const int rem = (int)(i - (long)L * T * 64); const int row = rem >> 6, c4 = (rem & 63) * 4;
          const float* src = row < 8192 ? a->in[2] + ((size_t)L * 8192 + row) * PLED + c4 : a->in[3] + ((size_t)L * 32768 + (row - 8192)) * PLED + c4;
          const f32x4 v = *(const f32x4*)src; u32x2 w; w.x = pk2(v[0], v[1]); w.y = pk2(v[2], v[3]);
          *(u32x2*)(PB + ((size_t)L * T + row) * PLED + c4) = w; } }
    { bf16_t* XB = (bf16_t*)(a->ws + WS_XB0); rs_t* rs = (rs_t*)(a->ws + WS_RS);
      const int w = tid >> 6, lane = tid & 63;
      for (int row = bid * 8 + w; row < T; row += G * 8) {
          const float* src = row < 8192 ? a->in[0] + (size_t)row * D : a->in[1] + (size_t)(row - 8192) * D;
          float ss = 0.f;
#pragma unroll
          for (int q = 0; q < 8; ++q) { const int c = (q * 64 + lane) * 4; const f32x4 v = *(const f32x4*)(src + c);
              *(f32x4*)(a->out + (size_t)row * D + c) = v; u32x2 wv; wv.x = pk2(v[0], v[1]); wv.y = pk2(v[2], v[3]); *(u32x2*)(XB + (size_t)row * D + c) = wv;
              ss += v[0] * v[0] + v[1] * v[1] + v[2] * v[2] + v[3] * v[3]; }
          ss = wave_sum(ss); if (lane == 0) rs[row] = rs_fix(ss); } }
}

__device__ __forceinline__ void na_attention(ArgsCP a, LAS unsigned char* lds, const bf16_t* QKV, bf16_t* AO) {
    const int tid = tidx(), w = tid >> 6, lane = tid & 63;
    LAS float* qs = (LAS float*)(lds + w * 1024); LAS float* ps = qs + 128;
    const float* rpb = a->in[10];
    for (long task = (long)blockIdx.x * 8 + w; task < (long)T * 16; task += (long)gridDim.x * 8) {
        const int seq = (int)(task >> 16), rem = (int)(task & 65535), h = rem >> 12, pos = rem & 4095, r = pos >> 6, c = pos & 63;
        const int r0 = min(max(r - 4, 0), 56), c0 = min(max(c - 8, 0), 48);
        const size_t trow = (size_t)seq * SEQ + pos;
        { const unsigned qq = *(const unsigned*)(QKV + trow * 6144 + h * 128 + 2 * lane); qs[2 * lane] = blo(qq); qs[2 * lane + 1] = bhi(qq); }
        __builtin_amdgcn_wave_barrier();
        float s[2];
#pragma unroll
        for (int kk = 0; kk < 2; ++kk) {
            const int j = lane + 64 * kk, kr = r0 + (j >> 4), kc = c0 + (j & 15);
            const u32x4* kp = (const u32x4*)(QKV + ((size_t)seq * SEQ + kr * 64 + kc) * 6144 + 2048 + h * 128);
            float acc = 0.f;
#pragma unroll 4
            for (int d8 = 0; d8 < 16; ++d8) { const u32x4 kv = kp[d8]; const f32x4 q0 = *(const LAS f32x4*)(qs + d8 * 8), q1 = *(const LAS f32x4*)(qs + d8 * 8 + 4);
                acc += q0[0] * blo(kv.x) + q0[1] * bhi(kv.x) + q0[2] * blo(kv.y) + q0[3] * bhi(kv.y) + q1[0] * blo(kv.z) + q1[1] * bhi(kv.z) + q1[2] * blo(kv.w) + q1[3] * bhi(kv.w); }
            s[kk] = acc + rpb[(h * 15 + (kr - r + 7)) * 31 + (kc - c + 15)];
        }
        const float mx = wave_max(fmaxf(s[0], s[1]));
        const float e0 = __expf(s[0] - mx), e1 = __expf(s[1] - mx);
        const float inv = 1.0f / wave_sum(e0 + e1);
        ps[lane] = e0 * inv; ps[lane + 64] = e1 * inv;
        __builtin_amdgcn_wave_barrier();
        float o0 = 0.f, o1 = 0.f;
        const bf16_t* vb = QKV + ((size_t)seq * SEQ) * 6144 + 4096 + h * 128 + 2 * lane;
#pragma unroll 4
        for (int j = 0; j < 128; ++j) { const int kr = r0 + (j >> 4), kc = c0 + (j & 15);
            const unsigned vv = *(const unsigned*)(vb + (size_t)(kr * 64 + kc) * 6144); const float p = ps[j]; o0 += p * blo(vv); o1 += p * bhi(vv); }
        *(unsigned*)(AO + trow * D + h * 128 + 2 * lane) = pk2(o0, o1);
        __builtin_amdgcn_wave_barrier();
    }
}

__device__ __forceinline__ void sgu_mix(ArgsCP a, LAS unsigned char* lds, const bf16_t* UV, const rs_t* rsv, bf16_t* MX) {
    const int tid = tidx(), G = gridDim.x;
    LAS float* WT = (LAS float*)lds;
    LAS float* VS = (LAS float*)(lds + 65536);
    const float* w_s = a->in[13]; const float* b_s = a->in[14]; const float* sgn = a->in[12];
    const int per = (5120 + G - 1) / G, u0 = blockIdx.x * per, u1 = min(5120, u0 + per);
    int gcur = -1;
    for (int u = u0; u < u1; ++u) {
        const int g = u / 320, sc = u - g * 320, seq = sc >> 5, n = sc & 31; const size_t row0 = (size_t)seq * SEQ + n * 128;
        __syncthreads();
        if (g != gcur) { gcur = g;
            for (int idx = tid; idx < 16384; idx += NTHR) { const int t = idx >> 7, s = idx & 127; WT[s * 128 + t] = w_s[(size_t)g * 16384 + idx]; } }
        { const int s = tid >> 2, c32 = (tid & 3) * 32; const float rsd = rstd_of(rsv[row0 + s]);
#pragma unroll
          for (int q = 0; q < 4; ++q) { float v[8]; unpack8(*(const u32x4*)(UV + (row0 + s) * 4096 + 2048 + g * 128 + c32 + q * 8), v);
#pragma unroll
              for (int j = 0; j < 8; ++j) VS[s * 128 + c32 + q * 8 + j] = v[j] * rsd * sgn[g * 128 + c32 + q * 8 + j]; } }
        __syncthreads();
        const int t0 = (tid >> 4) * 4, c0 = (tid & 15) * 8;
        float acc[4][8];
#pragma unroll
        for (int i = 0; i < 4; ++i)
#pragma unroll
            for (int j = 0; j < 8; ++j) acc[i][j] = 0.f;
#pragma unroll 4
        for (int s = 0; s < 128; ++s) {
            const f32x4 av = *(const LAS f32x4*)(WT + s * 128 + t0), v0 = *(const LAS f32x4*)(VS + s * 128 + c0), v1 = *(const LAS f32x4*)(VS + s * 128 + c0 + 4);
#pragma unroll
            for (int i = 0; i < 4; ++i) {
#pragma unroll
                for (int j = 0; j < 4; ++j) { acc[i][j] += av[i] * v0[j]; acc[i][4 + j] += av[i] * v1[j]; } }
        }
#pragma unroll
        for (int i = 0; i < 4; ++i) { const int t = t0 + i; const float bias = b_s[g * 128 + t]; const size_t row = row0 + t;
            float uv[8]; unpack8(*(const u32x4*)(UV + row * 4096 + g * 128 + c0), uv);
#pragma unroll
            for (int j = 0; j < 8; ++j) uv[j] *= (acc[i][j] + bias);
            *(u32x4*)(MX + row * D + g * 128 + c0) = pack8(uv); }
    }
}

__device__ __forceinline__ void ffn_convglu(ArgsCP a, int layer, const bf16_t* GU, bf16_t* HID, int rows) {
    const float* cw = a->in[32] + (size_t)layer * 3 * DFF; const float* cb = a->in[33] + (size_t)layer * DFF;
    const long total = (long)rows * 704;
    for (long i = (long)blockIdx.x * NTHR + tidx(); i < total; i += (long)gridDim.x * NTHR) {
        const int r = (int)(i / 704), cbk = (int)(i - (long)r * 704), ch = cbk * 8, pos = r & (SEQ - 1);
        const bf16_t* gp = GU + (size_t)r * (2 * DFF) + (cbk >> 4) * 256 + (cbk & 15) * 8;
        float g0[8], gm[8], gn[8], up[8];
        unpack8(*(const u32x4*)gp, g0); unpack8(*(const u32x4*)(gp + 128), up);
        if (pos > 0) unpack8(*(const u32x4*)(gp - 2 * DFF), gm); else {
#pragma unroll
            for (int j = 0; j < 8; ++j) gm[j] = 0.f; }
        if (pos < SEQ - 1) unpack8(*(const u32x4*)(gp + 2 * DFF), gn); else {
#pragma unroll
            for (int j = 0; j < 8; ++j) gn[j] = 0.f; }
        float o[8];
#pragma unroll
        for (int j = 0; j < 8; ++j) { const float gv = cw[ch + j] * gm[j] + cw[DFF + ch + j] * g0[j] + cw[2 * DFF + ch + j] * gn[j] + cb[ch + j]; o[j] = siluf_(gv) * up[j]; }
        *(u32x4*)(HID + (size_t)r * DFF + ch) = pack8(o);
    }
}

__device__ __forceinline__ void ffn_fixup(ArgsCP a, int layer, const bf16_t* EDGE, bf16_t* HID) {
    const float* cw = a->in[32] + (size_t)layer * 3 * DFF; const float* cb = a->in[33] + (size_t)layer * DFF;
    const int total = (T / 256) * 8 * 704;
    for (int it = blockIdx.x * NTHR + tidx(); it < total; it += gridDim.x * NTHR) {
        const int cbk = it % 704, rr = (it / 704) & 7, tile = it / (704 * 8), s = rr >> 1, last = rr & 1, ch = cbk * 8;
        const bf16_t* eb = EDGE + (size_t)tile * 16 * 2 * DFF + ch;
        float gc[8], uc[8], gi[8], go[8];
        unpack8(*(const u32x4*)(eb + (size_t)((4 * s + (last ? 3 : 0)) * 2) * DFF), gc);
        unpack8(*(const u32x4*)(eb + (size_t)((4 * s + (last ? 3 : 0)) * 2 + 1) * DFF), uc);
        unpack8(*(const u32x4*)(eb + (size_t)((4 * s + (last ? 2 : 1)) * 2) * DFF), gi);
        const bf16_t* op = nullptr;
        if (last) { if (s < 3) op = eb + (size_t)((4 * (s + 1)) * 2) * DFF; else if ((tile & 15) != 15) op = eb + (size_t)16 * 2 * DFF; }
        else      { if (s > 0) op = eb + (size_t)((4 * (s - 1) + 3) * 2) * DFF; else if ((tile & 15) != 0) op = eb - (size_t)16 * 2 * DFF + (size_t)(15 * 2) * DFF; }
        if (op) unpack8(*(const u32x4*)op, go); else {
#pragma unroll
            for (int j = 0; j < 8; ++j) go[j] = 0.f; }
        float hv[8];
#pragma unroll
        for (int j = 0; j < 8; ++j) { const float dn = last ? gi[j] : go[j], up = last ? go[j] : gi[j];
            hv[j] = siluf_(cw[ch + j] * dn + cw[DFF + ch + j] * gc[j] + cw[2 * DFF + ch + j] * up + cb[ch + j]) * uc[j]; }
        *(u32x4*)(HID + ((size_t)tile * 256 + 64 * s + 63 * last) * DFF + ch) = pack8(hv);
    }
}

__device__ __forceinline__ void gdn_conv(ArgsCP a, const bf16_t* PROJ, const float* AB, bf16_t* QK, bf16_t* VP, float* GB, int rows) {
    const int tid = tidx(), ch0 = tid * 16;
    const float* cw = a->in[17];
    float w0[16], w1[16], w2[16];
#pragma unroll
    for (int j = 0; j < 16; ++j) { w0[j] = cw[ch0 + j]; w1[j] = cw[8192 + ch0 + j]; w2[j] = cw[16384 + ch0 + j]; }
    for (int r = blockIdx.x; r < rows; r += gridDim.x) {
        const int pos = r & (SEQ - 1);
        const bf16_t* p = PROJ + (size_t)r * 8192 + ch0;
        float x0[16], xm[16], xn[16];
        { float t[8]; unpack8(*(const u32x4*)p, t);
#pragma unroll
          for (int j = 0; j < 8; ++j) x0[j] = t[j];
          unpack8(*(const u32x4*)(p + 8), t);
#pragma unroll
          for (int j = 0; j < 8; ++j) x0[8 + j] = t[j]; }
        if (pos > 0) { float t[8]; unpack8(*(const u32x4*)(p - 8192), t);
#pragma unroll
          for (int j = 0; j < 8; ++j) xm[j] = t[j];
          unpack8(*(const u32x4*)(p - 8192 + 8), t);
#pragma unroll
          for (int j = 0; j < 8; ++j) xm[8 + j] = t[j]; } else {
#pragma unroll
          for (int j = 0; j < 16; ++j) xm[j] = 0.f; }
        if (pos < SEQ - 1) { float t[8]; unpack8(*(const u32x4*)(p + 8192), t);
#pragma unroll
          for (int j = 0; j < 8; ++j) xn[j] = t[j];
          unpack8(*(const u32x4*)(p + 8192 + 8), t);
#pragma unroll
          for (int j = 0; j < 8; ++j) xn[8 + j] = t[j]; } else {
#pragma unroll
          for (int j = 0; j < 16; ++j) xn[j] = 0.f; }
        float y[16], ss = 0.f;
#pragma unroll
        for (int j = 0; j < 16; ++j) { y[j] = siluf_(w0[j] * xm[j] + w1[j] * x0[j] + w2[j] * xn[j]); ss += y[j] * y[j]; }
        ss += __shfl_xor(ss, 1); ss += __shfl_xor(ss, 2); ss += __shfl_xor(ss, 4);
        float sc = 1.0f;
        if (ch0 < 4096) { sc = rsqrtf(ss + EPS); if (ch0 < 2048) sc *= 0.08838834764831845f; }
        float o0[8], o1[8];
#pragma unroll
        for (int j = 0; j < 8; ++j) { o0[j] = y[j] * sc; o1[j] = y[8 + j] * sc; }
        bf16_t* dst = ch0 < 4096 ? QK + (size_t)r * 4096 + ch0 : VP + (size_t)r * 4096 + (ch0 - 4096);
        *(u32x4*)dst = pack8(o0); *(u32x4*)(dst + 8) = pack8(o1);
        if (tid < 64) { const int dir = tid >> 5, head = tid & 31;
            const float av = AB[(size_t)r * 128 + dir * 64 + head], bv = AB[(size_t)r * 128 + dir * 64 + 32 + head];
            const float xx = av + a->in[19][dir * 32 + head];
            const float sp = xx > 20.f ? xx : log1pf(expf(xx));
            GB[(size_t)r * 128 + dir * 64 + head] = -expf(a->in[18][dir * 32 + head]) * sp;
            GB[(size_t)r * 128 + dir * 64 + 32 + head] = 1.0f / (1.0f + expf(-bv)); }
    }
}
__device__ __forceinline__ void gdn_scan_naive(LAS unsigned char* lds, const bf16_t* QK, const bf16_t* VP, const float* GB, bf16_t* OF, bf16_t* OB, int nseq) {
    const int tid = tidx(), vh = tid >> 8, j = (tid & 255) >> 1, half = tid & 1;
    LAS float* KQ = (LAS float*)lds;
    LAS float* VS = (LAS float*)(lds + 16384);
    LAS float* GS = (LAS float*)(lds + 32768);
    const int nunits = nseq * 32;
    for (int unit = blockIdx.x; unit < nunits; unit += gridDim.x) {
        const int seq = unit >> 5, hq = (unit >> 1) & 15, dir = unit & 1, head = 2 * hq + vh;
        bf16_t* OD = dir ? OB : OF;
        float S[64];
#pragma unroll
        for (int i = 0; i < 64; ++i) S[i] = 0.f;
        for (int blk = 0; blk < SEQ / 16; ++blk) {
            __syncthreads();
            { const int tok = tid >> 5, part = tid & 31, step = blk * 16 + tok, pos = dir ? SEQ - 1 - step : step; const size_t row = (size_t)seq * SEQ + pos;
              const bf16_t* src = part < 16 ? QK + row * 4096 + hq * 128 + part * 8 : QK + row * 4096 + 2048 + hq * 128 + (part - 16) * 8;
              float v[8]; unpack8(*(const u32x4*)src, v);
              *(LAS f32x4*)(KQ + tok * 256 + part * 8) = (f32x4){v[0], v[1], v[2], v[3]}; *(LAS f32x4*)(KQ + tok * 256 + part * 8 + 4) = (f32x4){v[4], v[5], v[6], v[7]};
              unpack8(*(const u32x4*)(VP + row * 4096 + hq * 256 + part * 8), v);
              *(LAS f32x4*)(VS + tok * 256 + part * 8) = (f32x4){v[0], v[1], v[2], v[3]}; *(LAS f32x4*)(VS + tok * 256 + part * 8 + 4) = (f32x4){v[4], v[5], v[6], v[7]};
              if (tid < 64) { const int tk = tid >> 2, which = tid & 3, hh = 2 * hq + (which & 1), isb = which >> 1, st = blk * 16 + tk, ps = dir ? SEQ - 1 - st : st;
                  const float gv = GB[((size_t)seq * SEQ + ps) * 128 + dir * 64 + isb * 32 + hh]; GS[tk * 4 + which] = isb ? gv : expf(gv); } }
            __syncthreads();
            for (int s = 0; s < 16; ++s) {
                const float av = GS[s * 4 + vh], bv = GS[s * 4 + 2 + vh], vt = VS[s * 256 + vh * 128 + j];
                const LAS float* kp = KQ + s * 256 + 128 + half * 64; const LAS float* qp = KQ + s * 256 + half * 64;
                float ks = 0.f;
#pragma unroll
                for (int i = 0; i < 64; i += 4) { const f32x4 k4 = *(const LAS f32x4*)(kp + i); ks += k4[0] * S[i] + k4[1] * S[i + 1] + k4[2] * S[i + 2] + k4[3] * S[i + 3]; }
                ks += __shfl_xor(ks, 1);
                const float uu = bv * (vt - av * ks);
                float os = 0.f;
#pragma unroll
                for (int i = 0; i < 64; i += 4) { const f32x4 k4 = *(const LAS f32x4*)(kp + i), q4 = *(const LAS f32x4*)(qp + i);
#pragma unroll
                    for (int e = 0; e < 4; ++e) { S[i + e] = av * S[i + e] + k4[e] * uu; os += q4[e] * S[i + e]; } }
                os += __shfl_xor(os, 1);
                if (half == 0) { const int step = blk * 16 + s, pos = dir ? SEQ - 1 - step : step; OD[((size_t)seq * SEQ + pos) * 4096 + head * 128 + j] = f2bf(os); }
            }
        }
    }
}
__device__ __forceinline__ void gdn_sumnorm(ArgsCP a, bf16_t* OF, const bf16_t* OB, int rows) {
    const int tid = tidx(), rsub = tid >> 8, c0 = (tid & 255) * 16;
    const float* on = a->in[20];
    for (int r = blockIdx.x * 2 + rsub; r < rows; r += gridDim.x * 2) {
        float x[16], t[8];
        unpack8(*(const u32x4*)(OF + (size_t)r * 4096 + c0), t);
#pragma unroll
        for (int q = 0; q < 8; ++q) x[q] = t[q];
        unpack8(*(const u32x4*)(OF + (size_t)r * 4096 + c0 + 8), t);
#pragma unroll
        for (int q = 0; q < 8; ++q) x[8 + q] = t[q];
        unpack8(*(const u32x4*)(OB + (size_t)r * 4096 + c0), t);
#pragma unroll
        for (int q = 0; q < 8; ++q) x[q] += t[q];
        unpack8(*(const u32x4*)(OB + (size_t)r * 4096 + c0 + 8), t);
#pragma unroll
        for (int q = 0; q < 8; ++q) x[8 + q] += t[q];
        float ss = 0.f;
#pragma unroll
        for (int q = 0; q < 16; ++q) ss += x[q] * x[q];
        ss += __shfl_xor(ss, 1); ss += __shfl_xor(ss, 2); ss += __shfl_xor(ss, 4);
        const float sc = rsqrtf(ss * (1.0f / 128.0f) + EPS);
        float o0[8], o1[8];
#pragma unroll
        for (int q = 0; q < 8; ++q) { o0[q] = x[q] * sc * on[(c0 & 127) + q]; o1[q] = x[8 + q] * sc * on[(c0 & 127) + 8 + q]; }
        *(u32x4*)(OF + (size_t)r * 4096 + c0) = pack8(o0); *(u32x4*)(OF + (size_t)r * 4096 + c0 + 8) = pack8(o1);
    }
}

__device__ __forceinline__ void s5_scan(ArgsCP a, LAS unsigned char* lds, const float* X, const rs_t* rs, float* YF, bf16_t* Y) {
    const int tid = tidx(), w = tid >> 6, lane = tid & 63;
    LAS float* U = (LAS float*)(lds + w * 9216);
    LAS float* XS = U + 256;
    const float* gmix = a->in[4] + 3 * D;
    for (int task = blockIdx.x * 8 + w; task < NSEQ * 128; task += gridDim.x * 8) {
        const int seq = task >> 7, gr = task & 127;
        for (int dir = 0; dir < 2; ++dir) {
            const int dg = dir * 128 + gr;
            const float are = a->in[22][dg * 64 + lane], aim = a->in[23][dg * 64 + lane], dt = expf(a->in[24][dg]);
            const float er = expf(are * dt); float sn, cs; sincosf(aim * dt, &sn, &cs);
            const float abr = er * cs, abi = er * sn;
            const float den = 1.0f / (are * are + aim * aim);
            const float cr = ((abr - 1.0f) * are + abi * aim) * den, ci = (abi * are - (abr - 1.0f) * aim) * den;
            float Br[16], Bi[16];
#pragma unroll
            for (int c = 0; c < 16; ++c) { const float bre = a->in[25][((size_t)dg * 64 + lane) * 16 + c], bim = a->in[26][((size_t)dg * 64 + lane) * 16 + c]; Br[c] = cr * bre - ci * bim; Bi[c] = cr * bim + ci * bre; }
            const int oc = lane & 15, tb = lane >> 4;
            float Cr[64], Ci[64];
#pragma unroll
            for (int p = 0; p < 64; ++p) { Cr[p] = a->in[27][((size_t)dg * 16 + oc) * 64 + p]; Ci[p] = a->in[28][((size_t)dg * 16 + oc) * 64 + p]; }
            const float dsk = a->in[29][gr * 16 + oc];
            float xr = 0.f, xi = 0.f;
            for (int blk = 0; blk < SEQ / 16; ++blk) {
                { const int tt = lane >> 2, c4 = (lane & 3) * 4, step = blk * 16 + tt, pos = dir ? SEQ - 1 - step : step; const size_t row = (size_t)seq * SEQ + pos;
                  const f32x4 xv = *(const f32x4*)(X + row * D + gr * 16 + c4); const f32x4 gm = *(const f32x4*)(gmix + gr * 16 + c4); const float rsd = rstd_of(rs[row]);
                  *(LAS f32x4*)(U + tt * 16 + c4) = xv * gm * rsd; }
                __builtin_amdgcn_wave_barrier();
                for (int tt = 0; tt < 16; ++tt) {
                    float bur = 0.f, bui = 0.f;
#pragma unroll
                    for (int c = 0; c < 16; c += 4) { const f32x4 u4 = *(const LAS f32x4*)(U + tt * 16 + c);
#pragma unroll
                        for (int e = 0; e < 4; ++e) { bur += Br[c + e] * u4[e]; bui += Bi[c + e] * u4[e]; } }
                    const float nr = abr * xr - abi * xi + bur, ni = abr * xi + abi * xr + bui; xr = nr; xi = ni;
                    XS[(tt * 64 + lane) * 2] = xr; XS[(tt * 64 + lane) * 2 + 1] = xi;
                }
                __builtin_amdgcn_wave_barrier();
                for (int i = 0; i < 4; ++i) {
                    const int t = tb * 4 + i; float y = 0.f;
#pragma unroll
                    for (int p = 0; p < 64; p += 2) { const f32x4 x2 = *(const LAS f32x4*)(XS + (t * 64 + p) * 2); y += Cr[p] * x2[0] - Ci[p] * x2[1] + Cr[p + 1] * x2[2] - Ci[p + 1] * x2[3]; }
                    const int step = blk * 16 + t, pos = dir ? SEQ - 1 - step : step; const size_t row = (size_t)seq * SEQ + pos;
                    if (dir == 0) YF[row * D + gr * 16 + oc] = y;
                    else { const float yt = y + YF[row * D + gr * 16 + oc] + dsk * U[t * 16 + oc]; Y[row * D + gr * 16 + oc] = f2bf(geluf_(yt)); }
                }
                __builtin_amdgcn_wave_barrier();
            }
        }
    }
}

__device__ __forceinline__ void final_norm(ArgsCP a, const rs_t* rs) {
    const int tid = tidx(), w = tid >> 6, lane = tid & 63; const float* g = a->in[7];
    for (int row = blockIdx.x * 8 + w; row < T; row += gridDim.x * 8) {
        const float s = rstd_of(rs[row]);
#pragma unroll
        for (int q = 0; q < 8; ++q) { const int c = (q * 64 + lane) * 4; f32x4 v = *(const f32x4*)(a->out + (size_t)row * D + c); const f32x4 gv = *(const f32x4*)(g + c); v = v * gv * s; *(f32x4*)(a->out + (size_t)row * D + c) = v; }
    }
}


namespace gdn {
typedef short s16x8 __attribute__((ext_vector_type(8)));
typedef short s16x4 __attribute__((ext_vector_type(4)));
constexpr int QS = 0, QPITCH = 272;
constexpr int KS = QS + 64 * QPITCH;
constexpr int VS = KS + 64 * QPITCH;
constexpr int WS_ = VS + 64 * QPITCH;
constexpr int KT = WS_ + 64 * QPITCH, KTPITCH = 144;
constexpr int MB = KT + 128 * KTPITCH, MPITCH = 144;
constexpr int A2 = MB + 64 * MPITCH;
constexpr int MD = A2 + 64 * MPITCH;
constexpr int DV = MD + 4 * 16 * 17 * 4, DVPITCH = 40;
constexpr int TB = DV + 4 * 16 * DVPITCH;
constexpr int LDS_END = TB + 5 * 256;
static_assert(LDS_END <= LDS_STAGE, "gdn lds");

__device__ __forceinline__ s16x8 mk8(unsigned a, unsigned b, unsigned c, unsigned d) { u32x4 v; v.x = a; v.y = b; v.z = c; v.w = d; return __builtin_bit_cast(s16x8, v); }
__device__ __forceinline__ s16x8 cat8(u32x2 lo, u32x2 hi) { return mk8(lo.x, lo.y, hi.x, hi.y); }
__device__ __forceinline__ s16x4 mk4(unsigned a, unsigned b) { u32x2 v; v.x = a; v.y = b; return __builtin_bit_cast(s16x4, v); }

__device__ __forceinline__ void scan(LAS unsigned char* lds, const bf16_t* QK, const bf16_t* VP, const float* GB, bf16_t* OF, bf16_t* OB, int nseq) {
    const int tid = tidx(), w = __builtin_amdgcn_readfirstlane(tid >> 6), lane = tid & 63;
#define GDN_FRESH() int ln_ = lane; asm volatile("" : "+v"(ln_)); const int g = ln_ >> 4, n = ln_ & 15;
    LAS float* gam = (LAS float*)(lds + TB); LAS float* eg = gam + 64; LAS float* bg = gam + 128; LAS float* bt = gam + 192; LAS float* dl = gam + 256;
    const int nunits = nseq * 64;
    for (int unit = blockIdx.x; unit < nunits; unit += gridDim.x) {
        const int seq = unit >> 6, h = (unit >> 1) & 31, dir = unit & 1, hq = h >> 1;
        bf16_t* OD = dir ? OB : OF;
        f32x4 S[8];
#pragma unroll
        for (int i = 0; i < 8; ++i) S[i] = (f32x4){0.f, 0.f, 0.f, 0.f};
        u32x4 pq[2], pk[2], pv[2]; float pg = 0.f, pb = 0.f;
#define GDN_LOADG(c) do { _Pragma("unroll") for (int i_ = 0; i_ < 2; ++i_) { const int p_ = tid + 512 * i_, ir_ = p_ >> 4, c16_ = (p_ & 15) * 8; \
            const int st_ = (c) * 64 + ir_, pos_ = dir ? SEQ - 1 - st_ : st_; const size_t row_ = (size_t)seq * SEQ + pos_; \
            pq[i_] = *(const u32x4*)(QK + row_ * 4096 + hq * 128 + c16_); pk[i_] = *(const u32x4*)(QK + row_ * 4096 + 2048 + hq * 128 + c16_); pv[i_] = *(const u32x4*)(VP + row_ * 4096 + h * 128 + c16_); } \
            if (tid < 64) { const int st_ = (c) * 64 + tid, pos_ = dir ? SEQ - 1 - st_ : st_; const size_t row_ = (size_t)seq * SEQ + pos_; pg = GB[row_ * 128 + dir * 64 + h]; pb = GB[row_ * 128 + dir * 64 + 32 + h]; } } while (0)
#define GDN_STORE() do { _Pragma("unroll") for (int i_ = 0; i_ < 2; ++i_) { const int p_ = tid + 512 * i_, ir_ = p_ >> 4, c16_ = (p_ & 15) * 8; \
            *(LAS u32x4*)(lds + QS + ir_ * QPITCH + c16_ * 2) = pq[i_]; *(LAS u32x4*)(lds + KS + ir_ * QPITCH + c16_ * 2) = pk[i_]; *(LAS u32x4*)(lds + VS + ir_ * QPITCH + c16_ * 2) = pv[i_]; \
            const unsigned kw_[4] = {pk[i_].x, pk[i_].y, pk[i_].z, pk[i_].w}; \
            _Pragma("unroll") for (int e_ = 0; e_ < 4; ++e_) { *(LAS bf16_t*)(lds + KT + (c16_ + 2 * e_) * KTPITCH + ir_ * 2) = (bf16_t)(kw_[e_] & 0xffffu); *(LAS bf16_t*)(lds + KT + (c16_ + 2 * e_ + 1) * KTPITCH + ir_ * 2) = (bf16_t)(kw_[e_] >> 16); } } \
            if (tid < 64) { float gs_ = pg; _Pragma("unroll") for (int o_ = 1; o_ < 64; o_ <<= 1) { const float t_ = __shfl_up(gs_, o_); if (lane >= o_) gs_ += t_; } \
                const float gl_ = __shfl(gs_, 63), e_ = __expf(gs_); gam[tid] = gs_; eg[tid] = e_; bg[tid] = pb * e_; bt[tid] = pb; dl[tid] = __expf(gl_ - gs_); } } while (0)
        GDN_LOADG(0);
        __syncthreads();
        GDN_STORE();
        __syncthreads();
        for (int c = 0; c < 64; ++c) {
            { GDN_FRESH() const int rb = w & 3, cbp = w >> 2;
#pragma unroll
              for (int cc = 0; cc < 2; ++cc) { const int cb = cbp * 2 + cc;
                  f32x4 a1 = (f32x4){0.f, 0.f, 0.f, 0.f}, a2 = a1;
#pragma unroll
                  for (int ks = 0; ks < 4; ++ks) {
                      const s16x8 ak = *(const LAS s16x8*)(lds + KS + (16 * rb + n) * QPITCH + (32 * ks + 8 * g) * 2);
                      const s16x8 aq = *(const LAS s16x8*)(lds + QS + (16 * rb + n) * QPITCH + (32 * ks + 8 * g) * 2);
                      const s16x8 bk = *(const LAS s16x8*)(lds + KS + (16 * cb + n) * QPITCH + (32 * ks + 8 * g) * 2);
                      a1 = __builtin_amdgcn_mfma_f32_16x16x32_bf16(ak, bk, a1, 0, 0, 0);
                      a2 = __builtin_amdgcn_mfma_f32_16x16x32_bf16(aq, bk, a2, 0, 0, 0); }
                  const int j = 16 * cb + n; const float gj = gam[j];
#pragma unroll
                  for (int e = 0; e < 4; ++e) { const int i = 16 * rb + 4 * g + e; const float d = __expf(fminf(gam[i] - gj, 0.f));
                      const float mm = (j < i) ? a1[e] * d * bt[i] : 0.f, am = (j <= i) ? a2[e] * d : 0.f;
                      *(LAS bf16_t*)(lds + MB + i * MPITCH + j * 2) = f2bf(mm); *(LAS bf16_t*)(lds + A2 + i * MPITCH + j * 2) = f2bf(am);
                      if (cb == rb) *(LAS float*)(lds + MD + ((rb * 16 + 4 * g + e) * 17 + n) * 4) = mm; } } }
            __syncthreads();
            if (w < 4) { GDN_FRESH() const LAS float* N = (const LAS float*)(lds + MD + w * 16 * 17 * 4); float y[16];
#pragma unroll
                for (int j = 15; j >= 0; --j) { float s = (j == n) ? 1.f : 0.f;
#pragma unroll
                    for (int i = j + 1; i < 16; ++i) s -= y[i] * N[i * 17 + j];
                    y[j] = s; }
                float y4[4];
#pragma unroll
                for (int e = 0; e < 4; ++e) { float v = y[0];
#pragma unroll
                    for (int q = 1; q < 16; ++q) v = (4 * g + e == q) ? y[q] : v;
                    y4[e] = v; }
                u32x2 dv; dv.x = pk2(y4[0], y4[1]); dv.y = pk2(y4[2], y4[3]);
                *(LAS u32x2*)(lds + DV + (w * 16 + n) * DVPITCH + 4 * g * 2) = dv; }
            __syncthreads();
            f32x4 xw[4], u[4];
            { GDN_FRESH()
#pragma unroll
            for (int b = 0; b < 4; ++b) {
                f32x4 aw, au;
#pragma unroll
                for (int e = 0; e < 4; ++e) { const int i = 16 * b + 4 * g + e;
                    aw[e] = bf2f(*(const LAS bf16_t*)(lds + KS + i * QPITCH + (16 * w + n) * 2)) * bg[i];
                    au[e] = bf2f(*(const LAS bf16_t*)(lds + VS + i * QPITCH + (16 * w + n) * 2)) * bt[i]; }
#pragma unroll
                for (int j = 0; j < 4; ++j) if (j < b) {
                    const s16x4 am = *(const LAS s16x4*)(lds + MB + (16 * b + n) * MPITCH + (16 * j + 4 * g) * 2);
                    const s16x4 bw = mk4(pk2(xw[j][0], xw[j][1]) ^ 0x80008000u, pk2(xw[j][2], xw[j][3]) ^ 0x80008000u);
                    const s16x4 bu = mk4(pk2(u[j][0], u[j][1]) ^ 0x80008000u, pk2(u[j][2], u[j][3]) ^ 0x80008000u);
                    aw = __builtin_amdgcn_mfma_f32_16x16x16bf16_1k(am, bw, aw, 0, 0, 0);
                    au = __builtin_amdgcn_mfma_f32_16x16x16bf16_1k(am, bu, au, 0, 0, 0); }
                const s16x4 ad = *(const LAS s16x4*)(lds + DV + (b * 16 + n) * DVPITCH + 4 * g * 2);
                xw[b] = __builtin_amdgcn_mfma_f32_16x16x16bf16_1k(ad, mk4(pk2(aw[0], aw[1]), pk2(aw[2], aw[3])), (f32x4){0.f, 0.f, 0.f, 0.f}, 0, 0, 0);
                u[b]  = __builtin_amdgcn_mfma_f32_16x16x16bf16_1k(ad, mk4(pk2(au[0], au[1]), pk2(au[2], au[3])), (f32x4){0.f, 0.f, 0.f, 0.f}, 0, 0, 0);
#pragma unroll
                for (int e = 0; e < 4; ++e) *(LAS bf16_t*)(lds + WS_ + (16 * b + 4 * g + e) * QPITCH + (16 * w + n) * 2) = f2bf(xw[b][e]);
                __builtin_amdgcn_sched_barrier(0);
            } }
            __syncthreads();
            if (c + 1 < 64) GDN_LOADG(c + 1);
            s16x8 Sb[4];
#pragma unroll
            for (int ks = 0; ks < 4; ++ks) Sb[ks] = mk8(pk2(S[2 * ks][0], S[2 * ks][1]), pk2(S[2 * ks][2], S[2 * ks][3]), pk2(S[2 * ks + 1][0], S[2 * ks + 1][1]), pk2(S[2 * ks + 1][2], S[2 * ks + 1][3]));
            { GDN_FRESH()
#pragma unroll
            for (int rb = 0; rb < 4; ++rb) {
#pragma unroll
                for (int ks = 0; ks < 4; ++ks) {
                    const LAS unsigned char* wp = lds + WS_ + (16 * rb + n) * QPITCH + (32 * ks + 4 * g) * 2;
                    const s16x8 aw = cat8(*(const LAS u32x2*)wp, *(const LAS u32x2*)(wp + 32));
                    const u32x4 sv = __builtin_bit_cast(u32x4, Sb[ks]);
                    const s16x8 sneg = mk8(sv.x ^ 0x80008000u, sv.y ^ 0x80008000u, sv.z ^ 0x80008000u, sv.w ^ 0x80008000u);
                    u[rb] = __builtin_amdgcn_mfma_f32_16x16x32_bf16(aw, sneg, u[rb], 0, 0, 0); }
                __builtin_amdgcn_sched_barrier(0); } }
            s16x8 Ub[2], Ud[2];
            { GDN_FRESH()
#pragma unroll
            for (int ks = 0; ks < 2; ++ks) {
                Ub[ks] = mk8(pk2(u[2 * ks][0], u[2 * ks][1]), pk2(u[2 * ks][2], u[2 * ks][3]), pk2(u[2 * ks + 1][0], u[2 * ks + 1][1]), pk2(u[2 * ks + 1][2], u[2 * ks + 1][3]));
                const f32x4 d0 = *(const LAS f32x4*)(dl + 32 * ks + 4 * g), d1 = *(const LAS f32x4*)(dl + 32 * ks + 16 + 4 * g);
                Ud[ks] = mk8(pk2(u[2 * ks][0] * d0[0], u[2 * ks][1] * d0[1]), pk2(u[2 * ks][2] * d0[2], u[2 * ks][3] * d0[3]),
                             pk2(u[2 * ks + 1][0] * d1[0], u[2 * ks + 1][1] * d1[1]), pk2(u[2 * ks + 1][2] * d1[2], u[2 * ks + 1][3] * d1[3])); } }
            { GDN_FRESH()
#pragma unroll
            for (int rb = 0; rb < 4; ++rb) { f32x4 oa = (f32x4){0.f, 0.f, 0.f, 0.f}, o2 = oa;
#pragma unroll
                for (int ks = 0; ks < 4; ++ks) { const LAS unsigned char* qp = lds + QS + (16 * rb + n) * QPITCH + (32 * ks + 4 * g) * 2;
                    o2 = __builtin_amdgcn_mfma_f32_16x16x32_bf16(cat8(*(const LAS u32x2*)qp, *(const LAS u32x2*)(qp + 32)), Sb[ks], o2, 0, 0, 0); }
#pragma unroll
                for (int ks = 0; ks < 2; ++ks) { const LAS unsigned char* ap = lds + A2 + (16 * rb + n) * MPITCH + (32 * ks + 4 * g) * 2;
                    oa = __builtin_amdgcn_mfma_f32_16x16x32_bf16(cat8(*(const LAS u32x2*)ap, *(const LAS u32x2*)(ap + 32)), Ub[ks], oa, 0, 0, 0); }
#pragma unroll
                for (int e = 0; e < 4; ++e) { const int i = 16 * rb + 4 * g + e, st = c * 64 + i, pos = dir ? SEQ - 1 - st : st;
                    OD[((size_t)seq * SEQ + pos) * 4096 + h * 128 + 16 * w + n] = f2bf(eg[i] * o2[e] + oa[e]); }
                __builtin_amdgcn_sched_barrier(0); } }
            { GDN_FRESH() const float egl = eg[63];
#pragma unroll
              for (int sb = 0; sb < 8; ++sb) { f32x4 acc = S[sb] * egl;
#pragma unroll
                  for (int ks = 0; ks < 2; ++ks) { const LAS unsigned char* kp = lds + KT + (16 * sb + n) * KTPITCH + (32 * ks + 4 * g) * 2;
                      acc = __builtin_amdgcn_mfma_f32_16x16x32_bf16(cat8(*(const LAS u32x2*)kp, *(const LAS u32x2*)(kp + 32)), Ud[ks], acc, 0, 0, 0); }
                  S[sb] = acc; __builtin_amdgcn_sched_barrier(0); } }
            __syncthreads();
            if (c + 1 < 64) GDN_STORE();
            __syncthreads();
        }
#undef GDN_LOADG
#undef GDN_STORE
#undef GDN_FRESH
    }
}
}

namespace na {
typedef short s16x8 __attribute__((ext_vector_type(8)));
constexpr int VPITCH = 288;
constexpr int VRING = 0, RPB = 512 * VPITCH;
constexpr int LDS_END = RPB + 15 * 31 * 4 + 4;
__device__ __forceinline__ s16x8 mk8(unsigned a, unsigned b, unsigned c, unsigned d) { u32x4 v; v.x = a; v.y = b; v.z = c; v.w = d; return __builtin_bit_cast(s16x8, v); }

__device__ __forceinline__ void attention(ArgsCP a, LAS unsigned char* lds, const bf16_t* QKV, bf16_t* AO) {
    const int tid = tidx(), w = __builtin_amdgcn_readfirstlane(tid >> 6), lane = tid & 63, g = lane >> 4, n = lane & 15;
    const int j = w & 3, hh = w >> 2;
    const int c0 = min(max(16 * j - 8, 0), 32), qcol = 16 * j + n, cs = min(max(qcol - 8, 0), 48);
    LAS float* rpbs = (LAS float*)(lds + RPB);
    const int nitems = NSEQ * 16 * 64, G = gridDim.x;
    const int per = (nitems + G - 1) / G, it0 = blockIdx.x * per, it1 = min(nitems, it0 + per);
    int cur_sh = -1, have_lo = 0, have_hi = 0;
    const unsigned vbase = (unsigned)(size_t)(lds + VRING);
    for (int it = it0; it < it1; ++it) {
        const int sh = it >> 6, r = it & 63, seq = sh >> 4, h = sh & 15, r0 = min(max(r - 4, 0), 56);
        const size_t tbase = (size_t)seq * SEQ;
        __syncthreads();
        if (sh != cur_sh) { cur_sh = sh; have_lo = have_hi = 0; for (int i = tid; i < 15 * 31; i += NTHR) rpbs[i] = a->in[10][h * 465 + i]; }
        { int lo = r0, hi = r0 + 8; if (have_hi > lo && have_lo <= lo) lo = have_hi;
          for (int kr = lo; kr < hi; ++kr) {
#pragma unroll
              for (int i = 0; i < 2; ++i) { const int p = tid + 512 * i, col = p >> 4, c16 = (p & 15) * 8;
                  const u32x4 v = *(const u32x4*)(QKV + (tbase + kr * 64 + col) * 6144 + 4096 + h * 128 + c16);
                  *(LAS u32x4*)(lds + VRING + ((kr & 7) * 64 + col) * VPITCH + c16 * 2) = v; } }
          have_lo = r0; have_hi = r0 + 8; }
        s16x8 qf[4];
        { const bf16_t* qp = QKV + (tbase + r * 64 + qcol) * 6144 + h * 128 + 8 * g;
#pragma unroll
          for (int ks = 0; ks < 4; ++ks) qf[ks] = *(const s16x8*)(qp + 32 * ks); }
        f32x4 sacc[16];
        const bf16_t* kp0 = QKV + (tbase + r0 * 64 + c0 + n) * 6144 + 2048 + h * 128 + 8 * g;
#pragma unroll
        for (int kb = 0; kb < 16; ++kb) {
            const bf16_t* kp = kp0 + (size_t)((kb >> 1) * 64 + (kb & 1) * 16) * 6144;
            s16x8 kf[4];
#pragma unroll
            for (int ks = 0; ks < 4; ++ks) kf[ks] = *(const s16x8*)(kp + 32 * ks);
            f32x4 acc = (f32x4){0.f, 0.f, 0.f, 0.f};
#pragma unroll
            for (int ks = 0; ks < 4; ++ks) acc = __builtin_amdgcn_mfma_f32_16x16x32_bf16(kf[ks], qf[ks], acc, 0, 0, 0);
            sacc[kb] = acc;
        }
        __syncthreads();
        float mx = -1e30f;
#pragma unroll
        for (int kb = 0; kb < 16; ++kb) { const int aw = kb >> 1, dr = r0 + aw - r + 7;
#pragma unroll
            for (int e = 0; e < 4; ++e) { const int kc = c0 + 16 * (kb & 1) + 4 * g + e; const bool valid = (kc >= cs) && (kc < cs + 16);
                const int dc = min(max(kc - qcol + 15, 0), 30);
                const float s = valid ? sacc[kb][e] + rpbs[dr * 31 + dc] : -1e30f; sacc[kb][e] = s; mx = fmaxf(mx, s); } }
        mx = fmaxf(mx, __shfl_xor(mx, 16)); mx = fmaxf(mx, __shfl_xor(mx, 32));
        float sum = 0.f;
#pragma unroll
        for (int kb = 0; kb < 16; ++kb)
#pragma unroll
            for (int e = 0; e < 4; ++e) { const float p = __expf(sacc[kb][e] - mx); sacc[kb][e] = p; sum += p; }
        sum += __shfl_xor(sum, 16); sum += __shfl_xor(sum, 32);
        const float inv = 1.0f / sum;
        s16x8 pb[8];
#pragma unroll
        for (int kp = 0; kp < 8; ++kp) pb[kp] = mk8(pk2(sacc[2 * kp][0], sacc[2 * kp][1]), pk2(sacc[2 * kp][2], sacc[2 * kp][3]), pk2(sacc[2 * kp + 1][0], sacc[2 * kp + 1][1]), pk2(sacc[2 * kp + 1][2], sacc[2 * kp + 1][3]));
#pragma unroll
        for (int ci = 0; ci < 4; ++ci) { const int c = 4 * hh + ci;
            u32x2 vt[16];
            { const unsigned lanepart = (unsigned)((4 * g + (n >> 2)) * VPITCH + (16 * c + 4 * (n & 3)) * 2);
              unsigned ad[8];
#pragma unroll
              for (int kp = 0; kp < 8; ++kp) ad[kp] = vbase + (unsigned)((((r0 + kp) & 7) * 64 + c0) * VPITCH) + lanepart;
              asm volatile("ds_read_b64_tr_b16 %0, %16\n\tds_read_b64_tr_b16 %1, %16 offset:4608\n\tds_read_b64_tr_b16 %2, %17\n\tds_read_b64_tr_b16 %3, %17 offset:4608\n\t"
                           "ds_read_b64_tr_b16 %4, %18\n\tds_read_b64_tr_b16 %5, %18 offset:4608\n\tds_read_b64_tr_b16 %6, %19\n\tds_read_b64_tr_b16 %7, %19 offset:4608\n\t"
                           "ds_read_b64_tr_b16 %8, %20\n\tds_read_b64_tr_b16 %9, %20 offset:4608\n\tds_read_b64_tr_b16 %10, %21\n\tds_read_b64_tr_b16 %11, %21 offset:4608\n\t"
                           "ds_read_b64_tr_b16 %12, %22\n\tds_read_b64_tr_b16 %13, %22 offset:4608\n\tds_read_b64_tr_b16 %14, %23\n\tds_read_b64_tr_b16 %15, %23 offset:4608\n\t"
                           "s_waitcnt lgkmcnt(0)"
                           : "=&v"(vt[0]), "=&v"(vt[1]), "=&v"(vt[2]), "=&v"(vt[3]), "=&v"(vt[4]), "=&v"(vt[5]), "=&v"(vt[6]), "=&v"(vt[7]),
                             "=&v"(vt[8]), "=&v"(vt[9]), "=&v"(vt[10]), "=&v"(vt[11]), "=&v"(vt[12]), "=&v"(vt[13]), "=&v"(vt[14]), "=&v"(vt[15])
                           : "v"(ad[0]), "v"(ad[1]), "v"(ad[2]), "v"(ad[3]), "v"(ad[4]), "v"(ad[5]), "v"(ad[6]), "v"(ad[7]) : "memory"); }
            f32x4 oacc = (f32x4){0.f, 0.f, 0.f, 0.f};
#pragma unroll
            for (int kp = 0; kp < 8; ++kp) oacc = __builtin_amdgcn_mfma_f32_16x16x32_bf16(mk8(vt[2 * kp].x, vt[2 * kp].y, vt[2 * kp + 1].x, vt[2 * kp + 1].y), pb[kp], oacc, 0, 0, 0);
            u32x2 ov; ov.x = pk2(oacc[0] * inv, oacc[1] * inv); ov.y = pk2(oacc[2] * inv, oacc[3] * inv);
            *(u32x2*)(AO + (tbase + r * 64 + qcol) * D + h * 128 + 16 * c + 4 * g) = ov;
        }
    }
}
}

namespace s5 {
typedef short s16x8 __attribute__((ext_vector_type(8)));
typedef short s16x4 __attribute__((ext_vector_type(4)));
constexpr int XPITCH = 40, WAVE_LDS = 128 * XPITCH;
__device__ __forceinline__ void cpow(float are_dt, float aim_dt, float k, float& pr, float& pi) { const float e = expf(are_dt * k); float s, c; sincosf(aim_dt * k, &s, &c); pr = e * c; pi = e * s; }

__device__ __forceinline__ void scan(ArgsCP a, LAS unsigned char* lds, const float* X, const rs_t* rs, float* YF, bf16_t* Y) {
    const int tid = tidx(), w = __builtin_amdgcn_readfirstlane(tid >> 6), lane = tid & 63, g = lane >> 4, n = lane & 15;
    LAS unsigned char* xl = lds + w * WAVE_LDS;
    const unsigned xbase = (unsigned)(size_t)xl;
    const float* gmix = a->in[4] + 3 * D;
    for (int task = blockIdx.x * 8 + w; task < NSEQ * 128; task += gridDim.x * 8) {
        const int seq = task >> 7, gr = task & 127;
        const f32x4 gm4 = *(const f32x4*)(gmix + gr * 16 + 4 * g);
        const float gmn = gmix[gr * 16 + n], dsk = a->in[29][gr * 16 + n];
        for (int dir = 0; dir < 2; ++dir) {
            const int dg = dir * 128 + gr;
            const float dt = expf(a->in[24][dg]);
            float a1r[4], a1i[4], a4r[4], a4i[4], a8r[4], a8i[4], agr[4], agi[4];
            s16x4 bfr[8]; s16x8 cfr[4];
#pragma unroll
            for (int pb = 0; pb < 4; ++pb) { const int p = 16 * pb + n;
                const float are = a->in[22][dg * 64 + p], aim = a->in[23][dg * 64 + p], ad = are * dt, ai = aim * dt;
                cpow(ad, ai, 1.f, a1r[pb], a1i[pb]); cpow(ad, ai, 4.f, a4r[pb], a4i[pb]);
                cpow(ad, ai, 8.f, a8r[pb], a8i[pb]); cpow(ad, ai, (float)(4 * g), agr[pb], agi[pb]);
                const float den = 1.0f / (are * are + aim * aim);
                const float cr = ((a1r[pb] - 1.0f) * are + a1i[pb] * aim) * den, ci = (a1i[pb] * are - (a1r[pb] - 1.0f) * aim) * den;
                const f32x4 bre = *(const f32x4*)(a->in[25] + ((size_t)dg * 64 + p) * 16 + 4 * g), bim = *(const f32x4*)(a->in[26] + ((size_t)dg * 64 + p) * 16 + 4 * g);
                float br[4], bi[4];
#pragma unroll
                for (int e = 0; e < 4; ++e) { br[e] = cr * bre[e] - ci * bim[e]; bi[e] = cr * bim[e] + ci * bre[e]; }
                u32x2 t0; t0.x = pk2(br[0], br[1]); t0.y = pk2(br[2], br[3]); bfr[pb] = __builtin_bit_cast(s16x4, t0);
                u32x2 t1; t1.x = pk2(bi[0], bi[1]); t1.y = pk2(bi[2], bi[3]); bfr[4 + pb] = __builtin_bit_cast(s16x4, t1); }
#pragma unroll
            for (int ks = 0; ks < 4; ++ks) { const int p0 = 32 * ks + 8 * g; const bool im = p0 >= 64;
                const float* src = (im ? a->in[28] : a->in[27]) + ((size_t)dg * 16 + n) * 64 + (p0 & 63);
                const f32x4 c0 = *(const f32x4*)src, c1 = *(const f32x4*)(src + 4); const float sg = im ? -1.f : 1.f;
                u32x4 t; t.x = pk2(c0[0] * sg, c0[1] * sg); t.y = pk2(c0[2] * sg, c0[3] * sg); t.z = pk2(c1[0] * sg, c1[1] * sg); t.w = pk2(c1[2] * sg, c1[3] * sg);
                cfr[ks] = __builtin_bit_cast(s16x8, t); }
            float xpr[4], xpi[4];
#pragma unroll
            for (int pb = 0; pb < 4; ++pb) { xpr[pb] = 0.f; xpi[pb] = 0.f; }
            f32x4 un; rs_t rn;
            { const int pos = dir ? SEQ - 1 - n : n; const size_t row = (size_t)seq * SEQ + pos; un = *(const f32x4*)(X + row * D + gr * 16 + 4 * g); rn = rs[row]; }
            for (int blk = 0; blk < SEQ / 16; ++blk) {
                const f32x4 uc = un; const float rsd = rstd_of(rn);
                if (blk + 1 < SEQ / 16) { const int st = (blk + 1) * 16 + n, pos = dir ? SEQ - 1 - st : st; const size_t row = (size_t)seq * SEQ + pos; un = *(const f32x4*)(X + row * D + gr * 16 + 4 * g); rn = rs[row]; }
                u32x2 uf; uf.x = pk2(uc[0] * gm4[0] * rsd, uc[1] * gm4[1] * rsd); uf.y = pk2(uc[2] * gm4[2] * rsd, uc[3] * gm4[3] * rsd);
                const s16x4 ua = __builtin_bit_cast(s16x4, uf);
                f32x4 bu[8];
#pragma unroll
                for (int q = 0; q < 8; ++q) bu[q] = __builtin_amdgcn_mfma_f32_16x16x16bf16_1k(ua, bfr[q], (f32x4){0.f, 0.f, 0.f, 0.f}, 0, 0, 0);
#pragma unroll
                for (int pb = 0; pb < 4; ++pb) {
                    float Lr = bu[pb][0], Li = bu[4 + pb][0];
#pragma unroll
                    for (int e = 1; e < 4; ++e) { const float tr = a1r[pb] * Lr - a1i[pb] * Li + bu[pb][e], ti = a1r[pb] * Li + a1i[pb] * Lr + bu[4 + pb][e]; Lr = tr; Li = ti; }
                    { const float tr = __shfl(Lr, lane - 16), ti = __shfl(Li, lane - 16); if (g >= 1) { Lr += a4r[pb] * tr - a4i[pb] * ti; Li += a4r[pb] * ti + a4i[pb] * tr; } }
                    { const float tr = __shfl(Lr, lane - 32), ti = __shfl(Li, lane - 32); if (g >= 2) { Lr += a8r[pb] * tr - a8i[pb] * ti; Li += a8r[pb] * ti + a8i[pb] * tr; } }
                    float cr = agr[pb] * xpr[pb] - agi[pb] * xpi[pb], ci = agr[pb] * xpi[pb] + agi[pb] * xpr[pb];
                    { const float tr = __shfl(Lr, lane - 16), ti = __shfl(Li, lane - 16); if (g >= 1) { cr += tr; ci += ti; } }
                    float xr[4], xi[4];
#pragma unroll
                    for (int e = 0; e < 4; ++e) { const float pr = e ? xr[e - 1] : cr, pi = e ? xi[e - 1] : ci; xr[e] = a1r[pb] * pr - a1i[pb] * pi + bu[pb][e]; xi[e] = a1r[pb] * pi + a1i[pb] * pr + bu[4 + pb][e]; }
                    xpr[pb] = __shfl(xr[3], 48 + n); xpi[pb] = __shfl(xi[3], 48 + n);
                    u32x2 wr_; wr_.x = pk2(xr[0], xr[1]); wr_.y = pk2(xr[2], xr[3]); *(LAS u32x2*)(xl + (16 * pb + n) * XPITCH + 8 * g) = wr_;
                    u32x2 wi_; wi_.x = pk2(xi[0], xi[1]); wi_.y = pk2(xi[2], xi[3]); *(LAS u32x2*)(xl + (64 + 16 * pb + n) * XPITCH + 8 * g) = wi_;
                    __builtin_amdgcn_sched_barrier(0);
                }
                u32x2 xt[8];
                { const unsigned ad = xbase + (unsigned)((8 * g + (n >> 2)) * XPITCH + 8 * (n & 3));
                  asm volatile("s_waitcnt lgkmcnt(0)\n\tds_read_b64_tr_b16 %0, %8\n\tds_read_b64_tr_b16 %1, %8 offset:160\n\tds_read_b64_tr_b16 %2, %8 offset:1280\n\tds_read_b64_tr_b16 %3, %8 offset:1440\n\t"
                               "ds_read_b64_tr_b16 %4, %8 offset:2560\n\tds_read_b64_tr_b16 %5, %8 offset:2720\n\tds_read_b64_tr_b16 %6, %8 offset:3840\n\tds_read_b64_tr_b16 %7, %8 offset:4000\n\t"
                               "s_waitcnt lgkmcnt(0)"
                               : "=&v"(xt[0]), "=&v"(xt[1]), "=&v"(xt[2]), "=&v"(xt[3]), "=&v"(xt[4]), "=&v"(xt[5]), "=&v"(xt[6]), "=&v"(xt[7]) : "v"(ad) : "memory"); }
                f32x4 y = (f32x4){0.f, 0.f, 0.f, 0.f};
#pragma unroll
                for (int ks = 0; ks < 4; ++ks) { u32x4 t; t.x = xt[2 * ks].x; t.y = xt[2 * ks].y; t.z = xt[2 * ks + 1].x; t.w = xt[2 * ks + 1].y;
                    y = __builtin_amdgcn_mfma_f32_16x16x32_bf16(__builtin_bit_cast(s16x8, t), cfr[ks], y, 0, 0, 0); }
#pragma unroll
                for (int e = 0; e < 4; ++e) { const int st = blk * 16 + 4 * g + e, pos = dir ? SEQ - 1 - st : st; const size_t row = (size_t)seq * SEQ + pos;
                    if (dir == 0) YF[row * D + gr * 16 + n] = y[e];
                    else { const float hv = X[row * D + gr * 16 + n] * rstd_of(rs[row]) * gmn; Y[row * D + gr * 16 + n] = f2bf(geluf_(y[e] + YF[row * D + gr * 16 + n] + dsk * hv)); } }
            }
        }
    }
}
}
#ifndef MK_SINGLE
#define MK_SINGLE 1
#endif
constexpr int NPH = 38;

__global__ void __launch_bounds__(NTHR, 2) mk_fwd(Args a_unused) {
    extern __shared__ __attribute__((aligned(16))) unsigned char lds_raw[];
    LAS unsigned char* lds = (LAS unsigned char*)lds_raw;
    int ph_lo, ph_hi;
    XcdBarrier bar;
    { ArgsCP a0 = argp(); ph_lo = a0->ph_lo; ph_hi = a0->ph_hi;
      bar.bar = (unsigned*)(a0->ws + WS_CTL); bar.x = 0; bar.st = (volatile LAS unsigned*)(lds + LDS_BAR);
      if (ph_hi - ph_lo > 1) {
          if (threadIdx.x < 4) ((LAS unsigned*)(lds + LDS_BAR))[threadIdx.x] = 0u;
          __syncthreads();
          bar = xcd_barrier_post((unsigned*)(a0->ws + WS_CTL), (volatile LAS unsigned*)(lds + LDS_BAR));
      } }
    int ph = 0;
#define PH_BEGIN if (ph >= ph_lo && ph < ph_hi) { ArgsCP a = argp(); unsigned char* ws = a->ws; float* X = a->out; rs_t* RS = (rs_t*)(ws + WS_RS); \
        bf16_t* XB0 = (bf16_t*)(ws + WS_XB0); bf16_t* XB1 = (bf16_t*)(ws + WS_XB1); unsigned char* BIG = ws + WS_BIG; (void)X; (void)RS; (void)XB0; (void)XB1; (void)BIG;
#define PH_END   } if (ph >= ph_lo && ph + 1 < ph_hi) xcd_barrier(bar); ++ph;
#define RSB(k) (RS + (size_t)(k) * T)

    PH_BEGIN prologue(a, lds); PH_END

#define FFN_PLE(L, XBc, XBo) \
    PH_BEGIN { EpiFfn E{(bf16_t*)(BIG + BIG_HID2), (bf16_t*)(BIG + BIG_EDGE), RSB(3 * (L) + 1), a->in[32] + (size_t)(L) * 3 * DFF, a->in[33] + (size_t)(L) * DFF}; \
               run_gemm(lds, XBc, (const bf16_t*)(ws + WS_WGU + (L) * SZ_WGU), T, 2 * DFF, D, E); } PH_END \
    PH_BEGIN { ffn_fixup(a, (L), (const bf16_t*)(BIG + BIG_EDGE), (bf16_t*)(BIG + BIG_HID2)); \
               EpiScale E{XBo, D, nullptr, nullptr, -1}; \
               run_gemm(lds, (const bf16_t*)(ws + WS_PB) + (size_t)(L) * T * PLED, (const bf16_t*)(ws + WS_WPP + (L) * SZ_WPP), T, D, PLED, E); } PH_END \
    PH_BEGIN { EpiResid E{X, XBc, RSB(3 * (L) + 2)}; \
               run_gemm(lds, (const bf16_t*)(BIG + BIG_HID2), (const bf16_t*)(ws + WS_WDN + (L) * SZ_WDN), T, D, DFF, E); } PH_END \
    PH_BEGIN { EpiPle E{X, XBo, RSB(3 * (L) + 3), RSB(3 * (L) + 2), XBo}; \
               run_gemm(lds, XBc, (const bf16_t*)(ws + WS_WPG + (L) * SZ_WPG), T, D, D, E); } PH_END

    PH_BEGIN { EpiScale E{(bf16_t*)BIG, 6144, RSB(0), nullptr, -1}; run_gemm(lds, XB0, (const bf16_t*)(ws + WS_NAQ), T, 6144, D, E); } PH_END
    PH_BEGIN na::attention(a, lds, (const bf16_t*)BIG, XB1); PH_END
    PH_BEGIN { EpiResid E{X, XB0, RSB(1)}; run_gemm(lds, XB1, (const bf16_t*)(ws + WS_NAO), T, D, D, E); } PH_END
    FFN_PLE(0, XB0, XB1)
    PH_BEGIN { EpiGelu E{(bf16_t*)BIG, 4096, RSB(3), RSB(13), 8}; run_gemm(lds, XB1, (const bf16_t*)(ws + WS_SGI), T, 4096, D, E); } PH_END
    PH_BEGIN sgu_mix(a, lds, (const bf16_t*)BIG, RSB(13), XB0); PH_END
    PH_BEGIN { EpiResid E{X, XB1, RSB(4)}; run_gemm(lds, XB0, (const bf16_t*)(ws + WS_SGO), T, D, D, E); } PH_END
    FFN_PLE(1, XB1, XB0)
#pragma unroll 1
    for (int gg = 0; gg < NGG; ++gg) {
        const size_t r0 = (size_t)gg * GG_ROWS;
#define GDN_PTRS bf16_t* PROJ = (bf16_t*)(BIG + BIG_PROJ); bf16_t* OF = PROJ; bf16_t* OB = (bf16_t*)(BIG + BIG_OB); bf16_t* VP = (bf16_t*)(BIG + BIG_VP); \
        float* AB = (float*)(BIG + BIG_AB); float* GB = (float*)(BIG + BIG_GB); bf16_t* QK = XB1; (void)PROJ; (void)OF; (void)OB; (void)VP; (void)AB; (void)GB; (void)QK;
        PH_BEGIN { GDN_PTRS EpiScale E{PROJ, 8192, RSB(6) + r0, AB, 32}; run_gemm(lds, XB0 + r0 * D, (const bf16_t*)(ws + WS_GDI), GG_ROWS, GDI_N1, D, E); } PH_END
        PH_BEGIN { GDN_PTRS gdn_conv(a, PROJ, AB, QK, VP, GB, GG_ROWS); } PH_END
        PH_BEGIN { GDN_PTRS gdn::scan(lds, QK, VP, GB, OF, OB, GG_ROWS / SEQ); } PH_END
        PH_BEGIN { GDN_PTRS gdn_sumnorm(a, OF, OB, GG_ROWS); } PH_END
        PH_BEGIN { GDN_PTRS EpiGdnZ E{OF, 4096, RSB(6) + r0}; run_gemm(lds, XB0 + r0 * D, (const bf16_t*)(ws + WS_GDI) + (size_t)GDI_N1 * D, GG_ROWS, 4096, D, E); } PH_END
        PH_BEGIN { GDN_PTRS EpiResid E{X + r0 * D, XB0 + r0 * D, RSB(7) + r0}; run_gemm(lds, OF, (const bf16_t*)(ws + WS_GDO), GG_ROWS, D, 4096, E); } PH_END
    }
    FFN_PLE(2, XB0, XB1)
    PH_BEGIN s5::scan(a, lds, X, RSB(9), (float*)BIG, XB0); PH_END
    PH_BEGIN { EpiGlu E{X, XB1, RSB(10)}; run_gemm(lds, XB0, (const bf16_t*)(ws + WS_S5G), T, 4096, D, E); } PH_END
    FFN_PLE(3, XB1, XB0)
    PH_BEGIN final_norm(a, RSB(12)); PH_END
}
}

extern "C" void kernel_launch(void* const* d_in, const int* in_sizes, int n_in, void* d_out, int out_size, void* d_ws, size_t ws_size, hipStream_t stream) {
    using namespace mk;
    static int grid = 0;
    if (grid == 0) {
        if (n_in != 37 || out_size != T * D || ws_size < WS_END) { fprintf(stderr, "kernel_launch: unexpected problem (n_in %d, out %d, ws %zu < %zu)\n", n_in, out_size, ws_size, (size_t)WS_END); grid = -1; return; }
        int dev = 0, cus = 0;
        if (hipGetDevice(&dev) != hipSuccess || hipDeviceGetAttribute(&cus, hipDeviceAttributeMultiprocessorCount, dev) != hipSuccess) { grid = -1; return; }
        if (hipFuncSetAttribute((const void*)mk_fwd, hipFuncAttributeMaxDynamicSharedMemorySize, LDS_BYTES) != hipSuccess) { fprintf(stderr, "kernel_launch: hipFuncSetAttribute failed\n"); grid = -1; return; }
        int per_cu = 0;
        if (hipOccupancyMaxActiveBlocksPerMultiprocessor(&per_cu, (const void*)mk_fwd, NTHR, LDS_BYTES) != hipSuccess || per_cu < 1) fprintf(stderr, "kernel_launch: occupancy query says %d\n", per_cu);
        (void)hipGetLastError();
        grid = cus > 0 ? cus : 256;
    }
    if (grid < 0) return;
    (void)hipMemsetAsync(d_ws, 0, ZERO_BYTES, stream);
    Args a{};
    for (int i = 0; i < 37; ++i) a.in[i] = (const float*)d_in[i];
    a.out = (float*)d_out; a.ws = (unsigned char*)d_ws;
#if MK_SINGLE
    a.ph_lo = 0; a.ph_hi = NPH;
    hipLaunchKernelGGL(mk_fwd, dim3(grid), dim3(NTHR), LDS_BYTES, stream, a);
#else
    for (int p = 0; p < NPH; ++p) { a.ph_lo = p; a.ph_hi = p + 1; hipLaunchKernelGGL(mk_fwd, dim3(grid), dim3(NTHR), LDS_BYTES, stream, a); }
#endif
}
```

```cpp
#include <hip/hip_runtime.h>
#include <cstdio>
#include <cstdint>
#define XB_TMO      128
#define XB_XCNT(j)  (256  + 64 * (j))
#define XB_XSUB(j)  (1280 + 64 * (j))
#define XB_XGEN(j)  (2304 + 64 * (j))
#define XB_TOP      3328
#define XB_TOPGEN   3392
#define XCD_BAR_WORDS 3456
#define XB_SPIN_CAP (1u << 18)
#define LAS __attribute__((address_space(3)))

__device__ __forceinline__ unsigned xb_ld(unsigned* p)              { return __hip_atomic_load(p, __ATOMIC_RELAXED, __HIP_MEMORY_SCOPE_AGENT); }
__device__ __forceinline__ unsigned xb_add(unsigned* p, unsigned v) { return __hip_atomic_fetch_add(p, v, __ATOMIC_RELAXED, __HIP_MEMORY_SCOPE_AGENT); }
__device__ __forceinline__ unsigned xb_xcc_id() { return (unsigned)__builtin_amdgcn_s_getreg((3 << 11) | 20) & 0xFu; }
#define XB_SPIN(cond, bar) do { unsigned _sp = 0; while (cond) { __builtin_amdgcn_s_sleep(1); \
    if ((++_sp & 255u) == 0u) { if (xb_ld(&(bar)[XB_TMO])) break; if (_sp > XB_SPIN_CAP) { atomicAdd(&(bar)[XB_TMO], 1u); break; } } } } while (0)

struct XcdBarrier {
    unsigned* bar; unsigned x;
    volatile LAS unsigned* st;
};

__device__ __forceinline__ XcdBarrier xcd_barrier_post(unsigned* bar, volatile LAS unsigned* st) {
    XcdBarrier b; b.bar = bar; b.x = xb_xcc_id(); b.st = st;
    if (threadIdx.x == 0) (void)xb_add(&bar[XB_XCNT(b.x)], 1u);
    return b;
}
__device__ __forceinline__ void xcd_barrier_complete(unsigned* bar, unsigned x, unsigned& nloc, unsigned& nx) {
    const unsigned G = gridDim.x * gridDim.y * gridDim.z;
    unsigned sum, cnt, mine, sp = 0u;
    for (;;) {
        sum = 0u; cnt = 0u; mine = 0u;
#pragma unroll
        for (unsigned j = 0; j < 16; ++j) { const unsigned c = xb_ld(&bar[XB_XCNT(j)]); sum += c; cnt += (c > 0u) ? 1u : 0u; mine = (j == x) ? c : mine; }
        if (sum == G) break;
        __builtin_amdgcn_s_sleep(1);
        if ((++sp & 255u) == 0u) { if (xb_ld(&bar[XB_TMO])) break; if (sp > XB_SPIN_CAP) { atomicAdd(&bar[XB_TMO], 1u); break; } }
    }
    nloc = mine > 0u ? mine : 1u; nx = cnt > 0u ? cnt : 1u;
}

__device__ __forceinline__ void xcd_barrier(const XcdBarrier& b) {
    asm volatile("s_waitcnt vmcnt(0)" ::: "memory");
    __syncthreads();
    if (threadIdx.x == 0) {
        unsigned* bar = b.bar;
        __builtin_amdgcn_s_waitcnt(0);
        unsigned nloc = b.st[0], nx = b.st[1];
        if (nloc == 0u) { xcd_barrier_complete(bar, b.x, nloc, nx); b.st[0] = nloc; b.st[1] = nx; }
        const unsigned old = xb_add(&bar[XB_XSUB(b.x)], 1u);
        const unsigned gen = old / nloc;
        if (old + 1u == (gen + 1u) * nloc) {
            __builtin_amdgcn_fence(__ATOMIC_RELEASE, "agent");
            asm volatile("s_waitcnt vmcnt(0)" ::: "memory");
            const unsigned og = xb_add(&bar[XB_TOP], 1u);
            const unsigned tg = og / nx;
            if (og + 1u == (tg + 1u) * nx) xb_add(&bar[XB_TOPGEN], 1u);
            else XB_SPIN(xb_ld(&bar[XB_TOPGEN]) == tg, bar);
            __builtin_amdgcn_fence(__ATOMIC_ACQUIRE, "agent");
            xb_add(&bar[XB_XGEN(b.x)], 1u);
            asm volatile("s_waitcnt vmcnt(0)" ::: "memory");
        } else {
            XB_SPIN(xb_ld(&bar[XB_XGEN(b.x)]) == gen, bar);
            __builtin_amdgcn_fence(__ATOMIC_ACQUIRE, "agent");
            asm volatile("s_waitcnt vmcnt(0)" ::: "memory");
        }
    }
    __syncthreads();
}
namespace pg8 {
#define PG8_LAS __attribute__((address_space(3)))
typedef unsigned short bf16_t;
typedef short bf16x8 __attribute__((ext_vector_type(8)));
typedef float f32x4 __attribute__((ext_vector_type(4)));
typedef unsigned u32x4 __attribute__((ext_vector_type(4)));
constexpr int BM = 256, BK = 64, HALF = 128, HTB = HALF * BK * 2  , STAGE_BYTES = 8 * HTB, NXCD = 8, WGM = 8;

__host__ __device__ __forceinline__ int lds_byte(int r, int c) { const int st = (r >> 4) * 2 + (c >> 5), rr = r & 15, cc = c & 31, ob = rr * 64 + cc * 2; return st * 1024 + (ob ^ (((ob >> 9) & 1) << 5)); }
__host__ __device__ __forceinline__ void stage_rc(int b, int& R, int& C) { const int st = b / 1024, sb = b % 1024, swz = sb ^ (((sb >> 9) & 1) << 5); R = (st >> 1) * 16 + swz / 64; C = (st & 1) * 32 + (swz % 64) / 2; }
__host__ __device__ __forceinline__ int perm32(int rho) { const int n = rho >> 4, i = rho & 15; return 8 * (i >> 2) + 4 * n + (i & 3); }

struct Unit { int pm, pn; };
struct Gemm { const bf16_t* A; const bf16_t* Bt; int M, N, K; };

struct StaticOrder {
    int nM, nN, nwg, G, c, wgm;
    __host__ __device__ void init(int M, int N, int G_, int c_, int wgm_ = WGM) { nM = M / BM; nN = N / BM; nwg = nM * nN; G = G_; c = c_; wgm = wgm_; }
    __host__ __device__ bool next(int i, Unit& u) const {
        const long L = (long)i * G + c; if (L >= nwg) return false;
        int wgid = (int)L; { const int q = nwg / NXCD, r = nwg % NXCD, xcd = wgid % NXCD, off = wgid / NXCD; wgid = (xcd < r ? xcd * (q + 1) : r * (q + 1) + (xcd - r) * q) + off; }
        const int nig = wgm * nN, gid = wgid / nig, fm = gid * wgm, gsz = (nM - fm) < wgm ? (nM - fm) : wgm;
        u.pm = fm + ((wgid % nig) % gsz); u.pn = (wgid % nig) / gsz; return true;
    }
    __device__ __forceinline__ void a_ready(const Unit&) const {}
    __device__ __forceinline__ void done(const Unit&) const {}
};


__device__ __forceinline__ unsigned cvt_pk_bf16(float lo, float hi) { unsigned r; asm volatile("v_cvt_pk_bf16_f32 %0, %1, %2" : "=v"(r) : "v"(lo), "v"(hi)); return r; }

template <class Epi, class Sched, bool ALIGN_EPI = false, bool SP2 = false>
__device__ __forceinline__ void gemm_phase(PG8_LAS unsigned char* lds, const Gemm g, const Sched& S, const Epi& E) {
    int tid_ = threadIdx.x; asm volatile("" : "+v"(tid_)); const int tid = tid_, wid = __builtin_amdgcn_readfirstlane(tid >> 6), lane = tid & 63, wr = wid >> 2, wc = wid & 3, fr = lane & 15, fq = lane >> 4;
    const int K = g.K, nt = K / BK;
    unsigned voffA[2], voffB[2];
#pragma unroll
    for (int i = 0; i < 2; ++i) { int R, C; stage_rc(tid * 16 + i * 8192, R, C); const int Rb = Epi::PERM ? ((R & ~31) + perm32(R & 31)) : R;
        voffA[i] = (unsigned)(R * K + C) * 2u; voffB[i] = (unsigned)(Rb * K + C) * 2u; }
    const size_t kstep = (size_t)(BK * 2);
    const size_t hstep = (size_t)HALF * K * 2;
    const size_t tstep = 2 * hstep;
    const unsigned ldsw = (unsigned)wid * 1024u;
    const int aoff = lds_byte(wr * 64 + fr, fq * 8), boff = lds_byte(wc * 32 + fr, fq * 8);
#define PG8_SA(b, h) (((b) * 2 + (h)) * HTB)
#define PG8_SB(b, h) ((4 + (b) * 2 + (h)) * HTB)
#define PG8_STAGE(bufoff, gbase, voff) do { _Pragma("unroll") for (int _i = 0; _i < 2; ++_i) \
        __builtin_amdgcn_global_load_lds((const unsigned*)((const char*)(gbase) + (voff)[_i]), (PG8_LAS unsigned*)(lds + (bufoff) + ldsw + _i * 8192), 16, 0, 0); } while (0)
#define PG8_LDA(dst, b, h) do { _Pragma("unroll") for (int m = 0; m < 4; ++m) _Pragma("unroll") for (int k = 0; k < 2; ++k) dst[m][k] = *(const PG8_LAS bf16x8*)(lds + PG8_SA(b, h) + aoff + m * 2048 + k * 1024); } while (0)
#define PG8_LDB(dst, b, h) do { _Pragma("unroll") for (int n = 0; n < 2; ++n) _Pragma("unroll") for (int k = 0; k < 2; ++k) dst[n][k] = *(const PG8_LAS bf16x8*)(lds + PG8_SB(b, h) + boff + n * 2048 + k * 1024); } while (0)
#define PG8_MMA(ai, bj, At, Bt) do { __builtin_amdgcn_s_setprio(1); _Pragma("unroll") for (int m = 0; m < 4; ++m) _Pragma("unroll") for (int n = 0; n < 2; ++n) _Pragma("unroll") for (int k = 0; k < 2; ++k) \
        acc[ai][bj][m][n] = __builtin_amdgcn_mfma_f32_16x16x32_bf16(Bt[n][k], At[m][k], acc[ai][bj][m][n], 0, 0, 0); __builtin_amdgcn_s_setprio(0); } while (0)
#define PG8_WAIT_V(n) asm volatile("s_waitcnt vmcnt(" #n ")" ::: "memory")
#define PG8_WAIT_L(n) asm volatile("s_waitcnt lgkmcnt(" #n ")" ::: "memory")
#define PG8_BAR __builtin_amdgcn_s_barrier()
#define PG8_SCHED __builtin_amdgcn_sched_barrier(0)
    Unit cur, nxt; int ui = 0;
    if (!S.next(0, cur)) return;
    f32x4 acc[2][2][4][2];
#pragma unroll
    for (int a = 0; a < 2; ++a)
#pragma unroll
        for (int b = 0; b < 2; ++b)
#pragma unroll
            for (int m = 0; m < 4; ++m)
#pragma unroll
                for (int n = 0; n < 2; ++n) acc[a][b][m][n] = (f32x4){0.f, 0.f, 0.f, 0.f};
    bf16x8 At[4][2], B0[2][2], B1[2][2];
    const char* cA = (const char*)g.A + (size_t)cur.pm * tstep; const char* cB = (const char*)g.Bt + (size_t)cur.pn * tstep;
    S.a_ready(cur);
    E.prefetch(cur, 0);
    if constexpr (SP2) {
        PG8_STAGE(PG8_SB(0, 0), cB, voffB); PG8_STAGE(PG8_SB(0, 1), cB + hstep, voffB); PG8_STAGE(PG8_SA(0, 0), cA, voffA); PG8_STAGE(PG8_SA(0, 1), cA + hstep, voffA);
        if (wr == 1) PG8_BAR;
        PG8_WAIT_V(2); PG8_BAR;
        PG8_STAGE(PG8_SB(1, 0), cB + kstep, voffB); PG8_STAGE(PG8_SA(1, 0), cA + kstep, voffA); PG8_STAGE(PG8_SB(1, 1), cB + hstep + kstep, voffB);
        PG8_WAIT_V(6); PG8_BAR;
    } else {
        PG8_STAGE(PG8_SB(0, 0), cB, voffB); PG8_STAGE(PG8_SA(0, 0), cA, voffA); PG8_STAGE(PG8_SB(0, 1), cB + hstep, voffB); PG8_STAGE(PG8_SA(0, 1), cA + hstep, voffA);
        if (wr == 1) PG8_BAR;
        PG8_WAIT_V(4); PG8_BAR;
        PG8_STAGE(PG8_SB(1, 0), cB + kstep, voffB); PG8_STAGE(PG8_SA(1, 0), cA + kstep, voffA); PG8_STAGE(PG8_SB(1, 1), cB + hstep + kstep, voffB);
        PG8_WAIT_V(6); PG8_BAR;
    }
    for (;;) {
        const bool has_next = S.next(ui + 1, nxt);
        const char* nA = has_next ? (const char*)g.A + (size_t)nxt.pm * tstep : cA; const char* nB = has_next ? (const char*)g.Bt + (size_t)nxt.pn * tstep : cB;
        for (int t = 0; t < nt; t += 2) {
            const bool last = (t == nt - 2);
            const char* a1 = cA + (size_t)(t + 1) * kstep;
            const char* a2 = last ? nA : cA + (size_t)(t + 2) * kstep; const char* b2 = last ? nB : cB + (size_t)(t + 2) * kstep;
            const char* a3 = a2 + kstep; const char* b3 = b2 + kstep;
            if (last && has_next) S.a_ready(nxt);
            if constexpr (SP2) {
            PG8_LDB(B0, 0, 0); PG8_LDB(B1, 0, 1); PG8_SCHED; PG8_LDA(At, 0, 0); PG8_STAGE(PG8_SA(1, 1), a1 + hstep, voffA);
            PG8_WAIT_V(8); PG8_WAIT_L(0); PG8_BAR; PG8_MMA(0, 0, At, B0); PG8_MMA(0, 1, At, B1); PG8_BAR; PG8_SCHED;
            PG8_LDA(At, 0, 1); PG8_STAGE(PG8_SB(0, 0), b2, voffB); PG8_STAGE(PG8_SB(0, 1), b2 + hstep, voffB); PG8_STAGE(PG8_SA(0, 0), a2, voffA);
            PG8_WAIT_V(8); PG8_WAIT_L(0); PG8_BAR; PG8_MMA(1, 0, At, B0); PG8_MMA(1, 1, At, B1); PG8_BAR; PG8_SCHED;
            PG8_LDB(B0, 1, 0); PG8_LDB(B1, 1, 1); PG8_SCHED; PG8_LDA(At, 1, 0); PG8_STAGE(PG8_SA(0, 1), a2 + hstep, voffA);
            PG8_WAIT_V(8); PG8_WAIT_L(0); PG8_BAR; PG8_MMA(0, 0, At, B0); PG8_MMA(0, 1, At, B1); PG8_BAR; PG8_SCHED;
            PG8_LDA(At, 1, 1); PG8_STAGE(PG8_SB(1, 0), b3, voffB); PG8_STAGE(PG8_SB(1, 1), b3 + hstep, voffB); PG8_STAGE(PG8_SA(1, 0), a3, voffA);
            PG8_WAIT_V(8); PG8_WAIT_L(0); PG8_BAR; PG8_MMA(1, 0, At, B0); PG8_MMA(1, 1, At, B1); PG8_BAR; PG8_SCHED;
            } else {
            PG8_LDB(B0, 0, 0); PG8_SCHED; PG8_LDA(At, 0, 0); PG8_STAGE(PG8_SA(1, 1), a1 + hstep, voffA);
            PG8_WAIT_L(8); PG8_BAR; PG8_WAIT_L(0); PG8_MMA(0, 0, At, B0); PG8_BAR; PG8_SCHED;
            PG8_LDB(B1, 0, 1); PG8_STAGE(PG8_SB(0, 0), b2, voffB);
            PG8_BAR; PG8_WAIT_L(0); PG8_MMA(0, 1, At, B1); PG8_BAR;
            PG8_LDA(At, 0, 1); PG8_STAGE(PG8_SA(0, 0), a2, voffA);
            PG8_BAR; PG8_WAIT_L(0); PG8_MMA(1, 0, At, B0); PG8_BAR; PG8_SCHED;
            PG8_STAGE(PG8_SB(0, 1), b2 + hstep, voffB);
            PG8_WAIT_V(6); PG8_BAR; PG8_MMA(1, 1, At, B1); PG8_BAR;
            PG8_LDB(B0, 1, 0); PG8_SCHED; PG8_LDA(At, 1, 0); PG8_STAGE(PG8_SA(0, 1), a2 + hstep, voffA);
            PG8_WAIT_L(8); PG8_BAR; PG8_WAIT_L(0); PG8_MMA(0, 0, At, B0); PG8_BAR; PG8_SCHED;
            PG8_LDB(B1, 1, 1); PG8_STAGE(PG8_SB(1, 0), b3, voffB);
            PG8_BAR; PG8_WAIT_L(0); PG8_MMA(0, 1, At, B1); PG8_BAR;
            PG8_LDA(At, 1, 1); PG8_STAGE(PG8_SA(1, 0), a3, voffA);
            PG8_BAR; PG8_WAIT_L(0); PG8_MMA(1, 0, At, B0); PG8_BAR; PG8_SCHED;
            PG8_STAGE(PG8_SB(1, 1), b3 + hstep, voffB);
            PG8_WAIT_V(6); PG8_BAR; PG8_MMA(1, 1, At, B1); PG8_BAR;
            }
        }
        if constexpr (ALIGN_EPI) { if (wr == 0) PG8_BAR; }
        if constexpr (!Epi::AFTER_DRAIN) { if (has_next) E.prefetch(nxt, (ui + 1) & 1);
            E(acc, cur, wr, wc, fr, fq, ui & 1); S.done(cur); }
        if (!has_next) break;
#pragma unroll
        for (int a = 0; a < 2; ++a)
#pragma unroll
            for (int b = 0; b < 2; ++b)
#pragma unroll
                for (int m = 0; m < 4; ++m)
#pragma unroll
                    for (int n = 0; n < 2; ++n) acc[a][b][m][n] = (f32x4){0.f, 0.f, 0.f, 0.f};
        cur = nxt; cA = nA; cB = nB; ++ui;
        if constexpr (ALIGN_EPI) { if (wr == 1) PG8_BAR; }
    }
    PG8_WAIT_V(0);
    if constexpr (!ALIGN_EPI) { if (wr == 0) PG8_BAR; }
    PG8_BAR;
    if constexpr (Epi::AFTER_DRAIN) { E.fused(acc, cur, wr, wc, fr, fq, lds, wid, lane); S.done(cur); }
#undef PG8_SA
#undef PG8_SB
#undef PG8_STAGE
#undef PG8_LDA
#undef PG8_LDB
#undef PG8_MMA
#undef PG8_WAIT_V
#undef PG8_WAIT_L
#undef PG8_BAR
#undef PG8_SCHED
}
}

namespace mk {
using pg8::bf16_t; using pg8::f32x4; using pg8::u32x4; using pg8::Unit;
typedef unsigned u32x2 __attribute__((ext_vector_type(2)));
constexpr int D = 2048, T = 40960, NSEQ = 10, SEQ = 4096, DFF = 5632, PLED = 256;
constexpr float EPS = 1e-6f;
constexpr int NTHR = 512;

constexpr size_t AL(size_t x) { return (x + 255) & ~size_t(255); }
constexpr size_t WS_CTL = 0, CTL_BYTES = 65536;
constexpr int NRS = 14;
constexpr size_t WS_RS = WS_CTL + CTL_BYTES, RS_BYTES = (size_t)NRS * T * 8;
constexpr size_t ZERO_BYTES = WS_RS + RS_BYTES;
constexpr size_t SZ_WGU = (size_t)2 * DFF * D * 2, SZ_WDN = (size_t)D * DFF * 2, SZ_WPG = (size_t)D * D * 2, SZ_WPP = (size_t)D * PLED * 2;
constexpr size_t WS_WGU = AL(ZERO_BYTES);
constexpr size_t WS_WDN = WS_WGU + 4 * SZ_WGU;
constexpr size_t WS_WPG = WS_WDN + 4 * SZ_WDN;
constexpr size_t WS_WPP = WS_WPG + 4 * SZ_WPG;
constexpr size_t WS_NAQ = WS_WPP + 4 * SZ_WPP;
constexpr size_t WS_NAO = WS_NAQ + (size_t)6144 * D * 2;
constexpr size_t WS_SGI = WS_NAO + (size_t)D * D * 2;
constexpr size_t WS_SGO = WS_SGI + (size_t)4096 * D * 2;
constexpr int    GDI_N = 12544, GDI_N1 = 8448;
constexpr size_t WS_GDI = WS_SGO + (size_t)D * D * 2;
constexpr size_t WS_GDO = WS_GDI + (size_t)GDI_N * D * 2;
constexpr size_t WS_S5G = WS_GDO + (size_t)D * 4096 * 2;
constexpr size_t WS_PB  = WS_S5G + (size_t)4096 * D * 2;
constexpr size_t WS_XB0 = WS_PB + (size_t)4 * T * PLED * 2;
constexpr size_t WS_XB1 = WS_XB0 + (size_t)T * D * 2;
constexpr size_t WS_BIG = WS_XB1 + (size_t)T * D * 2;
constexpr size_t BIG_BYTES = 524288000;
constexpr size_t WS_END = WS_BIG + BIG_BYTES;
constexpr int FG_ROWS = 8192, NFG = 5;
constexpr size_t BIG_GU = 0, BIG_HID = (size_t)FG_ROWS * 2 * DFF * 2;
constexpr size_t BIG_HID2 = 0, BIG_EDGE = (size_t)T * DFF * 2;
static_assert(BIG_EDGE + (size_t)(T / 256) * 16 * 2 * DFF * 2 <= BIG_BYTES, "BIG");
constexpr int GG_ROWS = 16384, NGG = 3;
constexpr int G0_ROWS = 8192;
constexpr size_t G0_PROJ = 0, G0_OB = (size_t)G0_ROWS * 4096 * 2, G0_VP = (size_t)G0_ROWS * 8192 * 2, G0_AB = G0_VP + (size_t)G0_ROWS * 4096 * 2, G0_GB = G0_AB + (size_t)G0_ROWS * 128 * 4, R0_END = G0_GB + (size_t)G0_ROWS * 128 * 4;
constexpr size_t G1_VP = 0, G1_GB = (size_t)GG_ROWS * 4096 * 2, G1_PROJ = R0_END, G1_OB = G1_PROJ + (size_t)GG_ROWS * 4096 * 2, G1_AB = G1_PROJ + (size_t)GG_ROWS * 8192 * 2;
static_assert(G1_GB + (size_t)GG_ROWS * 128 * 4 <= R0_END && G1_AB + (size_t)GG_ROWS * 128 * 4 <= 524288000, "GDN BIG layout");
constexpr size_t BIG_PROJ = 0, BIG_OB = (size_t)GG_ROWS * 4096 * 2, BIG_VP = (size_t)GG_ROWS * 8192 * 2, BIG_AB = BIG_VP + (size_t)GG_ROWS * 4096 * 2, BIG_GB = BIG_AB + (size_t)GG_ROWS * 128 * 4;
static_assert(BIG_GB + (size_t)GG_ROWS * 128 * 4 <= BIG_BYTES, "BIG");
static_assert((size_t)T * 6144 * 2 <= BIG_BYTES, "BIG");

constexpr int LDS_STAGE = 131072, LDS_BYTES = 163840, LDS_BAR = LDS_BYTES - 16;

struct Args { const float* in[37]; float* out; unsigned char* ws; int ph_lo, ph_hi; };
typedef const Args __attribute__((address_space(4)))* ArgsCP;
__device__ __forceinline__ ArgsCP argp() { ArgsCP p = (ArgsCP)__builtin_amdgcn_kernarg_segment_ptr(); asm volatile("" : "+s"(p)); return p; }
__device__ __forceinline__ int tidx() { int t = threadIdx.x; asm volatile("" : "+v"(t)); return t; }

__device__ __forceinline__ float bf2f(bf16_t b) { return __uint_as_float(((unsigned)b) << 16); }
__device__ __forceinline__ float blo(unsigned w) { return __uint_as_float(w << 16); }
__device__ __forceinline__ float bhi(unsigned w) { return __uint_as_float(w & 0xffff0000u); }
typedef float f32x2_t __attribute__((ext_vector_type(2))); typedef __bf16 bf16x2_t __attribute__((ext_vector_type(2)));
__device__ __forceinline__ unsigned pk2(float lo, float hi) { const f32x2_t v = {lo, hi}; const bf16x2_t b = __builtin_convertvector(v, bf16x2_t); return __builtin_bit_cast(unsigned, b); }
__device__ __forceinline__ bf16_t f2bf(float f) { return (bf16_t)(pk2(f, 0.f) & 0xffffu); }
typedef unsigned long long rs_t;
__device__ __forceinline__ float rs_val(rs_t v) { return (float)(unsigned)(v >> 24) + (float)(unsigned)(v & 0xffffffull) * (1.0f / 16777216.0f); }
__device__ __forceinline__ rs_t rs_fix(float ss) { return (rs_t)__float2ull_rn(ss * 16777216.0f); }
__device__ __forceinline__ void rs_add(rs_t* p, float ss) { atomicAdd(p, rs_fix(ss)); }
__device__ __forceinline__ float rstd_of(rs_t v) { return __builtin_amdgcn_rsqf(rs_val(v) * (1.0f / (float)D) + EPS); }
__device__ __forceinline__ float sigmoidf_(float x) { return __builtin_amdgcn_rcpf(1.0f + __expf(-x)); }
__device__ __forceinline__ float siluf_(float x) { return x * sigmoidf_(x); }
__device__ __forceinline__ float geluf_(float x) { const float w = x * __builtin_fmaf(x * x, -0.1029432396f, -2.3022081985f); return x * __builtin_amdgcn_rcpf(1.0f + __builtin_amdgcn_exp2f(w)); }
__device__ __forceinline__ void unpack8(const u32x4 w, float (&v)[8]) { v[0] = blo(w.x); v[1] = bhi(w.x); v[2] = blo(w.y); v[3] = bhi(w.y); v[4] = blo(w.z); v[5] = bhi(w.z); v[6] = blo(w.w); v[7] = bhi(w.w); }
__device__ __forceinline__ u32x4 pack8(const float (&v)[8]) { u32x4 w; w.x = pk2(v[0], v[1]); w.y = pk2(v[2], v[3]); w.z = pk2(v[4], v[5]); w.w = pk2(v[6], v[7]); return w; }
__device__ __forceinline__ float wave_sum(float v) {
#pragma unroll
    for (int o = 32; o > 0; o >>= 1) v += __shfl_xor(v, o);
    return v; }
__device__ __forceinline__ float wave_max(float v) {
#pragma unroll
    for (int o = 32; o > 0; o >>= 1) v = fmaxf(v, __shfl_xor(v, o));
    return v; }

typedef const f32x4 (&AccT)[2][2][4][2];

constexpr int EPF_OFF = LDS_STAGE, EPF_SLOT = 4096, EPF_CW = 2048;
constexpr int XCH_OFF = LDS_STAGE + 2 * EPF_SLOT;
__device__ __forceinline__ void epf_rows(const rs_t* rs, const Unit& u, int slot) {
    extern __shared__ __attribute__((aligned(16))) unsigned char epf_lds_[];
    const int tid = tidx();
    if (tid < 64) { LAS unsigned char* d = (LAS unsigned char*)epf_lds_ + EPF_OFF + slot * EPF_SLOT; const rs_t* s = rs + (size_t)u.pm * 256 + 2 * tid;
        __builtin_amdgcn_global_load_lds((const unsigned*)s, (LAS unsigned*)d, 16, 0, 0);
        __builtin_amdgcn_global_load_lds((const unsigned*)(s + 128), (LAS unsigned*)(d + 1024), 16, 0, 0); }
}
__device__ __forceinline__ float epf_rstd(int slot, int r) {
    extern __shared__ __attribute__((aligned(16))) unsigned char epf_lds_[];
    return rstd_of(*(const LAS rs_t*)((LAS unsigned char*)epf_lds_ + EPF_OFF + slot * EPF_SLOT + r * 8));
}
#define EPI_ROWSCALES_LDS(slot_) float sc[2][4]; { \
        _Pragma("unroll") for (int ai = 0; ai < 2; ++ai) _Pragma("unroll") for (int m = 0; m < 4; ++m) sc[ai][m] = epf_rstd((slot_), ai * 128 + wr * 64 + m * 16 + fr); }
#define EPI_ROWSCALES(rsptr, row0_) float sc[2][4]; { rs_t r_[2][4]; \
        _Pragma("unroll") for (int ai = 0; ai < 2; ++ai) _Pragma("unroll") for (int m = 0; m < 4; ++m) r_[ai][m] = (rsptr)[(row0_) + ai * 128 + m * 16]; \
        _Pragma("unroll") for (int ai = 0; ai < 2; ++ai) _Pragma("unroll") for (int m = 0; m < 4; ++m) sc[ai][m] = rstd_of(r_[ai][m]); }

struct EpiScale {
    static constexpr bool PERM = true, AFTER_DRAIN = false;
    bf16_t* O; int ldc; const rs_t* rs; float* ab; int ab_pn;
    __device__ __forceinline__ void prefetch(const Unit& u, int slot) const { if (rs) epf_rows(rs, u, slot); }
    __device__ __forceinline__ void operator()(AccT acc, const Unit& u, int wr, int wc, int fr, int fq, int slot) const {
        const int row0 = u.pm * 256 + wr * 64 + fr, colw = wc * 32 + 8 * fq;
        const bool side = (ab != nullptr) && (u.pn == ab_pn);
        float sc[2][4];
        if (rs) {
#pragma unroll
            for (int ai = 0; ai < 2; ++ai)
#pragma unroll
                for (int m = 0; m < 4; ++m) sc[ai][m] = epf_rstd(slot, ai * 128 + wr * 64 + m * 16 + fr); }
        else {
#pragma unroll
            for (int ai = 0; ai < 2; ++ai)
#pragma unroll
                for (int m = 0; m < 4; ++m) sc[ai][m] = 1.0f; }
#pragma unroll
        for (int ai = 0; ai < 2; ++ai)
#pragma unroll
            for (int m = 0; m < 4; ++m) {
                const int row = row0 + ai * 128 + m * 16; const float s = sc[ai][m];
#pragma unroll
                for (int bj = 0; bj < 2; ++bj) {
                    const f32x4 v0 = acc[ai][bj][m][0] * s, v1 = acc[ai][bj][m][1] * s;
                    if (side) { if (bj == 0) { float* p = ab + (size_t)row * 128 + colw; *(f32x4*)p = v0; *(f32x4*)(p + 4) = v1; } }
                    else { u32x4 w; w.x = pk2(v0[0], v0[1]); w.y = pk2(v0[2], v0[3]); w.z = pk2(v1[0], v1[1]); w.w = pk2(v1[2], v1[3]);
                           *(u32x4*)(O + (size_t)row * ldc + u.pn * 256 + bj * 128 + colw) = w; }
                }
            }
    }
};
struct EpiGelu {
    static constexpr bool PERM = true, AFTER_DRAIN = false;
    bf16_t* O; int ldc; const rs_t* rs; rs_t* rsv; int vtile0;
    __device__ __forceinline__ void prefetch(const Unit& u, int slot) const { epf_rows(rs, u, slot); }
    __device__ __forceinline__ void operator()(AccT acc, const Unit& u, int wr, int wc, int fr, int fq, int slot) const {
        const int row0 = u.pm * 256 + wr * 64 + fr, colw = wc * 32 + 8 * fq;
        const bool isv = u.pn >= vtile0;
        EPI_ROWSCALES_LDS(slot)
#pragma unroll
        for (int ai = 0; ai < 2; ++ai)
#pragma unroll
            for (int m = 0; m < 4; ++m) {
                const int row = row0 + ai * 128 + m * 16;
                const float s = sc[ai][m]; float ss = 0.f;
#pragma unroll
                for (int bj = 0; bj < 2; ++bj) {
                    float v[8];
#pragma unroll
                    for (int j = 0; j < 4; ++j) { v[j] = geluf_(acc[ai][bj][m][0][j] * s); v[4 + j] = geluf_(acc[ai][bj][m][1][j] * s); }
#pragma unroll
                    for (int j = 0; j < 8; ++j) ss += v[j] * v[j];
                    *(u32x4*)(O + (size_t)row * ldc + u.pn * 256 + bj * 128 + colw) = pack8(v);
                }
                if (isv) { ss += __shfl_xor(ss, 16); ss += __shfl_xor(ss, 32); if (fq == 0) rs_add(rsv + row, ss); }
            }
    }
};
__device__ __forceinline__ float put_x(bf16_t* XB, size_t off, const float (&xn)[8]) {
    *(u32x4*)(XB + off) = pack8(xn);
    float ss = 0.f;
#pragma unroll
    for (int j = 0; j < 8; ++j) ss += xn[j] * xn[j];
    return ss;
}
struct EpiResid {
    static constexpr bool PERM = true, AFTER_DRAIN = false;
    const bf16_t* XR; bf16_t* XW; rs_t* rsq;
    __device__ __forceinline__ void prefetch(const Unit&, int) const {}
    __device__ __forceinline__ void operator()(AccT acc, const Unit& u, int wr, int wc, int fr, int fq, int slot) const {
        const int row0 = u.pm * 256 + wr * 64 + fr, colw = wc * 32 + 8 * fq;
        u32x4 xv[2][4][2];
#pragma unroll
        for (int ai = 0; ai < 2; ++ai)
#pragma unroll
            for (int m = 0; m < 4; ++m)
#pragma unroll
                for (int bj = 0; bj < 2; ++bj) xv[ai][m][bj] = *(const u32x4*)(XR + (size_t)(row0 + ai * 128 + m * 16) * D + u.pn * 256 + bj * 128 + colw);
        asm volatile("" ::: "memory");
#pragma unroll
        for (int ai = 0; ai < 2; ++ai)
#pragma unroll
            for (int m = 0; m < 4; ++m) {
                const int row = row0 + ai * 128 + m * 16; float ss = 0.f;
#pragma unroll
                for (int bj = 0; bj < 2; ++bj) {
                    const size_t off = (size_t)row * D + u.pn * 256 + bj * 128 + colw;
                    float xn[8]; unpack8(xv[ai][m][bj], xn);
#pragma unroll
                    for (int j = 0; j < 4; ++j) { xn[j] += acc[ai][bj][m][0][j]; xn[4 + j] += acc[ai][bj][m][1][j]; }
                    ss += put_x(XW, off, xn);
                }
                ss += __shfl_xor(ss, 16); ss += __shfl_xor(ss, 32); if (fq == 0) rs_add(rsq + row, ss);
            }
    }
};
struct EpiPle {
    static constexpr bool PERM = true, AFTER_DRAIN = false;
    const bf16_t* XR; bf16_t* XW; rs_t* rsq; const rs_t* rs_in;
    __device__ __forceinline__ void prefetch(const Unit& u, int slot) const { epf_rows(rs_in, u, slot); }
    __device__ __forceinline__ void operator()(AccT acc, const Unit& u, int wr, int wc, int fr, int fq, int slot) const {
        const int row0 = u.pm * 256 + wr * 64 + fr, colw = wc * 32 + 8 * fq;
        EPI_ROWSCALES_LDS(slot)
#pragma unroll
        for (int ai = 0; ai < 2; ++ai) {
            u32x4 xv[4][2], pq[4][2];
#pragma unroll
            for (int m = 0; m < 4; ++m)
#pragma unroll
                for (int bj = 0; bj < 2; ++bj) { const size_t off = (size_t)(row0 + ai * 128 + m * 16) * D + u.pn * 256 + bj * 128 + colw;
                    xv[m][bj] = *(const u32x4*)(XR + off); pq[m][bj] = *(const u32x4*)(XW + off); }
            asm volatile("" ::: "memory");
#pragma unroll
            for (int m = 0; m < 4; ++m) {
                const int row = row0 + ai * 128 + m * 16; float ss = 0.f; const float s = sc[ai][m];
#pragma unroll
                for (int bj = 0; bj < 2; ++bj) {
                    const size_t off = (size_t)row * D + u.pn * 256 + bj * 128 + colw;
                    float pv[8]; unpack8(pq[m][bj], pv);
                    float xn[8]; unpack8(xv[m][bj], xn);
#pragma unroll
                    for (int j = 0; j < 4; ++j) { xn[j] += sigmoidf_(acc[ai][bj][m][0][j] * s) * pv[j]; xn[4 + j] += sigmoidf_(acc[ai][bj][m][1][j] * s) * pv[4 + j]; }
                    ss += put_x(XW, off, xn);
                }
                ss += __shfl_xor(ss, 16); ss += __shfl_xor(ss, 32); if (fq == 0) rs_add(rsq + row, ss);
            }
            asm volatile("" ::: "memory");
        }
    }
};
struct EpiGlu {
    static constexpr bool PERM = true, AFTER_DRAIN = false;
    bf16_t* XB; rs_t* rsq;
    __device__ __forceinline__ void prefetch(const Unit&, int) const {}
    __device__ __forceinline__ void operator()(AccT acc, const Unit& u, int wr, int wc, int fr, int fq, int slot) const {
        const int row0 = u.pm * 256 + wr * 64 + fr, colw = wc * 32 + 8 * fq;
        u32x4 xv[2][4];
#pragma unroll
        for (int ai = 0; ai < 2; ++ai)
#pragma unroll
            for (int m = 0; m < 4; ++m) xv[ai][m] = *(const u32x4*)(XB + (size_t)(row0 + ai * 128 + m * 16) * D + u.pn * 128 + colw);
        asm volatile("" ::: "memory");
#pragma unroll
        for (int ai = 0; ai < 2; ++ai)
#pragma unroll
            for (int m = 0; m < 4; ++m) {
                const int row = row0 + ai * 128 + m * 16;
                const size_t off = (size_t)row * D + u.pn * 128 + colw;
                float xn[8]; unpack8(xv[ai][m], xn);
#pragma unroll
                for (int j = 0; j < 4; ++j) { xn[j] += acc[ai][0][m][0][j] * sigmoidf_(acc[ai][1][m][0][j]); xn[4 + j] += acc[ai][0][m][1][j] * sigmoidf_(acc[ai][1][m][1][j]); }
                float ss = put_x(XB, off, xn);
                ss += __shfl_xor(ss, 16); ss += __shfl_xor(ss, 32); if (fq == 0) rs_add(rsq + row, ss);
            }
    }
};
struct EpiGdnZ {
    static constexpr bool PERM = true, AFTER_DRAIN = false;
    bf16_t* O; const bf16_t* OB; int ldc; const rs_t* rs; const float* gain; LAS float* xch;
    __device__ __forceinline__ void prefetch(const Unit& u, int slot) const { epf_rows(rs, u, slot); }
    __device__ __forceinline__ void operator()(AccT acc, const Unit& u, int wr, int wc, int fr, int fq, int slot) const {
        const int row0 = u.pm * 256 + wr * 64 + fr, colw = wc * 32 + 8 * fq;
        EPI_ROWSCALES_LDS(slot)
        float gn[8];
        { const f32x4 g0 = *(const f32x4*)(gain + (colw & 127)), g1 = *(const f32x4*)(gain + (colw & 127) + 4);
#pragma unroll
          for (int j = 0; j < 4; ++j) { gn[j] = g0[j]; gn[4 + j] = g1[j]; } }
#pragma unroll
        for (int ai = 0; ai < 2; ++ai)
#pragma unroll
          for (int mh = 0; mh < 2; ++mh) {
            u32x4 of_[2][2], ob_[2][2];
#pragma unroll
            for (int mm = 0; mm < 2; ++mm)
#pragma unroll
                for (int bj = 0; bj < 2; ++bj) { const size_t off = (size_t)(row0 + ai * 128 + (2 * mh + mm) * 16) * ldc + u.pn * 256 + bj * 128 + colw;
                    of_[mm][bj] = *(const u32x4*)(O + off); ob_[mm][bj] = *(const u32x4*)(OB + off); }
            asm volatile("" ::: "memory");
            float sv[2][2][8];
#pragma unroll
            for (int mm = 0; mm < 2; ++mm)
#pragma unroll
                for (int bj = 0; bj < 2; ++bj) { float a8[8], b8[8]; unpack8(of_[mm][bj], a8); unpack8(ob_[mm][bj], b8); float ss = 0.f;
#pragma unroll
                    for (int j = 0; j < 8; ++j) { sv[mm][bj][j] = a8[j] + b8[j]; ss += sv[mm][bj][j] * sv[mm][bj][j]; }
                    ss += __shfl_xor(ss, 16); ss += __shfl_xor(ss, 32);
                    if (fq == 0) xch[((wr * 64 + (2 * mh + mm) * 16 + fr) * 2 + bj) * 4 + wc] = ss; }
            asm volatile("s_waitcnt lgkmcnt(0)" ::: "memory"); __builtin_amdgcn_s_barrier(); asm volatile("" ::: "memory");
#pragma unroll
            for (int mm = 0; mm < 2; ++mm) { const int m = 2 * mh + mm; const int row = row0 + ai * 128 + m * 16; const float s = sc[ai][m];
#pragma unroll
                for (int bj = 0; bj < 2; ++bj) {
                    const f32x4 p4 = *(const LAS f32x4*)(xch + ((wr * 64 + m * 16 + fr) * 2 + bj) * 4);
                    const float rn = rsqrtf(((p4[0] + p4[1]) + (p4[2] + p4[3])) * (1.0f / 128.0f) + EPS);
                    float ov[8];
#pragma unroll
                    for (int j = 0; j < 4; ++j) { ov[j] = sv[mm][bj][j] * rn * gn[j] * siluf_(acc[ai][bj][m][0][j] * s); ov[4 + j] = sv[mm][bj][4 + j] * rn * gn[4 + j] * siluf_(acc[ai][bj][m][1][j] * s); }
                    *(u32x4*)(O + (size_t)row * ldc + u.pn * 256 + bj * 128 + colw) = pack8(ov); } }
            asm volatile("s_waitcnt lgkmcnt(0)" ::: "memory"); __builtin_amdgcn_s_barrier(); asm volatile("" ::: "memory");
          }
    }
};
__device__ __forceinline__ float rot_up(float v) { return __int_as_float(__builtin_amdgcn_mov_dpp(__float_as_int(v), 0x12F, 0xF, 0xF, true)); }
__device__ __forceinline__ float rot_dn(float v) { return __int_as_float(__builtin_amdgcn_mov_dpp(__float_as_int(v), 0x121, 0xF, 0xF, true)); }
struct EpiFfn {
    static constexpr bool PERM = true, AFTER_DRAIN = false;
    bf16_t* HID; bf16_t* EDGE; const rs_t* rs; const float* cw; const float* cb;
    __device__ __forceinline__ void prefetch(const Unit& u, int slot) const {
        epf_rows(rs, u, slot);
        extern __shared__ __attribute__((aligned(16))) unsigned char epf_lds_[];
        const int tid = tidx();
        if (tid >= 64 && tid < 128) { const int l = tid - 64, half = l >> 5, c4 = (l & 31) * 4;
            LAS unsigned char* d = (LAS unsigned char*)epf_lds_ + EPF_OFF + slot * EPF_SLOT + EPF_CW;
            const float* s0 = cw + (size_t)half * DFF + u.pn * 128 + c4;
            const float* s1 = half ? cb + u.pn * 128 + c4 : cw + (size_t)2 * DFF + u.pn * 128 + c4;
            __builtin_amdgcn_global_load_lds((const unsigned*)s0, (LAS unsigned*)d, 16, 0, 0);
            __builtin_amdgcn_global_load_lds((const unsigned*)s1, (LAS unsigned*)(d + 1024), 16, 0, 0); }
    }
    __device__ __forceinline__ void operator()(AccT acc, const Unit& u, int wr, int wc, int fr, int fq, int slot) const {
        const int lane = fq * 16 + fr, ch = u.pn * 128 + wc * 32 + 8 * fq;
        float scall[2][4];
#pragma unroll
        for (int ai = 0; ai < 2; ++ai)
#pragma unroll
            for (int m = 0; m < 4; ++m) scall[ai][m] = epf_rstd(slot, ai * 128 + wr * 64 + m * 16 + fr);
        float w0[8], w1[8], w2[8], bb[8];
        { extern __shared__ __attribute__((aligned(16))) unsigned char epf_lds_[];
          const LAS float* wl = (const LAS float*)((LAS unsigned char*)epf_lds_ + EPF_OFF + slot * EPF_SLOT + EPF_CW) + wc * 32 + 8 * fq;
#pragma unroll
          for (int q = 0; q < 2; ++q) { const f32x4 a0 = *(const LAS f32x4*)(wl + 4 * q), a1 = *(const LAS f32x4*)(wl + 128 + 4 * q), a2 = *(const LAS f32x4*)(wl + 256 + 4 * q), a3 = *(const LAS f32x4*)(wl + 384 + 4 * q);
#pragma unroll
              for (int j = 0; j < 4; ++j) { w0[4 * q + j] = a0[j]; w1[4 * q + j] = a1[j]; w2[4 * q + j] = a2[j]; bb[4 * q + j] = a3[j]; } } }
#pragma unroll
        for (int ai = 0; ai < 2; ++ai) {
            const int row0 = u.pm * 256 + ai * 128 + wr * 64 + fr;
            float G[4][8], sc[4];
#pragma unroll
            for (int m = 0; m < 4; ++m) { sc[m] = scall[ai][m];
#pragma unroll
                for (int j = 0; j < 4; ++j) { G[m][j] = acc[ai][0][m][0][j] * sc[m]; G[m][4 + j] = acc[ai][0][m][1][j] * sc[m]; } }
            float ruc[8], rdp[8];
#pragma unroll
            for (int j = 0; j < 8; ++j) { ruc[j] = rot_up(G[0][j]); rdp[j] = 0.f; }
#pragma unroll
            for (int m = 0; m < 4; ++m) {
                float run[8], rdc[8];
#pragma unroll
                for (int j = 0; j < 8; ++j) { run[j] = (m < 3) ? rot_up(G[m < 3 ? m + 1 : 3][j]) : 0.f; rdc[j] = rot_dn(G[m][j]); }
                float hv[8], uv[8];
#pragma unroll
                for (int j = 0; j < 8; ++j) { const float up = (fr < 15) ? ruc[j] : run[j], dn = (fr > 0) ? rdc[j] : rdp[j];
                    uv[j] = (j < 4 ? acc[ai][1][m][0][j] : acc[ai][1][m][1][j - 4]) * sc[m];
                    hv[j] = siluf_(w0[j] * dn + w1[j] * G[m][j] + w2[j] * up + bb[j]) * uv[j]; }
                const int row = row0 + m * 16;
                *(u32x4*)(HID + (size_t)row * DFF + ch) = pack8(hv);
                if ((m == 0 && fr < 2) || (m == 3 && fr >= 14)) { const int e = 4 * (2 * ai + wr) + (m == 0 ? fr : fr - 12);
                    bf16_t* ep = EDGE + ((size_t)(u.pm * 16 + e) * 2) * DFF + ch;
                    *(u32x4*)ep = pack8(G[m]); *(u32x4*)(ep + DFF) = pack8(uv); }
#pragma unroll
                for (int j = 0; j < 8; ++j) { rdp[j] = rdc[j]; ruc[j] = run[j]; }
            }
        }
    }
};

__device__ __forceinline__ void stagger(int us) {
    const unsigned long long t0 = __builtin_amdgcn_s_memrealtime();
    const unsigned long long d = (unsigned long long)((blockIdx.x * 97u) & 255u) * (unsigned)us * 100ull / 256ull;
    while (__builtin_amdgcn_s_memrealtime() - t0 < d) __builtin_amdgcn_s_sleep(8);
}
struct LinearOrder {
    int nN, first, count, step;
    __device__ __forceinline__ bool next(int i, Unit& u) const { if (i >= count) return false; const int L = first + i * step; u.pm = L / nN; u.pn = L - u.pm * nN; return true; }
    __device__ __forceinline__ void a_ready(const Unit&) const {}
    __device__ __forceinline__ void done(const Unit&) const {}
};
template <class Epi>
__device__ __forceinline__ void run_gemm_linear(LAS unsigned char* lds, const bf16_t* A, const bf16_t* Bt, int M, int N, int K, const Epi& E, int first, int count, int step) {
    if (count <= 0) return;
    asm volatile("" : "+s"(K));
    pg8::Gemm g{A, Bt, M, N, K}; LinearOrder S; S.nN = N / 256; S.first = first; S.count = count; S.step = step;
    pg8::gemm_phase<Epi, LinearOrder, true, true>(lds, g, S, E);
}
template <class Epi>
__device__ __forceinline__ void run_gemm_sub(LAS unsigned char* lds, const bf16_t* A, const bf16_t* Bt, int M, int N, int K, const Epi& E, int G, int c) {
    pg8::Gemm g{A, Bt, M, N, K}; pg8::StaticOrder S; S.init(M, N, G, c, N == 2048 ? 4 : 8);
    pg8::gemm_phase<Epi, pg8::StaticOrder, true, true>(lds, g, S, E);
}
struct RangeOrder : pg8::StaticOrder {
    int lo, hi;
    __device__ __forceinline__ bool next(int i, Unit& u) const { return (lo + i < hi) && pg8::StaticOrder::next(lo + i, u); }
};
template <class Epi>
__device__ __forceinline__ void run_gemm_sub_range(LAS unsigned char* lds, const bf16_t* A, const bf16_t* Bt, int M, int N, int K, const Epi& E, int G, int c, int lo, int hi) {
    if (lo >= hi) return;
    asm volatile("" : "+s"(K));
    pg8::Gemm g{A, Bt, M, N, K}; RangeOrder S; S.init(M, N, G, c, N == 2048 ? 4 : 8); S.lo = lo; S.hi = hi;
    pg8::gemm_phase<Epi, RangeOrder, true, true>(lds, g, S, E);
}
template <class Epi>
__device__ __forceinline__ void run_gemm_range(LAS unsigned char* lds, const bf16_t* A, const bf16_t* Bt, int M, int N, int K, const Epi& E, int lo, int hi) {
    if (lo >= hi) return;
    asm volatile("" : "+s"(K));
    pg8::Gemm g{A, Bt, M, N, K}; RangeOrder S; S.init(M, N, (int)gridDim.x, (int)blockIdx.x, N == 2048 ? 4 : 8); S.lo = lo; S.hi = hi;
    pg8::gemm_phase<Epi, RangeOrder, true, true>(lds, g, S, E);
}
#ifndef MK_WGM_GU
#define MK_WGM_GU 8
#endif
template <class Epi>
__device__ __forceinline__ void run_gemm(LAS unsigned char* lds, const bf16_t* A, const bf16_t* Bt, int M, int N, int K, const Epi& E) {
    pg8::Gemm g{A, Bt, M, N, K}; pg8::StaticOrder S; S.init(M, N, (int)gridDim.x, (int)blockIdx.x, N == 2048 ? 4 : (N == 2 * DFF ? MK_WGM_GU : 8));
    pg8::gemm_phase<Epi, pg8::StaticOrder, true, true>(lds, g, S, E);
}

struct Job { const float* src; bf16_t* dst; const float* gain; int K, Nsrc, Ndst, map, qcols; };
__device__ __forceinline__ void get_job(ArgsCP a, int j, Job& J) {
    unsigned char* ws = a->ws; J.gain = nullptr; J.map = 0; J.qcols = 0;
    if (j < 16) { const int L = j >> 2, k = j & 3;
        if (k == 0)      { J.src = a->in[31] + (size_t)L * D * 2 * DFF; J.dst = (bf16_t*)(ws + WS_WGU + L * SZ_WGU); J.gain = a->in[5] + L * D; J.K = D; J.Nsrc = 2 * DFF; J.Ndst = 2 * DFF; J.map = 1; }
        else if (k == 1) { J.src = a->in[34] + (size_t)L * DFF * D;     J.dst = (bf16_t*)(ws + WS_WDN + L * SZ_WDN); J.K = DFF; J.Nsrc = D; J.Ndst = D; }
        else if (k == 2) { J.src = a->in[36] + (size_t)L * D * D;       J.dst = (bf16_t*)(ws + WS_WPG + L * SZ_WPG); J.gain = a->in[6] + L * D; J.K = D; J.Nsrc = D; J.Ndst = D; }
        else             { J.src = a->in[35] + (size_t)L * PLED * D;    J.dst = (bf16_t*)(ws + WS_WPP + L * SZ_WPP); J.K = PLED; J.Nsrc = D; J.Ndst = D; }
    } else switch (j) {
        case 16: J.src = a->in[8];  J.dst = (bf16_t*)(ws + WS_NAQ); J.gain = a->in[4] + 0 * D; J.K = D; J.Nsrc = 6144; J.Ndst = 6144; J.qcols = 2048; break;
        case 17: J.src = a->in[9];  J.dst = (bf16_t*)(ws + WS_NAO); J.K = D; J.Nsrc = D; J.Ndst = D; break;
        case 18: J.src = a->in[11]; J.dst = (bf16_t*)(ws + WS_SGI); J.gain = a->in[4] + 1 * D; J.K = D; J.Nsrc = 4096; J.Ndst = 4096; break;
        case 19: J.src = a->in[15]; J.dst = (bf16_t*)(ws + WS_SGO); J.K = D; J.Nsrc = D; J.Ndst = D; break;
        case 20: J.src = a->in[16]; J.dst = (bf16_t*)(ws + WS_GDI); J.gain = a->in[4] + 2 * D; J.K = D; J.Nsrc = 12416; J.Ndst = GDI_N; J.map = 2; break;
        case 21: J.src = a->in[21]; J.dst = (bf16_t*)(ws + WS_GDO); J.K = 4096; J.Nsrc = D; J.Ndst = D; break;
        default: J.src = a->in[30]; J.dst = (bf16_t*)(ws + WS_S5G); J.K = D; J.Nsrc = 4096; J.Ndst = 4096; J.map = 1; break;
    }
}
__device__ __forceinline__ int map_col(const Job& J, int n0) {
    if (J.map == 0) return n0;
    if (J.map == 1) { const int tile = n0 >> 8, w = n0 & 255, H = J.Nsrc >> 1; return w < 128 ? tile * 128 + w : H + tile * 128 + (w - 128); }
    if (n0 < 8192) return n0;
    if (n0 < 8320) return 12288 + (n0 - 8192);
    if (n0 < GDI_N1) return -1;
    return 8192 + (n0 - GDI_N1);
}
__device__ __forceinline__ void prologue(ArgsCP a, LAS unsigned char* lds) {
    const int tid = tidx(), G = gridDim.x, bid = blockIdx.x;
    LAS float* tile = (LAS float*)lds;
    int base = 0;
    for (int j = 0; j < 23; ++j) {
        Job J; get_job(a, j, J);
        const int kt = J.K >> 6, ntl = J.Ndst >> 6, nt = kt * ntl;
        const int first = (bid - (base % G) + G) % G;
        const int kk = tid >> 4, nn4 = (tid & 15) * 4;
        for (int i0 = first; i0 < nt; i0 += 4 * G) {
            f32x4 v[4][2]; float sc[4][2];
#pragma unroll
            for (int q = 0; q < 4; ++q) { const int i = i0 + q * G;
                if (i < nt) { const int nb = i / kt, kb = i - nb * kt, n0 = nb * 64, k0 = kb * 64, s0 = map_col(J, n0);
                    const float cs = (n0 < J.qcols) ? 0.08838834764831845f : 1.0f;
#pragma unroll
                    for (int p = 0; p < 2; ++p) { const int k = k0 + kk + 32 * p;
                        v[q][p] = (s0 >= 0) ? *(const f32x4*)(J.src + (size_t)k * J.Nsrc + s0 + nn4) : (f32x4){0.f, 0.f, 0.f, 0.f};
                        sc[q][p] = (J.gain ? J.gain[k] : 1.0f) * cs; } } }
#pragma unroll
            for (int q = 0; q < 4; ++q) if (i0 + q * G < nt) {
#pragma unroll
                for (int p = 0; p < 2; ++p)
#pragma unroll
                    for (int e = 0; e < 4; ++e) tile[q * 4160 + (nn4 + e) * 65 + kk + 32 * p] = v[q][p][e] * sc[q][p]; }
            __syncthreads();
#pragma unroll
            for (int q = 0; q < 4; ++q) { const int i = i0 + q * G;
                if (i < nt) { const int nb = i / kt, kb = i - nb * kt, n0 = nb * 64, k0 = kb * 64;
                    const int nn = tid >> 3, kk8 = (tid & 7) * 8; float o[8];
#pragma unroll
                    for (int e = 0; e < 8; ++e) o[e] = tile[q * 4160 + nn * 65 + kk8 + e];
                    *(u32x4*)(J.dst + (size_t)(n0 + nn) * J.K + k0 + kk8) = pack8(o); } }
            __syncthreads();
        }
        base += nt;
    }
    { bf16_t* PB = (bf16_t*)(a->ws + WS_PB);
      const long total = (long)4 * T * 64, stride = (long)G * NTHR;
      for (long i0 = (long)bid * NTHR + tid; i0 < total; i0 += 4 * stride) {
          f32x4 v[4]; size_t dsto[4]; bool ok[4];
#pragma unroll
          for (int q = 0; q < 4; ++q) { const long i = i0 + q * stride; ok[q] = i < total; const long ii = ok[q] ? i : i0;
              const int L = (int)(ii / ((long)T * 64)); const int rem = (int)(ii - (long)L * T * 64); const int row = rem >> 6, c4 = (rem & 63) * 4;
              const float* src = row < 8192 ? a->in[2] + ((size_t)L * 8192 + row) * PLED + c4 : a->in[3] + ((size_t)L * 32768 + (row - 8192)) * PLED + c4;
              v[q] = *(const f32x4*)src; dsto[q] = ((size_t)L * T + row) * PLED + c4; }
#pragma unroll
          for (int q = 0; q < 4; ++q) if (ok[q]) { u32x2 w; w.x = pk2(v[q][0], v[q][1]); w.y = pk2(v[q][2], v[q][3]); *(u32x2*)(PB + dsto[q]) = w; } } }
    { bf16_t* XB = (bf16_t*)(a->ws + WS_XB0); rs_t* rs = (rs_t*)(a->ws + WS_RS);
      const int w = tid >> 6, lane = tid & 63;
      for (int row = bid * 8 + w; row < T; row += G * 8) {
          const float* src = row < 8192 ? a->in[0] + (size_t)row * D : a->in[1] + (size_t)(row - 8192) * D;
          float ss = 0.f;
#pragma unroll
          for (int q = 0; q < 8; ++q) { const int c = (q * 64 + lane) * 4; const f32x4 v = *(const f32x4*)(src + c);
              u32x2 wv; wv.x = pk2(v[0], v[1]); wv.y = pk2(v[2], v[3]); *(u32x2*)(XB + (size_t)row * D + c) = wv;
              ss += v[0] * v[0] + v[1] * v[1] + v[2] * v[2] + v[3] * v[3]; }
          ss = wave_sum(ss); if (lane == 0) rs[row] = rs_fix(ss); } }
}

__device__ __forceinline__ void na_attention(ArgsCP a, LAS unsigned char* lds, const bf16_t* QKV, bf16_t* AO) {
    const int tid = tidx(), w = tid >> 6, lane = tid & 63;
    LAS float* qs = (LAS float*)(lds + w * 1024); LAS float* ps = qs + 128;
    const float* rpb = a->in[10];
    for (long task = (long)blockIdx.x * 8 + w; task < (long)T * 16; task += (long)gridDim.x * 8) {
        const int seq = (int)(task >> 16), rem = (int)(task & 65535), h = rem >> 12, pos = rem & 4095, r = pos >> 6, c = pos & 63;
        const int r0 = min(max(r - 4, 0), 56), c0 = min(max(c - 8, 0), 48);
        const size_t trow = (size_t)seq * SEQ + pos;
        { const unsigned qq = *(const unsigned*)(QKV + trow * 6144 + h * 128 + 2 * lane); qs[2 * lane] = blo(qq); qs[2 * lane + 1] = bhi(qq); }
        __builtin_amdgcn_wave_barrier();
        float s[2];
#pragma unroll
        for (int kk = 0; kk < 2; ++kk) {
            const int j = lane + 64 * kk, kr = r0 + (j >> 4), kc = c0 + (j & 15);
            const u32x4* kp = (const u32x4*)(QKV + ((size_t)seq * SEQ + kr * 64 + kc) * 6144 + 2048 + h * 128);
            float acc = 0.f;
#pragma unroll 4
            for (int d8 = 0; d8 < 16; ++d8) { const u32x4 kv = kp[d8]; const f32x4 q0 = *(const LAS f32x4*)(qs + d8 * 8), q1 = *(const LAS f32x4*)(qs + d8 * 8 + 4);
                acc += q0[0] * blo(kv.x) + q0[1] * bhi(kv.x) + q0[2] * blo(kv.y) + q0[3] * bhi(kv.y) + q1[0] * blo(kv.z) + q1[1] * bhi(kv.z) + q1[2] * blo(kv.w) + q1[3] * bhi(kv.w); }
            s[kk] = acc + rpb[(h * 15 + (kr - r + 7)) * 31 + (kc - c + 15)];
        }
        const float mx = wave_max(fmaxf(s[0], s[1]));
        const float e0 = __expf(s[0] - mx), e1 = __expf(s[1] - mx);
        const float inv = 1.0f / wave_sum(e0 + e1);
        ps[lane] = e0 * inv; ps[lane + 64] = e1 * inv;
        __builtin_amdgcn_wave_barrier();
        float o0 = 0.f, o1 = 0.f;
        const bf16_t* vb = QKV + ((size_t)seq * SEQ) * 6144 + 4096 + h * 128 + 2 * lane;
#pragma unroll 4
        for (int j = 0; j < 128; ++j) { const int kr = r0 + (j >> 4), kc = c0 + (j & 15);
            const unsigned vv = *(const unsigned*)(vb + (size_t)(kr * 64 + kc) * 6144); const float p = ps[j]; o0 += p * blo(vv); o1 += p * bhi(vv); }
        *(unsigned*)(AO + trow * D + h * 128 + 2 * lane) = pk2(o0, o1);
        __builtin_amdgcn_wave_barrier();
    }
}

__device__ __forceinline__ void sgu_mix(ArgsCP a, LAS unsigned char* lds, const bf16_t* UV, const rs_t* rsv, bf16_t* MX) {
    const int tid = tidx(), G = gridDim.x;
    LAS float* WT = (LAS float*)lds;
    LAS float* VS = (LAS float*)(lds + 65536);
    const float* w_s = a->in[13]; const float* b_s = a->in[14]; const float* sgn = a->in[12];
    const int per = (5120 + G - 1) / G, u0 = blockIdx.x * per, u1 = min(5120, u0 + per);
    int gcur = -1;
    for (int u = u0; u < u1; ++u) {
        const int g = u / 320, sc = u - g * 320, seq = sc >> 5, n = sc & 31; const size_t row0 = (size_t)seq * SEQ + n * 128;
        __syncthreads();
        if (g != gcur) { gcur = g;
            for (int idx = tid; idx < 16384; idx += NTHR) { const int t = idx >> 7, s = idx & 127; WT[s * 128 + t] = w_s[(size_t)g * 16384 + idx]; } }
        { const int s = tid >> 2, c32 = (tid & 3) * 32; const float rsd = rstd_of(rsv[row0 + s]);
#pragma unroll
          for (int q = 0; q < 4; ++q) { float v[8]; unpack8(*(const u32x4*)(UV + (row0 + s) * 4096 + 2048 + g * 128 + c32 + q * 8), v);
#pragma unroll
              for (int j = 0; j < 8; ++j) VS[s * 128 + c32 + q * 8 + j] = v[j] * rsd * sgn[g * 128 + c32 + q * 8 + j]; } }
        __syncthreads();
        const int t0 = (tid >> 4) * 4, c0 = (tid & 15) * 8;
        float acc[4][8];
#pragma unroll
        for (int i = 0; i < 4; ++i)
#pragma unroll
            for (int j = 0; j < 8; ++j) acc[i][j] = 0.f;
#pragma unroll 4
        for (int s = 0; s < 128; ++s) {
            const f32x4 av = *(const LAS f32x4*)(WT + s * 128 + t0), v0 = *(const LAS f32x4*)(VS + s * 128 + c0), v1 = *(const LAS f32x4*)(VS + s * 128 + c0 + 4);
#pragma unroll
            for (int i = 0; i < 4; ++i) {
#pragma unroll
                for (int j = 0; j < 4; ++j) { acc[i][j] += av[i] * v0[j]; acc[i][4 + j] += av[i] * v1[j]; } }
        }
#pragma unroll
        for (int i = 0; i < 4; ++i) { const int t = t0 + i; const float bias = b_s[g * 128 + t]; const size_t row = row0 + t;
            float uv[8]; unpack8(*(const u32x4*)(UV + row * 4096 + g * 128 + c0), uv);
#pragma unroll
            for (int j = 0; j < 8; ++j) uv[j] *= (acc[i][j] + bias);
            *(u32x4*)(MX + row * D + g * 128 + c0) = pack8(uv); }
    }
}

__device__ __forceinline__ void ffn_convglu(ArgsCP a, int layer, const bf16_t* GU, bf16_t* HID, int rows) {
    const float* cw = a->in[32] + (size_t)layer * 3 * DFF; const float* cb = a->in[33] + (size_t)layer * DFF;
    const long total = (long)rows * 704;
    for (long i = (long)blockIdx.x * NTHR + tidx(); i < total; i += (long)gridDim.x * NTHR) {
        const int r = (int)(i / 704), cbk = (int)(i - (long)r * 704), ch = cbk * 8, pos = r & (SEQ - 1);
        const bf16_t* gp = GU + (size_t)r * (2 * DFF) + (cbk >> 4) * 256 + (cbk & 15) * 8;
        float g0[8], gm[8], gn[8], up[8];
        unpack8(*(const u32x4*)gp, g0); unpack8(*(const u32x4*)(gp + 128), up);
        if (pos > 0) unpack8(*(const u32x4*)(gp - 2 * DFF), gm); else {
#pragma unroll
            for (int j = 0; j < 8; ++j) gm[j] = 0.f; }
        if (pos < SEQ - 1) unpack8(*(const u32x4*)(gp + 2 * DFF), gn); else {
#pragma unroll
            for (int j = 0; j < 8; ++j) gn[j] = 0.f; }
        float o[8];
#pragma unroll
        for (int j = 0; j < 8; ++j) { const float gv = cw[ch + j] * gm[j] + cw[DFF + ch + j] * g0[j] + cw[2 * DFF + ch + j] * gn[j] + cb[ch + j]; o[j] = siluf_(gv) * up[j]; }
        *(u32x4*)(HID + (size_t)r * DFF + ch) = pack8(o);
    }
}

__device__ __forceinline__ void ffn_fixup(ArgsCP a, int layer, const bf16_t* EDGE, bf16_t* HID) {
    const float* cw = a->in[32] + (size_t)layer * 3 * DFF; const float* cb = a->in[33] + (size_t)layer * DFF;
    const int total = (T / 256) * 8 * 704;
    for (int it = blockIdx.x * NTHR + tidx(); it < total; it += gridDim.x * NTHR) {
        const int cbk = it % 704, rr = (it / 704) & 7, tile = it / (704 * 8), s = rr >> 1, last = rr & 1, ch = cbk * 8;
        const bf16_t* eb = EDGE + (size_t)tile * 16 * 2 * DFF + ch;
        float gc[8], uc[8], gi[8], go[8];
        unpack8(*(const u32x4*)(eb + (size_t)((4 * s + (last ? 3 : 0)) * 2) * DFF), gc);
        unpack8(*(const u32x4*)(eb + (size_t)((4 * s + (last ? 3 : 0)) * 2 + 1) * DFF), uc);
        unpack8(*(const u32x4*)(eb + (size_t)((4 * s + (last ? 2 : 1)) * 2) * DFF), gi);
        const bf16_t* op = nullptr;
        if (last) { if (s < 3) op = eb + (size_t)((4 * (s + 1)) * 2) * DFF; else if ((tile & 15) != 15) op = eb + (size_t)16 * 2 * DFF; }
        else      { if (s > 0) op = eb + (size_t)((4 * (s - 1) + 3) * 2) * DFF; else if ((tile & 15) != 0) op = eb - (size_t)16 * 2 * DFF + (size_t)(15 * 2) * DFF; }
        if (op) unpack8(*(const u32x4*)op, go); else {
#pragma unroll
            for (int j = 0; j < 8; ++j) go[j] = 0.f; }
        float hv[8];
#pragma unroll
        for (int j = 0; j < 8; ++j) { const float dn = last ? gi[j] : go[j], up = last ? go[j] : gi[j];
            hv[j] = siluf_(cw[ch + j] * dn + cw[DFF + ch + j] * gc[j] + cw[2 * DFF + ch + j] * up + cb[ch + j]) * uc[j]; }
        *(u32x4*)(HID + ((size_t)tile * 256 + 64 * s + 63 * last) * DFF + ch) = pack8(hv);
    }
}

__device__ __forceinline__ void gdn_conv(ArgsCP a, const bf16_t* PROJ, const float* AB, bf16_t* QK, bf16_t* VP, float* GB, int rows) {
    const int tid = tidx(), ch0 = tid * 16;
    const float* cw = a->in[17];
    float w0[16], w1[16], w2[16];
#pragma unroll
    for (int j = 0; j < 16; ++j) { w0[j] = cw[ch0 + j]; w1[j] = cw[8192 + ch0 + j]; w2[j] = cw[16384 + ch0 + j]; }
    const float qsc = ch0 < 2048 ? 0.08838834764831845f : 1.0f;
    for (int r4 = blockIdx.x * 4; r4 < rows; r4 += gridDim.x * 4) {
        const int pos = r4 & (SEQ - 1);
        const bf16_t* p = PROJ + (size_t)r4 * 8192 + ch0;
        u32x4 raw[6][2];
#pragma unroll
        for (int q = 0; q < 6; ++q) { const bool ok = (q == 0) ? (pos > 0) : ((q == 5) ? (pos + 4 < SEQ) : true);
            if (ok) { raw[q][0] = *(const u32x4*)(p + (long)(q - 1) * 8192); raw[q][1] = *(const u32x4*)(p + (long)(q - 1) * 8192 + 8); }
            else { raw[q][0] = (u32x4){0u, 0u, 0u, 0u}; raw[q][1] = raw[q][0]; } }
        float xa[16], xb_[16], xc[16];
        { float t[8]; unpack8(raw[0][0], t);
#pragma unroll
          for (int j = 0; j < 8; ++j) xa[j] = t[j];
          unpack8(raw[0][1], t);
#pragma unroll
          for (int j = 0; j < 8; ++j) xa[8 + j] = t[j];
          unpack8(raw[1][0], t);
#pragma unroll
          for (int j = 0; j < 8; ++j) xb_[j] = t[j];
          unpack8(raw[1][1], t);
#pragma unroll
          for (int j = 0; j < 8; ++j) xb_[8 + j] = t[j]; }
#pragma unroll
        for (int q = 0; q < 4; ++q) {
            { float t[8]; unpack8(raw[q + 2][0], t);
#pragma unroll
              for (int j = 0; j < 8; ++j) xc[j] = t[j];
              unpack8(raw[q + 2][1], t);
#pragma unroll
              for (int j = 0; j < 8; ++j) xc[8 + j] = t[j]; }
            const int r = r4 + q;
            float y[16], ss = 0.f;
#pragma unroll
            for (int j = 0; j < 16; ++j) { y[j] = siluf_(w0[j] * xa[j] + w1[j] * xb_[j] + w2[j] * xc[j]); ss += y[j] * y[j]; }
            ss += __shfl_xor(ss, 1); ss += __shfl_xor(ss, 2); ss += __shfl_xor(ss, 4);
            const float sc = ch0 < 4096 ? rsqrtf(ss + EPS) * qsc : 1.0f;
            float o0[8], o1[8];
#pragma unroll
            for (int j = 0; j < 8; ++j) { o0[j] = y[j] * sc; o1[j] = y[8 + j] * sc; }
            bf16_t* dst = ch0 < 4096 ? QK + (size_t)r * 4096 + ch0 : VP + (size_t)r * 4096 + (ch0 - 4096);
            *(u32x4*)dst = pack8(o0); *(u32x4*)(dst + 8) = pack8(o1);
#pragma unroll
            for (int j = 0; j < 16; ++j) { xa[j] = xb_[j]; xb_[j] = xc[j]; }
        }
        if (tid < 256) { const int q = tid >> 6, dir = (tid >> 5) & 1, head = tid & 31; const int r = r4 + q;
            const float av = AB[(size_t)r * 128 + dir * 64 + head], bv = AB[(size_t)r * 128 + dir * 64 + 32 + head];
            const float xx = av + a->in[19][dir * 32 + head];
            const float sp = xx > 20.f ? xx : log1pf(expf(xx));
            GB[(size_t)r * 128 + dir * 64 + head] = -expf(a->in[18][dir * 32 + head]) * sp;
            GB[(size_t)r * 128 + dir * 64 + 32 + head] = 1.0f / (1.0f + expf(-bv)); }
    }
}
__device__ __forceinline__ void gdn_scan_naive(LAS unsigned char* lds, const bf16_t* QK, const bf16_t* VP, const float* GB, bf16_t* OF, bf16_t* OB, int nseq) {
    const int tid = tidx(), vh = tid >> 8, j = (tid & 255) >> 1, half = tid & 1;
    LAS float* KQ = (LAS float*)lds;
    LAS float* VS = (LAS float*)(lds + 16384);
    LAS float* GS = (LAS float*)(lds + 32768);
    const int nunits = nseq * 32;
    for (int unit = blockIdx.x; unit < nunits; unit += gridDim.x) {
        const int seq = unit >> 5, hq = (unit >> 1) & 15, dir = unit & 1, head = 2 * hq + vh;
        bf16_t* OD = dir ? OB : OF;
        float S[64];
#pragma unroll
        for (int i = 0; i < 64; ++i) S[i] = 0.f;
        for (int blk = 0; blk < SEQ / 16; ++blk) {
            __syncthreads();
            { const int tok = tid >> 5, part = tid & 31, step = blk * 16 + tok, pos = dir ? SEQ - 1 - step : step; const size_t row = (size_t)seq * SEQ + pos;
              const bf16_t* src = part < 16 ? QK + row * 4096 + hq * 128 + part * 8 : QK + row * 4096 + 2048 + hq * 128 + (part - 16) * 8;
              float v[8]; unpack8(*(const u32x4*)src, v);
              *(LAS f32x4*)(KQ + tok * 256 + part * 8) = (f32x4){v[0], v[1], v[2], v[3]}; *(LAS f32x4*)(KQ + tok * 256 + part * 8 + 4) = (f32x4){v[4], v[5], v[6], v[7]};
              unpack8(*(const u32x4*)(VP + row * 4096 + hq * 256 + part * 8), v);
              *(LAS f32x4*)(VS + tok * 256 + part * 8) = (f32x4){v[0], v[1], v[2], v[3]}; *(LAS f32x4*)(VS + tok * 256 + part * 8 + 4) = (f32x4){v[4], v[5], v[6], v[7]};
              if (tid < 64) { const int tk = tid >> 2, which = tid & 3, hh = 2 * hq + (which & 1), isb = which >> 1, st = blk * 16 + tk, ps = dir ? SEQ - 1 - st : st;
                  const float gv = GB[((size_t)seq * SEQ + ps) * 128 + dir * 64 + isb * 32 + hh]; GS[tk * 4 + which] = isb ? gv : expf(gv); } }
            __syncthreads();
            for (int s = 0; s < 16; ++s) {
                const float av = GS[s * 4 + vh], bv = GS[s * 4 + 2 + vh], vt = VS[s * 256 + vh * 128 + j];
                const LAS float* kp = KQ + s * 256 + 128 + half * 64; const LAS float* qp = KQ + s * 256 + half * 64;
                float ks = 0.f;
#pragma unroll
                for (int i = 0; i < 64; i += 4) { const f32x4 k4 = *(const LAS f32x4*)(kp + i); ks += k4[0] * S[i] + k4[1] * S[i + 1] + k4[2] * S[i + 2] + k4[3] * S[i + 3]; }
                ks += __shfl_xor(ks, 1);
                const float uu = bv * (vt - av * ks);
                float os = 0.f;
#pragma unroll
                for (int i = 0; i < 64; i += 4) { const f32x4 k4 = *(const LAS f32x4*)(kp + i), q4 = *(const LAS f32x4*)(qp + i);
#pragma unroll
                    for (int e = 0; e < 4; ++e) { S[i + e] = av * S[i + e] + k4[e] * uu; os += q4[e] * S[i + e]; } }
                os += __shfl_xor(os, 1);
                if (half == 0) { const int step = blk * 16 + s, pos = dir ? SEQ - 1 - step : step; OD[((size_t)seq * SEQ + pos) * 4096 + head * 128 + j] = f2bf(os); }
            }
        }
    }
}
__device__ __forceinline__ void gdn_sumnorm(ArgsCP a, bf16_t* OF, const bf16_t* OB, int rows) {
    const int tid = tidx(), rsub = tid >> 8, c0 = (tid & 255) * 16;
    const float* on = a->in[20];
    float gn[16];
#pragma unroll
    for (int q = 0; q < 16; ++q) gn[q] = on[(c0 & 127) + q];
    for (int r8 = blockIdx.x * 8; r8 < rows; r8 += gridDim.x * 8) {
        u32x4 f[4][2], b[4][2];
#pragma unroll
        for (int q = 0; q < 4; ++q) { const size_t off = (size_t)(r8 + 2 * q + rsub) * 4096 + c0;
            f[q][0] = *(const u32x4*)(OF + off); f[q][1] = *(const u32x4*)(OF + off + 8); b[q][0] = *(const u32x4*)(OB + off); b[q][1] = *(const u32x4*)(OB + off + 8); }
        asm volatile("" ::: "memory");
#pragma unroll
        for (int q = 0; q < 4; ++q) { const size_t off = (size_t)(r8 + 2 * q + rsub) * 4096 + c0;
            float x[16], t[8];
            unpack8(f[q][0], t);
#pragma unroll
            for (int e = 0; e < 8; ++e) x[e] = t[e];
            unpack8(f[q][1], t);
#pragma unroll
            for (int e = 0; e < 8; ++e) x[8 + e] = t[e];
            unpack8(b[q][0], t);
#pragma unroll
            for (int e = 0; e < 8; ++e) x[e] += t[e];
            unpack8(b[q][1], t);
#pragma unroll
            for (int e = 0; e < 8; ++e) x[8 + e] += t[e];
            float ss = 0.f;
#pragma unroll
            for (int e = 0; e < 16; ++e) ss += x[e] * x[e];
            ss += __shfl_xor(ss, 1); ss += __shfl_xor(ss, 2); ss += __shfl_xor(ss, 4);
            const float sc = rsqrtf(ss * (1.0f / 128.0f) + EPS);
            float o0[8], o1[8];
#pragma unroll
            for (int e = 0; e < 8; ++e) { o0[e] = x[e] * sc * gn[e]; o1[e] = x[8 + e] * sc * gn[8 + e]; }
            *(u32x4*)(OF + off) = pack8(o0); *(u32x4*)(OF + off + 8) = pack8(o1); }
    }
}

__device__ __forceinline__ void s5_scan(ArgsCP a, LAS unsigned char* lds, const float* X, const rs_t* rs, float* YF, bf16_t* Y) {
    const int tid = tidx(), w = tid >> 6, lane = tid & 63;
    LAS float* U = (LAS float*)(lds + w * 9216);
    LAS float* XS = U + 256;
    const float* gmix = a->in[4] + 3 * D;
    for (int task = blockIdx.x * 8 + w; task < NSEQ * 128; task += gridDim.x * 8) {
        const int seq = task >> 7, gr = task & 127;
        for (int dir = 0; dir < 2; ++dir) {
            const int dg = dir * 128 + gr;
            const float are = a->in[22][dg * 64 + lane], aim = a->in[23][dg * 64 + lane], dt = expf(a->in[24][dg]);
            const float er = expf(are * dt); float sn, cs; sincosf(aim * dt, &sn, &cs);
            const float abr = er * cs, abi = er * sn;
            const float den = 1.0f / (are * are + aim * aim);
            const float cr = ((abr - 1.0f) * are + abi * aim) * den, ci = (abi * are - (abr - 1.0f) * aim) * den;
            float Br[16], Bi[16];
#pragma unroll
            for (int c = 0; c < 16; ++c) { const float bre = a->in[25][((size_t)dg * 64 + lane) * 16 + c], bim = a->in[26][((size_t)dg * 64 + lane) * 16 + c]; Br[c] = cr * bre - ci * bim; Bi[c] = cr * bim + ci * bre; }
            const int oc = lane & 15, tb = lane >> 4;
            float Cr[64], Ci[64];
#pragma unroll
            for (int p = 0; p < 64; ++p) { Cr[p] = a->in[27][((size_t)dg * 16 + oc) * 64 + p]; Ci[p] = a->in[28][((size_t)dg * 16 + oc) * 64 + p]; }
            const float dsk = a->in[29][gr * 16 + oc];
            float xr = 0.f, xi = 0.f;
            for (int blk = 0; blk < SEQ / 16; ++blk) {
                { const int tt = lane >> 2, c4 = (lane & 3) * 4, step = blk * 16 + tt, pos = dir ? SEQ - 1 - step : step; const size_t row = (size_t)seq * SEQ + pos;
                  const f32x4 xv = *(const f32x4*)(X + row * D + gr * 16 + c4); const f32x4 gm = *(const f32x4*)(gmix + gr * 16 + c4); const float rsd = rstd_of(rs[row]);
                  *(LAS f32x4*)(U + tt * 16 + c4) = xv * gm * rsd; }
                __builtin_amdgcn_wave_barrier();
                for (int tt = 0; tt < 16; ++tt) {
                    float bur = 0.f, bui = 0.f;
#pragma unroll
                    for (int c = 0; c < 16; c += 4) { const f32x4 u4 = *(const LAS f32x4*)(U + tt * 16 + c);
#pragma unroll
                        for (int e = 0; e < 4; ++e) { bur += Br[c + e] * u4[e]; bui += Bi[c + e] * u4[e]; } }
                    const float nr = abr * xr - abi * xi + bur, ni = abr * xi + abi * xr + bui; xr = nr; xi = ni;
                    XS[(tt * 64 + lane) * 2] = xr; XS[(tt * 64 + lane) * 2 + 1] = xi;
                }
                __builtin_amdgcn_wave_barrier();
                for (int i = 0; i < 4; ++i) {
                    const int t = tb * 4 + i; float y = 0.f;
#pragma unroll
                    for (int p = 0; p < 64; p += 2) { const f32x4 x2 = *(const LAS f32x4*)(XS + (t * 64 + p) * 2); y += Cr[p] * x2[0] - Ci[p] * x2[1] + Cr[p + 1] * x2[2] - Ci[p + 1] * x2[3]; }
                    const int step = blk * 16 + t, pos = dir ? SEQ - 1 - step : step; const size_t row = (size_t)seq * SEQ + pos;
                    if (dir == 0) YF[row * D + gr * 16 + oc] = y;
                    else { const float yt = y + YF[row * D + gr * 16 + oc] + dsk * U[t * 16 + oc]; Y[row * D + gr * 16 + oc] = f2bf(geluf_(yt)); }
                }
                __builtin_amdgcn_wave_barrier();
            }
        }
    }
}

__device__ __forceinline__ void final_norm(ArgsCP a, const rs_t* rs, const bf16_t* XB) {
    const int tid = tidx(), w = tid >> 6, lane = tid & 63; const float* g = a->in[7];
    for (int row = blockIdx.x * 8 + w; row < T; row += gridDim.x * 8) {
        const float s = rstd_of(rs[row]);
#pragma unroll
        for (int q = 0; q < 4; ++q) { const int c = (q * 64 + lane) * 8; float v[8]; unpack8(*(const u32x4*)(XB + (size_t)row * D + c), v);
            const f32x4 g0 = *(const f32x4*)(g + c), g1 = *(const f32x4*)(g + c + 4);
            *(f32x4*)(a->out + (size_t)row * D + c) = (f32x4){v[0] * g0[0] * s, v[1] * g0[1] * s, v[2] * g0[2] * s, v[3] * g0[3] * s};
            *(f32x4*)(a->out + (size_t)row * D + c + 4) = (f32x4){v[4] * g1[0] * s, v[5] * g1[1] * s, v[6] * g1[2] * s, v[7] * g1[3] * s}; }
    }
}


namespace gdn {
typedef short s16x8 __attribute__((ext_vector_type(8)));
typedef short s16x4 __attribute__((ext_vector_type(4)));
constexpr int QS = 0, QPITCH = 272;
constexpr int KS = QS + 64 * QPITCH;
constexpr int VS = KS + 64 * QPITCH;
constexpr int WS_ = VS + 64 * QPITCH;
constexpr int MB = WS_ + 64 * QPITCH, MPITCH = 144;
constexpr int A2 = MB + 64 * MPITCH;
constexpr int MD = A2 + 64 * MPITCH, MDP = 20;
constexpr int DV = MD + 4 * 16 * MDP * 4, DVPITCH = 48;
constexpr int TB = DV + 4 * 16 * DVPITCH;
constexpr int TB1 = TB + 5 * 256;
constexpr int SET1 = TB1 + 5 * 256;
constexpr int LDS_END = SET1 + 3 * 64 * QPITCH;
static_assert(SET1 % 16 == 0, "gdn lds align");
static_assert(LDS_END <= LDS_BAR, "gdn lds");

__device__ __forceinline__ s16x8 mk8(unsigned a, unsigned b, unsigned c, unsigned d) { u32x4 v; v.x = a; v.y = b; v.z = c; v.w = d; return __builtin_bit_cast(s16x8, v); }
__device__ __forceinline__ s16x8 cat8(u32x2 lo, u32x2 hi) { return mk8(lo.x, lo.y, hi.x, hi.y); }
__device__ __forceinline__ s16x4 mk4(unsigned a, unsigned b) { u32x2 v; v.x = a; v.y = b; return __builtin_bit_cast(s16x4, v); }

__device__ __forceinline__ void scan(LAS unsigned char* lds, const bf16_t* QK, const bf16_t* VP, const float* GB, bf16_t* OF, bf16_t* OB, int nseq, int wg, int nwg) {
    const int tid = tidx(), w = __builtin_amdgcn_readfirstlane(tid >> 6), lane = tid & 63;
#define GDN_FRESH() int ln_ = lane; asm volatile("" : "+v"(ln_)); const int g = ln_ >> 4, n = ln_ & 15;
    const int nunits = nseq * 64;
    for (int unit = wg; unit < nunits; unit += nwg) {
        const int seq = unit >> 6, h = (unit >> 1) & 31, dir = unit & 1, hq = h >> 1;
        bf16_t* OD = dir ? OB : OF;
        f32x4 S[8];
#pragma unroll
        for (int i = 0; i < 8; ++i) S[i] = (f32x4){0.f, 0.f, 0.f, 0.f};
        u32x4 pq[2], pk[2], pv[2]; float pg = 0.f, pb = 0.f;
#define GDN_LOADG(c) do { _Pragma("unroll") for (int i_ = 0; i_ < 2; ++i_) { const int p_ = tid + 512 * i_, ir_ = p_ >> 4, c16_ = (p_ & 15) * 8; \
            const int st_ = (c) * 64 + ir_, pos_ = dir ? SEQ - 1 - st_ : st_; const size_t row_ = (size_t)seq * SEQ + pos_; \
            pq[i_] = *(const u32x4*)(QK + row_ * 4096 + hq * 128 + c16_); pk[i_] = *(const u32x4*)(QK + row_ * 4096 + 2048 + hq * 128 + c16_); pv[i_] = *(const u32x4*)(VP + row_ * 4096 + h * 128 + c16_); } \
            if (tid < 64) { const int st_ = (c) * 64 + tid, pos_ = dir ? SEQ - 1 - st_ : st_; const size_t row_ = (size_t)seq * SEQ + pos_; pg = GB[row_ * 128 + dir * 64 + h]; pb = GB[row_ * 128 + dir * 64 + 32 + h]; } } while (0)
#define GDN_DPPADD(ctrl_, rm_) { const int t_ = __builtin_amdgcn_update_dpp(0, xi_, ctrl_, rm_, 0xf, false); xi_ = __float_as_int(__int_as_float(xi_) + __int_as_float(t_)); }
#define GDN_STORE(P_) do { LAS unsigned char* const lx_ = lds + (P_) * SET1; LAS float* const gx_ = (LAS float*)(lds + ((P_) ? TB1 : TB)); _Pragma("unroll") for (int i_ = 0; i_ < 2; ++i_) { const int p_ = tid + 512 * i_, ir_ = p_ >> 4, c16_ = (p_ & 15) * 8; \
            *(LAS u32x4*)(lx_ + QS + ir_ * QPITCH + c16_ * 2) = pq[i_]; *(LAS u32x4*)(lx_ + KS + ir_ * QPITCH + c16_ * 2) = pk[i_]; *(LAS u32x4*)(lx_ + VS + ir_ * QPITCH + c16_ * 2) = pv[i_]; \
            } \
            if (tid < 64) { int xi_ = __float_as_int(pg);     \
                GDN_DPPADD(0x111, 0xf) GDN_DPPADD(0x112, 0xf) GDN_DPPADD(0x114, 0xf) GDN_DPPADD(0x118, 0xf) GDN_DPPADD(0x142, 0xa) GDN_DPPADD(0x143, 0xc) \
                const float gs_ = __int_as_float(xi_), gl_ = __int_as_float(__builtin_amdgcn_readlane(xi_, 63)), e_ = __expf(gs_); gx_[tid] = gs_; gx_[64 + tid] = e_; gx_[128 + tid] = pb * e_; gx_[192 + tid] = pb; gx_[256 + tid] = __expf(gl_ - gs_); } } while (0)
        GDN_LOADG(0);
        __syncthreads();
        GDN_STORE(0);
        for (int i_ = tid; i_ < 64 * MPITCH / 16; i_ += NTHR) *(LAS u32x4*)(lds + A2 + i_ * 16) = (u32x4){0u, 0u, 0u, 0u};
        __syncthreads();
        for (int c = 0; c < 64; ++c) {
            LAS unsigned char* const ldc = lds + (c & 1) * SET1;
            LAS float* const gam = (LAS float*)(lds + ((c & 1) ? TB1 : TB)); LAS float* const eg = gam + 64; LAS float* const bg = gam + 128; LAS float* const bt = gam + 192; LAS float* const dl = gam + 256;
            { GDN_FRESH()
#pragma unroll
              for (int t = 0; t < 2; ++t) if (t == 0 || w == 4 || w == 5) {
                  const int rb = (w < 4) ? w : (t == 0 ? (w == 4 ? 1 : (w == 5 ? 2 : 3)) : (w == 4 ? 2 : 3));
                  const int cb = (w < 4) ? w : (t == 0 ? (w == 4 ? 0 : (w == 7 ? 2 : 1)) : 0);
                  const f32x4 gi4 = *(const LAS f32x4*)(gam + 16 * rb + 4 * g), bti4 = *(const LAS f32x4*)(bt + 16 * rb + 4 * g);
                  const float gj = gam[16 * cb + n];
                  f32x4 a1 = (f32x4){0.f, 0.f, 0.f, 0.f}, a2 = a1;
#pragma unroll
                  for (int ks = 0; ks < 4; ++ks) {
                      const s16x8 ak = *(const LAS s16x8*)(ldc + KS + (16 * rb + n) * QPITCH + (32 * ks + 8 * g) * 2);
                      const s16x8 aq = *(const LAS s16x8*)(ldc + QS + (16 * rb + n) * QPITCH + (32 * ks + 8 * g) * 2);
                      const s16x8 bk = *(const LAS s16x8*)(ldc + KS + (16 * cb + n) * QPITCH + (32 * ks + 8 * g) * 2);
                      a1 = __builtin_amdgcn_mfma_f32_16x16x32_bf16(ak, bk, a1, 0, 0, 0);
                      a2 = __builtin_amdgcn_mfma_f32_16x16x32_bf16(aq, bk, a2, 0, 0, 0); }
                  const int j = 16 * cb + n;
#pragma unroll
                  for (int e = 0; e < 4; ++e) { const int i = 16 * rb + 4 * g + e; const float d = __expf(fminf(gi4[e] - gj, 0.f));
                      const float mm = (j < i) ? a1[e] * d * bti4[e] : 0.f, am = (j <= i) ? a2[e] * d : 0.f;
                      *(LAS bf16_t*)(lds + A2 + i * MPITCH + j * 2) = f2bf(am);
                      if (w < 4) *(LAS float*)(lds + MD + ((rb * 16 + 4 * g + e) * MDP + n) * 4) = mm;
                      else *(LAS bf16_t*)(lds + MB + i * MPITCH + j * 2) = f2bf(mm); } } }
            if (w < 4) { GDN_FRESH() const LAS float* N = (const LAS float*)(lds + MD + w * 16 * MDP * 4);
                f32x4 Nr[16][4];
#pragma unroll
                for (int i = 1; i < 16; ++i)
#pragma unroll
                    for (int q = 0; q < 4; ++q) if (4 * q < i) Nr[i][q] = *(const LAS f32x4*)(N + i * MDP + 4 * q);
                f32x4 s4[4];
#pragma unroll
                for (int q = 0; q < 4; ++q) s4[q] = (f32x4){(4 * q + 0 == n) ? 1.f : 0.f, (4 * q + 1 == n) ? 1.f : 0.f, (4 * q + 2 == n) ? 1.f : 0.f, (4 * q + 3 == n) ? 1.f : 0.f};
#pragma unroll
                for (int i = 15; i >= 1; --i) { const float yi = -s4[i >> 2][i & 3]; const f32x4 yv = (f32x4){yi, yi, yi, yi};
#pragma unroll
                    for (int q = 0; q < 4; ++q) if (4 * q < i) s4[q] = __builtin_elementwise_fma(yv, Nr[i][q], s4[q]); }
                float y[16];
#pragma unroll
                for (int j = 0; j < 16; ++j) y[j] = s4[j >> 2][j & 3];
                if (g == 0) { u32x4 d0, d1; d0.x = pk2(y[0], y[1]); d0.y = pk2(y[2], y[3]); d0.z = pk2(y[4], y[5]); d0.w = pk2(y[6], y[7]); d1.x = pk2(y[8], y[9]); d1.y = pk2(y[10], y[11]); d1.z = pk2(y[12], y[13]); d1.w = pk2(y[14], y[15]);
                    *(LAS u32x4*)(lds + DV + (w * 16 + n) * DVPITCH) = d0; *(LAS u32x4*)(lds + DV + (w * 16 + n) * DVPITCH + 16) = d1; } }
            __syncthreads();
            f32x4 xw[4], u[4];
            { GDN_FRESH()
            u32x2 rk[4], rv[4];
            { const unsigned ad = (unsigned)(size_t)ldc + (unsigned)((4 * g + (n >> 2)) * QPITCH + (16 * w + 4 * (n & 3)) * 2);
              asm volatile("ds_read_b64_tr_b16 %0, %8 offset:%9\n\tds_read_b64_tr_b16 %1, %8 offset:%10\n\tds_read_b64_tr_b16 %2, %8 offset:%11\n\tds_read_b64_tr_b16 %3, %8 offset:%12\n\t"
                           "ds_read_b64_tr_b16 %4, %8 offset:%13\n\tds_read_b64_tr_b16 %5, %8 offset:%14\n\tds_read_b64_tr_b16 %6, %8 offset:%15\n\tds_read_b64_tr_b16 %7, %8 offset:%16\n\ts_waitcnt lgkmcnt(0)"
                           : "=&v"(rk[0]), "=&v"(rk[1]), "=&v"(rk[2]), "=&v"(rk[3]), "=&v"(rv[0]), "=&v"(rv[1]), "=&v"(rv[2]), "=&v"(rv[3])
                           : "v"(ad), "n"(KS), "n"(KS + 16 * QPITCH), "n"(KS + 32 * QPITCH), "n"(KS + 48 * QPITCH), "n"(VS), "n"(VS + 16 * QPITCH), "n"(VS + 32 * QPITCH), "n"(VS + 48 * QPITCH) : "memory"); }
            f32x4 bgv[4], btv[4]; s16x4 amv[4][3], adv[4];
#pragma unroll
            for (int b = 0; b < 4; ++b) { bgv[b] = *(const LAS f32x4*)(bg + 16 * b + 4 * g); btv[b] = *(const LAS f32x4*)(bt + 16 * b + 4 * g);
                adv[b] = *(const LAS s16x4*)(lds + DV + (b * 16 + n) * DVPITCH + 4 * g * 2);
#pragma unroll
                for (int j = 0; j < 3; ++j) if (j < b) amv[b][j] = *(const LAS s16x4*)(lds + MB + (16 * b + n) * MPITCH + (16 * j + 4 * g) * 2); }
#pragma unroll
            for (int b = 0; b < 4; ++b) {
                f32x4 aw, au;
                { const f32x4 bg4 = bgv[b], bt4 = btv[b];
                  aw[0] = blo(rk[b].x) * bg4[0]; aw[1] = bhi(rk[b].x) * bg4[1]; aw[2] = blo(rk[b].y) * bg4[2]; aw[3] = bhi(rk[b].y) * bg4[3];
                  au[0] = blo(rv[b].x) * bt4[0]; au[1] = bhi(rv[b].x) * bt4[1]; au[2] = blo(rv[b].y) * bt4[2]; au[3] = bhi(rv[b].y) * bt4[3]; }
#pragma unroll
                for (int j = 0; j < 4; ++j) if (j < b) {
                    const s16x4 am = amv[b][j < 3 ? j : 0];
                    const s16x4 bw = mk4(pk2(xw[j][0], xw[j][1]) ^ 0x80008000u, pk2(xw[j][2], xw[j][3]) ^ 0x80008000u);
                    const s16x4 bu = mk4(pk2(u[j][0], u[j][1]) ^ 0x80008000u, pk2(u[j][2], u[j][3]) ^ 0x80008000u);
                    aw = __builtin_amdgcn_mfma_f32_16x16x16bf16_1k(am, bw, aw, 0, 0, 0);
                    au = __builtin_amdgcn_mfma_f32_16x16x16bf16_1k(am, bu, au, 0, 0, 0); }
                const s16x4 ad = adv[b];
                xw[b] = __builtin_amdgcn_mfma_f32_16x16x16bf16_1k(ad, mk4(pk2(aw[0], aw[1]), pk2(aw[2], aw[3])), (f32x4){0.f, 0.f, 0.f, 0.f}, 0, 0, 0);
                u[b]  = __builtin_amdgcn_mfma_f32_16x16x16bf16_1k(ad, mk4(pk2(au[0], au[1]), pk2(au[2], au[3])), (f32x4){0.f, 0.f, 0.f, 0.f}, 0, 0, 0);
#pragma unroll
                for (int e = 0; e < 4; ++e) *(LAS bf16_t*)(lds + WS_ + (16 * b + 4 * g + e) * QPITCH + (16 * w + n) * 2) = f2bf(-xw[b][e]);
                __builtin_amdgcn_sched_barrier(0);
            } }
            __syncthreads();
            if (c + 1 < 64) GDN_LOADG(c + 1);
            s16x8 Sb[4];
#pragma unroll
            for (int ks = 0; ks < 4; ++ks) Sb[ks] = mk8(pk2(S[2 * ks][0], S[2 * ks][1]), pk2(S[2 * ks][2], S[2 * ks][3]), pk2(S[2 * ks + 1][0], S[2 * ks + 1][1]), pk2(S[2 * ks + 1][2], S[2 * ks + 1][3]));
            { GDN_FRESH()
            s16x8 fw[2][4];
#define GDN_LDW(buf_, rb_) do { _Pragma("unroll") for (int ks_ = 0; ks_ < 4; ++ks_) { const LAS unsigned char* wp_ = lds + WS_ + (16 * (rb_) + n) * QPITCH + (32 * ks_ + 4 * g) * 2; \
                fw[buf_][ks_] = cat8(*(const LAS u32x2*)wp_, *(const LAS u32x2*)(wp_ + 32)); } } while (0)
            GDN_LDW(0, 0);
#pragma unroll
            for (int rb = 0; rb < 4; ++rb) {
                if (rb + 1 < 4) GDN_LDW((rb + 1) & 1, rb + 1);
                __builtin_amdgcn_sched_barrier(0);
#pragma unroll
                for (int ks = 0; ks < 4; ++ks) u[rb] = __builtin_amdgcn_mfma_f32_16x16x32_bf16(fw[rb & 1][ks], Sb[ks], u[rb], 0, 0, 0);
                __builtin_amdgcn_sched_barrier(0); }
#undef GDN_LDW
            }
            s16x8 Ub[2], Ud[2];
            { GDN_FRESH()
#pragma unroll
            for (int ks = 0; ks < 2; ++ks) {
                Ub[ks] = mk8(pk2(u[2 * ks][0], u[2 * ks][1]), pk2(u[2 * ks][2], u[2 * ks][3]), pk2(u[2 * ks + 1][0], u[2 * ks + 1][1]), pk2(u[2 * ks + 1][2], u[2 * ks + 1][3]));
                const f32x4 d0 = *(const LAS f32x4*)(dl + 32 * ks + 4 * g), d1 = *(const LAS f32x4*)(dl + 32 * ks + 16 + 4 * g);
                Ud[ks] = mk8(pk2(u[2 * ks][0] * d0[0], u[2 * ks][1] * d0[1]), pk2(u[2 * ks][2] * d0[2], u[2 * ks][3] * d0[3]),
                             pk2(u[2 * ks + 1][0] * d1[0], u[2 * ks + 1][1] * d1[1]), pk2(u[2 * ks + 1][2] * d1[2], u[2 * ks + 1][3] * d1[3])); } }
            { GDN_FRESH()
            s16x8 fo[2][6]; f32x4 ego[2];
#define GDN_LDO(buf_, rb_) do { _Pragma("unroll") for (int ks_ = 0; ks_ < 4; ++ks_) { const LAS unsigned char* qp_ = ldc + QS + (16 * (rb_) + n) * QPITCH + (32 * ks_ + 4 * g) * 2; \
                fo[buf_][ks_] = cat8(*(const LAS u32x2*)qp_, *(const LAS u32x2*)(qp_ + 32)); } \
              _Pragma("unroll") for (int ks_ = 0; ks_ < 2; ++ks_) { const LAS unsigned char* ap_ = lds + A2 + (16 * (rb_) + n) * MPITCH + (32 * ks_ + 4 * g) * 2; \
                fo[buf_][4 + ks_] = cat8(*(const LAS u32x2*)ap_, *(const LAS u32x2*)(ap_ + 32)); } \
              ego[buf_] = *(const LAS f32x4*)(eg + 16 * (rb_) + 4 * g); } while (0)
            GDN_LDO(0, 0);
#pragma unroll
            for (int rb = 0; rb < 4; ++rb) { f32x4 oa = (f32x4){0.f, 0.f, 0.f, 0.f}, o2 = oa;
                if (rb + 1 < 4) GDN_LDO((rb + 1) & 1, rb + 1);
                __builtin_amdgcn_sched_barrier(0);
#pragma unroll
                for (int ks = 0; ks < 4; ++ks) o2 = __builtin_amdgcn_mfma_f32_16x16x32_bf16(fo[rb & 1][ks], Sb[ks], o2, 0, 0, 0);
#pragma unroll
                for (int ks = 0; ks < 2; ++ks) oa = __builtin_amdgcn_mfma_f32_16x16x32_bf16(fo[rb & 1][4 + ks], Ub[ks], oa, 0, 0, 0);
                { const f32x4 eg4 = ego[rb & 1];
#pragma unroll
                  for (int e = 0; e < 4; ++e) *(LAS bf16_t*)(ldc + VS + (16 * rb + 4 * g + e) * QPITCH + (16 * w + n) * 2) = f2bf(eg4[e] * o2[e] + oa[e]); }
                __builtin_amdgcn_sched_barrier(0); }
#undef GDN_LDO
            }
            if (c + 1 < 64) GDN_STORE((c + 1) & 1);
            { GDN_FRESH() const float egl = eg[63];
              const unsigned adk = (unsigned)(size_t)ldc + (unsigned)((4 * g + (n >> 2)) * QPITCH + (4 * (n & 3)) * 2);
#pragma unroll
              for (int hf = 0; hf < 2; ++hf) {
                  u32x2 r[16];
                  const unsigned ah = adk + (unsigned)(hf * 128);
                  const unsigned a0_ = ah, a1_ = ah + 32u, a2_ = ah + 64u, a3_ = ah + 96u;
                  asm volatile("ds_read_b64_tr_b16 %0, %16 offset:%20\n\tds_read_b64_tr_b16 %1, %16 offset:%21\n\tds_read_b64_tr_b16 %2, %16 offset:%22\n\tds_read_b64_tr_b16 %3, %16 offset:%23\n\t"
                               "ds_read_b64_tr_b16 %4, %17 offset:%20\n\tds_read_b64_tr_b16 %5, %17 offset:%21\n\tds_read_b64_tr_b16 %6, %17 offset:%22\n\tds_read_b64_tr_b16 %7, %17 offset:%23\n\t"
                               "ds_read_b64_tr_b16 %8, %18 offset:%20\n\tds_read_b64_tr_b16 %9, %18 offset:%21\n\tds_read_b64_tr_b16 %10, %18 offset:%22\n\tds_read_b64_tr_b16 %11, %18 offset:%23\n\t"
                               "ds_read_b64_tr_b16 %12, %19 offset:%20\n\tds_read_b64_tr_b16 %13, %19 offset:%21\n\tds_read_b64_tr_b16 %14, %19 offset:%22\n\tds_read_b64_tr_b16 %15, %19 offset:%23\n\ts_waitcnt lgkmcnt(0)"
                               : "=&v"(r[0]), "=&v"(r[1]), "=&v"(r[2]), "=&v"(r[3]), "=&v"(r[4]), "=&v"(r[5]), "=&v"(r[6]), "=&v"(r[7]),
                                 "=&v"(r[8]), "=&v"(r[9]), "=&v"(r[10]), "=&v"(r[11]), "=&v"(r[12]), "=&v"(r[13]), "=&v"(r[14]), "=&v"(r[15])
                               : "v"(a0_), "v"(a1_), "v"(a2_), "v"(a3_), "n"(KS), "n"(KS + 16 * QPITCH), "n"(KS + 32 * QPITCH), "n"(KS + 48 * QPITCH) : "memory");
#pragma unroll
                  for (int q = 0; q < 4; ++q) { const int sb = 4 * hf + q; f32x4 acc = S[sb] * egl;
                      acc = __builtin_amdgcn_mfma_f32_16x16x32_bf16(cat8(r[4 * q + 0], r[4 * q + 1]), Ud[0], acc, 0, 0, 0);
                      acc = __builtin_amdgcn_mfma_f32_16x16x32_bf16(cat8(r[4 * q + 2], r[4 * q + 3]), Ud[1], acc, 0, 0, 0);
                      S[sb] = acc; }
                  __builtin_amdgcn_sched_barrier(0); }
            }
            __syncthreads();
#pragma unroll
            for (int i_ = 0; i_ < 2; ++i_) { const int p_ = tid + 512 * i_, ir_ = p_ >> 4, c16_ = (p_ & 15) * 8, st_ = c * 64 + ir_, pos_ = dir ? SEQ - 1 - st_ : st_;
                *(u32x4*)(OD + ((size_t)seq * SEQ + pos_) * 4096 + h * 128 + c16_) = *(const LAS u32x4*)(ldc + VS + ir_ * QPITCH + c16_ * 2); }
        }
#undef GDN_LOADG
#undef GDN_STORE
#undef GDN_DPPADD
#undef GDN_FRESH
    }
}
}

namespace na {
typedef short s16x8 __attribute__((ext_vector_type(8)));
constexpr int VPITCH = 272;
constexpr int VRING = 0, RPB = 512 * VPITCH;
constexpr int RPITCH = 64, XCH = RPB + 15 * RPITCH * 4;
constexpr int XW = 2560, LDS_END = XCH + 8 * XW;
static_assert(LDS_END <= LDS_BAR, "na lds");
__device__ __forceinline__ s16x8 mk8(unsigned a, unsigned b, unsigned c, unsigned d) { u32x4 v; v.x = a; v.y = b; v.z = c; v.w = d; return __builtin_bit_cast(s16x8, v); }

__device__ __forceinline__ void attention(ArgsCP a, LAS unsigned char* lds, const bf16_t* QKV, bf16_t* AO) {
    const int tid = tidx(), w = __builtin_amdgcn_readfirstlane(tid >> 6), lane = tid & 63, g = lane >> 4, n = lane & 15;
    const int j = w & 3, hh = w >> 2;
    const int c0 = min(max(16 * j - 8, 0), 32), qcol = 16 * j + n, cs = min(max(qcol - 8, 0), 48);
    LAS float* rpbs = (LAS float*)(lds + RPB);
    const int nitems = NSEQ * 16 * 64, G = gridDim.x;
    const int per = (nitems + G - 1) / G, it0 = blockIdx.x * per, it1 = min(nitems, it0 + per);
    int cur_sh = -1, have_lo = 0, have_hi = 0;
    const unsigned vbase = (unsigned)(size_t)(lds + VRING);
    for (int it = it0; it < it1; ++it) {
        const int sh = it >> 6, r = it & 63, seq = sh >> 4, h = sh & 15, r0 = min(max(r - 4, 0), 56);
        const size_t tbase = (size_t)seq * SEQ;
        s16x8 qf[4];
        const unsigned loff = (unsigned)((n * 6144 + 8 * g) * 2);
        { const unsigned char* qb = (const unsigned char*)(QKV + (tbase + r * 64 + 16 * j) * 6144 + h * 128);
#pragma unroll
          for (int ks = 0; ks < 4; ++ks) qf[ks] = *(const s16x8*)(qb + loff + 64 * ks); }
        f32x4 sacc[8];
        const unsigned char* kb0 = (const unsigned char*)(QKV + (tbase + (r0 + 4 * hh) * 64 + c0) * 6144 + 2048 + h * 128);
        s16x8 kfa[4][4], kfb[4][4];
#define NA_LOADK(buf, grp) do { _Pragma("unroll") for (int b_ = 0; b_ < 4; ++b_) { const int kb_ = 4 * (grp) + b_; const unsigned char* kp_ = kb0 + (size_t)((kb_ >> 1) * 64 + (kb_ & 1) * 16) * 6144 * 2; \
            _Pragma("unroll") for (int ks_ = 0; ks_ < 4; ++ks_) buf[b_][ks_] = *(const s16x8*)(kp_ + loff + 64 * ks_); } } while (0)
#define NA_MMAK(buf, grp) do { _Pragma("unroll") for (int b_ = 0; b_ < 4; ++b_) { f32x4 acc_ = (f32x4){0.f, 0.f, 0.f, 0.f}; \
            _Pragma("unroll") for (int ks_ = 0; ks_ < 4; ++ks_) acc_ = __builtin_amdgcn_mfma_f32_16x16x32_bf16(buf[b_][ks_], qf[ks_], acc_, 0, 0, 0); sacc[4 * (grp) + b_] = acc_; } } while (0)
        NA_LOADK(kfa, 0); asm volatile("" ::: "memory");
        NA_LOADK(kfb, 1); asm volatile("" ::: "memory");
        int lo = r0; const int hi = r0 + 8; const bool fresh = (sh != cur_sh);
        if (!fresh && have_hi > lo && have_lo <= lo) lo = have_hi;
        const bool defer = (hi - lo == 1);
        u32x4 vpre[2];
        if (defer) {
#pragma unroll
            for (int i = 0; i < 2; ++i) { const int p = tid + 512 * i, col = p >> 4, c16 = (p & 15) * 8; vpre[i] = *(const u32x4*)(QKV + (tbase + lo * 64 + col) * 6144 + 4096 + h * 128 + c16); } }
        if (fresh) { cur_sh = sh; for (int i = tid; i < 15 * 31; i += NTHR) { const int dr_ = i / 31, dc_ = i - dr_ * 31; rpbs[dr_ * RPITCH + 16 + dc_] = a->in[10][h * 465 + i]; } }
        if (!defer) {
          for (int kr = lo; kr < hi; ++kr) {
#pragma unroll
              for (int i = 0; i < 2; ++i) { const int p = tid + 512 * i, col = p >> 4, c16 = (p & 15) * 8;
                  const u32x4 v = *(const u32x4*)(QKV + (tbase + kr * 64 + col) * 6144 + 4096 + h * 128 + c16);
                  *(LAS u32x4*)(lds + VRING + ((kr & 7) * 64 + col) * VPITCH + c16 * 2) = v; } } }
        have_lo = r0; have_hi = r0 + 8;
        NA_MMAK(kfa, 0);
        NA_MMAK(kfb, 1);
#undef NA_LOADK
#undef NA_MMAK
        if (defer) {
#pragma unroll
            for (int i = 0; i < 2; ++i) { const int p = tid + 512 * i, col = p >> 4, c16 = (p & 15) * 8; *(LAS u32x4*)(lds + VRING + ((lo & 7) * 64 + col) * VPITCH + c16 * 2) = vpre[i]; } }
        __syncthreads();
        float mx = -1e30f;
        const LAS float* rbl = rpbs + (r0 + 4 * hh - r + 7) * RPITCH + (c0 - qcol + 31 + 4 * g);
        float bias[8][4];
#pragma unroll
        for (int kb = 0; kb < 8; ++kb)
#pragma unroll
            for (int e = 0; e < 4; ++e) bias[kb][e] = rbl[(kb >> 1) * RPITCH + 16 * (kb & 1) + e];
#pragma unroll
        for (int kb = 0; kb < 8; ++kb) {
#pragma unroll
            for (int e = 0; e < 4; ++e) { const int kc = c0 + 16 * (kb & 1) + 4 * g + e; const bool valid = (kc >= cs) && (kc < cs + 16);
                const float s = valid ? sacc[kb][e] + bias[kb][e] : -1e30f; sacc[kb][e] = s; mx = fmaxf(mx, s); } }
        mx = fmaxf(mx, __shfl_xor(mx, 16)); mx = fmaxf(mx, __shfl_xor(mx, 32));
        float sum = 0.f;
#pragma unroll
        for (int kb = 0; kb < 8; ++kb)
#pragma unroll
            for (int e = 0; e < 4; ++e) { const float p = __expf(sacc[kb][e] - mx); sacc[kb][e] = p; sum += p; }
        sum += __shfl_xor(sum, 16); sum += __shfl_xor(sum, 32);
        s16x8 pb[4];
#pragma unroll
        for (int kp = 0; kp < 4; ++kp) pb[kp] = mk8(pk2(sacc[2 * kp][0], sacc[2 * kp][1]), pk2(sacc[2 * kp][2], sacc[2 * kp][3]), pk2(sacc[2 * kp + 1][0], sacc[2 * kp + 1][1]), pk2(sacc[2 * kp + 1][2], sacc[2 * kp + 1][3]));
        f32x4 oacc[8];
        unsigned adl[4], adh[4];
#pragma unroll
        for (int kp = 0; kp < 4; ++kp) { const unsigned a_ = vbase + (unsigned)((((r0 + 4 * hh + kp) & 7) * 64 + c0) * VPITCH) + (unsigned)((4 * g + (n >> 2)) * VPITCH + (4 * (n & 3)) * 2);
            adl[kp] = a_ + (unsigned)(128 * hh); adh[kp] = a_ - 128u + (unsigned)(128 * (1 - hh)); }
#define NA_PV(i_, A_) do { u32x2 vt[8]; \
            asm volatile("ds_read_b64_tr_b16 %0, %8 offset:%12\n\tds_read_b64_tr_b16 %1, %8 offset:%13\n\tds_read_b64_tr_b16 %2, %9 offset:%12\n\tds_read_b64_tr_b16 %3, %9 offset:%13\n\t" \
                         "ds_read_b64_tr_b16 %4, %10 offset:%12\n\tds_read_b64_tr_b16 %5, %10 offset:%13\n\tds_read_b64_tr_b16 %6, %11 offset:%12\n\tds_read_b64_tr_b16 %7, %11 offset:%13\n\t" \
                         "s_waitcnt lgkmcnt(0)" \
                         : "=&v"(vt[0]), "=&v"(vt[1]), "=&v"(vt[2]), "=&v"(vt[3]), "=&v"(vt[4]), "=&v"(vt[5]), "=&v"(vt[6]), "=&v"(vt[7]) \
                         : "v"(A_[0]), "v"(A_[1]), "v"(A_[2]), "v"(A_[3]), "n"(32 * (i_)), "n"(16 * VPITCH + 32 * (i_)) : "memory"); \
            f32x4 oa = (f32x4){0.f, 0.f, 0.f, 0.f}; \
            _Pragma("unroll") for (int kp = 0; kp < 4; ++kp) oa = __builtin_amdgcn_mfma_f32_16x16x32_bf16(mk8(vt[2 * kp].x, vt[2 * kp].y, vt[2 * kp + 1].x, vt[2 * kp + 1].y), pb[kp], oa, 0, 0, 0); \
            oacc[i_] = oa; } while (0)
        NA_PV(0, adl); NA_PV(1, adl); NA_PV(2, adl); NA_PV(3, adl); NA_PV(4, adh); NA_PV(5, adh); NA_PV(6, adh); NA_PV(7, adh);
#undef NA_PV
        { LAS unsigned char* xo = lds + XCH + (w ^ 4) * XW;
          u32x4 s0, s1;
          { const f32x4 a0 = oacc[4], a1 = oacc[5], a2 = oacc[6], a3 = oacc[7];
            s0.x = pk2(a0[0], a0[1]); s0.y = pk2(a0[2], a0[3]); s0.z = pk2(a1[0], a1[1]); s0.w = pk2(a1[2], a1[3]);
            s1.x = pk2(a2[0], a2[1]); s1.y = pk2(a2[2], a2[3]); s1.z = pk2(a3[0], a3[1]); s1.w = pk2(a3[2], a3[3]); }
          *(LAS u32x4*)(xo + lane * 16) = s0; *(LAS u32x4*)(xo + 1024 + lane * 16) = s1;
          u32x2 ml; ml.x = __float_as_uint(mx); ml.y = __float_as_uint(sum); *(LAS u32x2*)(xo + 2048 + lane * 8) = ml; }
        __syncthreads();
        { const LAS unsigned char* xi = lds + XCH + w * XW;
          const u32x4 t0 = *(const LAS u32x4*)(xi + lane * 16), t1 = *(const LAS u32x4*)(xi + 1024 + lane * 16); const u32x2 ml = *(const LAS u32x2*)(xi + 2048 + lane * 8);
          const float mo = __uint_as_float(ml.x), lo_ = __uint_as_float(ml.y), mm = fmaxf(mx, mo), f0 = __expf(mx - mm), f1 = __expf(mo - mm), inv = 1.0f / (sum * f0 + lo_ * f1);
          const float w0 = f0 * inv, w1 = f1 * inv;
          const unsigned tw[8] = {t0.x, t0.y, t0.z, t0.w, t1.x, t1.y, t1.z, t1.w};
#pragma unroll
          for (int ci = 0; ci < 4; ++ci) { const f32x4 own = oacc[ci];
              u32x2 ov; ov.x = pk2(own[0] * w0 + blo(tw[2 * ci]) * w1, own[1] * w0 + bhi(tw[2 * ci]) * w1); ov.y = pk2(own[2] * w0 + blo(tw[2 * ci + 1]) * w1, own[3] * w0 + bhi(tw[2 * ci + 1]) * w1);
              *(u32x2*)(AO + (tbase + r * 64 + qcol) * D + h * 128 + 16 * (4 * hh + ci) + 4 * g) = ov; } }
    }
}
}

namespace s5 {
typedef short s16x8 __attribute__((ext_vector_type(8)));
typedef short s16x4 __attribute__((ext_vector_type(4)));
constexpr int XPITCH = 40, CF_OFF = 128 * XPITCH, WAVE_LDS = CF_OFF + 4096;
__device__ __forceinline__ float row_from_above16(float x) { auto s = __builtin_amdgcn_permlane16_swap(__float_as_uint(x), __float_as_uint(x), false, false); return __uint_as_float(s[1]); }
__device__ __forceinline__ float row_from_below16(float x) { auto s = __builtin_amdgcn_permlane16_swap(__float_as_uint(x), __float_as_uint(x), false, false); return __uint_as_float(s[0]); }
__device__ __forceinline__ float half_lo(float x) { auto s = __builtin_amdgcn_permlane32_swap(__float_as_uint(x), __float_as_uint(x), false, false); return __uint_as_float(s[0]); }
__device__ __forceinline__ float half_hi(float x) { auto s = __builtin_amdgcn_permlane32_swap(__float_as_uint(x), __float_as_uint(x), false, false); return __uint_as_float(s[1]); }
typedef float f32x2 __attribute__((ext_vector_type(2)));
__device__ __forceinline__ f32x2 cfma(f32x2 a, f32x2 z, f32x2 b) { const f32x2 t = __builtin_elementwise_fma((f32x2){a.x, a.x}, z, b); return __builtin_elementwise_fma((f32x2){-a.y, a.y}, (f32x2){z.y, z.x}, t); }
__device__ __forceinline__ void cpow(float are_dt, float aim_dt, float k, float& pr, float& pi) { const float e = expf(are_dt * k); float s, c; sincosf(aim_dt * k, &s, &c); pr = e * c; pi = e * s; }

template <int DIR> __device__ __forceinline__ void pass(ArgsCP a, LAS unsigned char* xl, const unsigned xbase, const int lane, const int g, const int n, const int task, const bool quarter, const int k,
                                                   const int b0, const int b1, const bool st_in, const bool st_out, const float* gmix, const bf16_t* X, const rs_t* rs, float* YF, bf16_t* Y,
                                                   LAS float* hand, volatile LAS int* flags) {
        asm volatile("s_waitcnt vmcnt(0)" ::: "memory");
        constexpr int dir = DIR; const int seq = task >> 7, gr = task & 127;
        const int tg4 = 4 * ((g == 0) ? 1 : (g == 1) ? 0 : g);
        const int sn = 4 * (((n >> 2) == 0) ? 1 : ((n >> 2) == 1) ? 0 : (n >> 2)) + (n & 3);
        const f32x4 gm4 = *(const f32x4*)(gmix + gr * 16 + 4 * g);
        const float dsk = a->in[29][gr * 16 + n];
        const int dg = dir * 128 + gr;
        const float dt = expf(a->in[24][dg]);
        float a1r[4], a1i[4], a4r[4], a4i[4];
        s16x4 bfr[8];
#pragma unroll
        for (int pb = 0; pb < 4; ++pb) { const int p = 16 * pb + n;
            const float are = a->in[22][dg * 64 + p], aim = a->in[23][dg * 64 + p], ad = are * dt, ai = aim * dt;
            cpow(ad, ai, 1.f, a1r[pb], a1i[pb]); cpow(ad, ai, 4.f, a4r[pb], a4i[pb]);
            const float den = 1.0f / (are * are + aim * aim);
            const float cr = ((a1r[pb] - 1.0f) * are + a1i[pb] * aim) * den, ci = (a1i[pb] * are - (a1r[pb] - 1.0f) * aim) * den;
            const f32x4 bre = *(const f32x4*)(a->in[25] + ((size_t)dg * 64 + p) * 16 + 4 * g), bim = *(const f32x4*)(a->in[26] + ((size_t)dg * 64 + p) * 16 + 4 * g);
            float br[4], bi[4];
#pragma unroll
            for (int e = 0; e < 4; ++e) { br[e] = cr * bre[e] - ci * bim[e]; bi[e] = cr * bim[e] + ci * bre[e]; }
            u32x2 t0; t0.x = pk2(br[0], br[1]); t0.y = pk2(br[2], br[3]); bfr[pb] = __builtin_bit_cast(s16x4, t0);
            u32x2 t1; t1.x = pk2(bi[0], bi[1]); t1.y = pk2(bi[2], bi[3]); bfr[4 + pb] = __builtin_bit_cast(s16x4, t1); }
#pragma unroll
        for (int ks = 0; ks < 4; ++ks) { const int p0 = 32 * ks + 8 * g; const bool im = p0 >= 64;
            const float* src = (im ? a->in[28] : a->in[27]) + ((size_t)dg * 16 + n) * 64 + (p0 & 63);
            const f32x4 c0 = *(const f32x4*)src, c1 = *(const f32x4*)(src + 4); const float sg = im ? -1.f : 1.f;
            u32x4 t; t.x = pk2(c0[0] * sg, c0[1] * sg); t.y = pk2(c0[2] * sg, c0[3] * sg); t.z = pk2(c1[0] * sg, c1[1] * sg); t.w = pk2(c1[2] * sg, c1[3] * sg);
            *(LAS u32x4*)(xl + CF_OFF + (ks * 64 + lane) * 16) = t; }
        float xpr[4], xpi[4];
#pragma unroll
        for (int pb = 0; pb < 4; ++pb) { xpr[pb] = st_in ? hand[lane * 8 + pb] : 0.f; xpi[pb] = st_in ? hand[lane * 8 + 4 + pb] : 0.f; }
        s16x4 dfr; { const float dq = dir ? dsk : 0.f;
          u32x2 t; t.x = pk2((4 * g + 0 == n) ? dq : 0.f, (4 * g + 1 == n) ? dq : 0.f); t.y = pk2((4 * g + 2 == n) ? dq : 0.f, (4 * g + 3 == n) ? dq : 0.f); dfr = __builtin_bit_cast(s16x4, t); }
        u32x2 un[2]; rs_t rn[2];
        const long rstep = dir ? -16 : 16;
        const size_t rowu0 = (size_t)seq * SEQ + (dir ? SEQ - 1 - sn : sn), rowy0 = (size_t)seq * SEQ + (dir ? SEQ - 1 - tg4 : tg4);
        const long estep = dir ? -1 : 1;
        const bf16_t* pu0 = X + rowu0 * D + gr * 16 + 4 * g; const rs_t* pr0 = rs + rowu0;
        float* py0 = YF + ((size_t)task * SEQ + (dir ? SEQ - 1 - tg4 : tg4)) * 16 + n;
        bf16_t* pY0 = Y + rowy0 * D + gr * 16 + n;
#define S5_PREF(q_, blk_) do { const long b_ = (long)(blk_) * rstep; un[q_] = *(const u32x2*)(pu0 + b_ * D); rn[q_] = pr0[b_]; \
            } while (0)
#pragma unroll
        for (int q = 0; q < 2; ++q) S5_PREF(q, b0 + q);
        float yfn[4];
#pragma unroll
        for (int e = 0; e < 4; ++e) yfn[e] = dir ? py0[((long)b0 * rstep + e * estep) * 16] : 0.f;
        for (int blk4_ = b0; blk4_ < b1; blk4_ += 2) {
          int blk4 = blk4_; asm volatile("" : "+s"(blk4));
#pragma unroll
          for (int q = 0; q < 2; ++q) {
            const int blk = blk4 + q;
            const u32x2 ur = un[q]; const float rsd = rstd_of(rn[q]); const f32x4 uc = (f32x4){blo(ur.x), bhi(ur.x), blo(ur.y), bhi(ur.y)};
            float yfc[4];
#pragma unroll
            for (int e = 0; e < 4; ++e) yfc[e] = yfn[e];
            { const int bn = (blk + 1 < SEQ / 16) ? blk + 1 : blk;
#pragma unroll
              for (int e = 0; e < 4; ++e) if (dir) yfn[e] = py0[((long)bn * rstep + e * estep) * 16]; }
            { const int bp = (blk + 2 < SEQ / 16) ? blk + 2 : SEQ / 16 - 1; S5_PREF(q, bp); }
            u32x2 uf; uf.x = pk2(uc[0] * gm4[0] * rsd, uc[1] * gm4[1] * rsd); uf.y = pk2(uc[2] * gm4[2] * rsd, uc[3] * gm4[3] * rsd);
            const s16x4 ua = __builtin_bit_cast(s16x4, uf);
            f32x4 bu[8];
#pragma unroll
            for (int qq = 0; qq < 8; ++qq) bu[qq] = __builtin_amdgcn_mfma_f32_16x16x16bf16_1k(ua, bfr[qq], (f32x4){0.f, 0.f, 0.f, 0.f}, 0, 0, 0);
            f32x2 L2[4], c2[4];
#pragma unroll
            for (int pb = 0; pb < 4; ++pb) {
                const f32x2 a1 = (f32x2){a1r[pb], a1i[pb]}; f32x2 l = (f32x2){bu[pb][0], bu[4 + pb][0]};
#pragma unroll
                for (int e = 1; e < 4; ++e) l = cfma(a1, l, (f32x2){bu[pb][e], bu[4 + pb][e]});
                L2[pb] = l; }
#define S5_SW16(x_, y_) __builtin_amdgcn_permlane16_swap(__float_as_uint(x_), __float_as_uint(y_), false, false)
#define S5_SW32(x_, y_) __builtin_amdgcn_permlane32_swap(__float_as_uint(x_), __float_as_uint(y_), false, false)
            {
                f32x2 kk[4], ss[4], k3s[4];
#pragma unroll
                for (int pb = 0; pb < 4; ++pb) { const auto qr = S5_SW32(xpr[pb], xpr[pb]), qi = S5_SW32(xpi[pb], xpi[pb]);
                    kk[pb] = (f32x2){__uint_as_float(qr[1]), __uint_as_float(qi[1])}; }
#pragma unroll
                for (int pb = 0; pb < 4; ++pb) ss[pb] = cfma((f32x2){a4r[pb], a4i[pb]}, kk[pb], L2[pb]);
#pragma unroll
                for (int pb = 0; pb < 4; ++pb) { const auto qr = S5_SW16(ss[pb].x, kk[pb].x), qi = S5_SW16(ss[pb].y, kk[pb].y);
                    kk[pb] = (f32x2){__uint_as_float(qr[1]), __uint_as_float(qi[1])}; }
#pragma unroll
                for (int pb = 0; pb < 4; ++pb) ss[pb] = cfma((f32x2){a4r[pb], a4i[pb]}, kk[pb], L2[pb]);
#pragma unroll
                for (int pb = 0; pb < 4; ++pb) { const auto qr = S5_SW32(kk[pb].x, ss[pb].x), qi = S5_SW32(kk[pb].y, ss[pb].y);
                    kk[pb] = (f32x2){__uint_as_float(qr[0]), __uint_as_float(qi[0])}; k3s[pb] = kk[pb]; }
#pragma unroll
                for (int pb = 0; pb < 4; ++pb) ss[pb] = cfma((f32x2){a4r[pb], a4i[pb]}, kk[pb], L2[pb]);
#pragma unroll
                for (int pb = 0; pb < 4; ++pb) { const auto qr = S5_SW16(kk[pb].x, ss[pb].x), qi = S5_SW16(kk[pb].y, ss[pb].y);
                    kk[pb] = (f32x2){__uint_as_float(qr[0]), __uint_as_float(qi[0])}; }
#pragma unroll
                for (int pb = 0; pb < 4; ++pb) { const f32x2 s4 = cfma((f32x2){a4r[pb], a4i[pb]}, kk[pb], L2[pb]); xpr[pb] = s4.x; xpi[pb] = s4.y;
                    c2[pb] = (g == 1) ? k3s[pb] : kk[pb]; }
            }
#undef S5_SW16
#undef S5_SW32
#pragma unroll
            for (int pb = 0; pb < 4; ++pb) {
                const f32x2 a1 = (f32x2){a1r[pb], a1i[pb]}; f32x2 z = c2[pb]; float xr[4], xi[4];
#pragma unroll
                for (int e = 0; e < 4; ++e) { z = cfma(a1, z, (f32x2){bu[pb][e], bu[4 + pb][e]}); xr[e] = z.x; xi[e] = z.y; }
                u32x2 wr_; wr_.x = pk2(xr[0], xr[1]); wr_.y = pk2(xr[2], xr[3]); *(LAS u32x2*)(xl + (16 * pb + n) * XPITCH + 8 * g) = wr_;
                u32x2 wi_; wi_.x = pk2(xi[0], xi[1]); wi_.y = pk2(xi[2], xi[3]); *(LAS u32x2*)(xl + (64 + 16 * pb + n) * XPITCH + 8 * g) = wi_; }
            s16x8 cf[4];
#pragma unroll
            for (int ks = 0; ks < 4; ++ks) cf[ks] = *(const LAS s16x8*)(xl + CF_OFF + (ks * 64 + lane) * 16);
            u32x2 xt[8];
            { const unsigned ad = xbase + (unsigned)((8 * g + (n >> 2)) * XPITCH + 8 * (n & 3));
              asm volatile("s_waitcnt lgkmcnt(0)\n\tds_read_b64_tr_b16 %0, %8\n\tds_read_b64_tr_b16 %1, %8 offset:160\n\tds_read_b64_tr_b16 %2, %8 offset:1280\n\tds_read_b64_tr_b16 %3, %8 offset:1440\n\t"
                           "ds_read_b64_tr_b16 %4, %8 offset:2560\n\tds_read_b64_tr_b16 %5, %8 offset:2720\n\tds_read_b64_tr_b16 %6, %8 offset:3840\n\tds_read_b64_tr_b16 %7, %8 offset:4000\n\t"
                           "s_waitcnt lgkmcnt(0)"
                           : "=&v"(xt[0]), "=&v"(xt[1]), "=&v"(xt[2]), "=&v"(xt[3]), "=&v"(xt[4]), "=&v"(xt[5]), "=&v"(xt[6]), "=&v"(xt[7]) : "v"(ad) : "memory"); }
            f32x4 y = (f32x4){0.f, 0.f, 0.f, 0.f};
            if (dir) y = __builtin_amdgcn_mfma_f32_16x16x16bf16_1k(ua, dfr, y, 0, 0, 0);
#pragma unroll
            for (int ks = 0; ks < 4; ++ks) { u32x4 t; t.x = xt[2 * ks].x; t.y = xt[2 * ks].y; t.z = xt[2 * ks + 1].x; t.w = xt[2 * ks + 1].y;
                y = __builtin_amdgcn_mfma_f32_16x16x32_bf16(__builtin_bit_cast(s16x8, t), cf[ks], y, 0, 0, 0); }
#pragma unroll
            for (int e = 0; e < 4; ++e) y[e] = dir ? geluf_(y[e] + yfc[e]) : y[e];
            if (dir == 0) {
#pragma unroll
                for (int e = 0; e < 4; ++e) py0[((long)blk * rstep + e * estep) * 16] = y[e]; }
            else {
#pragma unroll
                for (int e = 0; e < 4; ++e) pY0[((long)blk * rstep + e * estep) * D] = f2bf(y[e]); }
          }
        }
#undef S5_PREF
        if (quarter) {
            asm volatile("s_waitcnt vmcnt(0)" ::: "memory");
            if (st_out) {
#pragma unroll
                for (int pb = 0; pb < 4; ++pb) { hand[lane * 8 + pb] = xpr[pb]; hand[lane * 8 + 4 + pb] = xpi[pb]; } }
            asm volatile("s_waitcnt lgkmcnt(0)" ::: "memory");
            if (k < 3 && lane == 0) flags[k] = 1;
            __builtin_amdgcn_s_setprio(0);
        }
}

__device__ __forceinline__ void scan(ArgsCP a, LAS unsigned char* lds, const bf16_t* X, const rs_t* rs, float* YF, bf16_t* Y) {
    const int tid = tidx(), w = __builtin_amdgcn_readfirstlane(tid >> 6), lane = tid & 63, g = lane >> 4, n = lane & 15;
    LAS unsigned char* xl = lds + w * WAVE_LDS;
    const unsigned xbase = (unsigned)(size_t)xl;
    const float* gmix = a->in[4] + 3 * D;
    const int G = (int)gridDim.x; const bool split = (G == 256);
    const int tpw = (NSEQ * 128 + G - 1) / G;
    LAS float* hand = (LAS float*)(lds + 8 * WAVE_LDS);
    volatile LAS int* flags = (volatile LAS int*)(lds + 8 * WAVE_LDS + 2048);
    if (tid < 4) flags[tid] = 0;
    __syncthreads();
    const int ntw = split ? 1 : ((tpw - w + 7) >> 3);
    const int np = split ? (w < 4 ? 2 : 1) : 2 * ntw;
    for (int pi = 0; pi < np; ++pi) {
        const int k = w - 4;
        const bool quarter = split && w >= 4;
        const int task = split ? (int)blockIdx.x * 5 + (w < 4 ? w : 4) : (int)blockIdx.x * tpw + w + 8 * (pi >> 1);
        if (task >= NSEQ * 128 || (!split && task >= ((int)blockIdx.x + 1) * tpw)) break;
        const int dir = quarter ? (k >> 1) : (pi & 1);
        const int b0 = quarter ? (k & 1) * 128 : 0, b1 = quarter ? b0 + 128 : SEQ / 16;
        const bool st_in = quarter && (k & 1), st_out = quarter && !(k & 1);
        if (quarter) { if (k > 0) { while (flags[k - 1] == 0) __builtin_amdgcn_s_sleep(8); } __builtin_amdgcn_s_setprio(3); }
        if (dir) pass<1>(a, xl, xbase, lane, g, n, task, quarter, k, b0, b1, st_in, st_out, gmix, X, rs, YF, Y, hand, flags);
        else pass<0>(a, xl, xbase, lane, g, n, task, quarter, k, b0, b1, st_in, st_out, gmix, X, rs, YF, Y, hand, flags);
    }
}
}

namespace sgu {
typedef short s16x8 __attribute__((ext_vector_type(8)));
constexpr int VPITCH = 288, TILE = 128 * VPITCH;
__device__ __forceinline__ s16x8 mk8(unsigned a, unsigned b, unsigned c, unsigned d) { u32x4 v; v.x = a; v.y = b; v.z = c; v.w = d; return __builtin_bit_cast(s16x8, v); }

__device__ __forceinline__ void mix(ArgsCP a, LAS unsigned char* lds, const bf16_t* UV, const rs_t* rsv, bf16_t* MX) {
    const int tid = tidx(), w = __builtin_amdgcn_readfirstlane(tid >> 6), lane = tid & 63, g4 = lane >> 4, n = lane & 15, G = gridDim.x;
    const float* w_s = a->in[13]; const float* b_s = a->in[14]; const float* sgn = a->in[12];
    const int per = (5120 + G - 1) / G, u0 = blockIdx.x * per, u1 = min(5120, u0 + per);
    if (u0 >= u1) return;
    int gcur = -1; s16x8 wf[4]; float bias = 0.f; f32x4 gnall[8];
    u32x4 pv[4]; rs_t prs = 0;
#define SGU_LOADG(u_) do { const int g_ = (u_) / 320, sc_ = (u_) - g_ * 320; const size_t row_ = (size_t)(sc_ >> 5) * SEQ + (sc_ & 31) * 128 + (tid >> 2); \
        const bf16_t* p_ = UV + row_ * 4096 + 2048 + g_ * 128 + (tid & 3) * 32; _Pragma("unroll") for (int q_ = 0; q_ < 4; ++q_) pv[q_] = *(const u32x4*)(p_ + 8 * q_); prs = rsv[row_]; } while (0)
#define SGU_STORE(buf_) do { const float r_ = rstd_of(prs); LAS unsigned char* d_ = lds + (buf_) * TILE + (tid >> 2) * VPITCH + (tid & 3) * 64; \
        _Pragma("unroll") for (int q_ = 0; q_ < 4; ++q_) { float v_[8]; unpack8(pv[q_], v_); _Pragma("unroll") for (int j_ = 0; j_ < 8; ++j_) v_[j_] *= r_; *(LAS u32x4*)(d_ + 16 * q_) = pack8(v_); } } while (0)
    SGU_LOADG(u0);
    SGU_STORE(0);
    __syncthreads();
    for (int u = u0; u < u1; ++u) {
        const int buf = (u - u0) & 1;
        const int g = u / 320, sc = u - g * 320, seq = sc >> 5, nch = sc & 31; const size_t row0 = (size_t)seq * SEQ + nch * 128;
        if (u + 1 < u1) SGU_LOADG(u + 1);
        if (g != gcur) { gcur = g;
            const float* wp = w_s + ((size_t)g * 128 + 16 * w + n) * 128 + 8 * g4;
#pragma unroll
            for (int ks = 0; ks < 4; ++ks) { const f32x4 a0 = *(const f32x4*)(wp + 32 * ks), a1 = *(const f32x4*)(wp + 32 * ks + 4);
                wf[ks] = mk8(pk2(a0[0], a0[1]), pk2(a0[2], a0[3]), pk2(a1[0], a1[1]), pk2(a1[2], a1[3])); }
            bias = b_s[g * 128 + 16 * w + n];
#pragma unroll
            for (int cb = 0; cb < 8; ++cb) gnall[cb] = *(const f32x4*)(sgn + g * 128 + 16 * cb + 4 * g4); }
        const unsigned vb = (unsigned)(size_t)(lds + buf * TILE);
        const size_t row = row0 + 16 * w + n;
        u32x2 uall[8];
#pragma unroll
        for (int cb = 0; cb < 8; ++cb) uall[cb] = *(const u32x2*)(UV + row * 4096 + g * 128 + 16 * cb + 4 * g4);
#pragma unroll
        for (int cb = 0; cb < 8; ++cb) {
            u32x2 vt[8];
            { const unsigned ad = vb + (unsigned)((8 * g4 + (n >> 2)) * VPITCH + (16 * cb + 4 * (n & 3)) * 2);
              asm volatile("ds_read_b64_tr_b16 %0, %8\n\tds_read_b64_tr_b16 %1, %8 offset:1152\n\tds_read_b64_tr_b16 %2, %8 offset:9216\n\tds_read_b64_tr_b16 %3, %8 offset:10368\n\t"
                           "ds_read_b64_tr_b16 %4, %8 offset:18432\n\tds_read_b64_tr_b16 %5, %8 offset:19584\n\tds_read_b64_tr_b16 %6, %8 offset:27648\n\tds_read_b64_tr_b16 %7, %8 offset:28800\n\t"
                           "s_waitcnt lgkmcnt(0)"
                           : "=&v"(vt[0]), "=&v"(vt[1]), "=&v"(vt[2]), "=&v"(vt[3]), "=&v"(vt[4]), "=&v"(vt[5]), "=&v"(vt[6]), "=&v"(vt[7]) : "v"(ad) : "memory"); }
            f32x4 acc = (f32x4){0.f, 0.f, 0.f, 0.f};
#pragma unroll
            for (int ks = 0; ks < 4; ++ks) acc = __builtin_amdgcn_mfma_f32_16x16x32_bf16(mk8(vt[2 * ks].x, vt[2 * ks].y, vt[2 * ks + 1].x, vt[2 * ks + 1].y), wf[ks], acc, 0, 0, 0);
            const int c0 = g * 128 + 16 * cb + 4 * g4;
            const f32x4 gn = gnall[cb];
            const u32x2 uu = uall[cb];
            u32x2 o; o.x = pk2((acc[0] * gn[0] + bias) * blo(uu.x), (acc[1] * gn[1] + bias) * bhi(uu.x)); o.y = pk2((acc[2] * gn[2] + bias) * blo(uu.y), (acc[3] * gn[3] + bias) * bhi(uu.y));
            *(u32x2*)(MX + row * D + c0) = o;
        }
        if (u + 1 < u1) SGU_STORE(buf ^ 1);
        __syncthreads();
    }
#undef SGU_LOADG
#undef SGU_STORE
}
}
#ifndef MK_STAG
#define MK_STAG 90
#endif
#ifndef MK_SINGLE
#define MK_SINGLE 1
#endif
constexpr int NPH = 40;

__global__ void __launch_bounds__(NTHR, 2) mk_fwd(Args a_unused) {
    extern __shared__ __attribute__((aligned(16))) unsigned char lds_raw[];
    LAS unsigned char* lds = (LAS unsigned char*)lds_raw;
    int ph_lo, ph_hi;
    XcdBarrier bar;
    { ArgsCP a0 = argp(); ph_lo = a0->ph_lo; ph_hi = a0->ph_hi;
      bar.bar = (unsigned*)(a0->ws + WS_CTL); bar.x = 0; bar.st = (volatile LAS unsigned*)(lds + LDS_BAR);
      if (ph_hi - ph_lo > 1) {
          if (threadIdx.x < 4) ((LAS unsigned*)(lds + LDS_BAR))[threadIdx.x] = 0u;
          __syncthreads();
          bar = xcd_barrier_post((unsigned*)(a0->ws + WS_CTL), (volatile LAS unsigned*)(lds + LDS_BAR));
      } }
    int ph = 0;
#define PH_BEGIN if (ph >= ph_lo && ph < ph_hi) { ArgsCP a = argp(); unsigned char* ws = a->ws; float* X = a->out; rs_t* RS = (rs_t*)(ws + WS_RS); \
        bf16_t* XB0 = (bf16_t*)(ws + WS_XB0); bf16_t* XB1 = (bf16_t*)(ws + WS_XB1); unsigned char* BIG = ws + WS_BIG; (void)X; (void)RS; (void)XB0; (void)XB1; (void)BIG;
#define PH_END   } if (ph >= ph_lo && ph + 1 < ph_hi) xcd_barrier(bar); ++ph;
#define RSB(k) (RS + (size_t)(k) * T)

    PH_BEGIN prologue(a, lds); PH_END

#define FFN_PLE(L, XBc, XBo) \
    PH_BEGIN { EpiFfn E{(bf16_t*)(BIG + BIG_HID2), (bf16_t*)(BIG + BIG_EDGE), RSB(3 * (L) + 1), a->in[32] + (size_t)(L) * 3 * DFF, a->in[33] + (size_t)(L) * DFF}; \
               run_gemm(lds, XBc, (const bf16_t*)(ws + WS_WGU + (L) * SZ_WGU), T, 2 * DFF, D, E); } \
        \
      if (gridDim.x == 256 && blockIdx.x >= 128) { ArgsCP a = argp(); unsigned char* ws = a->ws; bf16_t* XB0 = (bf16_t*)(ws + WS_XB0); bf16_t* XB1 = (bf16_t*)(ws + WS_XB1); (void)XB0; (void)XB1; \
          EpiScale Ep{XBo, D, nullptr, nullptr, -1}; \
          run_gemm_linear(lds, (const bf16_t*)(ws + WS_PB) + (size_t)(L) * T * PLED, (const bf16_t*)(ws + WS_WPP + (L) * SZ_WPP), T, D, PLED, Ep, ((int)blockIdx.x - 128) * 7, 7, 1); } \
    PH_END \
    PH_BEGIN { ffn_fixup(a, (L), (const bf16_t*)(BIG + BIG_EDGE), (bf16_t*)(BIG + BIG_HID2)); \
               EpiScale E{XBo, D, nullptr, nullptr, -1}; const int done_ = (gridDim.x == 256) ? 896 : 0, left_ = 1280 - done_ - (int)blockIdx.x; \
               run_gemm_linear(lds, (const bf16_t*)(ws + WS_PB) + (size_t)(L) * T * PLED, (const bf16_t*)(ws + WS_WPP + (L) * SZ_WPP), T, D, PLED, E, done_ + (int)blockIdx.x, left_ > 0 ? (left_ + (int)gridDim.x - 1) / (int)gridDim.x : 0, (int)gridDim.x); } PH_END \
    PH_BEGIN { EpiResid E{XBc, XBc, RSB(3 * (L) + 2)}; \
               run_gemm(lds, (const bf16_t*)(BIG + BIG_HID2), (const bf16_t*)(ws + WS_WDN + (L) * SZ_WDN), T, D, DFF, E); } PH_END \
    PH_BEGIN { EpiPle E{XBc, XBo, RSB(3 * (L) + 3), RSB(3 * (L) + 2)}; \
               run_gemm(lds, XBc, (const bf16_t*)(ws + WS_WPG + (L) * SZ_WPG), T, D, D, E); } PH_END

    PH_BEGIN { EpiScale E{(bf16_t*)BIG, 6144, RSB(0), nullptr, -1}; run_gemm(lds, XB0, (const bf16_t*)(ws + WS_NAQ), T, 6144, D, E); } PH_END
    PH_BEGIN na::attention(a, lds, (const bf16_t*)BIG, XB1); PH_END
    PH_BEGIN { EpiResid E{XB0, XB0, RSB(1)}; run_gemm(lds, XB1, (const bf16_t*)(ws + WS_NAO), T, D, D, E); } PH_END
    FFN_PLE(0, XB0, XB1)
    PH_BEGIN { EpiGelu E{(bf16_t*)BIG, 4096, RSB(3), RSB(13), 8}; run_gemm(lds, XB1, (const bf16_t*)(ws + WS_SGI), T, 4096, D, E); } PH_END
    PH_BEGIN sgu::mix(a, lds, (const bf16_t*)BIG, RSB(13), XB0); PH_END
    PH_BEGIN { EpiResid E{XB1, XB1, RSB(4)}; run_gemm(lds, XB0, (const bf16_t*)(ws + WS_SGO), T, D, D, E); } PH_END
    FFN_PLE(1, XB1, XB0)
#define GDN0_PTRS bf16_t* PROJ = (bf16_t*)(BIG + G0_PROJ); bf16_t* OF = PROJ; bf16_t* OB = (bf16_t*)(BIG + G0_OB); bf16_t* VP = (bf16_t*)(BIG + G0_VP); \
        float* AB = (float*)(BIG + G0_AB); float* GB = (float*)(BIG + G0_GB); bf16_t* QK = XB1; (void)PROJ; (void)OF; (void)OB; (void)VP; (void)AB; (void)GB; (void)QK;
#define GDN1_PTRS bf16_t* PROJ = (bf16_t*)(BIG + G1_PROJ); bf16_t* OF = PROJ; bf16_t* OB = (bf16_t*)(BIG + G1_OB); bf16_t* VP = (bf16_t*)(BIG + G1_VP); \
        float* AB = (float*)(BIG + G1_AB); float* GB = (float*)(BIG + G1_GB); bf16_t* QK = XB1; (void)PROJ; (void)OF; (void)OB; (void)VP; (void)AB; (void)GB; (void)QK;
    PH_BEGIN { GDN0_PTRS EpiScale E{PROJ, 8192, RSB(6), AB, 32}; run_gemm(lds, XB0, (const bf16_t*)(ws + WS_GDI), G0_ROWS, GDI_N1, D, E); } PH_END
    PH_BEGIN { GDN0_PTRS gdn_conv(a, PROJ, AB, QK, VP, GB, G0_ROWS); } PH_END
    PH_BEGIN { const int Gh = (int)gridDim.x / 2, Gv = (int)gridDim.x - Gh;
               const int RB = (Gv == Gh) ? 14 : 1000;
               if ((int)blockIdx.x < Gh) { { GDN0_PTRS gdn::scan(lds, QK, VP, GB, OF, OB, G0_ROWS / SEQ, (int)blockIdx.x, Gh); }
                      __syncthreads();
                      { GDN1_PTRS const size_t r0 = G0_ROWS; EpiScale E{PROJ, 8192, RSB(6) + r0, AB, 32};
                        run_gemm_sub_range(lds, XB0 + r0 * D, (const bf16_t*)(ws + WS_GDI), GG_ROWS, GDI_N1, D, E, Gv, (int)blockIdx.x, RB, 100000); } }
               else { GDN1_PTRS const size_t r0 = G0_ROWS; EpiScale E{PROJ, 8192, RSB(6) + r0, AB, 32};
                      run_gemm_sub_range(lds, XB0 + r0 * D, (const bf16_t*)(ws + WS_GDI), GG_ROWS, GDI_N1, D, E, Gv, (int)blockIdx.x - Gh, 0, RB); } } PH_END
    PH_BEGIN { GDN0_PTRS EpiGdnZ E{OF, OB, 4096, RSB(6), a->in[20], (LAS float*)(lds + XCH_OFF)}; run_gemm(lds, XB0, (const bf16_t*)(ws + WS_GDI) + (size_t)GDI_N1 * D, G0_ROWS, 4096, D, E); } PH_END
    PH_BEGIN { GDN0_PTRS EpiResid E{XB0, XB0, RSB(7)}; run_gemm(lds, OF, (const bf16_t*)(ws + WS_GDO), G0_ROWS, D, 4096, E); } PH_END
#pragma unroll 1
    for (int gg = 0; gg < 2; ++gg) {
        const size_t r0 = (size_t)G0_ROWS + (size_t)gg * GG_ROWS;
        if (gg == 1) { PH_BEGIN { GDN1_PTRS EpiScale E{PROJ, 8192, RSB(6) + r0, AB, 32}; run_gemm(lds, XB0 + r0 * D, (const bf16_t*)(ws + WS_GDI), GG_ROWS, GDI_N1, D, E); } PH_END }
        PH_BEGIN { GDN1_PTRS gdn_conv(a, PROJ, AB, QK, VP, GB, GG_ROWS); } PH_END
        PH_BEGIN { GDN1_PTRS gdn::scan(lds, QK, VP, GB, OF, OB, GG_ROWS / SEQ, (int)blockIdx.x, (int)gridDim.x); } PH_END
        PH_BEGIN { GDN1_PTRS EpiGdnZ E{OF, OB, 4096, RSB(6) + r0, a->in[20], (LAS float*)(lds + XCH_OFF)}; run_gemm(lds, XB0 + r0 * D, (const bf16_t*)(ws + WS_GDI) + (size_t)GDI_N1 * D, GG_ROWS, 4096, D, E); } PH_END
        PH_BEGIN { GDN1_PTRS EpiResid E{XB0 + r0 * D, XB0 + r0 * D, RSB(7) + r0}; run_gemm(lds, OF, (const bf16_t*)(ws + WS_GDO), GG_ROWS, D, 4096, E); } PH_END
    }
    FFN_PLE(2, XB0, XB1)
    PH_BEGIN s5::scan(a, lds, XB1, RSB(9), (float*)BIG, XB0); PH_END
    PH_BEGIN { EpiGlu E{XB1, RSB(10)}; run_gemm(lds, XB0, (const bf16_t*)(ws + WS_S5G), T, 4096, D, E); } PH_END
    FFN_PLE(3, XB1, XB0)
    PH_BEGIN final_norm(a, RSB(12), XB0); PH_END
}
}

extern "C" void kernel_launch(void* const* d_in, const int* in_sizes, int n_in, void* d_out, int out_size, void* d_ws, size_t ws_size, hipStream_t stream) {
    using namespace mk;
    static int grid = 0;
    if (grid == 0) {
        if (n_in != 37 || out_size != T * D || ws_size < WS_END) { fprintf(stderr, "kernel_launch: unexpected problem (n_in %d, out %d, ws %zu < %zu)\n", n_in, out_size, ws_size, (size_t)WS_END); grid = -1; return; }
        int dev = 0, cus = 0;
        if (hipGetDevice(&dev) != hipSuccess || hipDeviceGetAttribute(&cus, hipDeviceAttributeMultiprocessorCount, dev) != hipSuccess) { grid = -1; return; }
        if (hipFuncSetAttribute((const void*)mk_fwd, hipFuncAttributeMaxDynamicSharedMemorySize, LDS_BYTES) != hipSuccess) { fprintf(stderr, "kernel_launch: hipFuncSetAttribute failed\n"); grid = -1; return; }
        int per_cu = 0;
        if (hipOccupancyMaxActiveBlocksPerMultiprocessor(&per_cu, (const void*)mk_fwd, NTHR, LDS_BYTES) != hipSuccess || per_cu < 1) fprintf(stderr, "kernel_launch: occupancy query says %d\n", per_cu);
        (void)hipGetLastError();
        grid = cus > 0 ? cus : 256;
    }
    if (grid < 0) return;
    (void)hipMemsetAsync(d_ws, 0, ZERO_BYTES, stream);
    Args a{};
    for (int i = 0; i < 37; ++i) a.in[i] = (const float*)d_in[i];
    a.out = (float*)d_out; a.ws = (unsigned char*)d_ws;
#if MK_SINGLE
    a.ph_lo = 0; a.ph_hi = NPH;
    hipLaunchKernelGGL(mk_fwd, dim3(grid), dim3(NTHR), LDS_BYTES, stream, a);
#else
    for (int p = 0; p < NPH; ++p) { a.ph_lo = p; a.ph_hi = p + 1; hipLaunchKernelGGL(mk_fwd, dim3(grid), dim3(NTHR), LDS_BYTES, stream, a); }
#endif
}
```

```cpp
#include <hip/hip_runtime.h>
#include <cstdio>
#include <cstdint>
#define XB_TMO      128
#define XB_XCNT(j)  (256  + 64 * (j))
#define XB_XSUB(j)  (1280 + 64 * (j))
#define XB_XGEN(j)  (2304 + 64 * (j))
#define XB_TOP      3328
#define XB_TOPGEN   3392
#define XCD_BAR_WORDS 3456
#define XB_SPIN_CAP (1u << 18)
#define LAS __attribute__((address_space(3)))

__device__ __forceinline__ unsigned xb_ld(unsigned* p)              { return __hip_atomic_load(p, __ATOMIC_RELAXED, __HIP_MEMORY_SCOPE_AGENT); }
__device__ __forceinline__ unsigned xb_add(unsigned* p, unsigned v) { return __hip_atomic_fetch_add(p, v, __ATOMIC_RELAXED, __HIP_MEMORY_SCOPE_AGENT); }
__device__ __forceinline__ unsigned xb_xcc_id() { return (unsigned)__builtin_amdgcn_s_getreg((3 << 11) | 20) & 0xFu; }
#define XB_SPIN(cond, bar) do { unsigned _sp = 0; while (cond) { __builtin_amdgcn_s_sleep(1); \
    if ((++_sp & 255u) == 0u) { if (xb_ld(&(bar)[XB_TMO])) break; if (_sp > XB_SPIN_CAP) { atomicAdd(&(bar)[XB_TMO], 1u); break; } } } } while (0)

struct XcdBarrier {
    unsigned* bar; unsigned x;
    volatile LAS unsigned* st;
};

__device__ __forceinline__ XcdBarrier xcd_barrier_post(unsigned* bar, volatile LAS unsigned* st) {
    XcdBarrier b; b.bar = bar; b.x = xb_xcc_id(); b.st = st;
    if (threadIdx.x == 0) (void)xb_add(&bar[XB_XCNT(b.x)], 1u);
    return b;
}
__device__ __forceinline__ void xcd_barrier_complete(unsigned* bar, unsigned x, unsigned& nloc, unsigned& nx) {
    const unsigned G = gridDim.x * gridDim.y * gridDim.z;
    unsigned sum, cnt, mine, sp = 0u;
    for (;;) {
        sum = 0u; cnt = 0u; mine = 0u;
#pragma unroll
        for (unsigned j = 0; j < 16; ++j) { const unsigned c = xb_ld(&bar[XB_XCNT(j)]); sum += c; cnt += (c > 0u) ? 1u : 0u; mine = (j == x) ? c : mine; }
        if (sum == G) break;
        __builtin_amdgcn_s_sleep(1);
        if ((++sp & 255u) == 0u) { if (xb_ld(&bar[XB_TMO])) break; if (sp > XB_SPIN_CAP) { atomicAdd(&bar[XB_TMO], 1u); break; } }
    }
    nloc = mine > 0u ? mine : 1u; nx = cnt > 0u ? cnt : 1u;
}

__device__ __forceinline__ void xcd_barrier(const XcdBarrier& b) {
    asm volatile("s_waitcnt vmcnt(0)" ::: "memory");
    __syncthreads();
    if (threadIdx.x == 0) {
        unsigned* bar = b.bar;
        __builtin_amdgcn_s_waitcnt(0);
        unsigned nloc = b.st[0], nx = b.st[1];
        if (nloc == 0u) { xcd_barrier_complete(bar, b.x, nloc, nx); b.st[0] = nloc; b.st[1] = nx; }
        const unsigned old = xb_add(&bar[XB_XSUB(b.x)], 1u);
        const unsigned gen = old / nloc;
        if (old + 1u == (gen + 1u) * nloc) {
            __builtin_amdgcn_fence(__ATOMIC_RELEASE, "agent");
            asm volatile("s_waitcnt vmcnt(0)" ::: "memory");
            const unsigned og = xb_add(&bar[XB_TOP], 1u);
            const unsigned tg = og / nx;
            if (og + 1u == (tg + 1u) * nx) xb_add(&bar[XB_TOPGEN], 1u);
            else XB_SPIN(xb_ld(&bar[XB_TOPGEN]) == tg, bar);
            __builtin_amdgcn_fence(__ATOMIC_ACQUIRE, "agent");
            xb_add(&bar[XB_XGEN(b.x)], 1u);
            asm volatile("s_waitcnt vmcnt(0)" ::: "memory");
        } else {
            XB_SPIN(xb_ld(&bar[XB_XGEN(b.x)]) == gen, bar);
            __builtin_amdgcn_fence(__ATOMIC_ACQUIRE, "agent");
            asm volatile("s_waitcnt vmcnt(0)" ::: "memory");
        }
    }
    __syncthreads();
}
namespace pg8 {
#define PG8_LAS __attribute__((address_space(3)))
typedef unsigned short bf16_t;
typedef short bf16x8 __attribute__((ext_vector_type(8)));
typedef float f32x4 __attribute__((ext_vector_type(4)));
typedef unsigned u32x4 __attribute__((ext_vector_type(4)));
constexpr int BM = 256, BK = 64, HALF = 128, HTB = HALF * BK * 2  , STAGE_BYTES = 8 * HTB, NXCD = 8, WGM = 8;

__host__ __device__ __forceinline__ int lds_byte(int r, int c) { const int st = (r >> 4) * 2 + (c >> 5), rr = r & 15, cc = c & 31, ob = rr * 64 + cc * 2; return st * 1024 + (ob ^ (((ob >> 9) & 1) << 5)); }
__host__ __device__ __forceinline__ void stage_rc(int b, int& R, int& C) { const int st = b / 1024, sb = b % 1024, swz = sb ^ (((sb >> 9) & 1) << 5); R = (st >> 1) * 16 + swz / 64; C = (st & 1) * 32 + (swz % 64) / 2; }
__host__ __device__ __forceinline__ int perm32(int rho) { const int n = rho >> 4, i = rho & 15; return 8 * (i >> 2) + 4 * n + (i & 3); }

struct Unit { int pm, pn; };
struct Gemm { const bf16_t* A; const bf16_t* Bt; int M, N, K; };

struct StaticOrder {
    int nM, nN, nwg, G, c, wgm;
    __host__ __device__ void init(int M, int N, int G_, int c_, int wgm_ = WGM) { nM = M / BM; nN = N / BM; nwg = nM * nN; G = G_; c = c_; wgm = wgm_; }
    __host__ __device__ bool next(int i, Unit& u) const {
        const long L = (long)i * G + c; if (L >= nwg) return false;
        int wgid = (int)L; { const int q = nwg / NXCD, r = nwg % NXCD, xcd = wgid % NXCD, off = wgid / NXCD; wgid = (xcd < r ? xcd * (q + 1) : r * (q + 1) + (xcd - r) * q) + off; }
        const int nig = wgm * nN, gid = wgid / nig, fm = gid * wgm, gsz = (nM - fm) < wgm ? (nM - fm) : wgm;
        u.pm = fm + ((wgid % nig) % gsz); u.pn = (wgid % nig) / gsz; return true;
    }
    __device__ __forceinline__ void a_ready(const Unit&) const {}
    __device__ __forceinline__ void done(const Unit&) const {}
};


__device__ __forceinline__ unsigned cvt_pk_bf16(float lo, float hi) { unsigned r; asm volatile("v_cvt_pk_bf16_f32 %0, %1, %2" : "=v"(r) : "v"(lo), "v"(hi)); return r; }

template <class Epi, class Sched, bool ALIGN_EPI = false, bool SP2 = false>
__device__ __forceinline__ void gemm_phase(PG8_LAS unsigned char* lds, const Gemm g, const Sched& S, const Epi& E) {
    int tid_ = threadIdx.x; asm volatile("" : "+v"(tid_)); const int tid = tid_, wid = __builtin_amdgcn_readfirstlane(tid >> 6), lane = tid & 63, wr = wid >> 2, wc = wid & 3, fr = lane & 15, fq = lane >> 4;
    const int K = g.K, nt = K / BK;
    unsigned voffA[2], voffB[2];
#pragma unroll
    for (int i = 0; i < 2; ++i) { int R, C; stage_rc(tid * 16 + i * 8192, R, C); const int Rb = Epi::PERM ? ((R & ~31) + perm32(R & 31)) : R;
        voffA[i] = (unsigned)(R * K + C) * 2u; voffB[i] = (unsigned)(Rb * K + C) * 2u; }
    const size_t kstep = (size_t)(BK * 2);
    const size_t hstep = (size_t)HALF * K * 2;
    const size_t tstep = 2 * hstep;
    const unsigned ldsw = (unsigned)wid * 1024u;
    const int aoff = lds_byte(wr * 64 + fr, fq * 8), boff = lds_byte(wc * 32 + fr, fq * 8);
#define PG8_SA(b, h) (((b) * 2 + (h)) * HTB)
#define PG8_SB(b, h) ((4 + (b) * 2 + (h)) * HTB)
#define PG8_STAGE(bufoff, gbase, voff) do { _Pragma("unroll") for (int _i = 0; _i < 2; ++_i) \
        __builtin_amdgcn_global_load_lds((const unsigned*)((const char*)(gbase) + (voff)[_i]), (PG8_LAS unsigned*)(lds + (bufoff) + ldsw + _i * 8192), 16, 0, 0); } while (0)
#define PG8_LDA(dst, b, h) do { _Pragma("unroll") for (int m = 0; m < 4; ++m) _Pragma("unroll") for (int k = 0; k < 2; ++k) dst[m][k] = *(const PG8_LAS bf16x8*)(lds + PG8_SA(b, h) + aoff + m * 2048 + k * 1024); } while (0)
#define PG8_LDB(dst, b, h) do { _Pragma("unroll") for (int n = 0; n < 2; ++n) _Pragma("unroll") for (int k = 0; k < 2; ++k) dst[n][k] = *(const PG8_LAS bf16x8*)(lds + PG8_SB(b, h) + boff + n * 2048 + k * 1024); } while (0)
#define PG8_MMA(ai, bj, At, Bt) do { __builtin_amdgcn_s_setprio(1); _Pragma("unroll") for (int m = 0; m < 4; ++m) _Pragma("unroll") for (int n = 0; n < 2; ++n) _Pragma("unroll") for (int k = 0; k < 2; ++k) \
        acc[ai][bj][m][n] = __builtin_amdgcn_mfma_f32_16x16x32_bf16(Bt[n][k], At[m][k], acc[ai][bj][m][n], 0, 0, 0); __builtin_amdgcn_s_setprio(0); } while (0)
#define PG8_WAIT_V(n) asm volatile("s_waitcnt vmcnt(" #n ")" ::: "memory")
#define PG8_WAIT_L(n) asm volatile("s_waitcnt lgkmcnt(" #n ")" ::: "memory")
#define PG8_BAR __builtin_amdgcn_s_barrier()
#define PG8_SCHED __builtin_amdgcn_sched_barrier(0)
    Unit cur, nxt; int ui = 0;
    if (!S.next(0, cur)) return;
    f32x4 acc[2][2][4][2];
#pragma unroll
    for (int a = 0; a < 2; ++a)
#pragma unroll
        for (int b = 0; b < 2; ++b)
#pragma unroll
            for (int m = 0; m < 4; ++m)
#pragma unroll
                for (int n = 0; n < 2; ++n) acc[a][b][m][n] = (f32x4){0.f, 0.f, 0.f, 0.f};
    bf16x8 At[4][2], B0[2][2], B1[2][2];
    const char* cA = (const char*)g.A + (size_t)cur.pm * tstep; const char* cB = (const char*)g.Bt + (size_t)cur.pn * tstep;
    S.a_ready(cur);
    E.prefetch(cur, 0);
    if constexpr (SP2) {
        PG8_STAGE(PG8_SB(0, 0), cB, voffB); PG8_STAGE(PG8_SB(0, 1), cB + hstep, voffB); PG8_STAGE(PG8_SA(0, 0), cA, voffA); PG8_STAGE(PG8_SA(0, 1), cA + hstep, voffA);
        if (wr == 1) PG8_BAR;
        PG8_WAIT_V(2); PG8_BAR;
        PG8_STAGE(PG8_SB(1, 0), cB + kstep, voffB); PG8_STAGE(PG8_SA(1, 0), cA + kstep, voffA); PG8_STAGE(PG8_SB(1, 1), cB + hstep + kstep, voffB);
        PG8_WAIT_V(6); PG8_BAR;
    } else {
        PG8_STAGE(PG8_SB(0, 0), cB, voffB); PG8_STAGE(PG8_SA(0, 0), cA, voffA); PG8_STAGE(PG8_SB(0, 1), cB + hstep, voffB); PG8_STAGE(PG8_SA(0, 1), cA + hstep, voffA);
        if (wr == 1) PG8_BAR;
        PG8_WAIT_V(4); PG8_BAR;
        PG8_STAGE(PG8_SB(1, 0), cB + kstep, voffB); PG8_STAGE(PG8_SA(1, 0), cA + kstep, voffA); PG8_STAGE(PG8_SB(1, 1), cB + hstep + kstep, voffB);
        PG8_WAIT_V(6); PG8_BAR;
    }
    for (;;) {
        const bool has_next = S.next(ui + 1, nxt);
        const char* nA = has_next ? (const char*)g.A + (size_t)nxt.pm * tstep : cA; const char* nB = has_next ? (const char*)g.Bt + (size_t)nxt.pn * tstep : cB;
        for (int t = 0; t < nt; t += 2) {
            const bool last = (t == nt - 2);
            const char* a1 = cA + (size_t)(t + 1) * kstep;
            const char* a2 = last ? nA : cA + (size_t)(t + 2) * kstep; const char* b2 = last ? nB : cB + (size_t)(t + 2) * kstep;
            const char* a3 = a2 + kstep; const char* b3 = b2 + kstep;
            if (last && has_next) S.a_ready(nxt);
            if constexpr (SP2) {
            PG8_LDB(B0, 0, 0); PG8_LDB(B1, 0, 1); PG8_SCHED; PG8_LDA(At, 0, 0); PG8_STAGE(PG8_SA(1, 1), a1 + hstep, voffA);
            PG8_WAIT_V(8); PG8_WAIT_L(0); PG8_BAR; PG8_MMA(0, 0, At, B0); PG8_MMA(0, 1, At, B1); PG8_BAR; PG8_SCHED;
            PG8_LDA(At, 0, 1); PG8_STAGE(PG8_SB(0, 0), b2, voffB); PG8_STAGE(PG8_SB(0, 1), b2 + hstep, voffB); PG8_STAGE(PG8_SA(0, 0), a2, voffA);
            PG8_WAIT_V(8); PG8_WAIT_L(0); PG8_BAR; PG8_MMA(1, 0, At, B0); PG8_MMA(1, 1, At, B1); PG8_BAR; PG8_SCHED;
            PG8_LDB(B0, 1, 0); PG8_LDB(B1, 1, 1); PG8_SCHED; PG8_LDA(At, 1, 0); PG8_STAGE(PG8_SA(0, 1), a2 + hstep, voffA);
            PG8_WAIT_V(8); PG8_WAIT_L(0); PG8_BAR; PG8_MMA(0, 0, At, B0); PG8_MMA(0, 1, At, B1); PG8_BAR; PG8_SCHED;
            PG8_LDA(At, 1, 1); PG8_STAGE(PG8_SB(1, 0), b3, voffB); PG8_STAGE(PG8_SB(1, 1), b3 + hstep, voffB); PG8_STAGE(PG8_SA(1, 0), a3, voffA);
            PG8_WAIT_V(8); PG8_WAIT_L(0); PG8_BAR; PG8_MMA(1, 0, At, B0); PG8_MMA(1, 1, At, B1); PG8_BAR; PG8_SCHED;
            } else {
            PG8_LDB(B0, 0, 0); PG8_SCHED; PG8_LDA(At, 0, 0); PG8_STAGE(PG8_SA(1, 1), a1 + hstep, voffA);
            PG8_WAIT_L(8); PG8_BAR; PG8_WAIT_L(0); PG8_MMA(0, 0, At, B0); PG8_BAR; PG8_SCHED;
            PG8_LDB(B1, 0, 1); PG8_STAGE(PG8_SB(0, 0), b2, voffB);
            PG8_BAR; PG8_WAIT_L(0); PG8_MMA(0, 1, At, B1); PG8_BAR;
            PG8_LDA(At, 0, 1); PG8_STAGE(PG8_SA(0, 0), a2, voffA);
            PG8_BAR; PG8_WAIT_L(0); PG8_MMA(1, 0, At, B0); PG8_BAR; PG8_SCHED;
            PG8_STAGE(PG8_SB(0, 1), b2 + hstep, voffB);
            PG8_WAIT_V(6); PG8_BAR; PG8_MMA(1, 1, At, B1); PG8_BAR;
            PG8_LDB(B0, 1, 0); PG8_SCHED; PG8_LDA(At, 1, 0); PG8_STAGE(PG8_SA(0, 1), a2 + hstep, voffA);
            PG8_WAIT_L(8); PG8_BAR; PG8_WAIT_L(0); PG8_MMA(0, 0, At, B0); PG8_BAR; PG8_SCHED;
            PG8_LDB(B1, 1, 1); PG8_STAGE(PG8_SB(1, 0), b3, voffB);
            PG8_BAR; PG8_WAIT_L(0); PG8_MMA(0, 1, At, B1); PG8_BAR;
            PG8_LDA(At, 1, 1); PG8_STAGE(PG8_SA(1, 0), a3, voffA);
            PG8_BAR; PG8_WAIT_L(0); PG8_MMA(1, 0, At, B0); PG8_BAR; PG8_SCHED;
            PG8_STAGE(PG8_SB(1, 1), b3 + hstep, voffB);
            PG8_WAIT_V(6); PG8_BAR; PG8_MMA(1, 1, At, B1); PG8_BAR;
            }
        }
        if constexpr (ALIGN_EPI) { if (wr == 0) PG8_BAR; }
        if constexpr (!Epi::AFTER_DRAIN) { if (has_next) E.prefetch(nxt, (ui + 1) & 1);
            E(acc, cur, wr, wc, fr, fq, ui & 1); S.done(cur); }
        if (!has_next) break;
#pragma unroll
        for (int a = 0; a < 2; ++a)
#pragma unroll
            for (int b = 0; b < 2; ++b)
#pragma unroll
                for (int m = 0; m < 4; ++m)
#pragma unroll
                    for (int n = 0; n < 2; ++n) acc[a][b][m][n] = (f32x4){0.f, 0.f, 0.f, 0.f};
        cur = nxt; cA = nA; cB = nB; ++ui;
        if constexpr (ALIGN_EPI) { if (wr == 1) PG8_BAR; }
    }
    PG8_WAIT_V(0);
    if constexpr (!ALIGN_EPI) { if (wr == 0) PG8_BAR; }
    PG8_BAR;
    if constexpr (Epi::AFTER_DRAIN) { E.fused(acc, cur, wr, wc, fr, fq, lds, wid, lane); S.done(cur); }
#undef PG8_SA
#undef PG8_SB
#undef PG8_STAGE
#undef PG8_LDA
#undef PG8_LDB
#undef PG8_MMA
#undef PG8_WAIT_V
#undef PG8_WAIT_L
#undef PG8_BAR
#undef PG8_SCHED
}
}

namespace mk {
using pg8::bf16_t; using pg8::f32x4; using pg8::u32x4; using pg8::Unit;
typedef unsigned u32x2 __attribute__((ext_vector_type(2)));
constexpr int D = 2048, T = 40960, NSEQ = 10, SEQ = 4096, DFF = 5632, PLED = 256;
constexpr float EPS = 1e-6f;
constexpr int NTHR = 512;

constexpr size_t AL(size_t x) { return (x + 255) & ~size_t(255); }
constexpr size_t WS_CTL = 0, CTL_BYTES = 65536;
constexpr int NRS = 14;
constexpr size_t WS_RS = WS_CTL + CTL_BYTES, RS_BYTES = (size_t)NRS * T * 8;
constexpr size_t ZERO_BYTES = WS_RS + RS_BYTES;
constexpr size_t SZ_WGU = (size_t)2 * DFF * D * 2, SZ_WDN = (size_t)D * DFF * 2, SZ_WPG = (size_t)D * D * 2, SZ_WPP = (size_t)D * PLED * 2;
constexpr size_t WS_WGU = AL(ZERO_BYTES);
constexpr size_t WS_WDN = WS_WGU + 4 * SZ_WGU;
constexpr size_t WS_WPG = WS_WDN + 4 * SZ_WDN;
constexpr size_t WS_WPP = WS_WPG + 4 * SZ_WPG;
constexpr size_t WS_NAQ = WS_WPP + 4 * SZ_WPP;
constexpr size_t WS_NAO = WS_NAQ + (size_t)6144 * D * 2;
constexpr size_t WS_SGI = WS_NAO + (size_t)D * D * 2;
constexpr size_t WS_SGO = WS_SGI + (size_t)4096 * D * 2;
constexpr int    GDI_N = 12544, GDI_N1 = 8448;
constexpr size_t WS_GDI = WS_SGO + (size_t)D * D * 2;
constexpr size_t WS_GDO = WS_GDI + (size_t)GDI_N * D * 2;
constexpr size_t WS_S5G = WS_GDO + (size_t)D * 4096 * 2;
constexpr size_t WS_PB  = WS_S5G + (size_t)4096 * D * 2;
constexpr size_t WS_XB0 = WS_PB + (size_t)4 * T * PLED * 2;
constexpr size_t WS_XB1 = WS_XB0 + (size_t)T * D * 2;
constexpr size_t WS_BIG = WS_XB1 + (size_t)T * D * 2;
constexpr size_t BIG_BYTES = 524288000;
constexpr size_t WS_END = WS_BIG + BIG_BYTES;
constexpr int FG_ROWS = 8192, NFG = 5;
constexpr size_t BIG_GU = 0, BIG_HID = (size_t)FG_ROWS * 2 * DFF * 2;
constexpr size_t BIG_HID2 = 0, BIG_EDGE = (size_t)T * DFF * 2;
static_assert(BIG_EDGE + (size_t)(T / 256) * 16 * 2 * DFF * 2 <= BIG_BYTES, "BIG");
constexpr int GG_ROWS = 16384, NGG = 3;
constexpr int G0_ROWS = 8192;
constexpr size_t G0_PROJ = 0, G0_OB = (size_t)G0_ROWS * 4096 * 2, G0_VP = (size_t)G0_ROWS * 8192 * 2, G0_AB = G0_VP + (size_t)G0_ROWS * 4096 * 2, G0_GB = G0_AB + (size_t)G0_ROWS * 128 * 4, R0_END = G0_GB + (size_t)G0_ROWS * 128 * 4;
constexpr size_t G1_VP = 0, G1_GB = (size_t)GG_ROWS * 4096 * 2, G1_PROJ = R0_END, G1_OB = G1_PROJ + (size_t)GG_ROWS * 4096 * 2, G1_AB = G1_PROJ + (size_t)GG_ROWS * 8192 * 2;
static_assert(G1_GB + (size_t)GG_ROWS * 128 * 4 <= R0_END && G1_AB + (size_t)GG_ROWS * 128 * 4 <= 524288000, "GDN BIG layout");
constexpr size_t BIG_PROJ = 0, BIG_OB = (size_t)GG_ROWS * 4096 * 2, BIG_VP = (size_t)GG_ROWS * 8192 * 2, BIG_AB = BIG_VP + (size_t)GG_ROWS * 4096 * 2, BIG_GB = BIG_AB + (size_t)GG_ROWS * 128 * 4;
static_assert(BIG_GB + (size_t)GG_ROWS * 128 * 4 <= BIG_BYTES, "BIG");
static_assert((size_t)T * 6144 * 2 <= BIG_BYTES, "BIG");

constexpr int LDS_STAGE = 131072, LDS_BYTES = 163840, LDS_BAR = LDS_BYTES - 16;

struct Args { const float* in[37]; float* out; unsigned char* ws; int ph_lo, ph_hi; };
typedef const Args __attribute__((address_space(4)))* ArgsCP;
__device__ __forceinline__ ArgsCP argp() { ArgsCP p = (ArgsCP)__builtin_amdgcn_kernarg_segment_ptr(); asm volatile("" : "+s"(p)); return p; }
__device__ __forceinline__ int tidx() { int t = threadIdx.x; asm volatile("" : "+v"(t)); return t; }

__device__ __forceinline__ float bf2f(bf16_t b) { return __uint_as_float(((unsigned)b) << 16); }
__device__ __forceinline__ float blo(unsigned w) { return __uint_as_float(w << 16); }
__device__ __forceinline__ float bhi(unsigned w) { return __uint_as_float(w & 0xffff0000u); }
typedef float f32x2_t __attribute__((ext_vector_type(2))); typedef __bf16 bf16x2_t __attribute__((ext_vector_type(2)));
__device__ __forceinline__ unsigned pk2(float lo, float hi) { const f32x2_t v = {lo, hi}; const bf16x2_t b = __builtin_convertvector(v, bf16x2_t); return __builtin_bit_cast(unsigned, b); }
__device__ __forceinline__ bf16_t f2bf(float f) { return (bf16_t)(pk2(f, 0.f) & 0xffffu); }
typedef unsigned long long rs_t;
__device__ __forceinline__ float rs_val(rs_t v) { return (float)(unsigned)(v >> 24) + (float)(unsigned)(v & 0xffffffull) * (1.0f / 16777216.0f); }
__device__ __forceinline__ rs_t rs_fix(float ss) { return (rs_t)__float2ull_rn(ss * 16777216.0f); }
__device__ __forceinline__ void rs_add(rs_t* p, float ss) { atomicAdd(p, rs_fix(ss)); }
__device__ __forceinline__ float rstd_of(rs_t v) { return __builtin_amdgcn_rsqf(rs_val(v) * (1.0f / (float)D) + EPS); }
__device__ __forceinline__ float sigmoidf_(float x) { return __builtin_amdgcn_rcpf(1.0f + __expf(-x)); }
__device__ __forceinline__ float siluf_(float x) { return x * sigmoidf_(x); }
__device__ __forceinline__ float geluf_(float x) { const float w = x * __builtin_fmaf(x * x, -0.1029432396f, -2.3022081985f); return x * __builtin_amdgcn_rcpf(1.0f + __builtin_amdgcn_exp2f(w)); }
__device__ __forceinline__ void unpack8(const u32x4 w, float (&v)[8]) { v[0] = blo(w.x); v[1] = bhi(w.x); v[2] = blo(w.y); v[3] = bhi(w.y); v[4] = blo(w.z); v[5] = bhi(w.z); v[6] = blo(w.w); v[7] = bhi(w.w); }
__device__ __forceinline__ u32x4 pack8(const float (&v)[8]) { u32x4 w; w.x = pk2(v[0], v[1]); w.y = pk2(v[2], v[3]); w.z = pk2(v[4], v[5]); w.w = pk2(v[6], v[7]); return w; }
__device__ __forceinline__ float wave_sum(float v) {
#pragma unroll
    for (int o = 32; o > 0; o >>= 1) v += __shfl_xor(v, o);
    return v; }
__device__ __forceinline__ float wave_max(float v) {
#pragma unroll
    for (int o = 32; o > 0; o >>= 1) v = fmaxf(v, __shfl_xor(v, o));
    return v; }

typedef const f32x4 (&AccT)[2][2][4][2];

constexpr int EPF_OFF = LDS_STAGE, EPF_SLOT = 4096, EPF_CW = 2048;
constexpr int XCH_OFF = LDS_STAGE + 2 * EPF_SLOT;
__device__ __forceinline__ void epf_rows(const rs_t* rs, const Unit& u, int slot) {
    extern __shared__ __attribute__((aligned(16))) unsigned char epf_lds_[];
    const int tid = tidx();
    if (tid < 64) { LAS unsigned char* d = (LAS unsigned char*)epf_lds_ + EPF_OFF + slot * EPF_SLOT; const rs_t* s = rs + (size_t)u.pm * 256 + 2 * tid;
        __builtin_amdgcn_global_load_lds((const unsigned*)s, (LAS unsigned*)d, 16, 0, 0);
        __builtin_amdgcn_global_load_lds((const unsigned*)(s + 128), (LAS unsigned*)(d + 1024), 16, 0, 0); }
}
__device__ __forceinline__ float epf_rstd(int slot, int r) {
    extern __shared__ __attribute__((aligned(16))) unsigned char epf_lds_[];
    return rstd_of(*(const LAS rs_t*)((LAS unsigned char*)epf_lds_ + EPF_OFF + slot * EPF_SLOT + r * 8));
}
#define EPI_ROWSCALES_LDS(slot_) float sc[2][4]; { \
        _Pragma("unroll") for (int ai = 0; ai < 2; ++ai) _Pragma("unroll") for (int m = 0; m < 4; ++m) sc[ai][m] = epf_rstd((slot_), ai * 128 + wr * 64 + m * 16 + fr); }
#define EPI_ROWSCALES(rsptr, row0_) float sc[2][4]; { rs_t r_[2][4]; \
        _Pragma("unroll") for (int ai = 0; ai < 2; ++ai) _Pragma("unroll") for (int m = 0; m < 4; ++m) r_[ai][m] = (rsptr)[(row0_) + ai * 128 + m * 16]; \
        _Pragma("unroll") for (int ai = 0; ai < 2; ++ai) _Pragma("unroll") for (int m = 0; m < 4; ++m) sc[ai][m] = rstd_of(r_[ai][m]); }

struct EpiScale {
    static constexpr bool PERM = true, AFTER_DRAIN = false;
    bf16_t* O; int ldc; const rs_t* rs; float* ab; int ab_pn;
    __device__ __forceinline__ void prefetch(const Unit& u, int slot) const { if (rs) epf_rows(rs, u, slot); }
    __device__ __forceinline__ void operator()(AccT acc, const Unit& u, int wr, int wc, int fr, int fq, int slot) const {
        const int row0 = u.pm * 256 + wr * 64 + fr, colw = wc * 32 + 8 * fq;
        const bool side = (ab != nullptr) && (u.pn == ab_pn);
        float sc[2][4];
        if (rs) {
#pragma unroll
            for (int ai = 0; ai < 2; ++ai)
#pragma unroll
                for (int m = 0; m < 4; ++m) sc[ai][m] = epf_rstd(slot, ai * 128 + wr * 64 + m * 16 + fr); }
        else {
#pragma unroll
            for (int ai = 0; ai < 2; ++ai)
#pragma unroll
                for (int m = 0; m < 4; ++m) sc[ai][m] = 1.0f; }
#pragma unroll
        for (int ai = 0; ai < 2; ++ai)
#pragma unroll
            for (int m = 0; m < 4; ++m) {
                const int row = row0 + ai * 128 + m * 16; const float s = sc[ai][m];
#pragma unroll
                for (int bj = 0; bj < 2; ++bj) {
                    const f32x4 v0 = acc[ai][bj][m][0] * s, v1 = acc[ai][bj][m][1] * s;
                    if (side) { if (bj == 0) { float* p = ab + (size_t)row * 128 + colw; *(f32x4*)p = v0; *(f32x4*)(p + 4) = v1; } }
                    else { u32x4 w; w.x = pk2(v0[0], v0[1]); w.y = pk2(v0[2], v0[3]); w.z = pk2(v1[0], v1[1]); w.w = pk2(v1[2], v1[3]);
                           *(u32x4*)(O + (size_t)row * ldc + u.pn * 256 + bj * 128 + colw) = w; }
                }
            }
    }
};
struct EpiGelu {
    static constexpr bool PERM = true, AFTER_DRAIN = false;
    bf16_t* O; int ldc; const rs_t* rs; rs_t* rsv; int vtile0;
    __device__ __forceinline__ void prefetch(const Unit& u, int slot) const { epf_rows(rs, u, slot); }
    __device__ __forceinline__ void operator()(AccT acc, const Unit& u, int wr, int wc, int fr, int fq, int slot) const {
        const int row0 = u.pm * 256 + wr * 64 + fr, colw = wc * 32 + 8 * fq;
        const bool isv = u.pn >= vtile0;
        EPI_ROWSCALES_LDS(slot)
#pragma unroll
        for (int ai = 0; ai < 2; ++ai)
#pragma unroll
            for (int m = 0; m < 4; ++m) {
                const int row = row0 + ai * 128 + m * 16;
                const float s = sc[ai][m]; float ss = 0.f;
#pragma unroll
                for (int bj = 0; bj < 2; ++bj) {
                    float v[8];
#pragma unroll
                    for (int j = 0; j < 4; ++j) { v[j] = geluf_(acc[ai][bj][m][0][j] * s); v[4 + j] = geluf_(acc[ai][bj][m][1][j] * s); }
#pragma unroll
                    for (int j = 0; j < 8; ++j) ss += v[j] * v[j];
                    *(u32x4*)(O + (size_t)row * ldc + u.pn * 256 + bj * 128 + colw) = pack8(v);
                }
                if (isv) { ss += __shfl_xor(ss, 16); ss += __shfl_xor(ss, 32); if (fq == 0) rs_add(rsv + row, ss); }
            }
    }
};
__device__ __forceinline__ float put_x(bf16_t* XB, size_t off, const float (&xn)[8]) {
    *(u32x4*)(XB + off) = pack8(xn);
    float ss = 0.f;
#pragma unroll
    for (int j = 0; j < 8; ++j) ss += xn[j] * xn[j];
    return ss;
}
struct EpiResid {
    static constexpr bool PERM = true, AFTER_DRAIN = false;
    const bf16_t* XR; bf16_t* XW; rs_t* rsq;
    __device__ __forceinline__ void prefetch(const Unit&, int) const {}
    __device__ __forceinline__ void operator()(AccT acc, const Unit& u, int wr, int wc, int fr, int fq, int slot) const {
        const int row0 = u.pm * 256 + wr * 64 + fr, colw = wc * 32 + 8 * fq;
        u32x4 xv[2][4][2];
#pragma unroll
        for (int ai = 0; ai < 2; ++ai)
#pragma unroll
            for (int m = 0; m < 4; ++m)
#pragma unroll
                for (int bj = 0; bj < 2; ++bj) xv[ai][m][bj] = *(const u32x4*)(XR + (size_t)(row0 + ai * 128 + m * 16) * D + u.pn * 256 + bj * 128 + colw);
        asm volatile("" ::: "memory");
#pragma unroll
        for (int ai = 0; ai < 2; ++ai)
#pragma unroll
            for (int m = 0; m < 4; ++m) {
                const int row = row0 + ai * 128 + m * 16; float ss = 0.f;
#pragma unroll
                for (int bj = 0; bj < 2; ++bj) {
                    const size_t off = (size_t)row * D + u.pn * 256 + bj * 128 + colw;
                    float xn[8]; unpack8(xv[ai][m][bj], xn);
#pragma unroll
                    for (int j = 0; j < 4; ++j) { xn[j] += acc[ai][bj][m][0][j]; xn[4 + j] += acc[ai][bj][m][1][j]; }
                    ss += put_x(XW, off, xn);
                }
                ss += __shfl_xor(ss, 16); ss += __shfl_xor(ss, 32); if (fq == 0) rs_add(rsq + row, ss);
            }
    }
};
struct EpiPle {
    static constexpr bool PERM = true, AFTER_DRAIN = false;
    const bf16_t* XR; bf16_t* XW; rs_t* rsq; const rs_t* rs_in;
    __device__ __forceinline__ void prefetch(const Unit& u, int slot) const { epf_rows(rs_in, u, slot); }
    __device__ __forceinline__ void operator()(AccT acc, const Unit& u, int wr, int wc, int fr, int fq, int slot) const {
        const int row0 = u.pm * 256 + wr * 64 + fr, colw = wc * 32 + 8 * fq;
        EPI_ROWSCALES_LDS(slot)
#pragma unroll
        for (int ai = 0; ai < 2; ++ai) {
            u32x4 xv[4][2], pq[4][2];
#pragma unroll
            for (int m = 0; m < 4; ++m)
#pragma unroll
                for (int bj = 0; bj < 2; ++bj) { const size_t off = (size_t)(row0 + ai * 128 + m * 16) * D + u.pn * 256 + bj * 128 + colw;
                    xv[m][bj] = *(const u32x4*)(XR + off); pq[m][bj] = *(const u32x4*)(XW + off); }
            asm volatile("" ::: "memory");
#pragma unroll
            for (int m = 0; m < 4; ++m) {
                const int row = row0 + ai * 128 + m * 16; float ss = 0.f; const float s = sc[ai][m];
#pragma unroll
                for (int bj = 0; bj < 2; ++bj) {
                    const size_t off = (size_t)row * D + u.pn * 256 + bj * 128 + colw;
                    float pv[8]; unpack8(pq[m][bj], pv);
                    float xn[8]; unpack8(xv[m][bj], xn);
#pragma unroll
                    for (int j = 0; j < 4; ++j) { xn[j] += sigmoidf_(acc[ai][bj][m][0][j] * s) * pv[j]; xn[4 + j] += sigmoidf_(acc[ai][bj][m][1][j] * s) * pv[4 + j]; }
                    ss += put_x(XW, off, xn);
                }
                ss += __shfl_xor(ss, 16); ss += __shfl_xor(ss, 32); if (fq == 0) rs_add(rsq + row, ss);
            }
            asm volatile("" ::: "memory");
        }
    }
};
struct EpiGlu {
    static constexpr bool PERM = true, AFTER_DRAIN = false;
    bf16_t* XB; rs_t* rsq;
    __device__ __forceinline__ void prefetch(const Unit&, int) const {}
    __device__ __forceinline__ void operator()(AccT acc, const Unit& u, int wr, int wc, int fr, int fq, int slot) const {
        const int row0 = u.pm * 256 + wr * 64 + fr, colw = wc * 32 + 8 * fq;
        u32x4 xv[2][4];
#pragma unroll
        for (int ai = 0; ai < 2; ++ai)
#pragma unroll
            for (int m = 0; m < 4; ++m) xv[ai][m] = *(const u32x4*)(XB + (size_t)(row0 + ai * 128 + m * 16) * D + u.pn * 128 + colw);
        asm volatile("" ::: "memory");
#pragma unroll
        for (int ai = 0; ai < 2; ++ai)
#pragma unroll
            for (int m = 0; m < 4; ++m) {
                const int row = row0 + ai * 128 + m * 16;
                const size_t off = (size_t)row * D + u.pn * 128 + colw;
                float xn[8]; unpack8(xv[ai][m], xn);
#pragma unroll
                for (int j = 0; j < 4; ++j) { xn[j] += acc[ai][0][m][0][j] * sigmoidf_(acc[ai][1][m][0][j]); xn[4 + j] += acc[ai][0][m][1][j] * sigmoidf_(acc[ai][1][m][1][j]); }
                float ss = put_x(XB, off, xn);
                ss += __shfl_xor(ss, 16); ss += __shfl_xor(ss, 32); if (fq == 0) rs_add(rsq + row, ss);
            }
    }
};
struct EpiGdnZ {
    static constexpr bool PERM = true, AFTER_DRAIN = false;
    bf16_t* O; const bf16_t* OB; int ldc; const rs_t* rs; const float* gain; LAS float* xch;
    __device__ __forceinline__ void prefetch(const Unit& u, int slot) const { epf_rows(rs, u, slot); }
    __device__ __forceinline__ void operator()(AccT acc, const Unit& u, int wr, int wc, int fr, int fq, int slot) const {
        const int row0 = u.pm * 256 + wr * 64 + fr, colw = wc * 32 + 8 * fq;
        EPI_ROWSCALES_LDS(slot)
        float gn[8];
        { const f32x4 g0 = *(const f32x4*)(gain + (colw & 127)), g1 = *(const f32x4*)(gain + (colw & 127) + 4);
#pragma unroll
          for (int j = 0; j < 4; ++j) { gn[j] = g0[j]; gn[4 + j] = g1[j]; } }
#pragma unroll
        for (int ai = 0; ai < 2; ++ai)
#pragma unroll
          for (int mh = 0; mh < 2; ++mh) {
            u32x4 of_[2][2], ob_[2][2];
#pragma unroll
            for (int mm = 0; mm < 2; ++mm)
#pragma unroll
                for (int bj = 0; bj < 2; ++bj) { const size_t off = (size_t)(row0 + ai * 128 + (2 * mh + mm) * 16) * ldc + u.pn * 256 + bj * 128 + colw;
                    of_[mm][bj] = *(const u32x4*)(O + off); ob_[mm][bj] = *(const u32x4*)(OB + off); }
            asm volatile("" ::: "memory");
            float sv[2][2][8];
#pragma unroll
            for (int mm = 0; mm < 2; ++mm)
#pragma unroll
                for (int bj = 0; bj < 2; ++bj) { float a8[8], b8[8]; unpack8(of_[mm][bj], a8); unpack8(ob_[mm][bj], b8); float ss = 0.f;
#pragma unroll
                    for (int j = 0; j < 8; ++j) { sv[mm][bj][j] = a8[j] + b8[j]; ss += sv[mm][bj][j] * sv[mm][bj][j]; }
                    ss += __shfl_xor(ss, 16); ss += __shfl_xor(ss, 32);
                    if (fq == 0) xch[((wr * 64 + (2 * mh + mm) * 16 + fr) * 2 + bj) * 4 + wc] = ss; }
            asm volatile("s_waitcnt lgkmcnt(0)" ::: "memory"); __builtin_amdgcn_s_barrier(); asm volatile("" ::: "memory");
#pragma unroll
            for (int mm = 0; mm < 2; ++mm) { const int m = 2 * mh + mm; const int row = row0 + ai * 128 + m * 16; const float s = sc[ai][m];
#pragma unroll
                for (int bj = 0; bj < 2; ++bj) {
                    const f32x4 p4 = *(const LAS f32x4*)(xch + ((wr * 64 + m * 16 + fr) * 2 + bj) * 4);
                    const float rn = rsqrtf(((p4[0] + p4[1]) + (p4[2] + p4[3])) * (1.0f / 128.0f) + EPS);
                    float ov[8];
#pragma unroll
                    for (int j = 0; j < 4; ++j) { ov[j] = sv[mm][bj][j] * rn * gn[j] * siluf_(acc[ai][bj][m][0][j] * s); ov[4 + j] = sv[mm][bj][4 + j] * rn * gn[4 + j] * siluf_(acc[ai][bj][m][1][j] * s); }
                    *(u32x4*)(O + (size_t)row * ldc + u.pn * 256 + bj * 128 + colw) = pack8(ov); } }
            asm volatile("s_waitcnt lgkmcnt(0)" ::: "memory"); __builtin_amdgcn_s_barrier(); asm volatile("" ::: "memory");
          }
    }
};
__device__ __forceinline__ float rot_up(float v) { return __int_as_float(__builtin_amdgcn_mov_dpp(__float_as_int(v), 0x12F, 0xF, 0xF, true)); }
__device__ __forceinline__ float rot_dn(float v) { return __int_as_float(__builtin_amdgcn_mov_dpp(__float_as_int(v), 0x121, 0xF, 0xF, true)); }
struct EpiFfn {
    static constexpr bool PERM = true, AFTER_DRAIN = false;
    bf16_t* HID; bf16_t* EDGE; const rs_t* rs; const float* cw; const float* cb;
    __device__ __forceinline__ void prefetch(const Unit& u, int slot) const {
        epf_rows(rs, u, slot);
        extern __shared__ __attribute__((aligned(16))) unsigned char epf_lds_[];
        const int tid = tidx();
        if (tid >= 64 && tid < 128) { const int l = tid - 64, half = l >> 5, c4 = (l & 31) * 4;
            LAS unsigned char* d = (LAS unsigned char*)epf_lds_ + EPF_OFF + slot * EPF_SLOT + EPF_CW;
            const float* s0 = cw + (size_t)half * DFF + u.pn * 128 + c4;
            const float* s1 = half ? cb + u.pn * 128 + c4 : cw + (size_t)2 * DFF + u.pn * 128 + c4;
            __builtin_amdgcn_global_load_lds((const unsigned*)s0, (LAS unsigned*)d, 16, 0, 0);
            __builtin_amdgcn_global_load_lds((const unsigned*)s1, (LAS unsigned*)(d + 1024), 16, 0, 0); }
    }
    __device__ __forceinline__ void operator()(AccT acc, const Unit& u, int wr, int wc, int fr, int fq, int slot) const {
        const int lane = fq * 16 + fr, ch = u.pn * 128 + wc * 32 + 8 * fq;
        float scall[2][4];
#pragma unroll
        for (int ai = 0; ai < 2; ++ai)
#pragma unroll
            for (int m = 0; m < 4; ++m) scall[ai][m] = epf_rstd(slot, ai * 128 + wr * 64 + m * 16 + fr);
        float w0[8], w1[8], w2[8], bb[8];
        { extern __shared__ __attribute__((aligned(16))) unsigned char epf_lds_[];
          const LAS float* wl = (const LAS float*)((LAS unsigned char*)epf_lds_ + EPF_OFF + slot * EPF_SLOT + EPF_CW) + wc * 32 + 8 * fq;
#pragma unroll
          for (int q = 0; q < 2; ++q) { const f32x4 a0 = *(const LAS f32x4*)(wl + 4 * q), a1 = *(const LAS f32x4*)(wl + 128 + 4 * q), a2 = *(const LAS f32x4*)(wl + 256 + 4 * q), a3 = *(const LAS f32x4*)(wl + 384 + 4 * q);
#pragma unroll
              for (int j = 0; j < 4; ++j) { w0[4 * q + j] = a0[j]; w1[4 * q + j] = a1[j]; w2[4 * q + j] = a2[j]; bb[4 * q + j] = a3[j]; } } }
#pragma unroll
        for (int ai = 0; ai < 2; ++ai) {
            const int row0 = u.pm * 256 + ai * 128 + wr * 64 + fr;
            float G[4][8], sc[4];
#pragma unroll
            for (int m = 0; m < 4; ++m) { sc[m] = scall[ai][m];
#pragma unroll
                for (int j = 0; j < 4; ++j) { G[m][j] = acc[ai][0][m][0][j] * sc[m]; G[m][4 + j] = acc[ai][0][m][1][j] * sc[m]; } }
            float ruc[8], rdp[8];
#pragma unroll
            for (int j = 0; j < 8; ++j) { ruc[j] = rot_up(G[0][j]); rdp[j] = 0.f; }
#pragma unroll
            for (int m = 0; m < 4; ++m) {
                float run[8], rdc[8];
#pragma unroll
                for (int j = 0; j < 8; ++j) { run[j] = (m < 3) ? rot_up(G[m < 3 ? m + 1 : 3][j]) : 0.f; rdc[j] = rot_dn(G[m][j]); }
                float hv[8], uv[8];
#pragma unroll
                for (int j = 0; j < 8; ++j) { const float up = (fr < 15) ? ruc[j] : run[j], dn = (fr > 0) ? rdc[j] : rdp[j];
                    uv[j] = (j < 4 ? acc[ai][1][m][0][j] : acc[ai][1][m][1][j - 4]) * sc[m];
                    hv[j] = siluf_(w0[j] * dn + w1[j] * G[m][j] + w2[j] * up + bb[j]) * uv[j]; }
                const int row = row0 + m * 16;
                *(u32x4*)(HID + (size_t)row * DFF + ch) = pack8(hv);
                if ((m == 0 && fr < 2) || (m == 3 && fr >= 14)) { const int e = 4 * (2 * ai + wr) + (m == 0 ? fr : fr - 12);
                    bf16_t* ep = EDGE + ((size_t)(u.pm * 16 + e) * 2) * DFF + ch;
                    *(u32x4*)ep = pack8(G[m]); *(u32x4*)(ep + DFF) = pack8(uv); }
#pragma unroll
                for (int j = 0; j < 8; ++j) { rdp[j] = rdc[j]; ruc[j] = run[j]; }
            }
        }
    }
};

__device__ __forceinline__ void stagger(int us) {
    const unsigned long long t0 = __builtin_amdgcn_s_memrealtime();
    const unsigned long long d = (unsigned long long)((blockIdx.x * 97u) & 255u) * (unsigned)us * 100ull / 256ull;
    while (__builtin_amdgcn_s_memrealtime() - t0 < d) __builtin_amdgcn_s_sleep(8);
}
struct LinearOrder {
    int nN, first, count, step;
    __device__ __forceinline__ bool next(int i, Unit& u) const { if (i >= count) return false; const int L = first + i * step; u.pm = L / nN; u.pn = L - u.pm * nN; return true; }
    __device__ __forceinline__ void a_ready(const Unit&) const {}
    __device__ __forceinline__ void done(const Unit&) const {}
};
template <class Epi>
__device__ __forceinline__ void run_gemm_linear(LAS unsigned char* lds, const bf16_t* A, const bf16_t* Bt, int M, int N, int K, const Epi& E, int first, int count, int step) {
    if (count <= 0) return;
    asm volatile("" : "+s"(K));
    pg8::Gemm g{A, Bt, M, N, K}; LinearOrder S; S.nN = N / 256; S.first = first; S.count = count; S.step = step;
    pg8::gemm_phase<Epi, LinearOrder, true, true>(lds, g, S, E);
}
template <class Epi>
__device__ __forceinline__ void run_gemm_sub(LAS unsigned char* lds, const bf16_t* A, const bf16_t* Bt, int M, int N, int K, const Epi& E, int G, int c) {
    pg8::Gemm g{A, Bt, M, N, K}; pg8::StaticOrder S; S.init(M, N, G, c, N == 2048 ? 4 : 8);
    pg8::gemm_phase<Epi, pg8::StaticOrder, true, true>(lds, g, S, E);
}
struct RangeOrder : pg8::StaticOrder {
    int lo, hi;
    __device__ __forceinline__ bool next(int i, Unit& u) const { return (lo + i < hi) && pg8::StaticOrder::next(lo + i, u); }
};
template <class Epi>
__device__ __forceinline__ void run_gemm_sub_range(LAS unsigned char* lds, const bf16_t* A, const bf16_t* Bt, int M, int N, int K, const Epi& E, int G, int c, int lo, int hi) {
    if (lo >= hi) return;
    asm volatile("" : "+s"(K));
    pg8::Gemm g{A, Bt, M, N, K}; RangeOrder S; S.init(M, N, G, c, N == 2048 ? 4 : 8); S.lo = lo; S.hi = hi;
    pg8::gemm_phase<Epi, RangeOrder, true, true>(lds, g, S, E);
}
template <class Epi>
__device__ __forceinline__ void run_gemm_range(LAS unsigned char* lds, const bf16_t* A, const bf16_t* Bt, int M, int N, int K, const Epi& E, int lo, int hi) {
    if (lo >= hi) return;
    asm volatile("" : "+s"(K));
    pg8::Gemm g{A, Bt, M, N, K}; RangeOrder S; S.init(M, N, (int)gridDim.x, (int)blockIdx.x, N == 2048 ? 4 : 8); S.lo = lo; S.hi = hi;
    pg8::gemm_phase<Epi, RangeOrder, true, true>(lds, g, S, E);
}
#ifndef MK_WGM_GU
#define MK_WGM_GU 8
#endif
template <class Epi>
__device__ __forceinline__ void run_gemm(LAS unsigned char* lds, const bf16_t* A, const bf16_t* Bt, int M, int N, int K, const Epi& E) {
    pg8::Gemm g{A, Bt, M, N, K}; pg8::StaticOrder S; S.init(M, N, (int)gridDim.x, (int)blockIdx.x, N == 2048 ? 4 : (N == 2 * DFF ? MK_WGM_GU : 8));
    pg8::gemm_phase<Epi, pg8::StaticOrder, true, true>(lds, g, S, E);
}

struct Job { const float* src; bf16_t* dst; const float* gain; int K, Nsrc, Ndst, map, qcols; };
__device__ __forceinline__ void get_job(ArgsCP a, int j, Job& J) {
    unsigned char* ws = a->ws; J.gain = nullptr; J.map = 0; J.qcols = 0;
    if (j < 16) { const int L = j >> 2, k = j & 3;
        if (k == 0)      { J.src = a->in[31] + (size_t)L * D * 2 * DFF; J.dst = (bf16_t*)(ws + WS_WGU + L * SZ_WGU); J.gain = a->in[5] + L * D; J.K = D; J.Nsrc = 2 * DFF; J.Ndst = 2 * DFF; J.map = 1; }
        else if (k == 1) { J.src = a->in[34] + (size_t)L * DFF * D;     J.dst = (bf16_t*)(ws + WS_WDN + L * SZ_WDN); J.K = DFF; J.Nsrc = D; J.Ndst = D; }
        else if (k == 2) { J.src = a->in[36] + (size_t)L * D * D;       J.dst = (bf16_t*)(ws + WS_WPG + L * SZ_WPG); J.gain = a->in[6] + L * D; J.K = D; J.Nsrc = D; J.Ndst = D; }
        else             { J.src = a->in[35] + (size_t)L * PLED * D;    J.dst = (bf16_t*)(ws + WS_WPP + L * SZ_WPP); J.K = PLED; J.Nsrc = D; J.Ndst = D; }
    } else switch (j) {
        case 16: J.src = a->in[8];  J.dst = (bf16_t*)(ws + WS_NAQ); J.gain = a->in[4] + 0 * D; J.K = D; J.Nsrc = 6144; J.Ndst = 6144; J.qcols = 2048; break;
        case 17: J.src = a->in[9];  J.dst = (bf16_t*)(ws + WS_NAO); J.K = D; J.Nsrc = D; J.Ndst = D; break;
        case 18: J.src = a->in[11]; J.dst = (bf16_t*)(ws + WS_SGI); J.gain = a->in[4] + 1 * D; J.K = D; J.Nsrc = 4096; J.Ndst = 4096; break;
        case 19: J.src = a->in[15]; J.dst = (bf16_t*)(ws + WS_SGO); J.K = D; J.Nsrc = D; J.Ndst = D; break;
        case 20: J.src = a->in[16]; J.dst = (bf16_t*)(ws + WS_GDI); J.gain = a->in[4] + 2 * D; J.K = D; J.Nsrc = 12416; J.Ndst = GDI_N; J.map = 2; break;
        case 21: J.src = a->in[21]; J.dst = (bf16_t*)(ws + WS_GDO); J.K = 4096; J.Nsrc = D; J.Ndst = D; break;
        default: J.src = a->in[30]; J.dst = (bf16_t*)(ws + WS_S5G); J.K = D; J.Nsrc = 4096; J.Ndst = 4096; J.map = 1; break;
    }
}
__device__ __forceinline__ int map_col(const Job& J, int n0) {
    if (J.map == 0) return n0;
    if (J.map == 1) { const int tile = n0 >> 8, w = n0 & 255, H = J.Nsrc >> 1; return w < 128 ? tile * 128 + w : H + tile * 128 + (w - 128); }
    if (n0 < 8192) return n0;
    if (n0 < 8320) return 12288 + (n0 - 8192);
    if (n0 < GDI_N1) return -1;
    return 8192 + (n0 - GDI_N1);
}
__device__ __forceinline__ void prologue(ArgsCP a, LAS unsigned char* lds) {
    const int tid = tidx(), G = gridDim.x, bid = blockIdx.x;
    LAS float* tile = (LAS float*)lds;
    int base = 0;
    for (int j = 0; j < 23; ++j) {
        Job J; get_job(a, j, J);
        const int kt = J.K >> 6, ntl = J.Ndst >> 6, nt = kt * ntl;
        const int first = (bid - (base % G) + G) % G;
        const int kk = tid >> 4, nn4 = (tid & 15) * 4;
        for (int i0 = first; i0 < nt; i0 += 4 * G) {
            f32x4 v[4][2]; float sc[4][2];
#pragma unroll
            for (int q = 0; q < 4; ++q) { const int i = i0 + q * G;
                if (i < nt) { const int nb = i / kt, kb = i - nb * kt, n0 = nb * 64, k0 = kb * 64, s0 = map_col(J, n0);
                    const float cs = (n0 < J.qcols) ? 0.08838834764831845f : 1.0f;
#pragma unroll
                    for (int p = 0; p < 2; ++p) { const int k = k0 + kk + 32 * p;
                        v[q][p] = (s0 >= 0) ? *(const f32x4*)(J.src + (size_t)k * J.Nsrc + s0 + nn4) : (f32x4){0.f, 0.f, 0.f, 0.f};
                        sc[q][p] = (J.gain ? J.gain[k] : 1.0f) * cs; } } }
#pragma unroll
            for (int q = 0; q < 4; ++q) if (i0 + q * G < nt) {
#pragma unroll
                for (int p = 0; p < 2; ++p)
#pragma unroll
                    for (int e = 0; e < 4; ++e) tile[q * 4160 + (nn4 + e) * 65 + kk + 32 * p] = v[q][p][e] * sc[q][p]; }
            __syncthreads();
#pragma unroll
            for (int q = 0; q < 4; ++q) { const int i = i0 + q * G;
                if (i < nt) { const int nb = i / kt, kb = i - nb * kt, n0 = nb * 64, k0 = kb * 64;
                    const int nn = tid >> 3, kk8 = (tid & 7) * 8; float o[8];
#pragma unroll
                    for (int e = 0; e < 8; ++e) o[e] = tile[q * 4160 + nn * 65 + kk8 + e];
                    *(u32x4*)(J.dst + (size_t)(n0 + nn) * J.K + k0 + kk8) = pack8(o); } }
            __syncthreads();
        }
        base += nt;
    }
    { bf16_t* PB = (bf16_t*)(a->ws + WS_PB);
      const long total = (long)4 * T * 64, stride = (long)G * NTHR;
      for (long i0 = (long)bid * NTHR + tid; i0 < total; i0 += 4 * stride) {
          f32x4 v[4]; size_t dsto[4]; bool ok[4];
#pragma unroll
          for (int q = 0; q < 4; ++q) { const long i = i0 + q * stride; ok[q] = i < total; const long ii = ok[q] ? i : i0;
              const int L = (int)(ii / ((long)T * 64)); const int rem = (int)(ii - (long)L * T * 64); const int row = rem >> 6, c4 = (rem & 63) * 4;
              const float* src = row < 8192 ? a->in[2] + ((size_t)L * 8192 + row) * PLED + c4 : a->in[3] + ((size_t)L * 32768 + (row - 8192)) * PLED + c4;
              v[q] = *(const f32x4*)src; dsto[q] = ((size_t)L * T + row) * PLED + c4; }
#pragma unroll
          for (int q = 0; q < 4; ++q) if (ok[q]) { u32x2 w; w.x = pk2(v[q][0], v[q][1]); w.y = pk2(v[q][2], v[q][3]); *(u32x2*)(PB + dsto[q]) = w; } } }
    { bf16_t* XB = (bf16_t*)(a->ws + WS_XB0); rs_t* rs = (rs_t*)(a->ws + WS_RS);
      const int w = tid >> 6, lane = tid & 63;
      for (int row = bid * 8 + w; row < T; row += G * 8) {
          const float* src = row < 8192 ? a->in[0] + (size_t)row * D : a->in[1] + (size_t)(row - 8192) * D;
          float ss = 0.f;
#pragma unroll
          for (int q = 0; q < 8; ++q) { const int c = (q * 64 + lane) * 4; const f32x4 v = *(const f32x4*)(src + c);
              u32x2 wv; wv.x = pk2(v[0], v[1]); wv.y = pk2(v[2], v[3]); *(u32x2*)(XB + (size_t)row * D + c) = wv;
              ss += v[0] * v[0] + v[1] * v[1] + v[2] * v[2] + v[3] * v[3]; }
          ss = wave_sum(ss); if (lane == 0) rs[row] = rs_fix(ss); } }
}

__device__ __forceinline__ void na_attention(ArgsCP a, LAS unsigned char* lds, const bf16_t* QKV, bf16_t* AO) {
    const int tid = tidx(), w = tid >> 6, lane = tid & 63;
    LAS float* qs = (LAS float*)(lds + w * 1024); LAS float* ps = qs + 128;
    const float* rpb = a->in[10];
    for (long task = (long)blockIdx.x * 8 + w; task < (long)T * 16; task += (long)gridDim.x * 8) {
        const int seq = (int)(task >> 16), rem = (int)(task & 65535), h = rem >> 12, pos = rem & 4095, r = pos >> 6, c = pos & 63;
        const int r0 = min(max(r - 4, 0), 56), c0 = min(max(c - 8, 0), 48);
        const size_t trow = (size_t)seq * SEQ + pos;
        { const unsigned qq = *(const unsigned*)(QKV + trow * 6144 + h * 128 + 2 * lane); qs[2 * lane] = blo(qq); qs[2 * lane + 1] = bhi(qq); }
        __builtin_amdgcn_wave_barrier();
        float s[2];
#pragma unroll
        for (int kk = 0; kk < 2; ++kk) {
            const int j = lane + 64 * kk, kr = r0 + (j >> 4), kc = c0 + (j & 15);
            const u32x4* kp = (const u32x4*)(QKV + ((size_t)seq * SEQ + kr * 64 + kc) * 6144 + 2048 + h * 128);
            float acc = 0.f;
#pragma unroll 4
            for (int d8 = 0; d8 < 16; ++d8) { const u32x4 kv = kp[d8]; const f32x4 q0 = *(const LAS f32x4*)(qs + d8 * 8), q1 = *(const LAS f32x4*)(qs + d8 * 8 + 4);
                acc += q0[0] * blo(kv.x) + q0[1] * bhi(kv.x) + q0[2] * blo(kv.y) + q0[3] * bhi(kv.y) + q1[0] * blo(kv.z) + q1[1] * bhi(kv.z) + q1[2] * blo(kv.w) + q1[3] * bhi(kv.w); }
            s[kk] = acc + rpb[(h * 15 + (kr - r + 7)) * 31 + (kc - c + 15)];
        }
        const float mx = wave_max(fmaxf(s[0], s[1]));
        const float e0 = __expf(s[0] - mx), e1 = __expf(s[1] - mx);
        const float inv = 1.0f / wave_sum(e0 + e1);
        ps[lane] = e0 * inv; ps[lane + 64] = e1 * inv;
        __builtin_amdgcn_wave_barrier();
        float o0 = 0.f, o1 = 0.f;
        const bf16_t* vb = QKV + ((size_t)seq * SEQ) * 6144 + 4096 + h * 128 + 2 * lane;
#pragma unroll 4
        for (int j = 0; j < 128; ++j) { const int kr = r0 + (j >> 4), kc = c0 + (j & 15);
            const unsigned vv = *(const unsigned*)(vb + (size_t)(kr * 64 + kc) * 6144); const float p = ps[j]; o0 += p * blo(vv); o1 += p * bhi(vv); }
        *(unsigned*)(AO + trow * D + h * 128 + 2 * lane) = pk2(o0, o1);
        __builtin_amdgcn_wave_barrier();
    }
}

__device__ __forceinline__ void sgu_mix(ArgsCP a, LAS unsigned char* lds, const bf16_t* UV, const rs_t* rsv, bf16_t* MX) {
    const int tid = tidx(), G = gridDim.x;
    LAS float* WT = (LAS float*)lds;
    LAS float* VS = (LAS float*)(lds + 65536);
    const float* w_s = a->in[13]; const float* b_s = a->in[14]; const float* sgn = a->in[12];
    const int per = (5120 + G - 1) / G, u0 = blockIdx.x * per, u1 = min(5120, u0 + per);
    int gcur = -1;
    for (int u = u0; u < u1; ++u) {
        const int g = u / 320, sc = u - g * 320, seq = sc >> 5, n = sc & 31; const size_t row0 = (size_t)seq * SEQ + n * 128;
        __syncthreads();
        if (g != gcur) { gcur = g;
            for (int idx = tid; idx < 16384; idx += NTHR) { const int t = idx >> 7, s = idx & 127; WT[s * 128 + t] = w_s[(size_t)g * 16384 + idx]; } }
        { const int s = tid >> 2, c32 = (tid & 3) * 32; const float rsd = rstd_of(rsv[row0 + s]);
#pragma unroll
          for (int q = 0; q < 4; ++q) { float v[8]; unpack8(*(const u32x4*)(UV + (row0 + s) * 4096 + 2048 + g * 128 + c32 + q * 8), v);
#pragma unroll
              for (int j = 0; j < 8; ++j) VS[s * 128 + c32 + q * 8 + j] = v[j] * rsd * sgn[g * 128 + c32 + q * 8 + j]; } }
        __syncthreads();
        const int t0 = (tid >> 4) * 4, c0 = (tid & 15) * 8;
        float acc[4][8];
#pragma unroll
        for (int i = 0; i < 4; ++i)
#pragma unroll
            for (int j = 0; j < 8; ++j) acc[i][j] = 0.f;
#pragma unroll 4
        for (int s = 0; s < 128; ++s) {
            const f32x4 av = *(const LAS f32x4*)(WT + s * 128 + t0), v0 = *(const LAS f32x4*)(VS + s * 128 + c0), v1 = *(const LAS f32x4*)(VS + s * 128 + c0 + 4);
#pragma unroll
            for (int i = 0; i < 4; ++i) {
#pragma unroll
                for (int j = 0; j < 4; ++j) { acc[i][j] += av[i] * v0[j]; acc[i][4 + j] += av[i] * v1[j]; } }
        }
#pragma unroll
        for (int i = 0; i < 4; ++i) { const int t = t0 + i; const float bias = b_s[g * 128 + t]; const size_t row = row0 + t;
            float uv[8]; unpack8(*(const u32x4*)(UV + row * 4096 + g * 128 + c0), uv);
#pragma unroll
            for (int j = 0; j < 8; ++j) uv[j] *= (acc[i][j] + bias);
            *(u32x4*)(MX + row * D + g * 128 + c0) = pack8(uv); }
    }
}

__device__ __forceinline__ void ffn_convglu(ArgsCP a, int layer, const bf16_t* GU, bf16_t* HID, int rows) {
    const float* cw = a->in[32] + (size_t)layer * 3 * DFF; const float* cb = a->in[33] + (size_t)layer * DFF;
    const long total = (long)rows * 704;
    for (long i = (long)blockIdx.x * NTHR + tidx(); i < total; i += (long)gridDim.x * NTHR) {
        const int r = (int)(i / 704), cbk = (int)(i - (long)r * 704), ch = cbk * 8, pos = r & (SEQ - 1);
        const bf16_t* gp = GU + (size_t)r * (2 * DFF) + (cbk >> 4) * 256 + (cbk & 15) * 8;
        float g0[8], gm[8], gn[8], up[8];
        unpack8(*(const u32x4*)gp, g0); unpack8(*(const u32x4*)(gp + 128), up);
        if (pos > 0) unpack8(*(const u32x4*)(gp - 2 * DFF), gm); else {
#pragma unroll
            for (int j = 0; j < 8; ++j) gm[j] = 0.f; }
        if (pos < SEQ - 1) unpack8(*(const u32x4*)(gp + 2 * DFF), gn); else {
#pragma unroll
            for (int j = 0; j < 8; ++j) gn[j] = 0.f; }
        float o[8];
#pragma unroll
        for (int j = 0; j < 8; ++j) { const float gv = cw[ch + j] * gm[j] + cw[DFF + ch + j] * g0[j] + cw[2 * DFF + ch + j] * gn[j] + cb[ch + j]; o[j] = siluf_(gv) * up[j]; }
        *(u32x4*)(HID + (size_t)r * DFF + ch) = pack8(o);
    }
}

__device__ __forceinline__ void ffn_fixup(ArgsCP a, int layer, const bf16_t* EDGE, bf16_t* HID) {
    const float* cw = a->in[32] + (size_t)layer * 3 * DFF; const float* cb = a->in[33] + (size_t)layer * DFF;
    const int total = (T / 256) * 8 * 704;
    for (int it = blockIdx.x * NTHR + tidx(); it < total; it += gridDim.x * NTHR) {
        const int cbk = it % 704, rr = (it / 704) & 7, tile = it / (704 * 8), s = rr >> 1, last = rr & 1, ch = cbk * 8;
        const bf16_t* eb = EDGE + (size_t)tile * 16 * 2 * DFF + ch;
        float gc[8], uc[8], gi[8], go[8];
        unpack8(*(const u32x4*)(eb + (size_t)((4 * s + (last ? 3 : 0)) * 2) * DFF), gc);
        unpack8(*(const u32x4*)(eb + (size_t)((4 * s + (last ? 3 : 0)) * 2 + 1) * DFF), uc);
        unpack8(*(const u32x4*)(eb + (size_t)((4 * s + (last ? 2 : 1)) * 2) * DFF), gi);
        const bf16_t* op = nullptr;
        if (last) { if (s < 3) op = eb + (size_t)((4 * (s + 1)) * 2) * DFF; else if ((tile & 15) != 15) op = eb + (size_t)16 * 2 * DFF; }
        else      { if (s > 0) op = eb + (size_t)((4 * (s - 1) + 3) * 2) * DFF; else if ((tile & 15) != 0) op = eb - (size_t)16 * 2 * DFF + (size_t)(15 * 2) * DFF; }
        if (op) unpack8(*(const u32x4*)op, go); else {
#pragma unroll
            for (int j = 0; j < 8; ++j) go[j] = 0.f; }
        float hv[8];
#pragma unroll
        for (int j = 0; j < 8; ++j) { const float dn = last ? gi[j] : go[j], up = last ? go[j] : gi[j];
            hv[j] = siluf_(cw[ch + j] * dn + cw[DFF + ch + j] * gc[j] + cw[2 * DFF + ch + j] * up + cb[ch + j]) * uc[j]; }
        *(u32x4*)(HID + ((size_t)tile * 256 + 64 * s + 63 * last) * DFF + ch) = pack8(hv);
    }
}

__device__ __forceinline__ void gdn_conv(ArgsCP a, const bf16_t* PROJ, const float* AB, bf16_t* QK, bf16_t* VP, float* GB, int rows) {
    const int tid = tidx(), ch0 = tid * 16;
    const float* cw = a->in[17];
    float w0[16], w1[16], w2[16];
#pragma unroll
    for (int j = 0; j < 16; ++j) { w0[j] = cw[ch0 + j]; w1[j] = cw[8192 + ch0 + j]; w2[j] = cw[16384 + ch0 + j]; }
    const float qsc = ch0 < 2048 ? 0.08838834764831845f : 1.0f;
    for (int r4 = blockIdx.x * 4; r4 < rows; r4 += gridDim.x * 4) {
        const int pos = r4 & (SEQ - 1);
        const bf16_t* p = PROJ + (size_t)r4 * 8192 + ch0;
        u32x4 raw[6][2];
#pragma unroll
        for (int q = 0; q < 6; ++q) { const bool ok = (q == 0) ? (pos > 0) : ((q == 5) ? (pos + 4 < SEQ) : true);
            if (ok) { raw[q][0] = *(const u32x4*)(p + (long)(q - 1) * 8192); raw[q][1] = *(const u32x4*)(p + (long)(q - 1) * 8192 + 8); }
            else { raw[q][0] = (u32x4){0u, 0u, 0u, 0u}; raw[q][1] = raw[q][0]; } }
        float xa[16], xb_[16], xc[16];
        { float t[8]; unpack8(raw[0][0], t);
#pragma unroll
          for (int j = 0; j < 8; ++j) xa[j] = t[j];
          unpack8(raw[0][1], t);
#pragma unroll
          for (int j = 0; j < 8; ++j) xa[8 + j] = t[j];
          unpack8(raw[1][0], t);
#pragma unroll
          for (int j = 0; j < 8; ++j) xb_[j] = t[j];
          unpack8(raw[1][1], t);
#pragma unroll
          for (int j = 0; j < 8; ++j) xb_[8 + j] = t[j]; }
#pragma unroll
        for (int q = 0; q < 4; ++q) {
            { float t[8]; unpack8(raw[q + 2][0], t);
#pragma unroll
              for (int j = 0; j < 8; ++j) xc[j] = t[j];
              unpack8(raw[q + 2][1], t);
#pragma unroll
              for (int j = 0; j < 8; ++j) xc[8 + j] = t[j]; }
            const int r = r4 + q;
            float y[16], ss = 0.f;
#pragma unroll
            for (int j = 0; j < 16; ++j) { y[j] = siluf_(w0[j] * xa[j] + w1[j] * xb_[j] + w2[j] * xc[j]); ss += y[j] * y[j]; }
            ss += __shfl_xor(ss, 1); ss += __shfl_xor(ss, 2); ss += __shfl_xor(ss, 4);
            const float sc = ch0 < 4096 ? rsqrtf(ss + EPS) * qsc : 1.0f;
            float o0[8], o1[8];
#pragma unroll
            for (int j = 0; j < 8; ++j) { o0[j] = y[j] * sc; o1[j] = y[8 + j] * sc; }
            bf16_t* dst = ch0 < 4096 ? QK + (size_t)r * 4096 + ch0 : VP + (size_t)r * 4096 + (ch0 - 4096);
            *(u32x4*)dst = pack8(o0); *(u32x4*)(dst + 8) = pack8(o1);
#pragma unroll
            for (int j = 0; j < 16; ++j) { xa[j] = xb_[j]; xb_[j] = xc[j]; }
        }
        if (tid < 256) { const int q = tid >> 6, dir = (tid >> 5) & 1, head = tid & 31; const int r = r4 + q;
            const float av = AB[(size_t)r * 128 + dir * 64 + head], bv = AB[(size_t)r * 128 + dir * 64 + 32 + head];
            const float xx = av + a->in[19][dir * 32 + head];
            const float sp = xx > 20.f ? xx : log1pf(expf(xx));
            GB[(size_t)r * 128 + dir * 64 + head] = -expf(a->in[18][dir * 32 + head]) * sp;
            GB[(size_t)r * 128 + dir * 64 + 32 + head] = 1.0f / (1.0f + expf(-bv)); }
    }
}
__device__ __forceinline__ void gdn_scan_naive(LAS unsigned char* lds, const bf16_t* QK, const bf16_t* VP, const float* GB, bf16_t* OF, bf16_t* OB, int nseq) {
    const int tid = tidx(), vh = tid >> 8, j = (tid & 255) >> 1, half = tid & 1;
    LAS float* KQ = (LAS float*)lds;
    LAS float* VS = (LAS float*)(lds + 16384);
    LAS float* GS = (LAS float*)(lds + 32768);
    const int nunits = nseq * 32;
    for (int unit = blockIdx.x; unit < nunits; unit += gridDim.x) {
        const int seq = unit >> 5, hq = (unit >> 1) & 15, dir = unit & 1, head = 2 * hq + vh;
        bf16_t* OD = dir ? OB : OF;
        float S[64];
#pragma unroll
        for (int i = 0; i < 64; ++i) S[i] = 0.f;
        for (int blk = 0; blk < SEQ / 16; ++blk) {
            __syncthreads();
            { const int tok = tid >> 5, part = tid & 31, step = blk * 16 + tok, pos = dir ? SEQ - 1 - step : step; const size_t row = (size_t)seq * SEQ + pos;
              const bf16_t* src = part < 16 ? QK + row * 4096 + hq * 128 + part * 8 : QK + row * 4096 + 2048 + hq * 128 + (part - 16) * 8;
              float v[8]; unpack8(*(const u32x4*)src, v);
              *(LAS f32x4*)(KQ + tok * 256 + part * 8) = (f32x4){v[0], v[1], v[2], v[3]}; *(LAS f32x4*)(KQ + tok * 256 + part * 8 + 4) = (f32x4){v[4], v[5], v[6], v[7]};
              unpack8(*(const u32x4*)(VP + row * 4096 + hq * 256 + part * 8), v);
              *(LAS f32x4*)(VS + tok * 256 + part * 8) = (f32x4){v[0], v[1], v[2], v[3]}; *(LAS f32x4*)(VS + tok * 256 + part * 8 + 4) = (f32x4){v[4], v[5], v[6], v[7]};
              if (tid < 64) { const int tk = tid >> 2, which = tid & 3, hh = 2 * hq + (which & 1), isb = which >> 1, st = blk * 16 + tk, ps = dir ? SEQ - 1 - st : st;
                  const float gv = GB[((size_t)seq * SEQ + ps) * 128 + dir * 64 + isb * 32 + hh]; GS[tk * 4 + which] = isb ? gv : expf(gv); } }
            __syncthreads();
            for (int s = 0; s < 16; ++s) {
                const float av = GS[s * 4 + vh], bv = GS[s * 4 + 2 + vh], vt = VS[s * 256 + vh * 128 + j];
                const LAS float* kp = KQ + s * 256 + 128 + half * 64; const LAS float* qp = KQ + s * 256 + half * 64;
                float ks = 0.f;
#pragma unroll
                for (int i = 0; i < 64; i += 4) { const f32x4 k4 = *(const LAS f32x4*)(kp + i); ks += k4[0] * S[i] + k4[1] * S[i + 1] + k4[2] * S[i + 2] + k4[3] * S[i + 3]; }
                ks += __shfl_xor(ks, 1);
                const float uu = bv * (vt - av * ks);
                float os = 0.f;
#pragma unroll
                for (int i = 0; i < 64; i += 4) { const f32x4 k4 = *(const LAS f32x4*)(kp + i), q4 = *(const LAS f32x4*)(qp + i);
#pragma unroll
                    for (int e = 0; e < 4; ++e) { S[i + e] = av * S[i + e] + k4[e] * uu; os += q4[e] * S[i + e]; } }
                os += __shfl_xor(os, 1);
                if (half == 0) { const int step = blk * 16 + s, pos = dir ? SEQ - 1 - step : step; OD[((size_t)seq * SEQ + pos) * 4096 + head * 128 + j] = f2bf(os); }
            }
        }
    }
}
__device__ __forceinline__ void gdn_sumnorm(ArgsCP a, bf16_t* OF, const bf16_t* OB, int rows) {
    const int tid = tidx(), rsub = tid >> 8, c0 = (tid & 255) * 16;
    const float* on = a->in[20];
    float gn[16];
#pragma unroll
    for (int q = 0; q < 16; ++q) gn[q] = on[(c0 & 127) + q];
    for (int r8 = blockIdx.x * 8; r8 < rows; r8 += gridDim.x * 8) {
        u32x4 f[4][2], b[4][2];
#pragma unroll
        for (int q = 0; q < 4; ++q) { const size_t off = (size_t)(r8 + 2 * q + rsub) * 4096 + c0;
            f[q][0] = *(const u32x4*)(OF + off); f[q][1] = *(const u32x4*)(OF + off + 8); b[q][0] = *(const u32x4*)(OB + off); b[q][1] = *(const u32x4*)(OB + off + 8); }
        asm volatile("" ::: "memory");
#pragma unroll
        for (int q = 0; q < 4; ++q) { const size_t off = (size_t)(r8 + 2 * q + rsub) * 4096 + c0;
            float x[16], t[8];
            unpack8(f[q][0], t);
#pragma unroll
            for (int e = 0; e < 8; ++e) x[e] = t[e];
            unpack8(f[q][1], t);
#pragma unroll
            for (int e = 0; e < 8; ++e) x[8 + e] = t[e];
            unpack8(b[q][0], t);
#pragma unroll
            for (int e = 0; e < 8; ++e) x[e] += t[e];
            unpack8(b[q][1], t);
#pragma unroll
            for (int e = 0; e < 8; ++e) x[8 + e] += t[e];
            float ss = 0.f;
#pragma unroll
            for (int e = 0; e < 16; ++e) ss += x[e] * x[e];
            ss += __shfl_xor(ss, 1); ss += __shfl_xor(ss, 2); ss += __shfl_xor(ss, 4);
            const float sc = rsqrtf(ss * (1.0f / 128.0f) + EPS);
            float o0[8], o1[8];
#pragma unroll
            for (int e = 0; e < 8; ++e) { o0[e] = x[e] * sc * gn[e]; o1[e] = x[8 + e] * sc * gn[8 + e]; }
            *(u32x4*)(OF + off) = pack8(o0); *(u32x4*)(OF + off + 8) = pack8(o1); }
    }
}

__device__ __forceinline__ void s5_scan(ArgsCP a, LAS unsigned char* lds, const float* X, const rs_t* rs, float* YF, bf16_t* Y) {
    const int tid = tidx(), w = tid >> 6, lane = tid & 63;
    LAS float* U = (LAS float*)(lds + w * 9216);
    LAS float* XS = U + 256;
    const float* gmix = a->in[4] + 3 * D;
    for (int task = blockIdx.x * 8 + w; task < NSEQ * 128; task += gridDim.x * 8) {
        const int seq = task >> 7, gr = task & 127;
        for (int dir = 0; dir < 2; ++dir) {
            const int dg = dir * 128 + gr;
            const float are = a->in[22][dg * 64 + lane], aim = a->in[23][dg * 64 + lane], dt = expf(a->in[24][dg]);
            const float er = expf(are * dt); float sn, cs; sincosf(aim * dt, &sn, &cs);
            const float abr = er * cs, abi = er * sn;
            const float den = 1.0f / (are * are + aim * aim);
            const float cr = ((abr - 1.0f) * are + abi * aim) * den, ci = (abi * are - (abr - 1.0f) * aim) * den;
            float Br[16], Bi[16];
#pragma unroll
            for (int c = 0; c < 16; ++c) { const float bre = a->in[25][((size_t)dg * 64 + lane) * 16 + c], bim = a->in[26][((size_t)dg * 64 + lane) * 16 + c]; Br[c] = cr * bre - ci * bim; Bi[c] = cr * bim + ci * bre; }
            const int oc = lane & 15, tb = lane >> 4;
            float Cr[64], Ci[64];
#pragma unroll
            for (int p = 0; p < 64; ++p) { Cr[p] = a->in[27][((size_t)dg * 16 + oc) * 64 + p]; Ci[p] = a->in[28][((size_t)dg * 16 + oc) * 64 + p]; }
            const float dsk = a->in[29][gr * 16 + oc];
            float xr = 0.f, xi = 0.f;
            for (int blk = 0; blk < SEQ / 16; ++blk) {
                { const int tt = lane >> 2, c4 = (lane & 3) * 4, step = blk * 16 + tt, pos = dir ? SEQ - 1 - step : step; const size_t row = (size_t)seq * SEQ + pos;
                  const f32x4 xv = *(const f32x4*)(X + row * D + gr * 16 + c4); const f32x4 gm = *(const f32x4*)(gmix + gr * 16 + c4); const float rsd = rstd_of(rs[row]);
                  *(LAS f32x4*)(U + tt * 16 + c4) = xv * gm * rsd; }
                __builtin_amdgcn_wave_barrier();
                for (int tt = 0; tt < 16; ++tt) {
                    float bur = 0.f, bui = 0.f;
#pragma unroll
                    for (int c = 0; c < 16; c += 4) { const f32x4 u4 = *(const LAS f32x4*)(U + tt * 16 + c);
#pragma unroll
                        for (int e = 0; e < 4; ++e) { bur += Br[c + e] * u4[e]; bui += Bi[c + e] * u4[e]; } }
                    const float nr = abr * xr - abi * xi + bur, ni = abr * xi + abi * xr + bui; xr = nr; xi = ni;
                    XS[(tt * 64 + lane) * 2] = xr; XS[(tt * 64 + lane) * 2 + 1] = xi;
                }
                __builtin_amdgcn_wave_barrier();
                for (int i = 0; i < 4; ++i) {
                    const int t = tb * 4 + i; float y = 0.f;
#pragma unroll
                    for (int p = 0; p < 64; p += 2) { const f32x4 x2 = *(const LAS f32x4*)(XS + (t * 64 + p) * 2); y += Cr[p] * x2[0] - Ci[p] * x2[1] + Cr[p + 1] * x2[2] - Ci[p + 1] * x2[3]; }
                    const int step = blk * 16 + t, pos = dir ? SEQ - 1 - step : step; const size_t row = (size_t)seq * SEQ + pos;
                    if (dir == 0) YF[row * D + gr * 16 + oc] = y;
                    else { const float yt = y + YF[row * D + gr * 16 + oc] + dsk * U[t * 16 + oc]; Y[row * D + gr * 16 + oc] = f2bf(geluf_(yt)); }
                }
                __builtin_amdgcn_wave_barrier();
            }
        }
    }
}

__device__ __forceinline__ void final_norm(ArgsCP a, const rs_t* rs, const bf16_t* XB) {
    const int tid = tidx(), w = tid >> 6, lane = tid & 63; const float* g = a->in[7];
    for (int row = blockIdx.x * 8 + w; row < T; row += gridDim.x * 8) {
        const float s = rstd_of(rs[row]);
#pragma unroll
        for (int q = 0; q < 4; ++q) { const int c = (q * 64 + lane) * 8; float v[8]; unpack8(*(const u32x4*)(XB + (size_t)row * D + c), v);
            const f32x4 g0 = *(const f32x4*)(g + c), g1 = *(const f32x4*)(g + c + 4);
            *(f32x4*)(a->out + (size_t)row * D + c) = (f32x4){v[0] * g0[0] * s, v[1] * g0[1] * s, v[2] * g0[2] * s, v[3] * g0[3] * s};
            *(f32x4*)(a->out + (size_t)row * D + c + 4) = (f32x4){v[4] * g1[0] * s, v[5] * g1[1] * s, v[6] * g1[2] * s, v[7] * g1[3] * s}; }
    }
}


namespace gdn {
typedef short s16x8 __attribute__((ext_vector_type(8)));
typedef short s16x4 __attribute__((ext_vector_type(4)));
constexpr int QS = 0, QPITCH = 272;
constexpr int KS = QS + 64 * QPITCH;
constexpr int VS = KS + 64 * QPITCH;
constexpr int WS_ = VS + 64 * QPITCH;
constexpr int MB = WS_ + 64 * QPITCH, MPITCH = 144;
constexpr int A2 = MB + 64 * MPITCH;
constexpr int MD = A2 + 64 * MPITCH, MDP = 20;
constexpr int DV = MD + 4 * 16 * MDP * 4, DVPITCH = 48;
constexpr int TB = DV + 4 * 16 * DVPITCH;
constexpr int TB1 = TB + 5 * 256;
constexpr int SET1 = TB1 + 5 * 256;
constexpr int LDS_END = SET1 + 3 * 64 * QPITCH;
static_assert(SET1 % 16 == 0, "gdn lds align");
static_assert(LDS_END <= LDS_BAR, "gdn lds");

__device__ __forceinline__ s16x8 mk8(unsigned a, unsigned b, unsigned c, unsigned d) { u32x4 v; v.x = a; v.y = b; v.z = c; v.w = d; return __builtin_bit_cast(s16x8, v); }
__device__ __forceinline__ s16x8 cat8(u32x2 lo, u32x2 hi) { return mk8(lo.x, lo.y, hi.x, hi.y); }
__device__ __forceinline__ s16x4 mk4(unsigned a, unsigned b) { u32x2 v; v.x = a; v.y = b; return __builtin_bit_cast(s16x4, v); }

__device__ __forceinline__ void scan(LAS unsigned char* lds, const bf16_t* QK, const bf16_t* VP, const float* GB, bf16_t* OF, bf16_t* OB, int nseq, int wg, int nwg) {
    const int tid = tidx(), w = __builtin_amdgcn_readfirstlane(tid >> 6), lane = tid & 63;
#define GDN_FRESH() int ln_ = lane; asm volatile("" : "+v"(ln_)); const int g = ln_ >> 4, n = ln_ & 15;
    const int nunits = nseq * 64;
    for (int unit = wg; unit < nunits; unit += nwg) {
        const int seq = unit >> 6, h = (unit >> 1) & 31, dir = unit & 1, hq = h >> 1;
        bf16_t* OD = dir ? OB : OF;
        f32x4 S[8];
#pragma unroll
        for (int i = 0; i < 8; ++i) S[i] = (f32x4){0.f, 0.f, 0.f, 0.f};
        u32x4 pq[2], pk[2], pv[2]; float pg = 0.f, pb = 0.f;
#define GDN_LOADG(c) do { _Pragma("unroll") for (int i_ = 0; i_ < 2; ++i_) { const int p_ = tid + 512 * i_, ir_ = p_ >> 4, c16_ = (p_ & 15) * 8; \
            const int st_ = (c) * 64 + ir_, pos_ = dir ? SEQ - 1 - st_ : st_; const size_t row_ = (size_t)seq * SEQ + pos_; \
            pq[i_] = *(const u32x4*)(QK + row_ * 4096 + hq * 128 + c16_); pk[i_] = *(const u32x4*)(QK + row_ * 4096 + 2048 + hq * 128 + c16_); pv[i_] = *(const u32x4*)(VP + row_ * 4096 + h * 128 + c16_); } \
            if (tid < 64) { const int st_ = (c) * 64 + tid, pos_ = dir ? SEQ - 1 - st_ : st_; const size_t row_ = (size_t)seq * SEQ + pos_; pg = GB[row_ * 128 + dir * 64 + h]; pb = GB[row_ * 128 + dir * 64 + 32 + h]; } } while (0)
#define GDN_DPPADD(ctrl_, rm_) { const int t_ = __builtin_amdgcn_update_dpp(0, xi_, ctrl_, rm_, 0xf, false); xi_ = __float_as_int(__int_as_float(xi_) + __int_as_float(t_)); }
#define GDN_STORE(P_) do { LAS unsigned char* const lx_ = lds + (P_) * SET1; LAS float* const gx_ = (LAS float*)(lds + ((P_) ? TB1 : TB)); _Pragma("unroll") for (int i_ = 0; i_ < 2; ++i_) { const int p_ = tid + 512 * i_, ir_ = p_ >> 4, c16_ = (p_ & 15) * 8; \
            *(LAS u32x4*)(lx_ + QS + ir_ * QPITCH + c16_ * 2) = pq[i_]; *(LAS u32x4*)(lx_ + KS + ir_ * QPITCH + c16_ * 2) = pk[i_]; *(LAS u32x4*)(lx_ + VS + ir_ * QPITCH + c16_ * 2) = pv[i_]; \
            } \
            if (tid < 64) { int xi_ = __float_as_int(pg);     \
                GDN_DPPADD(0x111, 0xf) GDN_DPPADD(0x112, 0xf) GDN_DPPADD(0x114, 0xf) GDN_DPPADD(0x118, 0xf) GDN_DPPADD(0x142, 0xa) GDN_DPPADD(0x143, 0xc) \
                const float gs_ = __int_as_float(xi_), gl_ = __int_as_float(__builtin_amdgcn_readlane(xi_, 63)), e_ = __expf(gs_); gx_[tid] = gs_; gx_[64 + tid] = e_; gx_[128 + tid] = pb * e_; gx_[192 + tid] = pb; gx_[256 + tid] = __expf(gl_ - gs_); } } while (0)
        GDN_LOADG(0);
        __syncthreads();
        GDN_STORE(0);
        for (int i_ = tid; i_ < 64 * MPITCH / 16; i_ += NTHR) *(LAS u32x4*)(lds + A2 + i_ * 16) = (u32x4){0u, 0u, 0u, 0u};
        __syncthreads();
        for (int c = 0; c < 64; ++c) {
            LAS unsigned char* const ldc = lds + (c & 1) * SET1;
            LAS float* const gam = (LAS float*)(lds + ((c & 1) ? TB1 : TB)); LAS float* const eg = gam + 64; LAS float* const bg = gam + 128; LAS float* const bt = gam + 192; LAS float* const dl = gam + 256;
            { GDN_FRESH()
              if (w < 4) {
                  const f32x4 gi4 = *(const LAS f32x4*)(gam + 16 * w + 4 * g), bti4 = *(const LAS f32x4*)(bt + 16 * w + 4 * g);
                  const float gj = gam[16 * w + n];
                  f32x4 a1 = (f32x4){0.f, 0.f, 0.f, 0.f};
#pragma unroll
                  for (int ks = 0; ks < 4; ++ks) {
                      const s16x8 ak = *(const LAS s16x8*)(ldc + KS + (16 * w + n) * QPITCH + (32 * ks + 8 * g) * 2);
                      a1 = __builtin_amdgcn_mfma_f32_16x16x32_bf16(ak, ak, a1, 0, 0, 0); }
#pragma unroll
                  for (int e = 0; e < 4; ++e) { const float d = __expf(fminf(gi4[e] - gj, 0.f));
                      *(LAS float*)(lds + MD + ((w * 16 + 4 * g + e) * MDP + n) * 4) = (n < 4 * g + e) ? a1[e] * d * bti4[e] : 0.f; }
              } else {
#pragma unroll
                for (int t = 0; t < 2; ++t) if (t == 0 || w == 4 || w == 5) {
                  const int rb = t == 0 ? (w == 4 ? 1 : (w == 5 ? 2 : 3)) : (w == 4 ? 2 : 3);
                  const int cb = t == 0 ? (w == 4 ? 0 : (w == 7 ? 2 : 1)) : 0;
                  const f32x4 gi4 = *(const LAS f32x4*)(gam + 16 * rb + 4 * g), bti4 = *(const LAS f32x4*)(bt + 16 * rb + 4 * g);
                  const float gj = gam[16 * cb + n];
                  f32x4 a1 = (f32x4){0.f, 0.f, 0.f, 0.f}, a2 = a1;
#pragma unroll
                  for (int ks = 0; ks < 4; ++ks) {
                      const s16x8 ak = *(const LAS s16x8*)(ldc + KS + (16 * rb + n) * QPITCH + (32 * ks + 8 * g) * 2);
                      const s16x8 aq = *(const LAS s16x8*)(ldc + QS + (16 * rb + n) * QPITCH + (32 * ks + 8 * g) * 2);
                      const s16x8 bk = *(const LAS s16x8*)(ldc + KS + (16 * cb + n) * QPITCH + (32 * ks + 8 * g) * 2);
                      a1 = __builtin_amdgcn_mfma_f32_16x16x32_bf16(ak, bk, a1, 0, 0, 0);
                      a2 = __builtin_amdgcn_mfma_f32_16x16x32_bf16(aq, bk, a2, 0, 0, 0); }
                  const int j = 16 * cb + n;
#pragma unroll
                  for (int e = 0; e < 4; ++e) { const int i = 16 * rb + 4 * g + e; const float d = __expf(fminf(gi4[e] - gj, 0.f));
                      *(LAS bf16_t*)(lds + A2 + i * MPITCH + j * 2) = f2bf(a2[e] * d);
                      *(LAS bf16_t*)(lds + MB + i * MPITCH + j * 2) = f2bf(a1[e] * d * bti4[e]); } }
                if (w >= 6) {
#pragma unroll
                  for (int t = 0; t < 2; ++t) { const int rb = 2 * (w - 6) + t;
                      const f32x4 gi4 = *(const LAS f32x4*)(gam + 16 * rb + 4 * g); const float gj = gam[16 * rb + n];
                      f32x4 a2 = (f32x4){0.f, 0.f, 0.f, 0.f};
#pragma unroll
                      for (int ks = 0; ks < 4; ++ks) {
                          const s16x8 aq = *(const LAS s16x8*)(ldc + QS + (16 * rb + n) * QPITCH + (32 * ks + 8 * g) * 2);
                          const s16x8 bk = *(const LAS s16x8*)(ldc + KS + (16 * rb + n) * QPITCH + (32 * ks + 8 * g) * 2);
                          a2 = __builtin_amdgcn_mfma_f32_16x16x32_bf16(aq, bk, a2, 0, 0, 0); }
#pragma unroll
                      for (int e = 0; e < 4; ++e) { const int i = 16 * rb + 4 * g + e; const float d = __expf(fminf(gi4[e] - gj, 0.f));
                          *(LAS bf16_t*)(lds + A2 + i * MPITCH + (16 * rb + n) * 2) = f2bf((n <= 4 * g + e) ? a2[e] * d : 0.f); } } } } }
            if (w < 4) { GDN_FRESH() const LAS float* N = (const LAS float*)(lds + MD + w * 16 * MDP * 4);
                f32x4 Nr[16][4];
#pragma unroll
                for (int i = 1; i < 16; ++i)
#pragma unroll
                    for (int q = 0; q < 4; ++q) if (4 * q < i) Nr[i][q] = *(const LAS f32x4*)(N + i * MDP + 4 * q);
                f32x4 s4[4];
#pragma unroll
                for (int q = 0; q < 4; ++q) s4[q] = (f32x4){(4 * q + 0 == n) ? 1.f : 0.f, (4 * q + 1 == n) ? 1.f : 0.f, (4 * q + 2 == n) ? 1.f : 0.f, (4 * q + 3 == n) ? 1.f : 0.f};
#pragma unroll
                for (int i = 15; i >= 1; --i) { const float yi = -s4[i >> 2][i & 3]; const f32x4 yv = (f32x4){yi, yi, yi, yi};
#pragma unroll
                    for (int q = 0; q < 4; ++q) if (4 * q < i) s4[q] = __builtin_elementwise_fma(yv, Nr[i][q], s4[q]); }
                float y[16];
#pragma unroll
                for (int j = 0; j < 16; ++j) y[j] = s4[j >> 2][j & 3];
                if (g == 0) { u32x4 d0, d1; d0.x = pk2(y[0], y[1]); d0.y = pk2(y[2], y[3]); d0.z = pk2(y[4], y[5]); d0.w = pk2(y[6], y[7]); d1.x = pk2(y[8], y[9]); d1.y = pk2(y[10], y[11]); d1.z = pk2(y[12], y[13]); d1.w = pk2(y[14], y[15]);
                    *(LAS u32x4*)(lds + DV + (w * 16 + n) * DVPITCH) = d0; *(LAS u32x4*)(lds + DV + (w * 16 + n) * DVPITCH + 16) = d1; } }
            __syncthreads();
            f32x4 xw[4], u[4];
            { GDN_FRESH()
            u32x2 rk[4], rv[4];
            { const unsigned ad = (unsigned)(size_t)ldc + (unsigned)((4 * g + (n >> 2)) * QPITCH + (16 * w + 4 * (n & 3)) * 2);
              asm volatile("ds_read_b64_tr_b16 %0, %8 offset:%9\n\tds_read_b64_tr_b16 %1, %8 offset:%10\n\tds_read_b64_tr_b16 %2, %8 offset:%11\n\tds_read_b64_tr_b16 %3, %8 offset:%12\n\t"
                           "ds_read_b64_tr_b16 %4, %8 offset:%13\n\tds_read_b64_tr_b16 %5, %8 offset:%14\n\tds_read_b64_tr_b16 %6, %8 offset:%15\n\tds_read_b64_tr_b16 %7, %8 offset:%16\n\ts_waitcnt lgkmcnt(0)"
                           : "=&v"(rk[0]), "=&v"(rk[1]), "=&v"(rk[2]), "=&v"(rk[3]), "=&v"(rv[0]), "=&v"(rv[1]), "=&v"(rv[2]), "=&v"(rv[3])
                           : "v"(ad), "n"(KS), "n"(KS + 16 * QPITCH), "n"(KS + 32 * QPITCH), "n"(KS + 48 * QPITCH), "n"(VS), "n"(VS + 16 * QPITCH), "n"(VS + 32 * QPITCH), "n"(VS + 48 * QPITCH) : "memory"); }
            f32x4 bgv[4], btv[4]; s16x4 amv[4][3], adv[4];
#pragma unroll
            for (int b = 0; b < 4; ++b) { bgv[b] = *(const LAS f32x4*)(bg + 16 * b + 4 * g); btv[b] = *(const LAS f32x4*)(bt + 16 * b + 4 * g);
                adv[b] = *(const LAS s16x4*)(lds + DV + (b * 16 + n) * DVPITCH + 4 * g * 2);
#pragma unroll
                for (int j = 0; j < 3; ++j) if (j < b) amv[b][j] = *(const LAS s16x4*)(lds + MB + (16 * b + n) * MPITCH + (16 * j + 4 * g) * 2); }
#pragma unroll
            for (int b = 0; b < 4; ++b) {
                f32x4 aw, au;
                { const f32x4 bg4 = bgv[b], bt4 = btv[b];
                  aw[0] = blo(rk[b].x) * bg4[0]; aw[1] = bhi(rk[b].x) * bg4[1]; aw[2] = blo(rk[b].y) * bg4[2]; aw[3] = bhi(rk[b].y) * bg4[3];
                  au[0] = blo(rv[b].x) * bt4[0]; au[1] = bhi(rv[b].x) * bt4[1]; au[2] = blo(rv[b].y) * bt4[2]; au[3] = bhi(rv[b].y) * bt4[3]; }
#pragma unroll
                for (int j = 0; j < 4; ++j) if (j < b) {
                    const s16x4 am = amv[b][j < 3 ? j : 0];
                    const s16x4 bw = mk4(pk2(xw[j][0], xw[j][1]) ^ 0x80008000u, pk2(xw[j][2], xw[j][3]) ^ 0x80008000u);
                    const s16x4 bu = mk4(pk2(u[j][0], u[j][1]) ^ 0x80008000u, pk2(u[j][2], u[j][3]) ^ 0x80008000u);
                    aw = __builtin_amdgcn_mfma_f32_16x16x16bf16_1k(am, bw, aw, 0, 0, 0);
                    au = __builtin_amdgcn_mfma_f32_16x16x16bf16_1k(am, bu, au, 0, 0, 0); }
                const s16x4 ad = adv[b];
                xw[b] = __builtin_amdgcn_mfma_f32_16x16x16bf16_1k(ad, mk4(pk2(aw[0], aw[1]), pk2(aw[2], aw[3])), (f32x4){0.f, 0.f, 0.f, 0.f}, 0, 0, 0);
                u[b]  = __builtin_amdgcn_mfma_f32_16x16x16bf16_1k(ad, mk4(pk2(au[0], au[1]), pk2(au[2], au[3])), (f32x4){0.f, 0.f, 0.f, 0.f}, 0, 0, 0);
#pragma unroll
                for (int e = 0; e < 4; ++e) *(LAS bf16_t*)(lds + WS_ + (16 * b + 4 * g + e) * QPITCH + (16 * w + n) * 2) = f2bf(-xw[b][e]);
                __builtin_amdgcn_sched_barrier(0);
            } }
            __syncthreads();
            if (c + 1 < 64) GDN_LOADG(c + 1);
            s16x8 Sb[4];
#pragma unroll
            for (int ks = 0; ks < 4; ++ks) Sb[ks] = mk8(pk2(S[2 * ks][0], S[2 * ks][1]), pk2(S[2 * ks][2], S[2 * ks][3]), pk2(S[2 * ks + 1][0], S[2 * ks + 1][1]), pk2(S[2 * ks + 1][2], S[2 * ks + 1][3]));
            { GDN_FRESH()
            s16x8 fw[2][4];
#define GDN_LDW(buf_, rb_) do { _Pragma("unroll") for (int ks_ = 0; ks_ < 4; ++ks_) { const LAS unsigned char* wp_ = lds + WS_ + (16 * (rb_) + n) * QPITCH + (32 * ks_ + 4 * g) * 2; \
                fw[buf_][ks_] = cat8(*(const LAS u32x2*)wp_, *(const LAS u32x2*)(wp_ + 32)); } } while (0)
            GDN_LDW(0, 0);
#pragma unroll
            for (int rb = 0; rb < 4; ++rb) {
                if (rb + 1 < 4) GDN_LDW((rb + 1) & 1, rb + 1);
                __builtin_amdgcn_sched_barrier(0);
#pragma unroll
                for (int ks = 0; ks < 4; ++ks) u[rb] = __builtin_amdgcn_mfma_f32_16x16x32_bf16(fw[rb & 1][ks], Sb[ks], u[rb], 0, 0, 0);
                __builtin_amdgcn_sched_barrier(0); }
#undef GDN_LDW
            }
            s16x8 Ub[2], Ud[2];
            { GDN_FRESH()
#pragma unroll
            for (int ks = 0; ks < 2; ++ks) {
                Ub[ks] = mk8(pk2(u[2 * ks][0], u[2 * ks][1]), pk2(u[2 * ks][2], u[2 * ks][3]), pk2(u[2 * ks + 1][0], u[2 * ks + 1][1]), pk2(u[2 * ks + 1][2], u[2 * ks + 1][3]));
                const f32x4 d0 = *(const LAS f32x4*)(dl + 32 * ks + 4 * g), d1 = *(const LAS f32x4*)(dl + 32 * ks + 16 + 4 * g);
                Ud[ks] = mk8(pk2(u[2 * ks][0] * d0[0], u[2 * ks][1] * d0[1]), pk2(u[2 * ks][2] * d0[2], u[2 * ks][3] * d0[3]),
                             pk2(u[2 * ks + 1][0] * d1[0], u[2 * ks + 1][1] * d1[1]), pk2(u[2 * ks + 1][2] * d1[2], u[2 * ks + 1][3] * d1[3])); } }
            { GDN_FRESH()
            s16x8 fo[2][6]; f32x4 ego[2];
#define GDN_LDO(buf_, rb_) do { _Pragma("unroll") for (int ks_ = 0; ks_ < 4; ++ks_) { const LAS unsigned char* qp_ = ldc + QS + (16 * (rb_) + n) * QPITCH + (32 * ks_ + 4 * g) * 2; \
                fo[buf_][ks_] = cat8(*(const LAS u32x2*)qp_, *(const LAS u32x2*)(qp_ + 32)); } \
              _Pragma("unroll") for (int ks_ = 0; ks_ < 2; ++ks_) { const LAS unsigned char* ap_ = lds + A2 + (16 * (rb_) + n) * MPITCH + (32 * ks_ + 4 * g) * 2; \
                fo[buf_][4 + ks_] = cat8(*(const LAS u32x2*)ap_, *(const LAS u32x2*)(ap_ + 32)); } \
              ego[buf_] = *(const LAS f32x4*)(eg + 16 * (rb_) + 4 * g); } while (0)
            GDN_LDO(0, 0);
#pragma unroll
            for (int rb = 0; rb < 4; ++rb) { f32x4 oa = (f32x4){0.f, 0.f, 0.f, 0.f}, o2 = oa;
                if (rb + 1 < 4) GDN_LDO((rb + 1) & 1, rb + 1);
                __builtin_amdgcn_sched_barrier(0);
#pragma unroll
                for (int ks = 0; ks < 4; ++ks) o2 = __builtin_amdgcn_mfma_f32_16x16x32_bf16(fo[rb & 1][ks], Sb[ks], o2, 0, 0, 0);
#pragma unroll
                for (int ks = 0; ks < 2; ++ks) oa = __builtin_amdgcn_mfma_f32_16x16x32_bf16(fo[rb & 1][4 + ks], Ub[ks], oa, 0, 0, 0);
                { const f32x4 eg4 = ego[rb & 1];
#pragma unroll
                  for (int e = 0; e < 4; ++e) *(LAS bf16_t*)(ldc + VS + (16 * rb + 4 * g + e) * QPITCH + (16 * w + n) * 2) = f2bf(eg4[e] * o2[e] + oa[e]); }
                __builtin_amdgcn_sched_barrier(0); }
#undef GDN_LDO
            }
            if (c + 1 < 64) GDN_STORE((c + 1) & 1);
            { GDN_FRESH() const float egl = eg[63];
              const unsigned adk = (unsigned)(size_t)ldc + (unsigned)((4 * g + (n >> 2)) * QPITCH + (4 * (n & 3)) * 2);
#pragma unroll
              for (int hf = 0; hf < 2; ++hf) {
                  u32x2 r[16];
                  const unsigned ah = adk + (unsigned)(hf * 128);
                  const unsigned a0_ = ah, a1_ = ah + 32u, a2_ = ah + 64u, a3_ = ah + 96u;
                  asm volatile("ds_read_b64_tr_b16 %0, %16 offset:%20\n\tds_read_b64_tr_b16 %1, %16 offset:%21\n\tds_read_b64_tr_b16 %2, %16 offset:%22\n\tds_read_b64_tr_b16 %3, %16 offset:%23\n\t"
                               "ds_read_b64_tr_b16 %4, %17 offset:%20\n\tds_read_b64_tr_b16 %5, %17 offset:%21\n\tds_read_b64_tr_b16 %6, %17 offset:%22\n\tds_read_b64_tr_b16 %7, %17 offset:%23\n\t"
                               "ds_read_b64_tr_b16 %8, %18 offset:%20\n\tds_read_b64_tr_b16 %9, %18 offset:%21\n\tds_read_b64_tr_b16 %10, %18 offset:%22\n\tds_read_b64_tr_b16 %11, %18 offset:%23\n\t"
                               "ds_read_b64_tr_b16 %12, %19 offset:%20\n\tds_read_b64_tr_b16 %13, %19 offset:%21\n\tds_read_b64_tr_b16 %14, %19 offset:%22\n\tds_read_b64_tr_b16 %15, %19 offset:%23\n\ts_waitcnt lgkmcnt(0)"
                               : "=&v"(r[0]), "=&v"(r[1]), "=&v"(r[2]), "=&v"(r[3]), "=&v"(r[4]), "=&v"(r[5]), "=&v"(r[6]), "=&v"(r[7]),
                                 "=&v"(r[8]), "=&v"(r[9]), "=&v"(r[10]), "=&v"(r[11]), "=&v"(r[12]), "=&v"(r[13]), "=&v"(r[14]), "=&v"(r[15])
                               : "v"(a0_), "v"(a1_), "v"(a2_), "v"(a3_), "n"(KS), "n"(KS + 16 * QPITCH), "n"(KS + 32 * QPITCH), "n"(KS + 48 * QPITCH) : "memory");
#pragma unroll
                  for (int q = 0; q < 4; ++q) { const int sb = 4 * hf + q; f32x4 acc = S[sb] * egl;
                      acc = __builtin_amdgcn_mfma_f32_16x16x32_bf16(cat8(r[4 * q + 0], r[4 * q + 1]), Ud[0], acc, 0, 0, 0);
                      acc = __builtin_amdgcn_mfma_f32_16x16x32_bf16(cat8(r[4 * q + 2], r[4 * q + 3]), Ud[1], acc, 0, 0, 0);
                      S[sb] = acc; }
                  __builtin_amdgcn_sched_barrier(0); }
            }
            __syncthreads();
#pragma unroll
            for (int i_ = 0; i_ < 2; ++i_) { const int p_ = tid + 512 * i_, ir_ = p_ >> 4, c16_ = (p_ & 15) * 8, st_ = c * 64 + ir_, pos_ = dir ? SEQ - 1 - st_ : st_;
                *(u32x4*)(OD + ((size_t)seq * SEQ + pos_) * 4096 + h * 128 + c16_) = *(const LAS u32x4*)(ldc + VS + ir_ * QPITCH + c16_ * 2); }
        }
#undef GDN_LOADG
#undef GDN_STORE
#undef GDN_DPPADD
#undef GDN_FRESH
    }
}
}

namespace na {
typedef short s16x8 __attribute__((ext_vector_type(8)));
constexpr int VPITCH = 272;
constexpr int VRING = 0, RPB = 512 * VPITCH;
constexpr int RPITCH = 64, XCH = RPB + 15 * RPITCH * 4;
constexpr int XW = 2560, LDS_END = XCH + 8 * XW;
static_assert(LDS_END <= LDS_BAR, "na lds");
__device__ __forceinline__ s16x8 mk8(unsigned a, unsigned b, unsigned c, unsigned d) { u32x4 v; v.x = a; v.y = b; v.z = c; v.w = d; return __builtin_bit_cast(s16x8, v); }

__device__ __forceinline__ void attention(ArgsCP a, LAS unsigned char* lds, const bf16_t* QKV, bf16_t* AO) {
    const int tid = tidx(), w = __builtin_amdgcn_readfirstlane(tid >> 6), lane = tid & 63, g = lane >> 4, n = lane & 15;
    const int j = w & 3, hh = w >> 2;
    const int c0 = min(max(16 * j - 8, 0), 32), qcol = 16 * j + n, cs = min(max(qcol - 8, 0), 48);
    LAS float* rpbs = (LAS float*)(lds + RPB);
    const int nitems = NSEQ * 16 * 64, G = gridDim.x;
    const int per = (nitems + G - 1) / G, it0 = blockIdx.x * per, it1 = min(nitems, it0 + per);
    int cur_sh = -1, have_lo = 0, have_hi = 0;
    const unsigned vbase = (unsigned)(size_t)(lds + VRING);
    for (int it = it0; it < it1; ++it) {
        const int sh = it >> 6, r = it & 63, seq = sh >> 4, h = sh & 15, r0 = min(max(r - 4, 0), 56);
        const size_t tbase = (size_t)seq * SEQ;
        s16x8 qf[4];
        const unsigned loff = (unsigned)((n * 6144 + 8 * g) * 2);
        { const unsigned char* qb = (const unsigned char*)(QKV + (tbase + r * 64 + 16 * j) * 6144 + h * 128);
#pragma unroll
          for (int ks = 0; ks < 4; ++ks) qf[ks] = *(const s16x8*)(qb + loff + 64 * ks); }
        f32x4 sacc[8];
        const unsigned char* kb0 = (const unsigned char*)(QKV + (tbase + (r0 + 4 * hh) * 64 + c0) * 6144 + 2048 + h * 128);
        s16x8 kfa[4][4], kfb[4][4];
#define NA_LOADK(buf, grp) do { _Pragma("unroll") for (int b_ = 0; b_ < 4; ++b_) { const int kb_ = 4 * (grp) + b_; const unsigned char* kp_ = kb0 + (size_t)((kb_ >> 1) * 64 + (kb_ & 1) * 16) * 6144 * 2; \
            _Pragma("unroll") for (int ks_ = 0; ks_ < 4; ++ks_) buf[b_][ks_] = *(const s16x8*)(kp_ + loff + 64 * ks_); } } while (0)
#define NA_MMAK(buf, grp) do { _Pragma("unroll") for (int b_ = 0; b_ < 4; ++b_) { f32x4 acc_ = (f32x4){0.f, 0.f, 0.f, 0.f}; \
            _Pragma("unroll") for (int ks_ = 0; ks_ < 4; ++ks_) acc_ = __builtin_amdgcn_mfma_f32_16x16x32_bf16(buf[b_][ks_], qf[ks_], acc_, 0, 0, 0); sacc[4 * (grp) + b_] = acc_; } } while (0)
        NA_LOADK(kfa, 0); asm volatile("" ::: "memory");
        NA_LOADK(kfb, 1); asm volatile("" ::: "memory");
        int lo = r0; const int hi = r0 + 8; const bool fresh = (sh != cur_sh);
        if (!fresh && have_hi > lo && have_lo <= lo) lo = have_hi;
        const bool defer = (hi - lo == 1);
        u32x4 vpre[2];
        if (defer) {
#pragma unroll
            for (int i = 0; i < 2; ++i) { const int p = tid + 512 * i, col = p >> 4, c16 = (p & 15) * 8; vpre[i] = *(const u32x4*)(QKV + (tbase + lo * 64 + col) * 6144 + 4096 + h * 128 + c16); } }
        if (fresh) { cur_sh = sh; for (int i = tid; i < 15 * 31; i += NTHR) { const int dr_ = i / 31, dc_ = i - dr_ * 31; rpbs[dr_ * RPITCH + 16 + dc_] = a->in[10][h * 465 + i]; } }
        if (!defer) {
          for (int kr = lo; kr < hi; ++kr) {
#pragma unroll
              for (int i = 0; i < 2; ++i) { const int p = tid + 512 * i, col = p >> 4, c16 = (p & 15) * 8;
                  const u32x4 v = *(const u32x4*)(QKV + (tbase + kr * 64 + col) * 6144 + 4096 + h * 128 + c16);
                  *(LAS u32x4*)(lds + VRING + ((kr & 7) * 64 + col) * VPITCH + c16 * 2) = v; } } }
        have_lo = r0; have_hi = r0 + 8;
        NA_MMAK(kfa, 0);
        NA_MMAK(kfb, 1);
#undef NA_LOADK
#undef NA_MMAK
        if (defer) {
#pragma unroll
            for (int i = 0; i < 2; ++i) { const int p = tid + 512 * i, col = p >> 4, c16 = (p & 15) * 8; *(LAS u32x4*)(lds + VRING + ((lo & 7) * 64 + col) * VPITCH + c16 * 2) = vpre[i]; } }
        __syncthreads();
        float mx = -1e30f;
        const LAS float* rbl = rpbs + (r0 + 4 * hh - r + 7) * RPITCH + (c0 - qcol + 31 + 4 * g);
        float bias[8][4];
#pragma unroll
        for (int kb = 0; kb < 8; ++kb)
#pragma unroll
            for (int e = 0; e < 4; ++e) bias[kb][e] = rbl[(kb >> 1) * RPITCH + 16 * (kb & 1) + e];
#pragma unroll
        for (int kb = 0; kb < 8; ++kb) {
#pragma unroll
            for (int e = 0; e < 4; ++e) { const int kc = c0 + 16 * (kb & 1) + 4 * g + e; const bool valid = (kc >= cs) && (kc < cs + 16);
                const float s = valid ? sacc[kb][e] + bias[kb][e] : -1e30f; sacc[kb][e] = s; mx = fmaxf(mx, s); } }
        mx = fmaxf(mx, __shfl_xor(mx, 16)); mx = fmaxf(mx, __shfl_xor(mx, 32));
        float sum = 0.f;
#pragma unroll
        for (int kb = 0; kb < 8; ++kb)
#pragma unroll
            for (int e = 0; e < 4; ++e) { const float p = __expf(sacc[kb][e] - mx); sacc[kb][e] = p; sum += p; }
        sum += __shfl_xor(sum, 16); sum += __shfl_xor(sum, 32);
        s16x8 pb[4];
#pragma unroll
        for (int kp = 0; kp < 4; ++kp) pb[kp] = mk8(pk2(sacc[2 * kp][0], sacc[2 * kp][1]), pk2(sacc[2 * kp][2], sacc[2 * kp][3]), pk2(sacc[2 * kp + 1][0], sacc[2 * kp + 1][1]), pk2(sacc[2 * kp + 1][2], sacc[2 * kp + 1][3]));
        f32x4 oacc[8];
        unsigned adl[4], adh[4];
#pragma unroll
        for (int kp = 0; kp < 4; ++kp) { const unsigned a_ = vbase + (unsigned)((((r0 + 4 * hh + kp) & 7) * 64 + c0) * VPITCH) + (unsigned)((4 * g + (n >> 2)) * VPITCH + (4 * (n & 3)) * 2);
            adl[kp] = a_ + (unsigned)(128 * hh); adh[kp] = a_ - 128u + (unsigned)(128 * (1 - hh)); }
#define NA_PV(i_, A_) do { u32x2 vt[8]; \
            asm volatile("ds_read_b64_tr_b16 %0, %8 offset:%12\n\tds_read_b64_tr_b16 %1, %8 offset:%13\n\tds_read_b64_tr_b16 %2, %9 offset:%12\n\tds_read_b64_tr_b16 %3, %9 offset:%13\n\t" \
                         "ds_read_b64_tr_b16 %4, %10 offset:%12\n\tds_read_b64_tr_b16 %5, %10 offset:%13\n\tds_read_b64_tr_b16 %6, %11 offset:%12\n\tds_read_b64_tr_b16 %7, %11 offset:%13\n\t" \
                         "s_waitcnt lgkmcnt(0)" \
                         : "=&v"(vt[0]), "=&v"(vt[1]), "=&v"(vt[2]), "=&v"(vt[3]), "=&v"(vt[4]), "=&v"(vt[5]), "=&v"(vt[6]), "=&v"(vt[7]) \
                         : "v"(A_[0]), "v"(A_[1]), "v"(A_[2]), "v"(A_[3]), "n"(32 * (i_)), "n"(16 * VPITCH + 32 * (i_)) : "memory"); \
            f32x4 oa = (f32x4){0.f, 0.f, 0.f, 0.f}; \
            _Pragma("unroll") for (int kp = 0; kp < 4; ++kp) oa = __builtin_amdgcn_mfma_f32_16x16x32_bf16(mk8(vt[2 * kp].x, vt[2 * kp].y, vt[2 * kp + 1].x, vt[2 * kp + 1].y), pb[kp], oa, 0, 0, 0); \
            oacc[i_] = oa; } while (0)
        NA_PV(0, adl); NA_PV(1, adl); NA_PV(2, adl); NA_PV(3, adl); NA_PV(4, adh); NA_PV(5, adh); NA_PV(6, adh); NA_PV(7, adh);
#undef NA_PV
        { LAS unsigned char* xo = lds + XCH + (w ^ 4) * XW;
          u32x4 s0, s1;
          { const f32x4 a0 = oacc[4], a1 = oacc[5], a2 = oacc[6], a3 = oacc[7];
            s0.x = pk2(a0[0], a0[1]); s0.y = pk2(a0[2], a0[3]); s0.z = pk2(a1[0], a1[1]); s0.w = pk2(a1[2], a1[3]);
            s1.x = pk2(a2[0], a2[1]); s1.y = pk2(a2[2], a2[3]); s1.z = pk2(a3[0], a3[1]); s1.w = pk2(a3[2], a3[3]); }
          *(LAS u32x4*)(xo + lane * 16) = s0; *(LAS u32x4*)(xo + 1024 + lane * 16) = s1;
          u32x2 ml; ml.x = __float_as_uint(mx); ml.y = __float_as_uint(sum); *(LAS u32x2*)(xo + 2048 + lane * 8) = ml; }
        __syncthreads();
        { const LAS unsigned char* xi = lds + XCH + w * XW;
          const u32x4 t0 = *(const LAS u32x4*)(xi + lane * 16), t1 = *(const LAS u32x4*)(xi + 1024 + lane * 16); const u32x2 ml = *(const LAS u32x2*)(xi + 2048 + lane * 8);
          const float mo = __uint_as_float(ml.x), lo_ = __uint_as_float(ml.y), mm = fmaxf(mx, mo), f0 = __expf(mx - mm), f1 = __expf(mo - mm), inv = 1.0f / (sum * f0 + lo_ * f1);
          const float w0 = f0 * inv, w1 = f1 * inv;
          const unsigned tw[8] = {t0.x, t0.y, t0.z, t0.w, t1.x, t1.y, t1.z, t1.w};
#pragma unroll
          for (int ci = 0; ci < 4; ++ci) { const f32x4 own = oacc[ci];
              u32x2 ov; ov.x = pk2(own[0] * w0 + blo(tw[2 * ci]) * w1, own[1] * w0 + bhi(tw[2 * ci]) * w1); ov.y = pk2(own[2] * w0 + blo(tw[2 * ci + 1]) * w1, own[3] * w0 + bhi(tw[2 * ci + 1]) * w1);
              *(u32x2*)(AO + (tbase + r * 64 + qcol) * D + h * 128 + 16 * (4 * hh + ci) + 4 * g) = ov; } }
    }
}
}

namespace s5 {
typedef short s16x8 __attribute__((ext_vector_type(8)));
typedef short s16x4 __attribute__((ext_vector_type(4)));
constexpr int XPITCH = 40, CF_OFF = 128 * XPITCH, WAVE_LDS = CF_OFF + 4096;
__device__ __forceinline__ float row_from_above16(float x) { auto s = __builtin_amdgcn_permlane16_swap(__float_as_uint(x), __float_as_uint(x), false, false); return __uint_as_float(s[1]); }
__device__ __forceinline__ float row_from_below16(float x) { auto s = __builtin_amdgcn_permlane16_swap(__float_as_uint(x), __float_as_uint(x), false, false); return __uint_as_float(s[0]); }
__device__ __forceinline__ float half_lo(float x) { auto s = __builtin_amdgcn_permlane32_swap(__float_as_uint(x), __float_as_uint(x), false, false); return __uint_as_float(s[0]); }
__device__ __forceinline__ float half_hi(float x) { auto s = __builtin_amdgcn_permlane32_swap(__float_as_uint(x), __float_as_uint(x), false, false); return __uint_as_float(s[1]); }
typedef float f32x2 __attribute__((ext_vector_type(2)));
__device__ __forceinline__ f32x2 cfma(f32x2 a, f32x2 z, f32x2 b) { const f32x2 t = __builtin_elementwise_fma((f32x2){a.x, a.x}, z, b); return __builtin_elementwise_fma((f32x2){-a.y, a.y}, (f32x2){z.y, z.x}, t); }
__device__ __forceinline__ void cpow(float are_dt, float aim_dt, float k, float& pr, float& pi) { const float e = expf(are_dt * k); float s, c; sincosf(aim_dt * k, &s, &c); pr = e * c; pi = e * s; }

template <int DIR> __device__ __forceinline__ void pass(ArgsCP a, LAS unsigned char* xl, const unsigned xbase, const int lane, const int g, const int n, const int task, const bool quarter, const int k,
                                                   const int b0, const int b1, const bool st_in, const bool st_out, const float* gmix, const bf16_t* X, const rs_t* rs, float* YF, bf16_t* Y,
                                                   LAS float* hand, volatile LAS int* flags) {
        asm volatile("s_waitcnt vmcnt(0)" ::: "memory");
        constexpr int dir = DIR; const int seq = task >> 7, gr = task & 127;
        const int tg4 = 4 * ((g == 0) ? 1 : (g == 1) ? 0 : g);
        const int sn = 4 * (((n >> 2) == 0) ? 1 : ((n >> 2) == 1) ? 0 : (n >> 2)) + (n & 3);
        const f32x4 gm4 = *(const f32x4*)(gmix + gr * 16 + 4 * g);
        const float dsk = a->in[29][gr * 16 + n];
        const int dg = dir * 128 + gr;
        const float dt = expf(a->in[24][dg]);
        float a1r[4], a1i[4], a4r[4], a4i[4];
        s16x4 bfr[8];
#pragma unroll
        for (int pb = 0; pb < 4; ++pb) { const int p = 16 * pb + n;
            const float are = a->in[22][dg * 64 + p], aim = a->in[23][dg * 64 + p], ad = are * dt, ai = aim * dt;
            cpow(ad, ai, 1.f, a1r[pb], a1i[pb]); cpow(ad, ai, 4.f, a4r[pb], a4i[pb]);
            const float den = 1.0f / (are * are + aim * aim);
            const float cr = ((a1r[pb] - 1.0f) * are + a1i[pb] * aim) * den, ci = (a1i[pb] * are - (a1r[pb] - 1.0f) * aim) * den;
            const f32x4 bre = *(const f32x4*)(a->in[25] + ((size_t)dg * 64 + p) * 16 + 4 * g), bim = *(const f32x4*)(a->in[26] + ((size_t)dg * 64 + p) * 16 + 4 * g);
            float br[4], bi[4];
#pragma unroll
            for (int e = 0; e < 4; ++e) { br[e] = cr * bre[e] - ci * bim[e]; bi[e] = cr * bim[e] + ci * bre[e]; }
            u32x2 t0; t0.x = pk2(br[0], br[1]); t0.y = pk2(br[2], br[3]); bfr[pb] = __builtin_bit_cast(s16x4, t0);
            u32x2 t1; t1.x = pk2(bi[0], bi[1]); t1.y = pk2(bi[2], bi[3]); bfr[4 + pb] = __builtin_bit_cast(s16x4, t1); }
#pragma unroll
        for (int ks = 0; ks < 4; ++ks) { const int p0 = 32 * ks + 8 * g; const bool im = p0 >= 64;
            const float* src = (im ? a->in[28] : a->in[27]) + ((size_t)dg * 16 + n) * 64 + (p0 & 63);
            const f32x4 c0 = *(const f32x4*)src, c1 = *(const f32x4*)(src + 4); const float sg = im ? -1.f : 1.f;
            u32x4 t; t.x = pk2(c0[0] * sg, c0[1] * sg); t.y = pk2(c0[2] * sg, c0[3] * sg); t.z = pk2(c1[0] * sg, c1[1] * sg); t.w = pk2(c1[2] * sg, c1[3] * sg);
            *(LAS u32x4*)(xl + CF_OFF + (ks * 64 + lane) * 16) = t; }
        float xpr[4], xpi[4];
#pragma unroll
        for (int pb = 0; pb < 4; ++pb) { xpr[pb] = st_in ? hand[lane * 8 + pb] : 0.f; xpi[pb] = st_in ? hand[lane * 8 + 4 + pb] : 0.f; }
        s16x4 dfr; { const float dq = dir ? dsk : 0.f;
          u32x2 t; t.x = pk2((4 * g + 0 == n) ? dq : 0.f, (4 * g + 1 == n) ? dq : 0.f); t.y = pk2((4 * g + 2 == n) ? dq : 0.f, (4 * g + 3 == n) ? dq : 0.f); dfr = __builtin_bit_cast(s16x4, t); }
        u32x2 un[2]; rs_t rn[2];
        const long rstep = dir ? -16 : 16;
        const size_t rowu0 = (size_t)seq * SEQ + (dir ? SEQ - 1 - sn : sn), rowy0 = (size_t)seq * SEQ + (dir ? SEQ - 1 - tg4 : tg4);
        const long estep = dir ? -1 : 1;
        const bf16_t* pu0 = X + rowu0 * D + gr * 16 + 4 * g; const rs_t* pr0 = rs + rowu0;
        float* py0 = YF + ((size_t)task * SEQ + (dir ? SEQ - 1 - tg4 : tg4)) * 16 + n;
        bf16_t* pY0 = Y + rowy0 * D + gr * 16 + n;
#define S5_PREF(q_, blk_) do { const long b_ = (long)(blk_) * rstep; un[q_] = *(const u32x2*)(pu0 + b_ * D); rn[q_] = pr0[b_]; \
            } while (0)
#pragma unroll
        for (int q = 0; q < 2; ++q) S5_PREF(q, b0 + q);
        float yfn[4];
#pragma unroll
        for (int e = 0; e < 4; ++e) yfn[e] = dir ? py0[((long)b0 * rstep + e * estep) * 16] : 0.f;
        for (int blk4_ = b0; blk4_ < b1; blk4_ += 2) {
          int blk4 = blk4_; asm volatile("" : "+s"(blk4));
#pragma unroll
          for (int q = 0; q < 2; ++q) {
            const int blk = blk4 + q;
            const u32x2 ur = un[q]; const float rsd = rstd_of(rn[q]); const f32x4 uc = (f32x4){blo(ur.x), bhi(ur.x), blo(ur.y), bhi(ur.y)};
            float yfc[4];
#pragma unroll
            for (int e = 0; e < 4; ++e) yfc[e] = yfn[e];
            { const int bn = (blk + 1 < SEQ / 16) ? blk + 1 : blk;
#pragma unroll
              for (int e = 0; e < 4; ++e) if (dir) yfn[e] = py0[((long)bn * rstep + e * estep) * 16]; }
            { const int bp = (blk + 2 < SEQ / 16) ? blk + 2 : SEQ / 16 - 1; S5_PREF(q, bp); }
            u32x2 uf; uf.x = pk2(uc[0] * gm4[0] * rsd, uc[1] * gm4[1] * rsd); uf.y = pk2(uc[2] * gm4[2] * rsd, uc[3] * gm4[3] * rsd);
            const s16x4 ua = __builtin_bit_cast(s16x4, uf);
            f32x4 bu[8];
#pragma unroll
            for (int qq = 0; qq < 8; ++qq) bu[qq] = __builtin_amdgcn_mfma_f32_16x16x16bf16_1k(ua, bfr[qq], (f32x4){0.f, 0.f, 0.f, 0.f}, 0, 0, 0);
            f32x2 L2[4], c2[4];
#pragma unroll
            for (int pb = 0; pb < 4; ++pb) {
                const f32x2 a1 = (f32x2){a1r[pb], a1i[pb]}; f32x2 l = (f32x2){bu[pb][0], bu[4 + pb][0]};
#pragma unroll
                for (int e = 1; e < 4; ++e) l = cfma(a1, l, (f32x2){bu[pb][e], bu[4 + pb][e]});
                L2[pb] = l; }
#define S5_SW16(x_, y_) __builtin_amdgcn_permlane16_swap(__float_as_uint(x_), __float_as_uint(y_), false, false)
#define S5_SW32(x_, y_) __builtin_amdgcn_permlane32_swap(__float_as_uint(x_), __float_as_uint(y_), false, false)
            {
                f32x2 kk[4], ss[4], k3s[4];
#pragma unroll
                for (int pb = 0; pb < 4; ++pb) { const auto qr = S5_SW32(xpr[pb], xpr[pb]), qi = S5_SW32(xpi[pb], xpi[pb]);
                    kk[pb] = (f32x2){__uint_as_float(qr[1]), __uint_as_float(qi[1])}; }
#pragma unroll
                for (int pb = 0; pb < 4; ++pb) ss[pb] = cfma((f32x2){a4r[pb], a4i[pb]}, kk[pb], L2[pb]);
#pragma unroll
                for (int pb = 0; pb < 4; ++pb) { const auto qr = S5_SW16(ss[pb].x, kk[pb].x), qi = S5_SW16(ss[pb].y, kk[pb].y);
                    kk[pb] = (f32x2){__uint_as_float(qr[1]), __uint_as_float(qi[1])}; }
#pragma unroll
                for (int pb = 0; pb < 4; ++pb) ss[pb] = cfma((f32x2){a4r[pb], a4i[pb]}, kk[pb], L2[pb]);
#pragma unroll
                for (int pb = 0; pb < 4; ++pb) { const auto qr = S5_SW32(kk[pb].x, ss[pb].x), qi = S5_SW32(kk[pb].y, ss[pb].y);
                    kk[pb] = (f32x2){__uint_as_float(qr[0]), __uint_as_float(qi[0])}; k3s[pb] = kk[pb]; }
#pragma unroll
                for (int pb = 0; pb < 4; ++pb) ss[pb] = cfma((f32x2){a4r[pb], a4i[pb]}, kk[pb], L2[pb]);
#pragma unroll
                for (int pb = 0; pb < 4; ++pb) { const auto qr = S5_SW16(kk[pb].x, ss[pb].x), qi = S5_SW16(kk[pb].y, ss[pb].y);
                    kk[pb] = (f32x2){__uint_as_float(qr[0]), __uint_as_float(qi[0])}; }
#pragma unroll
                for (int pb = 0; pb < 4; ++pb) { const f32x2 s4 = cfma((f32x2){a4r[pb], a4i[pb]}, kk[pb], L2[pb]); xpr[pb] = s4.x; xpi[pb] = s4.y;
                    c2[pb] = (g == 1) ? k3s[pb] : kk[pb]; }
            }
#undef S5_SW16
#undef S5_SW32
#pragma unroll
            for (int pb = 0; pb < 4; ++pb) {
                const f32x2 a1 = (f32x2){a1r[pb], a1i[pb]}; f32x2 z = c2[pb]; float xr[4], xi[4];
#pragma unroll
                for (int e = 0; e < 4; ++e) { z = cfma(a1, z, (f32x2){bu[pb][e], bu[4 + pb][e]}); xr[e] = z.x; xi[e] = z.y; }
                u32x2 wr_; wr_.x = pk2(xr[0], xr[1]); wr_.y = pk2(xr[2], xr[3]); *(LAS u32x2*)(xl + (16 * pb + n) * XPITCH + 8 * g) = wr_;
                u32x2 wi_; wi_.x = pk2(xi[0], xi[1]); wi_.y = pk2(xi[2], xi[3]); *(LAS u32x2*)(xl + (64 + 16 * pb + n) * XPITCH + 8 * g) = wi_; }
            s16x8 cf[4];
#pragma unroll
            for (int ks = 0; ks < 4; ++ks) cf[ks] = *(const LAS s16x8*)(xl + CF_OFF + (ks * 64 + lane) * 16);
            u32x2 xt[8];
            { const unsigned ad = xbase + (unsigned)((8 * g + (n >> 2)) * XPITCH + 8 * (n & 3));
              asm volatile("s_waitcnt lgkmcnt(0)\n\tds_read_b64_tr_b16 %0, %8\n\tds_read_b64_tr_b16 %1, %8 offset:160\n\tds_read_b64_tr_b16 %2, %8 offset:1280\n\tds_read_b64_tr_b16 %3, %8 offset:1440\n\t"
                           "ds_read_b64_tr_b16 %4, %8 offset:2560\n\tds_read_b64_tr_b16 %5, %8 offset:2720\n\tds_read_b64_tr_b16 %6, %8 offset:3840\n\tds_read_b64_tr_b16 %7, %8 offset:4000\n\t"
                           "s_waitcnt lgkmcnt(0)"
                           : "=&v"(xt[0]), "=&v"(xt[1]), "=&v"(xt[2]), "=&v"(xt[3]), "=&v"(xt[4]), "=&v"(xt[5]), "=&v"(xt[6]), "=&v"(xt[7]) : "v"(ad) : "memory"); }
            f32x4 y = (f32x4){0.f, 0.f, 0.f, 0.f};
            if (dir) y = __builtin_amdgcn_mfma_f32_16x16x16bf16_1k(ua, dfr, y, 0, 0, 0);
#pragma unroll
            for (int ks = 0; ks < 4; ++ks) { u32x4 t; t.x = xt[2 * ks].x; t.y = xt[2 * ks].y; t.z = xt[2 * ks + 1].x; t.w = xt[2 * ks + 1].y;
                y = __builtin_amdgcn_mfma_f32_16x16x32_bf16(__builtin_bit_cast(s16x8, t), cf[ks], y, 0, 0, 0); }
#pragma unroll
            for (int e = 0; e < 4; ++e) y[e] = dir ? geluf_(y[e] + yfc[e]) : y[e];
            if (dir == 0) {
#pragma unroll
                for (int e = 0; e < 4; ++e) py0[((long)blk * rstep + e * estep) * 16] = y[e]; }
            else {
#pragma unroll
                for (int e = 0; e < 4; ++e) pY0[((long)blk * rstep + e * estep) * D] = f2bf(y[e]); }
          }
        }
#undef S5_PREF
        if (quarter) {
            asm volatile("s_waitcnt vmcnt(0)" ::: "memory");
            if (st_out) {
#pragma unroll
                for (int pb = 0; pb < 4; ++pb) { hand[lane * 8 + pb] = xpr[pb]; hand[lane * 8 + 4 + pb] = xpi[pb]; } }
            asm volatile("s_waitcnt lgkmcnt(0)" ::: "memory");
            if (k < 3 && lane == 0) flags[k] = 1;
            __builtin_amdgcn_s_setprio(0);
        }
}

__device__ __forceinline__ void scan(ArgsCP a, LAS unsigned char* lds, const bf16_t* X, const rs_t* rs, float* YF, bf16_t* Y) {
    const int tid = tidx(), w = __builtin_amdgcn_readfirstlane(tid >> 6), lane = tid & 63, g = lane >> 4, n = lane & 15;
    LAS unsigned char* xl = lds + w * WAVE_LDS;
    const unsigned xbase = (unsigned)(size_t)xl;
    const float* gmix = a->in[4] + 3 * D;
    const int G = (int)gridDim.x; const bool split = (G == 256);
    const int tpw = (NSEQ * 128 + G - 1) / G;
    LAS float* hand = (LAS float*)(lds + 8 * WAVE_LDS);
    volatile LAS int* flags = (volatile LAS int*)(lds + 8 * WAVE_LDS + 2048);
    if (tid < 4) flags[tid] = 0;
    __syncthreads();
    const int ntw = split ? 1 : ((tpw - w + 7) >> 3);
    const int np = split ? (w < 4 ? 2 : 1) : 2 * ntw;
    for (int pi = 0; pi < np; ++pi) {
        const int k = w - 4;
        const bool quarter = split && w >= 4;
        const int task = split ? (int)blockIdx.x * 5 + (w < 4 ? w : 4) : (int)blockIdx.x * tpw + w + 8 * (pi >> 1);
        if (task >= NSEQ * 128 || (!split && task >= ((int)blockIdx.x + 1) * tpw)) break;
        const int dir = quarter ? (k >> 1) : (pi & 1);
        const int b0 = quarter ? (k & 1) * 128 : 0, b1 = quarter ? b0 + 128 : SEQ / 16;
        const bool st_in = quarter && (k & 1), st_out = quarter && !(k & 1);
        if (quarter) { if (k > 0) { while (flags[k - 1] == 0) __builtin_amdgcn_s_sleep(8); } __builtin_amdgcn_s_setprio(3); }
        if (dir) pass<1>(a, xl, xbase, lane, g, n, task, quarter, k, b0, b1, st_in, st_out, gmix, X, rs, YF, Y, hand, flags);
        else pass<0>(a, xl, xbase, lane, g, n, task, quarter, k, b0, b1, st_in, st_out, gmix, X, rs, YF, Y, hand, flags);
    }
}
}

namespace sgu {
typedef short s16x8 __attribute__((ext_vector_type(8)));
constexpr int VPITCH = 288, TILE = 128 * VPITCH;
__device__ __forceinline__ s16x8 mk8(unsigned a, unsigned b, unsigned c, unsigned d) { u32x4 v; v.x = a; v.y = b; v.z = c; v.w = d; return __builtin_bit_cast(s16x8, v); }

__device__ __forceinline__ void mix(ArgsCP a, LAS unsigned char* lds, const bf16_t* UV, const rs_t* rsv, bf16_t* MX) {
    const int tid = tidx(), w = __builtin_amdgcn_readfirstlane(tid >> 6), lane = tid & 63, g4 = lane >> 4, n = lane & 15, G = gridDim.x;
    const float* w_s = a->in[13]; const float* b_s = a->in[14]; const float* sgn = a->in[12];
    const int per = (5120 + G - 1) / G, u0 = blockIdx.x * per, u1 = min(5120, u0 + per);
    if (u0 >= u1) return;
    int gcur = -1; s16x8 wf[4]; float bias = 0.f; f32x4 gnall[8];
    u32x4 pv[4]; rs_t prs = 0;
#define SGU_LOADG(u_) do { const int g_ = (u_) / 320, sc_ = (u_) - g_ * 320; const size_t row_ = (size_t)(sc_ >> 5) * SEQ + (sc_ & 31) * 128 + (tid >> 2); \
        const bf16_t* p_ = UV + row_ * 4096 + 2048 + g_ * 128 + (tid & 3) * 32; _Pragma("unroll") for (int q_ = 0; q_ < 4; ++q_) pv[q_] = *(const u32x4*)(p_ + 8 * q_); prs = rsv[row_]; } while (0)
#define SGU_STORE(buf_) do { const float r_ = rstd_of(prs); LAS unsigned char* d_ = lds + (buf_) * TILE + (tid >> 2) * VPITCH + (tid & 3) * 64; \
        _Pragma("unroll") for (int q_ = 0; q_ < 4; ++q_) { float v_[8]; unpack8(pv[q_], v_); _Pragma("unroll") for (int j_ = 0; j_ < 8; ++j_) v_[j_] *= r_; *(LAS u32x4*)(d_ + 16 * q_) = pack8(v_); } } while (0)
    SGU_LOADG(u0);
    SGU_STORE(0);
    __syncthreads();
    for (int u = u0; u < u1; ++u) {
        const int buf = (u - u0) & 1;
        const int g = u / 320, sc = u - g * 320, seq = sc >> 5, nch = sc & 31; const size_t row0 = (size_t)seq * SEQ + nch * 128;
        if (u + 1 < u1) SGU_LOADG(u + 1);
        if (g != gcur) { gcur = g;
            const float* wp = w_s + ((size_t)g * 128 + 16 * w + n) * 128 + 8 * g4;
#pragma unroll
            for (int ks = 0; ks < 4; ++ks) { const f32x4 a0 = *(const f32x4*)(wp + 32 * ks), a1 = *(const f32x4*)(wp + 32 * ks + 4);
                wf[ks] = mk8(pk2(a0[0], a0[1]), pk2(a0[2], a0[3]), pk2(a1[0], a1[1]), pk2(a1[2], a1[3])); }
            bias = b_s[g * 128 + 16 * w + n];
#pragma unroll
            for (int cb = 0; cb < 8; ++cb) gnall[cb] = *(const f32x4*)(sgn + g * 128 + 16 * cb + 4 * g4); }
        const unsigned vb = (unsigned)(size_t)(lds + buf * TILE);
        const size_t row = row0 + 16 * w + n;
        u32x2 uall[8];
#pragma unroll
        for (int cb = 0; cb < 8; ++cb) uall[cb] = *(const u32x2*)(UV + row * 4096 + g * 128 + 16 * cb + 4 * g4);
#pragma unroll
        for (int cb = 0; cb < 8; ++cb) {
            u32x2 vt[8];
            { const unsigned ad = vb + (unsigned)((8 * g4 + (n >> 2)) * VPITCH + (16 * cb + 4 * (n & 3)) * 2);
              asm volatile("ds_read_b64_tr_b16 %0, %8\n\tds_read_b64_tr_b16 %1, %8 offset:1152\n\tds_read_b64_tr_b16 %2, %8 offset:9216\n\tds_read_b64_tr_b16 %3, %8 offset:10368\n\t"
                           "ds_read_b64_tr_b16 %4, %8 offset:18432\n\tds_read_b64_tr_b16 %5, %8 offset:19584\n\tds_read_b64_tr_b16 %6, %8 offset:27648\n\tds_read_b64_tr_b16 %7, %8 offset:28800\n\t"
                           "s_waitcnt lgkmcnt(0)"
                           : "=&v"(vt[0]), "=&v"(vt[1]), "=&v"(vt[2]), "=&v"(vt[3]), "=&v"(vt[4]), "=&v"(vt[5]), "=&v"(vt[6]), "=&v"(vt[7]) : "v"(ad) : "memory"); }
            f32x4 acc = (f32x4){0.f, 0.f, 0.f, 0.f};
#pragma unroll
            for (int ks = 0; ks < 4; ++ks) acc = __builtin_amdgcn_mfma_f32_16x16x32_bf16(mk8(vt[2 * ks].x, vt[2 * ks].y, vt[2 * ks + 1].x, vt[2 * ks + 1].y), wf[ks], acc, 0, 0, 0);
            const int c0 = g * 128 + 16 * cb + 4 * g4;
            const f32x4 gn = gnall[cb];
            const u32x2 uu = uall[cb];
            u32x2 o; o.x = pk2((acc[0] * gn[0] + bias) * blo(uu.x), (acc[1] * gn[1] + bias) * bhi(uu.x)); o.y = pk2((acc[2] * gn[2] + bias) * blo(uu.y), (acc[3] * gn[3] + bias) * bhi(uu.y));
            *(u32x2*)(MX + row * D + c0) = o;
        }
        if (u + 1 < u1) SGU_STORE(buf ^ 1);
        __syncthreads();
    }
#undef SGU_LOADG
#undef SGU_STORE
}
}
#ifndef MK_STAG
#define MK_STAG 90
#endif
#ifndef MK_SINGLE
#define MK_SINGLE 1
#endif
constexpr int NPH = 40;

__global__ void __launch_bounds__(NTHR, 2) mk_fwd(Args a_unused) {
    extern __shared__ __attribute__((aligned(16))) unsigned char lds_raw[];
    LAS unsigned char* lds = (LAS unsigned char*)lds_raw;
    int ph_lo, ph_hi;
    XcdBarrier bar;
    { ArgsCP a0 = argp(); ph_lo = a0->ph_lo; ph_hi = a0->ph_hi;
      bar.bar = (unsigned*)(a0->ws + WS_CTL); bar.x = 0; bar.st = (volatile LAS unsigned*)(lds + LDS_BAR);
      if (ph_hi - ph_lo > 1) {
          if (threadIdx.x < 4) ((LAS unsigned*)(lds + LDS_BAR))[threadIdx.x] = 0u;
          __syncthreads();
          bar = xcd_barrier_post((unsigned*)(a0->ws + WS_CTL), (volatile LAS unsigned*)(lds + LDS_BAR));
      } }
    int ph = 0;
#define PH_BEGIN if (ph >= ph_lo && ph < ph_hi) { ArgsCP a = argp(); unsigned char* ws = a->ws; float* X = a->out; rs_t* RS = (rs_t*)(ws + WS_RS); \
        bf16_t* XB0 = (bf16_t*)(ws + WS_XB0); bf16_t* XB1 = (bf16_t*)(ws + WS_XB1); unsigned char* BIG = ws + WS_BIG; (void)X; (void)RS; (void)XB0; (void)XB1; (void)BIG;
#define PH_END   } if (ph >= ph_lo && ph + 1 < ph_hi) xcd_barrier(bar); ++ph;
#define RSB(k) (RS + (size_t)(k) * T)

    PH_BEGIN prologue(a, lds); PH_END

#define FFN_PLE(L, XBc, XBo) \
    PH_BEGIN { EpiFfn E{(bf16_t*)(BIG + BIG_HID2), (bf16_t*)(BIG + BIG_EDGE), RSB(3 * (L) + 1), a->in[32] + (size_t)(L) * 3 * DFF, a->in[33] + (size_t)(L) * DFF}; \
               run_gemm(lds, XBc, (const bf16_t*)(ws + WS_WGU + (L) * SZ_WGU), T, 2 * DFF, D, E); } \
        \
      if (gridDim.x == 256 && blockIdx.x >= 128) { ArgsCP a = argp(); unsigned char* ws = a->ws; bf16_t* XB0 = (bf16_t*)(ws + WS_XB0); bf16_t* XB1 = (bf16_t*)(ws + WS_XB1); (void)XB0; (void)XB1; \
          EpiScale Ep{XBo, D, nullptr, nullptr, -1}; \
          run_gemm_linear(lds, (const bf16_t*)(ws + WS_PB) + (size_t)(L) * T * PLED, (const bf16_t*)(ws + WS_WPP + (L) * SZ_WPP), T, D, PLED, Ep, ((int)blockIdx.x - 128) * 7, 7, 1); } \
    PH_END \
    PH_BEGIN { ffn_fixup(a, (L), (const bf16_t*)(BIG + BIG_EDGE), (bf16_t*)(BIG + BIG_HID2)); \
               EpiScale E{XBo, D, nullptr, nullptr, -1}; const int done_ = (gridDim.x == 256) ? 896 : 0, left_ = 1280 - done_ - (int)blockIdx.x; \
               run_gemm_linear(lds, (const bf16_t*)(ws + WS_PB) + (size_t)(L) * T * PLED, (const bf16_t*)(ws + WS_WPP + (L) * SZ_WPP), T, D, PLED, E, done_ + (int)blockIdx.x, left_ > 0 ? (left_ + (int)gridDim.x - 1) / (int)gridDim.x : 0, (int)gridDim.x); } PH_END \
    PH_BEGIN { EpiResid E{XBc, XBc, RSB(3 * (L) + 2)}; \
               run_gemm(lds, (const bf16_t*)(BIG + BIG_HID2), (const bf16_t*)(ws + WS_WDN + (L) * SZ_WDN), T, D, DFF, E); } PH_END \
    PH_BEGIN { EpiPle E{XBc, XBo, RSB(3 * (L) + 3), RSB(3 * (L) + 2)}; \
               run_gemm(lds, XBc, (const bf16_t*)(ws + WS_WPG + (L) * SZ_WPG), T, D, D, E); } PH_END

    PH_BEGIN { EpiScale E{(bf16_t*)BIG, 6144, RSB(0), nullptr, -1}; run_gemm(lds, XB0, (const bf16_t*)(ws + WS_NAQ), T, 6144, D, E); } PH_END
    PH_BEGIN na::attention(a, lds, (const bf16_t*)BIG, XB1); PH_END
    PH_BEGIN { EpiResid E{XB0, XB0, RSB(1)}; run_gemm(lds, XB1, (const bf16_t*)(ws + WS_NAO), T, D, D, E); } PH_END
    FFN_PLE(0, XB0, XB1)
    PH_BEGIN { EpiGelu E{(bf16_t*)BIG, 4096, RSB(3), RSB(13), 8}; run_gemm(lds, XB1, (const bf16_t*)(ws + WS_SGI), T, 4096, D, E); } PH_END
    PH_BEGIN sgu::mix(a, lds, (const bf16_t*)BIG, RSB(13), XB0); PH_END
    PH_BEGIN { EpiResid E{XB1, XB1, RSB(4)}; run_gemm(lds, XB0, (const bf16_t*)(ws + WS_SGO), T, D, D, E); } PH_END
    FFN_PLE(1, XB1, XB0)
#define GDN0_PTRS bf16_t* PROJ = (bf16_t*)(BIG + G0_PROJ); bf16_t* OF = PROJ; bf16_t* OB = (bf16_t*)(BIG + G0_OB); bf16_t* VP = (bf16_t*)(BIG + G0_VP); \
        float* AB = (float*)(BIG + G0_AB); float* GB = (float*)(BIG + G0_GB); bf16_t* QK = XB1; (void)PROJ; (void)OF; (void)OB; (void)VP; (void)AB; (void)GB; (void)QK;
#define GDN1_PTRS bf16_t* PROJ = (bf16_t*)(BIG + G1_PROJ); bf16_t* OF = PROJ; bf16_t* OB = (bf16_t*)(BIG + G1_OB); bf16_t* VP = (bf16_t*)(BIG + G1_VP); \
        float* AB = (float*)(BIG + G1_AB); float* GB = (float*)(BIG + G1_GB); bf16_t* QK = XB1; (void)PROJ; (void)OF; (void)OB; (void)VP; (void)AB; (void)GB; (void)QK;
    PH_BEGIN { GDN0_PTRS EpiScale E{PROJ, 8192, RSB(6), AB, 32}; run_gemm(lds, XB0, (const bf16_t*)(ws + WS_GDI), G0_ROWS, GDI_N1, D, E); } PH_END
    PH_BEGIN { GDN0_PTRS gdn_conv(a, PROJ, AB, QK, VP, GB, G0_ROWS); } PH_END
    PH_BEGIN { const int Gh = (int)gridDim.x / 2, Gv = (int)gridDim.x - Gh;
               const int RB = (Gv == Gh) ? 14 : 1000;
               if ((int)blockIdx.x < Gh) { { GDN0_PTRS gdn::scan(lds, QK, VP, GB, OF, OB, G0_ROWS / SEQ, (int)blockIdx.x, Gh); }
                      __syncthreads();
                      { GDN1_PTRS const size_t r0 = G0_ROWS; EpiScale E{PROJ, 8192, RSB(6) + r0, AB, 32};
                        run_gemm_sub_range(lds, XB0 + r0 * D, (const bf16_t*)(ws + WS_GDI), GG_ROWS, GDI_N1, D, E, Gv, (int)blockIdx.x, RB, 100000); } }
               else { GDN1_PTRS const size_t r0 = G0_ROWS; EpiScale E{PROJ, 8192, RSB(6) + r0, AB, 32};
                      run_gemm_sub_range(lds, XB0 + r0 * D, (const bf16_t*)(ws + WS_GDI), GG_ROWS, GDI_N1, D, E, Gv, (int)blockIdx.x - Gh, 0, RB); } } PH_END
    PH_BEGIN { GDN0_PTRS EpiGdnZ E{OF, OB, 4096, RSB(6), a->in[20], (LAS float*)(lds + XCH_OFF)}; run_gemm(lds, XB0, (const bf16_t*)(ws + WS_GDI) + (size_t)GDI_N1 * D, G0_ROWS, 4096, D, E); } PH_END
    PH_BEGIN { GDN0_PTRS EpiResid E{XB0, XB0, RSB(7)}; run_gemm(lds, OF, (const bf16_t*)(ws + WS_GDO), G0_ROWS, D, 4096, E); } PH_END
#pragma unroll 1
    for (int gg = 0; gg < 2; ++gg) {
        const size_t r0 = (size_t)G0_ROWS + (size_t)gg * GG_ROWS;
        if (gg == 1) { PH_BEGIN { GDN1_PTRS EpiScale E{PROJ, 8192, RSB(6) + r0, AB, 32}; run_gemm(lds, XB0 + r0 * D, (const bf16_t*)(ws + WS_GDI), GG_ROWS, GDI_N1, D, E); } PH_END }
        PH_BEGIN { GDN1_PTRS gdn_conv(a, PROJ, AB, QK, VP, GB, GG_ROWS); } PH_END
        PH_BEGIN { GDN1_PTRS gdn::scan(lds, QK, VP, GB, OF, OB, GG_ROWS / SEQ, (int)blockIdx.x, (int)gridDim.x); } PH_END
        PH_BEGIN { GDN1_PTRS EpiGdnZ E{OF, OB, 4096, RSB(6) + r0, a->in[20], (LAS float*)(lds + XCH_OFF)}; run_gemm(lds, XB0 + r0 * D, (const bf16_t*)(ws + WS_GDI) + (size_t)GDI_N1 * D, GG_ROWS, 4096, D, E); } PH_END
        PH_BEGIN { GDN1_PTRS EpiResid E{XB0 + r0 * D, XB0 + r0 * D, RSB(7) + r0}; run_gemm(lds, OF, (const bf16_t*)(ws + WS_GDO), GG_ROWS, D, 4096, E); } PH_END
    }
    FFN_PLE(2, XB0, XB1)
    PH_BEGIN s5::scan(a, lds, XB1, RSB(9), (float*)BIG, XB0); PH_END
    PH_BEGIN { EpiGlu E{XB1, RSB(10)}; run_gemm(lds, XB0, (const bf16_t*)(ws + WS_S5G), T, 4096, D, E); } PH_END
    FFN_PLE(3, XB1, XB0)
    PH_BEGIN final_norm(a, RSB(12), XB0); PH_END
}
}

extern "C" void kernel_launch(void* const* d_in, const int* in_sizes, int n_in, void* d_out, int out_size, void* d_ws, size_t ws_size, hipStream_t stream) {
    using namespace mk;
    static int grid = 0;
    if (grid == 0) {
        if (n_in != 37 || out_size != T * D || ws_size < WS_END) { fprintf(stderr, "kernel_launch: unexpected problem (n_in %d, out %d, ws %zu < %zu)\n", n_in, out_size, ws_size, (size_t)WS_END); grid = -1; return; }
        int dev = 0, cus = 0;
        if (hipGetDevice(&dev) != hipSuccess || hipDeviceGetAttribute(&cus, hipDeviceAttributeMultiprocessorCount, dev) != hipSuccess) { grid = -1; return; }
        if (hipFuncSetAttribute((const void*)mk_fwd, hipFuncAttributeMaxDynamicSharedMemorySize, LDS_BYTES) != hipSuccess) { fprintf(stderr, "kernel_launch: hipFuncSetAttribute failed\n"); grid = -1; return; }
        int per_cu = 0;
        if (hipOccupancyMaxActiveBlocksPerMultiprocessor(&per_cu, (const void*)mk_fwd, NTHR, LDS_BYTES) != hipSuccess || per_cu < 1) fprintf(stderr, "kernel_launch: occupancy query says %d\n", per_cu);
        (void)hipGetLastError();
        grid = cus > 0 ? cus : 256;
    }
    if (grid < 0) return;
    (void)hipMemsetAsync(d_ws, 0, ZERO_BYTES, stream);
    Args a{};
    for (int i = 0; i < 37; ++i) a.in[i] = (const float*)d_in[i];
    a.out = (float*)d_out; a.ws = (unsigned char*)d_ws;
#if MK_SINGLE
    a.ph_lo = 0; a.ph_hi = NPH;
    hipLaunchKernelGGL(mk_fwd, dim3(grid), dim3(NTHR), LDS_BYTES, stream, a);
#else
    for (int p = 0; p < NPH; ++p) { a.ph_lo = p; a.ph_hi = p + 1; hipLaunchKernelGGL(mk_fwd, dim3(grid), dim3(NTHR), LDS_BYTES, stream, a); }
#endif
}
```
